# Optimizing an MI355X kernel written in HIP

```python
import math, functools
import jax, jax.numpy as jnp
from jax import lax
import numpy as np

D_MODEL = 1024
BATCH = 32
SEQ = 256
DEPTH = 2
DEC_BATCH = 2
DEC_SEQ = 2048
PAST_LEN = 256

GRID_W = 64
HEAD_DIM = 64
NA_HEADS = 4
NA_WIN_R = 8
NA_WIN_C = 16
MLA_HEADS = 4
MLA_NOPE = 64
MLA_ROPE = 32
MLA_V = 64
MLA_Q_RANK = 192
MLA_KV_RANK = 128
SWA_HEADS = 4
SWA_KV_HEADS = 2
SWA_WINDOW = 128
SWA_BLOCK = 128
POOL_WINDOWS = (2, 4, 8, 16)
POOL_GROUP = 64
N_POOL = len(POOL_WINDOWS)
POOL_WIDTH = N_POOL * POOL_GROUP
BRANCH_W = 256
N_BRANCH = 4
D_FF = 2752
CONV_W = 3
Q_BLOCK = 128
ROPE_BASE = 10000.0
EPS = 1e-6
NEG_INF = -1e30
ATT_SCALE = HEAD_DIM ** -0.5
MLA_SCALE = (MLA_NOPE + MLA_ROPE) ** -0.5

IN_A = 3 * NA_HEADS * HEAD_DIM
IN_B = MLA_Q_RANK + MLA_KV_RANK + MLA_ROPE
IN_C = (SWA_HEADS + 2 * SWA_KV_HEADS) * HEAD_DIM
IN_D = POOL_WIDTH
IN_DIM = IN_A + IN_B + IN_C + IN_D

kernel_name = 'hybrid_diffusion_prefix_trunk_step'


def rmsnorm(x, g):
    xf = x.astype(jnp.float32)
    y = xf * lax.rsqrt(jnp.mean(xf * xf, -1, keepdims=True) + EPS)
    return (y * g.astype(jnp.float32)).astype(x.dtype)


def _heads(t, n):
    return t.reshape(*t.shape[:-1], n, t.shape[-1] // n)


def _rope_1d(x, pos):
    half = x.shape[-1] // 2
    inv = ROPE_BASE ** (-jnp.arange(half, dtype=jnp.float32) / half)
    ang = pos.astype(jnp.float32)[:, None] * inv[None, :]
    cos = jnp.cos(ang)[:, None, :]
    sin = jnp.sin(ang)[:, None, :]
    xf = x.astype(jnp.float32)
    x1, x2 = xf[..., :half], xf[..., half:]
    return jnp.concatenate([x1 * cos - x2 * sin, x1 * sin + x2 * cos], -1).astype(x.dtype)


def rope_2d(x):
    t = jnp.arange(x.shape[1])
    h = x.shape[-1] // 2
    return jnp.concatenate([_rope_1d(x[..., :h], t // GRID_W), _rope_1d(x[..., h:], t % GRID_W)], -1)


def sink_softmax(s, sink):
    m = jnp.maximum(jnp.max(s, -1, keepdims=True), sink)
    e = jnp.exp(s - m)
    return e / (jnp.sum(e, -1, keepdims=True) + jnp.exp(sink - m))


def sweep_queries(fn, *qs):
    blocks = tuple(jnp.moveaxis(t.reshape(t.shape[0], t.shape[1] // Q_BLOCK, Q_BLOCK, *t.shape[2:]), 1, 0)
                   for t in qs)
    out = jnp.moveaxis(lax.map(lambda bl: fn(*bl), blocks), 0, 1)
    return out.reshape(out.shape[0], out.shape[1] * out.shape[2], *out.shape[3:])


def softmax_attend(q, k, v):
    s = jnp.einsum('bqhd,bkhd->bhqk', q, k).astype(jnp.float32) * ATT_SCALE
    p = jax.nn.softmax(s, -1).astype(v.dtype)
    return jnp.einsum('bhqk,bkhd->bqhd', p, v)


def gqa_sink_attend(q, k, v, sink):
    B, Lq, H, d = q.shape
    kvh = k.shape[2]
    g = H // kvh
    qg = q.reshape(B, Lq, kvh, g, d)
    s = jnp.einsum('bqhgd,bkhd->bhgqk', qg, k).astype(jnp.float32) * ATT_SCALE
    p = sink_softmax(s, sink.reshape(1, kvh, g, 1, 1).astype(jnp.float32)).astype(v.dtype)
    return jnp.einsum('bhgqk,bkhd->bqhgd', p, v).reshape(B, Lq, H, d)


def mla_queries(c_q, q_norm, w_uq):
    q = _heads(rmsnorm(c_q, q_norm) @ w_uq, MLA_HEADS)
    return q[..., :MLA_NOPE], q[..., MLA_NOPE:]


def mla_keys_values(c_kv, kv_norm, w_ukv):
    kv = _heads(rmsnorm(c_kv, kv_norm) @ w_ukv, MLA_HEADS)
    return kv[..., :MLA_NOPE], kv[..., MLA_NOPE:]


def mla_attend(qn, qr, kn, kr, v):
    s = (jnp.einsum('bqhd,bkhd->bhqk', qn, kn) + jnp.einsum('bqhr,bkr->bhqk', qr, kr)).astype(jnp.float32) * MLA_SCALE
    p = jax.nn.softmax(s, -1).astype(v.dtype)
    return jnp.einsum('bhqk,bkhd->bqhd', p, v)


def na_latent(q, k, v, k_ctx, v_ctx, rpb):
    B, L, H, d = q.shape
    rows = L // GRID_W
    kr = min(NA_WIN_R, rows)
    qg = q.reshape(B, rows, GRID_W, H, d)
    kg = k.reshape(B, rows, GRID_W, H, d)
    vg = v.reshape(B, rows, GRID_W, H, d)
    r = jnp.arange(rows)
    r_idx = jnp.clip(r - kr // 2, 0, rows - kr)[:, None] + jnp.arange(kr)[None, :]
    cq = jnp.arange(GRID_W)
    c_start = jnp.clip(cq - NA_WIN_C // 2, 0, GRID_W - NA_WIN_C)
    col_ok = (cq[None, :] >= c_start[:, None]) & (cq[None, :] < c_start[:, None] + NA_WIN_C)
    k_rows = kg[:, r_idx]
    v_rows = vg[:, r_idx]
    s = jnp.einsum('brchd,brjwhd->bhrcjw', qg, k_rows).astype(jnp.float32) * ATT_SCALE
    dr = r_idx - r[:, None] + (NA_WIN_R - 1)
    dc = jnp.clip(cq[None, :] - cq[:, None] + (NA_WIN_C - 1), 0, 2 * NA_WIN_C - 2)
    bias = rpb[:, dr[:, None, :, None], dc[None, :, None, :]].astype(jnp.float32)
    s = jnp.where(col_ok[:, None, :], s + bias[None], NEG_INF)
    s = s.reshape(B, H, rows, GRID_W, kr * GRID_W)
    s_ctx = jnp.einsum('brchd,bkhd->bhrck', qg, k_ctx).astype(jnp.float32) * ATT_SCALE
    p = jax.nn.softmax(jnp.concatenate([s, s_ctx], -1), -1).astype(v.dtype)
    p_lat = p[..., :kr * GRID_W].reshape(B, H, rows, GRID_W, kr, GRID_W)
    y = (jnp.einsum('bhrcjw,brjwhd->brchd', p_lat, v_rows)
         + jnp.einsum('bhrck,bkhd->brchd', p[..., kr * GRID_W:], v_ctx))
    return y.reshape(B, L, H * d)


def swa_latent(q, k, v, k_ctx, v_ctx, sink):
    B, L, H, d = q.shape
    kvh = k.shape[2]
    g = H // kvh
    nb = L // SWA_BLOCK
    side = -(-SWA_WINDOW // SWA_BLOCK)
    span = (2 * side + 1) * SWA_BLOCK
    pad = side * SWA_BLOCK
    k_pad = jnp.pad(k, ((0, 0), (pad, pad), (0, 0), (0, 0)))
    v_pad = jnp.pad(v, ((0, 0), (pad, pad), (0, 0), (0, 0)))
    idx = jnp.arange(nb)[:, None] * SWA_BLOCK + jnp.arange(span)[None, :]
    kb = k_pad[:, idx]
    vb = v_pad[:, idx]
    qb = q.reshape(B, nb, SWA_BLOCK, kvh, g, d)
    s = jnp.einsum('bnqhgd,bnjhd->bhgnqj', qb, kb).astype(jnp.float32) * ATT_SCALE
    q_pos = jnp.arange(L).reshape(nb, SWA_BLOCK)
    k_pos = (idx - pad)[:, None, :]
    valid = (jnp.abs(q_pos[:, :, None] - k_pos) <= SWA_WINDOW) & (k_pos >= 0) & (k_pos < L)
    s = jnp.where(valid, s, NEG_INF)
    s_ctx = jnp.einsum('bnqhgd,bkhd->bhgnqk', qb, k_ctx).astype(jnp.float32) * ATT_SCALE
    p = sink_softmax(jnp.concatenate([s, s_ctx], -1),
                     sink.reshape(1, kvh, g, 1, 1, 1).astype(jnp.float32)).astype(v.dtype)
    y = (jnp.einsum('bhgnqj,bnjhd->bnqhgd', p[..., :span], vb)
         + jnp.einsum('bhgnqk,bkhd->bnqhgd', p[..., span:], v_ctx))
    return y.reshape(B, L, H * d)


def swa_split(pc):
    q, k, v = jnp.split(pc, [SWA_HEADS * HEAD_DIM, (SWA_HEADS + SWA_KV_HEADS) * HEAD_DIM], -1)
    return _heads(q, SWA_HEADS), _heads(k, SWA_KV_HEADS), _heads(v, SWA_KV_HEADS)


def pool_mixer(x, pool_w, pool_scale):
    B, L, _ = x.shape
    xf = x.astype(jnp.float32)
    cs = jnp.concatenate([jnp.zeros((B, 1, POOL_WIDTH), jnp.float32), jnp.cumsum(xf, axis=1)], 1)
    t = jnp.arange(L)
    diffs = []
    for gi, w in enumerate(POOL_WINDOWS):
        lo = jnp.clip(t - w // 2, 0, L)
        hi = jnp.clip(t - w // 2 + w, 0, L)
        sl = slice(gi * POOL_GROUP, (gi + 1) * POOL_GROUP)
        mean = (cs[:, hi, sl] - cs[:, lo, sl]) / (hi - lo).astype(jnp.float32)[:, None]
        diffs.append(mean - xf[:, :, sl])
    dlt = jnp.stack(diffs, 2).astype(x.dtype)
    y = jnp.einsum('blgc,gce->blge', dlt, pool_w).reshape(B, L, POOL_WIDTH)
    return y * pool_scale


def conv_ffn(h, w_up, conv_w, w_down):
    L = h.shape[1]
    u = h @ w_up
    pad = CONV_W // 2
    up = jnp.pad(u, ((0, 0), (pad, CONV_W - 1 - pad), (0, 0)))
    uc = up[:, 0:L] * conv_w[0]
    for j in range(1, CONV_W):
        uc = uc + up[:, j:j + L] * conv_w[j]
    a, gt = jnp.split(uc, 2, -1)
    return (jax.nn.silu(gt) * a) @ w_down


def context_mixers(pa, pb, pc, pd, lp):
    B, L, _ = pa.shape
    qa, ka, va = (_heads(t, NA_HEADS) for t in jnp.split(pa, 3, -1))
    ya = sweep_queries(lambda q: softmax_attend(q, ka, va), qa).reshape(B, L, BRANCH_W)
    c_q, c_kv, k_rope = jnp.split(pb, [MLA_Q_RANK, MLA_Q_RANK + MLA_KV_RANK], -1)
    qn, qr = mla_queries(c_q, lp['mla_q_norm'], lp['mla_w_uq'])
    kn, vb = mla_keys_values(c_kv, lp['mla_kv_norm'], lp['mla_w_ukv'])
    yb = sweep_queries(lambda a, b_: mla_attend(a, b_, kn, k_rope, vb), qn, qr).reshape(B, L, BRANCH_W)
    qc, kc, vc = swa_split(pc)
    yc = sweep_queries(lambda q: gqa_sink_attend(q, kc, vc, lp['swa_sink']), qc).reshape(B, L, BRANCH_W)
    yd = pool_mixer(pd, lp['pool_w'], lp['pool_scale'])
    return (ya, yb, yc, yd), (ka, va, c_kv, k_rope, kc, vc)


def latent_mixers(pa, pb, pc, pd, lp, cache):
    na_k, na_v, mla_ckv, mla_krope, swa_k, swa_v = cache
    B, L, _ = pa.shape
    qa, ka, va = (_heads(t, NA_HEADS) for t in jnp.split(pa, 3, -1))
    ya = na_latent(qa, ka, va, na_k, na_v, lp['na_rpb'])
    c_q, c_kv, k_rope = jnp.split(pb, [MLA_Q_RANK, MLA_Q_RANK + MLA_KV_RANK], -1)
    qn, qr = mla_queries(c_q, lp['mla_q_norm'], lp['mla_w_uq'])
    qr = rope_2d(qr)
    kn, vb = mla_keys_values(c_kv, lp['mla_kv_norm'], lp['mla_w_ukv'])
    kr = rope_2d(k_rope[:, :, None, :])[:, :, 0]
    kn_ctx, v_ctx = mla_keys_values(mla_ckv, lp['mla_kv_norm'], lp['mla_w_ukv'])
    kn_all = jnp.concatenate([kn_ctx, kn], 1)
    kr_all = jnp.concatenate([mla_krope, kr], 1)
    v_all = jnp.concatenate([v_ctx, vb], 1)
    yb = sweep_queries(lambda a, b_: mla_attend(a, b_, kn_all, kr_all, v_all), qn, qr).reshape(B, L, BRANCH_W)
    qc, kc, vc = swa_split(pc)
    yc = swa_latent(rope_2d(qc), rope_2d(kc), vc, swa_k, swa_v, lp['swa_sink'])
    yd = pool_mixer(pd, lp['pool_w'], lp['pool_scale'])
    return (ya, yb, yc, yd), ()


def sandwich_layer(x, cvec, mixers, lp):
    mod = jax.nn.silu(cvec) @ lp['w_mod'] + lp['b_mod']
    sh1, sc1, g1, sh2, sc2, g2 = jnp.split(mod, 6, -1)
    h = rmsnorm(x, lp['g_attn_pre']) * (1 + sc1) + sh1
    pa, pb, pc, pd = jnp.split(h @ lp['w_in'], [IN_A, IN_A + IN_B, IN_A + IN_B + IN_C], -1)
    branches, ctx_state = mixers(pa, pb, pc, pd)
    br = jnp.stack(branches, 2)
    gates = jax.nn.sigmoid(h @ lp['w_gate'] + lp['b_gate']).reshape(h.shape[0], h.shape[1], N_BRANCH, D_MODEL)
    merged = jnp.sum(gates * jnp.einsum('blkc,kcd->blkd', br, lp['w_branch']), 2)
    x = x + g1 * rmsnorm(merged @ lp['w_out'], lp['g_attn_post'])
    h = rmsnorm(x, lp['g_ffn_pre']) * (1 + sc2) + sh2
    x = x + g2 * rmsnorm(conv_ffn(h, lp['ffn_w_up'], lp['ffn_conv'], lp['ffn_w_down']), lp['g_ffn_post'])
    return x, ctx_state


def setup_inputs(seed: int = 0) -> dict:
    key = jax.random.key(seed)
    ks = jax.random.split(key, 34)
    f32 = jnp.float32

    def nrm(i, shape, scale=1.0):
        return jax.random.normal(ks[i], shape, f32) * scale

    D = D_MODEL
    return {
        'x_prompt': nrm(0, (BATCH, SEQ, D)),
        'x_sample': nrm(1, (DEC_BATCH, DEC_SEQ, D)),
        'cache_na_k': nrm(2, (DEC_BATCH, DEPTH, PAST_LEN, NA_HEADS, HEAD_DIM)),
        'cache_na_v': nrm(3, (DEC_BATCH, DEPTH, PAST_LEN, NA_HEADS, HEAD_DIM)),
        'cache_mla_ckv': nrm(4, (DEC_BATCH, DEPTH, PAST_LEN, MLA_KV_RANK)),
        'cache_mla_krope': nrm(5, (DEC_BATCH, DEPTH, PAST_LEN, MLA_ROPE)),
        'cache_swa_k': nrm(6, (DEC_BATCH, DEPTH, PAST_LEN, SWA_KV_HEADS, HEAD_DIM)),
        'cache_swa_v': nrm(7, (DEC_BATCH, DEPTH, PAST_LEN, SWA_KV_HEADS, HEAD_DIM)),
        'c': nrm(8, (DEC_BATCH, D)),
        'c_ctx': nrm(9, (D,)),
        'w_mod': nrm(10, (DEPTH, D, 6 * D), 0.3 * D ** -0.5),
        'b_mod': nrm(11, (DEPTH, 6 * D), 0.02),
        'g_attn_pre': 1.0 + nrm(12, (DEPTH, D), 0.05),
        'g_attn_post': 1.0 + nrm(13, (DEPTH, D), 0.05),
        'g_ffn_pre': 1.0 + nrm(14, (DEPTH, D), 0.05),
        'g_ffn_post': 1.0 + nrm(15, (DEPTH, D), 0.05),
        'w_in': nrm(16, (DEPTH, D, IN_DIM), D ** -0.5),
        'w_gate': nrm(17, (DEPTH, D, N_BRANCH * D), D ** -0.5),
        'b_gate': nrm(18, (DEPTH, N_BRANCH * D), 0.02),
        'na_rpb': nrm(19, (DEPTH, NA_HEADS, 2 * NA_WIN_R - 1, 2 * NA_WIN_C - 1), 0.1),
        'mla_q_norm': 1.0 + nrm(20, (DEPTH, MLA_Q_RANK), 0.05),
        'mla_w_uq': nrm(21, (DEPTH, MLA_Q_RANK, MLA_HEADS * (MLA_NOPE + MLA_ROPE)), MLA_Q_RANK ** -0.5),
        'mla_kv_norm': 1.0 + nrm(22, (DEPTH, MLA_KV_RANK), 0.05),
        'mla_w_ukv': nrm(23, (DEPTH, MLA_KV_RANK, MLA_HEADS * (MLA_NOPE + MLA_V)), MLA_KV_RANK ** -0.5),
        'swa_sink': nrm(24, (DEPTH, SWA_HEADS), 0.5),
        'pool_w': nrm(25, (DEPTH, N_POOL, POOL_GROUP, POOL_GROUP), POOL_GROUP ** -0.5),
        'pool_scale': 1.0 + nrm(26, (DEPTH, POOL_WIDTH), 0.1),
        'w_branch': nrm(27, (DEPTH, N_BRANCH, BRANCH_W, D), BRANCH_W ** -0.5),
        'w_out': nrm(28, (DEPTH, D, D), D ** -0.5),
        'ffn_w_up': nrm(29, (DEPTH, D, 2 * D_FF), D ** -0.5),
        'ffn_conv': nrm(30, (DEPTH, CONV_W, 2 * D_FF), CONV_W ** -0.5),
        'ffn_w_down': nrm(31, (DEPTH, D_FF, D), D_FF ** -0.5),
    }


def reference(x_prompt, x_sample, cache_na_k, cache_na_v, cache_mla_ckv, cache_mla_krope, cache_swa_k,
              cache_swa_v, c, c_ctx, w_mod, b_mod, g_attn_pre, g_attn_post, g_ffn_pre, g_ffn_post, w_in,
              w_gate, b_gate, na_rpb, mla_q_norm, mla_w_uq, mla_kv_norm, mla_w_ukv, swa_sink, pool_w,
              pool_scale, w_branch, w_out, ffn_w_up, ffn_conv, ffn_w_down):
    x_p, x_s = x_prompt, x_sample
    c_ctx_vec = c_ctx[None, None, :]
    c_lat = c[:, None, :]
    states = []
    for i in range(DEPTH):
        lp = dict(w_mod=w_mod[i], b_mod=b_mod[i], g_attn_pre=g_attn_pre[i], g_attn_post=g_attn_post[i],
                  g_ffn_pre=g_ffn_pre[i], g_ffn_post=g_ffn_post[i], w_in=w_in[i], w_gate=w_gate[i],
                  b_gate=b_gate[i], na_rpb=na_rpb[i], mla_q_norm=mla_q_norm[i], mla_w_uq=mla_w_uq[i],
                  mla_kv_norm=mla_kv_norm[i], mla_w_ukv=mla_w_ukv[i], swa_sink=swa_sink[i],
                  pool_w=pool_w[i], pool_scale=pool_scale[i], w_branch=w_branch[i], w_out=w_out[i],
                  ffn_w_up=ffn_w_up[i], ffn_conv=ffn_conv[i], ffn_w_down=ffn_w_down[i])
        x_p, st = sandwich_layer(x_p, c_ctx_vec, functools.partial(context_mixers, lp=lp), lp)
        states.append(st)
        cache = (cache_na_k[:, i], cache_na_v[:, i], cache_mla_ckv[:, i], cache_mla_krope[:, i],
                 cache_swa_k[:, i], cache_swa_v[:, i])
        x_s, _ = sandwich_layer(x_s, c_lat, functools.partial(latent_mixers, lp=lp, cache=cache), lp)
    new_na_k = jnp.stack([st[0] for st in states], 1)
    new_na_v = jnp.stack([st[1] for st in states], 1)
    new_mla_ckv = jnp.stack([st[2] for st in states], 1)
    new_mla_krope = jnp.stack([st[3] for st in states], 1)
    new_swa_k = jnp.stack([st[4] for st in states], 1)
    new_swa_v = jnp.stack([st[5] for st in states], 1)
    return (x_p, x_s, new_na_k, new_na_v, new_mla_ckv, new_mla_krope, new_swa_k, new_swa_v)
```

```cpp
#include <hip/hip_runtime.h>
#include <cstdio>
#include <cstdint>

#define LAS __attribute__((address_space(3)))
typedef unsigned short bf16_t;
typedef short bf16x8 __attribute__((ext_vector_type(8)));
typedef short s16x4 __attribute__((ext_vector_type(4)));
typedef float f32x4 __attribute__((ext_vector_type(4)));
typedef float f32x2 __attribute__((ext_vector_type(2)));
typedef unsigned u32x4 __attribute__((ext_vector_type(4)));
typedef unsigned u32x2 __attribute__((ext_vector_type(2)));
typedef __bf16 bf16x2_t __attribute__((ext_vector_type(2)));
#define LOG2E_ 1.4426950408889634f
typedef long lx2 __attribute__((ext_vector_type(2)));
typedef int i32x8 __attribute__((ext_vector_type(8)));
typedef int i32x4 __attribute__((ext_vector_type(4)));

constexpr int DM = 1024, NCTX = 8192, NLAT = 4096, NTOK = 12288;
constexpr int INP = 2048, IN_DIM = 1888, DFF = 2752, DFFP = 2816, NUP = 5632;
constexpr int LD8 = 1152;
constexpr int LDH = 1088, LDP = 1984, LDACT = 2880, LDQ = 448, LDKV = 576, LDW = 1088, LDWB = 320, LDWD = 2880, LDUQ = 192, LDUKV = 192, LDNAC = 320, LDSWC = 192, LDCKVC = 192, LDBK = 4160;
constexpr int COL_QA = 0, COL_KA = 256, COL_VA = 512, COL_CQ = 768, COL_CKV = 960, COL_KR = 1088, COL_QC = 1120, COL_KC = 1376, COL_VC = 1504, COL_PD = 1632;
constexpr float EPS = 1e-6f;
constexpr float LOG2E = 1.4426950408889634f;
constexpr size_t OFF_Y = 0, OFF_NAK = 12582912, OFF_NAV = 16777216, OFF_CKV = 20971520, OFF_KR = 23068672, OFF_SWK = 23592960, OFF_SWV = 25690112;

constexpr size_t MiB = 1u << 20;
constexpr size_t WS_CTL = 0, CTL_BYTES = 1 * MiB;
constexpr size_t WS_MODV = 1 * MiB;
constexpr size_t WS_NACK = 2 * MiB;
constexpr size_t WS_NACV = WS_NACK + 640 * 1024;
constexpr size_t WS_SWCK = WS_NACV + 640 * 1024;
constexpr size_t WS_SWCV = WS_SWCK + 384 * 1024;
constexpr size_t WS_CKVC = WS_SWCV + 384 * 1024;
constexpr size_t WS_KRC = WS_CKVC + 384 * 1024;
constexpr size_t WS_KVCUP = WS_KRC + 64 * 1024;
static_assert(WS_KVCUP + (size_t)2 * 512 * LDKV * 2 <= 6 * MiB, "cache region");
constexpr size_t WS_W = 6 * MiB, W_LAYER = 36 * MiB + 512 * 1024;
constexpr size_t WO_IN = 0, WO_GATE = 4 * MiB + 512 * 1024, WO_BR = 13 * MiB, WO_OUT = 15 * MiB + 512 * 1024, WO_UP = 18 * MiB, WO_DOWN = 30 * MiB, WO_UQ = 35 * MiB + 768 * 1024, WO_UKV = 36 * MiB;
static_assert((size_t)2048 * LDW * 2 <= WO_GATE && WO_GATE + (size_t)4096 * LDW * 2 <= WO_BR && WO_BR + (size_t)4096 * LDWB * 2 <= WO_OUT && WO_OUT + (size_t)1024 * LDW * 2 <= WO_UP && WO_UP + (size_t)NUP * LDW * 2 <= WO_DOWN && WO_DOWN + (size_t)1024 * LDWD * 2 <= WO_UQ && WO_UQ + (size_t)512 * LDUQ * 2 <= WO_UKV && WO_UKV + (size_t)512 * LDUKV * 2 <= W_LAYER, "weight map");
constexpr size_t WS_X1 = 79 * MiB;
constexpr size_t WS_H8 = WS_X1;
constexpr size_t WS_H = 127 * MiB;
constexpr size_t WS_P = 153 * MiB;
constexpr size_t WS_BK = 93 * MiB;
constexpr size_t WS_MERGED = WS_P;
constexpr size_t WS_BR = 200 * MiB;
constexpr size_t WS_O = WS_BR;
constexpr size_t WS_QUP = 226 * MiB;
constexpr size_t WS_KVUP = 237 * MiB;
constexpr size_t WS_ACT = WS_P;
constexpr size_t WS_END = 252 * MiB;
static_assert((size_t)NTOK * LD8 <= (size_t)NTOK * DM * 4 && (size_t)4096 * LD8 <= WO_BR - WO_GATE, "fp8 buffers");
static_assert(WS_W + 2 * W_LAYER <= WS_X1 && WS_X1 + (size_t)NTOK * DM * 4 <= WS_H && WS_H + (size_t)NTOK * LDH * 2 <= WS_P && WS_P + (size_t)NTOK * LDP * 2 <= WS_BR && WS_BR + (size_t)NTOK * LDH * 2 <= WS_QUP
              && WS_QUP + (size_t)NTOK * LDQ * 2 <= WS_KVUP && WS_KVUP + (size_t)NTOK * LDKV * 2 <= WS_END && WS_ACT + (size_t)NTOK * LDACT * 2 <= WS_QUP
              && WS_H8 + (size_t)NTOK * LD8 <= WS_BK && WS_BK + (size_t)NTOK * LDBK * 2 <= WS_BR && WS_MERGED + (size_t)NTOK * LDH * 2 <= WS_END, "workspace map");
constexpr int CW_BAR = 1024;
constexpr int CW_QUEUE = 8192;
constexpr int CW_SEAM = 16384;
constexpr int CW_XBUF = 65536;

constexpr int LDS_CTL = 147456, LDS_TAB = LDS_CTL + 64, LDS_BYTES = LDS_TAB + 4096;

struct Params { const float* in[32]; float* out; unsigned char* ws; };

__device__ __forceinline__ float bf2f(bf16_t b) { return __uint_as_float((unsigned)b << 16); }
__device__ __forceinline__ unsigned pk2(float lo, float hi) { f32x2 v = {lo, hi}; bf16x2_t b = __builtin_convertvector(v, bf16x2_t); return __builtin_bit_cast(unsigned, b); }
__device__ __forceinline__ float lo16(unsigned u) { return __uint_as_float(u << 16); }
__device__ __forceinline__ float hi16(unsigned u) { return __uint_as_float(u & 0xffff0000u); }
__device__ __forceinline__ float wave_sum(float v) {
#pragma unroll
    for (int o = 1; o < 64; o <<= 1) v += __shfl_xor(v, o);
    return v;
}
__device__ __forceinline__ float qmax4(float x) {
    const auto a = __builtin_amdgcn_permlane16_swap(__float_as_uint(x), __float_as_uint(x), false, false); x = fmaxf(__uint_as_float(a[0]), __uint_as_float(a[1]));
    const auto b = __builtin_amdgcn_permlane32_swap(__float_as_uint(x), __float_as_uint(x), false, false); return fmaxf(__uint_as_float(b[0]), __uint_as_float(b[1]));
}
__device__ __forceinline__ float sigmoidf_(float x) { return __builtin_amdgcn_rcpf(1.0f + __builtin_amdgcn_exp2f(x * -LOG2E_)); }
__device__ __forceinline__ float siluf_(float x) { return x * __builtin_amdgcn_rcpf(1.0f + __builtin_amdgcn_exp2f(x * -LOG2E_)); }
#define VM_WAIT_UNUSED_()
#define VM_WAIT() asm volatile("s_waitcnt vmcnt(0)" ::: "memory")

#define XB_TMO      128
#define XB_XCNT(j)  (256  + 64 * (j))
#define XB_XSUB(j)  (1280 + 64 * (j))
#define XB_XGEN(j)  (2304 + 64 * (j))
#define XB_TOP      3328
#define XB_TOPGEN   3392
#define XCD_BAR_WORDS 3456
#define XB_SPIN_CAP (1u << 22)
__device__ __forceinline__ unsigned xb_ld(unsigned* p)              { return __hip_atomic_load(p, __ATOMIC_RELAXED, __HIP_MEMORY_SCOPE_AGENT); }
__device__ __forceinline__ unsigned xb_add(unsigned* p, unsigned v) { return __hip_atomic_fetch_add(p, v, __ATOMIC_RELAXED, __HIP_MEMORY_SCOPE_AGENT); }
__device__ __forceinline__ unsigned xb_xcc_id() { return (unsigned)__builtin_amdgcn_s_getreg((3 << 11) | 20) & 0xFu; }
#define XB_SPIN(cond, bar) do { unsigned _sp = 0; while (cond) { __builtin_amdgcn_s_sleep(1); \
    if ((++_sp & 255u) == 0u) { if (xb_ld(&(bar)[XB_TMO])) break; if (_sp > XB_SPIN_CAP) { atomicAdd(&(bar)[XB_TMO], 1u); break; } } } } while (0)
struct XcdBarrier { unsigned* bar; unsigned x; volatile LAS unsigned* st; };
__device__ __forceinline__ XcdBarrier xcd_barrier_post(unsigned* bar, volatile LAS unsigned* st) {
    XcdBarrier b; b.bar = bar; b.x = xb_xcc_id(); b.st = st;
    if (threadIdx.x == 0) (void)xb_add(&bar[XB_XCNT(b.x)], 1u);
    return b;
}
__device__ __forceinline__ void xcd_barrier_complete(unsigned* bar, unsigned x, unsigned& nloc, unsigned& nx) {
    const unsigned G = gridDim.x * gridDim.y * gridDim.z;
    unsigned sum, cnt, mine, sp = 0u;
    for (;;) {
        sum = 0u; cnt = 0u; mine = 0u;
#pragma unroll
        for (unsigned j = 0; j < 16; ++j) { const unsigned c = xb_ld(&bar[XB_XCNT(j)]); sum += c; cnt += (c > 0u) ? 1u : 0u; mine = (j == x) ? c : mine; }
        if (sum == G) break;
        __builtin_amdgcn_s_sleep(1);
        if ((++sp & 255u) == 0u) { if (xb_ld(&bar[XB_TMO])) break; if (sp > XB_SPIN_CAP) { atomicAdd(&bar[XB_TMO], 1u); break; } }
    }
    nloc = mine > 0u ? mine : 1u; nx = cnt > 0u ? cnt : 1u;
}
__device__ __forceinline__ void xcd_barrier(const XcdBarrier& b) {
    asm volatile("s_waitcnt vmcnt(0)" ::: "memory");
    __syncthreads();
    if (threadIdx.x == 0) {
        unsigned* bar = b.bar; unsigned bx = b.x; asm volatile("" : "+s"(bar), "+s"(bx));
        __builtin_amdgcn_s_waitcnt(0);
        unsigned nloc = b.st[0], nx = b.st[1];
        if (nloc == 0u) { xcd_barrier_complete(bar, bx, nloc, nx); b.st[0] = nloc; b.st[1] = nx; }
        const unsigned old = xb_add(&bar[XB_XSUB(bx)], 1u);
        const unsigned gen = old / nloc;
        if (old + 1u == (gen + 1u) * nloc) {
            __builtin_amdgcn_fence(__ATOMIC_RELEASE, "agent");
            asm volatile("s_waitcnt vmcnt(0)" ::: "memory");
            const unsigned og = xb_add(&bar[XB_TOP], 1u);
            const unsigned tg = og / nx;
            if (og + 1u == (tg + 1u) * nx) xb_add(&bar[XB_TOPGEN], 1u);
            else XB_SPIN(xb_ld(&bar[XB_TOPGEN]) == tg, bar);
            __builtin_amdgcn_fence(__ATOMIC_ACQUIRE, "agent");
            xb_add(&bar[XB_XGEN(bx)], 1u);
            asm volatile("s_waitcnt vmcnt(0)" ::: "memory");
        } else {
            XB_SPIN(xb_ld(&bar[XB_XGEN(bx)]) == gen, bar);
            __builtin_amdgcn_fence(__ATOMIC_ACQUIRE, "agent");
            asm volatile("s_waitcnt vmcnt(0)" ::: "memory");
        }
    }
    __syncthreads();
}

struct Ctx {
    LAS unsigned char* lds;
    int tid, lane, wid, fr, fq;
    int G, bid;
};

__device__ __forceinline__ int tok_cls(int T) { return T < NCTX ? 0 : 1 + ((T - NCTX) >> 11); }
__device__ __forceinline__ const float* x_in_row(const Params& p, int T) { return T < NCTX ? p.in[0] + (size_t)T * DM : p.in[1] + (size_t)(T - NCTX) * DM; }

__device__ __forceinline__ void p0_item(const float* W, int ldw, int k0, int n0, const float* kscale, bf16_t* WT, int ldt, int dst_row0, LAS float* scr, int lane) {
    float ld[32];
#pragma unroll
    for (int i = 0; i < 32; ++i) { const int kk = 2 * i + (lane >> 5); ld[i] = W[(size_t)(k0 + kk) * ldw + n0 + (lane & 31)]; }
#pragma unroll
    for (int i = 0; i < 32; ++i) { const int kk = 2 * i + (lane >> 5); float v = ld[i]; if (kscale) v *= kscale[k0 + kk]; scr[kk * 33 + (lane & 31)] = v; }
    asm volatile("s_waitcnt lgkmcnt(0)" ::: "memory");
    const int c = lane & 7;
#pragma unroll
    for (int j = 0; j < 4; ++j) { const int n = (lane >> 3) + 8 * j; const LAS float* s = scr + (8 * c) * 33 + n;
        u32x4 o; o.x = pk2(s[0 * 33], s[1 * 33]); o.y = pk2(s[2 * 33], s[3 * 33]); o.z = pk2(s[4 * 33], s[5 * 33]); o.w = pk2(s[6 * 33], s[7 * 33]);
        *(u32x4*)(WT + (size_t)(dst_row0 + n) * ldt + k0 + 8 * c) = o; }
    asm volatile("s_waitcnt lgkmcnt(0)" ::: "memory");
}
__device__ __forceinline__ void p0_item8(const float* W, int ldw, int k0, int n0, float scale, unsigned char* WT, int ldt, int dst_row0, LAS float* scr, int lane) {
    float ld[32];
#pragma unroll
    for (int i = 0; i < 32; ++i) { const int kk = 2 * i + (lane >> 5); ld[i] = W[(size_t)(k0 + kk) * ldw + n0 + (lane & 31)]; }
#pragma unroll
    for (int i = 0; i < 32; ++i) { const int kk = 2 * i + (lane >> 5); scr[kk * 33 + (lane & 31)] = ld[i] * scale; }
    asm volatile("s_waitcnt lgkmcnt(0)" ::: "memory");
    const int c = lane & 7;
#pragma unroll
    for (int j = 0; j < 4; ++j) { const int n = (lane >> 3) + 8 * j; const LAS float* s = scr + (8 * c) * 33 + n;
        int w0 = __builtin_amdgcn_cvt_pk_fp8_f32(s[0 * 33], s[1 * 33], 0, false); w0 = __builtin_amdgcn_cvt_pk_fp8_f32(s[2 * 33], s[3 * 33], w0, true);
        int w1 = __builtin_amdgcn_cvt_pk_fp8_f32(s[4 * 33], s[5 * 33], 0, false); w1 = __builtin_amdgcn_cvt_pk_fp8_f32(s[6 * 33], s[7 * 33], w1, true);
        *(u32x2*)(WT + (size_t)(dst_row0 + n) * ldt + k0 + 8 * c) = (u32x2){(unsigned)w0, (unsigned)w1}; }
    asm volatile("s_waitcnt lgkmcnt(0)" ::: "memory");
}
constexpr int IT_IN = 16 * 59, IT_GATE = 16 * 128, IT_BR = 4 * 4 * 32, IT_OUT = 16 * 32, IT_UP = 16 * 172, IT_DOWN = 43 * 32, IT_UQ = 3 * 12, IT_UKV = 2 * 16;
constexpr int IT_LAYER = IT_IN + IT_GATE + IT_BR + IT_OUT + IT_UP + IT_DOWN + IT_UQ + IT_UKV;

__device__ __forceinline__ void zero_bf16(bf16_t* p, size_t n8, int gtid, int gthreads) {
    for (size_t i = gtid; i < n8; i += gthreads) ((u32x4*)p)[i] = (u32x4){0u, 0u, 0u, 0u};
}

__device__ __forceinline__ void phase0(const Params& p, Ctx& C) {
    LAS float* scr = (LAS float*)(C.lds + C.wid * 16384);
    const int gw = C.bid * 8 + C.wid, NGW = C.G * 8;
    for (int it = gw; it < 2 * IT_LAYER; it += NGW) {
        const int L = it / IT_LAYER; int r = it % IT_LAYER;
        unsigned char* wb = p.ws + WS_W + (size_t)L * W_LAYER;
        if (r < IT_IN) { const int kb = r / 59, nb = r % 59; p0_item(p.in[16] + (size_t)L * 1024 * 1888, 1888, kb * 64, nb * 32, nullptr, (bf16_t*)(wb + WO_IN), LDW, nb * 32, scr, C.lane); continue; } r -= IT_IN;
        if (r < IT_GATE) { const int kb = r / 128, nb = r % 128; p0_item8(p.in[17] + (size_t)L * 1024 * 4096, 4096, kb * 64, nb * 32, 32.0f, (unsigned char*)(wb + WO_GATE), LD8, nb * 32, scr, C.lane); continue; } r -= IT_GATE;
        if (r < IT_BR) { const int k = r / 128, rr = r % 128, kb = rr / 32, nb = rr % 32; p0_item(p.in[27] + (size_t)(L * 4 + k) * 256 * 1024, 1024, kb * 64, nb * 32, nullptr, (bf16_t*)(wb + WO_BR) + (size_t)k * 1024 * LDWB, LDWB, nb * 32, scr, C.lane); continue; } r -= IT_BR;
        if (r < IT_OUT) { const int kb = r / 32, nb = r % 32; p0_item(p.in[28] + (size_t)L * 1024 * 1024, 1024, kb * 64, nb * 32, nullptr, (bf16_t*)(wb + WO_OUT), LDW, nb * 32, scr, C.lane); continue; } r -= IT_OUT;
        if (r < IT_UP) { const int kb = r / 172, nb = r % 172; const int n0 = nb * 32, part = n0 / DFF, j0 = n0 % DFF; const int drow = (j0 >> 7) * 256 + part * 128 + (j0 & 127);
            p0_item(p.in[29] + (size_t)L * 1024 * 5504, 5504, kb * 64, n0, nullptr, (bf16_t*)(wb + WO_UP), LDW, drow, scr, C.lane); continue; } r -= IT_UP;
        if (r < IT_DOWN) { const int kb = r / 32, nb = r % 32; p0_item(p.in[31] + (size_t)L * DFF * 1024, 1024, kb * 64, nb * 32, nullptr, (bf16_t*)(wb + WO_DOWN), LDWD, nb * 32, scr, C.lane); continue; } r -= IT_DOWN;
        if (r < IT_UQ) { const int kb = r / 12, nb = r % 12; p0_item(p.in[21] + (size_t)L * 192 * 384, 384, kb * 64, nb * 32, p.in[20] + L * 192, (bf16_t*)(wb + WO_UQ), LDUQ, nb * 32, scr, C.lane); continue; } r -= IT_UQ;
        { const int kb = r / 16, nb = r % 16; p0_item(p.in[23] + (size_t)L * 128 * 512, 512, kb * 64, nb * 32, p.in[22] + L * 128, (bf16_t*)(wb + WO_UKV), LDUKV, nb * 32, scr, C.lane); }
    }
    const int gtid = C.bid * 512 + C.tid, gth = C.G * 512;
    for (int L = 0; L < 2; ++L) {
        unsigned char* wb = p.ws + WS_W + (size_t)L * W_LAYER;
        zero_bf16((bf16_t*)(wb + WO_IN) + (size_t)IN_DIM * LDW, (size_t)(INP - IN_DIM) * LDW / 8, gtid, gth);
        zero_bf16((bf16_t*)(wb + WO_UP) + (size_t)(21 * 256 + 64) * LDW, (size_t)64 * LDW / 8, gtid, gth);
        zero_bf16((bf16_t*)(wb + WO_UP) + (size_t)(21 * 256 + 128 + 64) * LDW, (size_t)64 * LDW / 8, gtid, gth);
        zero_bf16((bf16_t*)(wb + WO_UQ) + (size_t)384 * LDUQ, (size_t)128 * LDUQ / 8, gtid, gth);
        for (int i = gtid; i < 1024 * 8; i += gth) { const int row = i >> 3, c = i & 7; *(u32x4*)((bf16_t*)(wb + WO_DOWN) + (size_t)row * LDWD + DFF + c * 8) = (u32x4){0u, 0u, 0u, 0u}; }
    }
    __syncthreads();
    LAS float* sv = (LAS float*)(C.lds);
    LAS float* part = (LAS float*)(C.lds + 16384);
    for (int i = C.tid; i < 3 * 1024; i += 512) { const int cls = i >> 10, k = i & 1023; const float v = cls == 0 ? p.in[9][k] : p.in[8][(cls - 1) * 1024 + k]; sv[i] = siluf_(v); }
    __syncthreads();
    float* modv = (float*)(p.ws + WS_MODV);
    for (int it = C.bid; it < 2 * 96; it += C.G) {
        const int L = it / 96, col = (it % 96) * 64 + C.lane;
        const float* w = p.in[10] + (size_t)L * 1024 * 6144 + col;
        float a0 = 0.f, a1 = 0.f, a2 = 0.f;
#pragma unroll 8
        for (int kk = 0; kk < 128; ++kk) { const int k = C.wid * 128 + kk; const float wv = w[(size_t)k * 6144]; a0 += sv[k] * wv; a1 += sv[1024 + k] * wv; a2 += sv[2048 + k] * wv; }
        part[(C.wid * 3 + 0) * 64 + C.lane] = a0; part[(C.wid * 3 + 1) * 64 + C.lane] = a1; part[(C.wid * 3 + 2) * 64 + C.lane] = a2;
        __syncthreads();
        if (C.tid < 192) { const int cls = C.tid >> 6, l = C.tid & 63; float s = 0.f;
#pragma unroll
            for (int w8 = 0; w8 < 8; ++w8) s += part[(w8 * 3 + cls) * 64 + l];
            const int cc = (it % 96) * 64 + l;
            modv[((size_t)L * 3 + cls) * 6144 + cc] = s + p.in[11][(size_t)L * 6144 + cc]; }
        __syncthreads();
    }
}

__device__ __forceinline__ void row_norm_mod(const f32x4 (&v)[4], const float* g, const float* sc, const float* sh, bf16_t* orow, int lane, unsigned char* o8 = nullptr) {
    float ss = 0.f;
#pragma unroll
    for (int j = 0; j < 4; ++j) ss += (v[j].x * v[j].x + v[j].y * v[j].y) + (v[j].z * v[j].z + v[j].w * v[j].w);
    const float rstd = 1.0f / sqrtf(wave_sum(ss) * (1.0f / DM) + EPS);
#pragma unroll
    for (int j = 0; j < 4; ++j) {
        const f32x4 gg = ((const f32x4*)g)[lane + 64 * j], s1 = ((const f32x4*)sc)[lane + 64 * j], s0 = ((const f32x4*)sh)[lane + 64 * j];
        const f32x4 y = v[j] * rstd * gg * (s1 + 1.0f) + s0;
        u32x2 o; o.x = pk2(y.x, y.y); o.y = pk2(y.z, y.w);
        ((u32x2*)orow)[lane + 64 * j] = o;
        if (o8) { int w8 = __builtin_amdgcn_cvt_pk_fp8_f32(y.x, y.y, 0, false); w8 = __builtin_amdgcn_cvt_pk_fp8_f32(y.z, y.w, w8, true); ((int*)o8)[lane + 64 * j] = w8; }
    }
}
__device__ __forceinline__ void load_row_bf16(const bf16_t* r, f32x4 (&v)[4], int lane) {
#pragma unroll
    for (int j = 0; j < 4; ++j) { const u32x2 u = ((const u32x2*)r)[lane + 64 * j]; v[j] = (f32x4){lo16(u.x), hi16(u.x), lo16(u.y), hi16(u.y)}; }
}

__device__ __forceinline__ void phase1(const Params& p, Ctx& C) {
    const int gw = C.bid * 8 + C.wid, NGW = C.G * 8;
    const float* modv = (const float*)(p.ws + WS_MODV);
    bf16_t* H = (bf16_t*)(p.ws + WS_H);
    for (int T = gw; T < NTOK; T += NGW) {
        const float* xr = x_in_row(p, T); f32x4 v[4];
#pragma unroll
        for (int j = 0; j < 4; ++j) v[j] = ((const f32x4*)xr)[C.lane + 64 * j];
        const float* mv = modv + (size_t)(0 * 3 + tok_cls(T)) * 6144;
        row_norm_mod(v, p.in[12], mv + 1024, mv, H + (size_t)T * LDH, C.lane, p.ws + WS_H8 + (size_t)T * LD8);
    }
    const int gtid = C.bid * 512 + C.tid, gth = C.G * 512;
    bf16_t* nak = (bf16_t*)(p.ws + WS_NACK); bf16_t* nav = (bf16_t*)(p.ws + WS_NACV);
    for (int i = gtid; i < 2 * 2 * 256 * 256 / 4; i += gth) {
        const int e = i * 4, w = e & 255, t = (e >> 8) & 255, L = (e >> 16) & 1, b = e >> 17;
        const size_t d = ((size_t)(L * 2 + b) * 256 + t) * LDNAC + w;
        const f32x4 a = *(const f32x4*)(p.in[2] + e), c = *(const f32x4*)(p.in[3] + e);
        *(u32x2*)(nak + d) = (u32x2){pk2(a.x, a.y), pk2(a.z, a.w)}; *(u32x2*)(nav + d) = (u32x2){pk2(c.x, c.y), pk2(c.z, c.w)};
    }
    bf16_t* swk = (bf16_t*)(p.ws + WS_SWCK); bf16_t* swv = (bf16_t*)(p.ws + WS_SWCV); bf16_t* ckv = (bf16_t*)(p.ws + WS_CKVC);
    for (int i = gtid; i < 2 * 2 * 256 * 128 / 4; i += gth) {
        const int e = i * 4, w = e & 127, t = (e >> 7) & 255, L = (e >> 15) & 1, b = e >> 16;
        const size_t d = ((size_t)(L * 2 + b) * 256 + t) * LDSWC + w, d2 = ((size_t)(L * 2 + b) * 256 + t) * LDCKVC + w;
        const f32x4 a = *(const f32x4*)(p.in[6] + e), c = *(const f32x4*)(p.in[7] + e), m = *(const f32x4*)(p.in[4] + e);
        *(u32x2*)(swk + d) = (u32x2){pk2(a.x, a.y), pk2(a.z, a.w)}; *(u32x2*)(swv + d) = (u32x2){pk2(c.x, c.y), pk2(c.z, c.w)};
        *(u32x2*)(ckv + d2) = (u32x2){pk2(m.x, m.y), pk2(m.z, m.w)};
    }
    bf16_t* krc = (bf16_t*)(p.ws + WS_KRC);
    for (int i = gtid; i < 2 * 2 * 256 * 32 / 4; i += gth) {
        const int e = i * 4, w = e & 31, t = (e >> 5) & 255, L = (e >> 13) & 1, b = e >> 14;
        const size_t d = ((size_t)(L * 2 + b) * 256 + t) * 32 + w;
        const f32x4 a = *(const f32x4*)(p.in[5] + e);
        *(u32x2*)(krc + d) = (u32x2){pk2(a.x, a.y), pk2(a.z, a.w)};
    }
}

__device__ __forceinline__ void phase7(const Params& p, Ctx& C, int L) {
    const int gw = C.bid * 8 + C.wid, NGW = C.G * 8;
    const float* modv = (const float*)(p.ws + WS_MODV);
    const bf16_t* O = (const bf16_t*)(p.ws + WS_O); float* X1 = p.out + OFF_Y; bf16_t* H = (bf16_t*)(p.ws + WS_H);
    const float* gpost = p.in[13] + L * DM; const float* gpre = p.in[14] + L * DM;
    for (int T = gw; T < NTOK; T += NGW) {
        const float* xr = (L == 0) ? x_in_row(p, T) : p.out + OFF_Y + (size_t)T * DM;
        const float* mv = modv + (size_t)(L * 3 + tok_cls(T)) * 6144;
        f32x4 o[4]; load_row_bf16(O + (size_t)T * LDH, o, C.lane);
        float ss = 0.f;
#pragma unroll
        for (int j = 0; j < 4; ++j) ss += (o[j].x * o[j].x + o[j].y * o[j].y) + (o[j].z * o[j].z + o[j].w * o[j].w);
        const float rstd = 1.0f / sqrtf(wave_sum(ss) * (1.0f / DM) + EPS);
        f32x4 x1[4];
#pragma unroll
        for (int j = 0; j < 4; ++j) {
            const f32x4 xv = ((const f32x4*)xr)[C.lane + 64 * j], gp = ((const f32x4*)gpost)[C.lane + 64 * j], g1 = ((const f32x4*)(mv + 2048))[C.lane + 64 * j];
            x1[j] = xv + g1 * (o[j] * rstd * gp);
            ((f32x4*)(X1 + (size_t)T * DM))[C.lane + 64 * j] = x1[j];
        }
        row_norm_mod(x1, gpre, mv + 4096, mv + 3072, H + (size_t)T * LDH, C.lane);
    }
}
__device__ __forceinline__ void phase10(const Params& p, Ctx& C, int L) {
    const int gw = C.bid * 8 + C.wid, NGW = C.G * 8;
    const float* modv = (const float*)(p.ws + WS_MODV);
    const float* X1 = p.out + OFF_Y; bf16_t* H = (bf16_t*)(p.ws + WS_H);
    const float* gpost = p.in[15] + L * DM;
    for (int T = gw; T < NTOK; T += NGW) {
        const float* mv = modv + (size_t)(L * 3 + tok_cls(T)) * 6144;
        f32x4 f[4]; load_row_bf16(H + (size_t)T * LDH, f, C.lane);
        float ss = 0.f;
#pragma unroll
        for (int j = 0; j < 4; ++j) ss += (f[j].x * f[j].x + f[j].y * f[j].y) + (f[j].z * f[j].z + f[j].w * f[j].w);
        const float rstd = 1.0f / sqrtf(wave_sum(ss) * (1.0f / DM) + EPS);
        f32x4 y[4];
#pragma unroll
        for (int j = 0; j < 4; ++j) {
            const f32x4 xv = ((const f32x4*)(X1 + (size_t)T * DM))[C.lane + 64 * j], gp = ((const f32x4*)gpost)[C.lane + 64 * j], g2 = ((const f32x4*)(mv + 5120))[C.lane + 64 * j];
            y[j] = xv + g2 * (f[j] * rstd * gp);
            ((f32x4*)(p.out + OFF_Y + (size_t)T * DM))[C.lane + 64 * j] = y[j];
        }
        if (L == 0) { const float* mv1 = modv + (size_t)(1 * 3 + tok_cls(T)) * 6144; row_norm_mod(y, p.in[12] + DM, mv1 + 1024, mv1, H + (size_t)T * LDH, C.lane, p.ws + WS_H8 + (size_t)T * LD8); }
    }
}

__device__ __forceinline__ int lds_byte(int r, int c) { const int st = (r >> 4) * 2 + (c >> 5), ob = (r & 15) * 64 + (c & 31) * 2; return st * 1024 + (ob ^ (((ob >> 9) & 1) << 5)); }
__device__ __forceinline__ void stage_rc(int b, int& R, int& Cc) { const int st = b >> 10, sb = b & 1023, swz = sb ^ (((sb >> 9) & 1) << 5); R = (st >> 1) * 16 + swz / 64; Cc = (st & 1) * 32 + (swz % 64) / 2; }
#define GLDS16(gp, lp) __builtin_amdgcn_global_load_lds((const unsigned*)(gp), (LAS unsigned*)(lp), 16, 0, 0)

template <int TM, int TN> struct GemmStage {
    static constexpr int STAGE = (TM + TN) * 128;
    int offA, offB;
    int lda, ldb;
    __device__ __forceinline__ void init(const Ctx& C, int lda_, int ldb_) { int R, Cc; stage_rc(C.wid * 1024 + C.lane * 16, R, Cc); lda = lda_; ldb = ldb_; offA = R * lda + Cc; offB = R * ldb + Cc; }
    __device__ __forceinline__ void stage(const Ctx& C, int buf, const bf16_t* a, const bf16_t* b) const {
        LAS unsigned char* base = C.lds + buf * STAGE + C.wid * 1024;
#pragma unroll
        for (int i = 0; i < TM / 64; ++i) GLDS16(a + offA + (size_t)i * 64 * lda, base + i * 8192);
#pragma unroll
        for (int i = 0; i < TN / 64; ++i) GLDS16(b + offB + (size_t)i * 64 * ldb, base + TM * 128 + i * 8192);
    }
};
template <int TM, int TN, int MF, int NF>
__device__ __forceinline__ void gemm_compute(const Ctx& C, int buf, int wr, int wc, f32x4 (&acc)[MF][NF]) {
    constexpr int STAGE = (TM + TN) * 128;
    LAS unsigned char* sa = C.lds + buf * STAGE; LAS unsigned char* sb = sa + TM * 128;
#pragma unroll
    for (int ks = 0; ks < 2; ++ks) {
        bf16x8 Af[MF], Bf[NF];
        const int ao = lds_byte(wr * MF * 16 + C.fr, ks * 32 + C.fq * 8), bo = lds_byte(wc * NF * 16 + C.fr, ks * 32 + C.fq * 8);
#pragma unroll
        for (int m = 0; m < MF; ++m) Af[m] = *(const LAS bf16x8*)(sa + ao + m * 2048);
#pragma unroll
        for (int n = 0; n < NF; ++n) Bf[n] = *(const LAS bf16x8*)(sb + bo + n * 2048);
#pragma unroll
        for (int m = 0; m < MF; ++m)
#pragma unroll
            for (int n = 0; n < NF; ++n) acc[m][n] = __builtin_amdgcn_mfma_f32_16x16x32_bf16(Bf[n], Af[m], acc[m][n], 0, 0, 0);
        __builtin_amdgcn_sched_barrier(0);
    }
}
template <int TM, int TN, int MF, int NF>
__device__ __forceinline__ void gemm_kloop(const Ctx& C, const GemmStage<TM, TN>& S, const bf16_t* A, const bf16_t* B, int nt, int wr, int wc, f32x4 (&acc)[MF][NF]) {
    S.stage(C, 0, A, B); VM_WAIT(); __syncthreads();
    for (int t = 0; t < nt; ++t) {
        const int cur = t & 1;
        if (t + 1 < nt) S.stage(C, cur ^ 1, A + (t + 1) * 64, B + (t + 1) * 64);
        gemm_compute<TM, TN, MF, NF>(C, cur, wr, wc, acc);
        VM_WAIT(); __syncthreads();
    }
}
__device__ __forceinline__ void unit_map(int u, int nM, int nN, int& pm, int& pn) {
    const int nwg = nM * nN; int wgid = u;
    { const int q = nwg / 8, r = nwg % 8, xcd = wgid % 8, off = wgid / 8; wgid = (xcd < r ? xcd * (q + 1) : r * (q + 1) + (xcd - r) * q) + off; }
    const int nig = 8 * nN, gid = wgid / nig, fm = gid * 8, gsz = (nM - fm) < 8 ? (nM - fm) : 8;
    pm = fm + ((wgid % nig) % gsz); pn = (wgid % nig) / gsz;
}
#define ZERO_ACC(acc, MF, NF) _Pragma("unroll") for (int m_ = 0; m_ < MF; ++m_) _Pragma("unroll") for (int n_ = 0; n_ < NF; ++n_) acc[m_][n_] = (f32x4){0.f, 0.f, 0.f, 0.f}


struct G8Unit { const char* A; const char* B; int e0, e1, e2, e3; };
__device__ __forceinline__ int perm32(int rho) { const int n = rho >> 4, i = rho & 15; return 8 * (i >> 2) + 4 * n + (i & 3); }
__device__ __forceinline__ i32x8 cat8(bf16x8 a, bf16x8 b) { return __builtin_shufflevector(__builtin_bit_cast(i32x4, a), __builtin_bit_cast(i32x4, b), 0, 1, 2, 3, 4, 5, 6, 7); }
#define G8_EPI_PLAIN static constexpr bool FP8 = false; static constexpr int HROWS_B = 128; static __device__ __forceinline__ int brow(int R) { return PERM ? ((R & ~31) + perm32(R & 31)) : R; }
template <class Epi, class Sched>
__device__ __forceinline__ void gemm8(const Ctx& C, int K, int lda, int ldb, const Sched& S, const Epi& E) {
    constexpr int HTB = 16384;
    LAS unsigned char* lds = C.lds;
    const int tid = C.tid, wid = C.wid, lane = C.lane, wr = wid >> 2, wc = wid & 3, fr = lane & 15, fq = lane >> 4;
    const int nt = K / 64;
    unsigned voffA, voffB;
    { int R, Cc; stage_rc(tid * 16, R, Cc); voffA = (unsigned)(R * lda + Cc) * 2u; voffB = (unsigned)(Epi::brow(R) * ldb + Cc) * 2u; }
    const size_t kstep = 128;
    const size_t hstepA = (size_t)128 * lda * 2, hstepB = (size_t)Epi::HROWS_B * ldb * 2;
    const size_t r64A = (size_t)64 * lda * 2, r64B = (size_t)(Epi::brow(64) - Epi::brow(0)) * ldb * 2;
    const unsigned ldsw = (unsigned)(size_t)lds + (unsigned)wid * 1024u;
    const int aoff = lds_byte(wr * 64 + fr, fq * 8), boff = lds_byte(wc * 32 + fr, fq * 8);
#define G8_SA(b, h) (((b) * 2 + (h)) * HTB)
#define G8_SB(b, h) ((4 + (b) * 2 + (h)) * HTB)
#define G8_GLDS(vo, sb, la) asm volatile("s_mov_b32 m0, %2\n\ts_nop 0\n\tglobal_load_lds_dwordx4 %0, %1" :: "v"(vo), "s"(sb), "s"(la) : "memory", "m0")
#define G8_STAGE(bufoff, gbase, voff, r64) do { const char* _g = (const char*)(gbase); const unsigned _l = ldsw + (unsigned)(bufoff); G8_GLDS(voff, _g, _l); \
        const char* _g2 = _g + (r64); G8_GLDS(voff, _g2, _l + 8192u); } while (0)
#define G8_LDA(dst, b, h) do { _Pragma("unroll") for (int m = 0; m < 4; ++m) _Pragma("unroll") for (int k = 0; k < 2; ++k) dst[m][k] = *(const LAS bf16x8*)(lds + G8_SA(b, h) + aoff + m * 2048 + k * 1024); } while (0)
#define G8_LDB(dst, b, h) do { _Pragma("unroll") for (int n = 0; n < 2; ++n) _Pragma("unroll") for (int k = 0; k < 2; ++k) dst[n][k] = *(const LAS bf16x8*)(lds + G8_SB(b, h) + boff + n * 2048 + k * 1024); } while (0)
#define G8_MMA(ai, bj, At, Bt) do { __builtin_amdgcn_s_setprio(1); _Pragma("unroll") for (int m = 0; m < 4; ++m) _Pragma("unroll") for (int n = 0; n < 2; ++n) { \
        if constexpr (Epi::FP8) acc[ai][bj][m][n] = __builtin_amdgcn_mfma_scale_f32_16x16x128_f8f6f4(cat8(Bt[n][0], Bt[n][1]), cat8(At[m][0], At[m][1]), acc[ai][bj][m][n], 0, 0, 0, 0, 0, 0); \
        else { _Pragma("unroll") for (int k = 0; k < 2; ++k) acc[ai][bj][m][n] = __builtin_amdgcn_mfma_f32_16x16x32_bf16(Bt[n][k], At[m][k], acc[ai][bj][m][n], 0, 0, 0); } } \
        __builtin_amdgcn_s_setprio(0); } while (0)
#define G8_WAIT_V(n) asm volatile("s_waitcnt vmcnt(" #n ")" ::: "memory")
#define G8_WAIT_L(n) asm volatile("s_waitcnt lgkmcnt(" #n ")" ::: "memory")
#define G8_BAR __builtin_amdgcn_s_barrier()
#define G8_SCHED __builtin_amdgcn_sched_barrier(0)
    G8Unit cur, nxt; int ui = 0;
    if (!S.next(0, cur)) return;
    f32x4 acc[2][2][4][2];
#pragma unroll
    for (int a = 0; a < 2; ++a)
#pragma unroll
        for (int b = 0; b < 2; ++b)
#pragma unroll
            for (int m = 0; m < 4; ++m)
#pragma unroll
                for (int n = 0; n < 2; ++n) acc[a][b][m][n] = (f32x4){0.f, 0.f, 0.f, 0.f};
    bf16x8 At[4][2], B0[2][2], B1[2][2];
    const char* cA = cur.A; const char* cB = cur.B;
    G8_STAGE(G8_SB(0, 0), cB, voffB, r64B); G8_STAGE(G8_SA(0, 0), cA, voffA, r64A); G8_STAGE(G8_SB(0, 1), cB + hstepB, voffB, r64B); G8_STAGE(G8_SA(0, 1), cA + hstepA, voffA, r64A);
    if (wr == 1) G8_BAR;
    G8_WAIT_V(4); G8_BAR;
    G8_STAGE(G8_SB(1, 0), cB + kstep, voffB, r64B); G8_STAGE(G8_SA(1, 0), cA + kstep, voffA, r64A); G8_STAGE(G8_SB(1, 1), cB + hstepB + kstep, voffB, r64B);
    G8_WAIT_V(6); G8_BAR;
    for (;;) {
        const bool has_next = S.next(ui + 1, nxt);
        const char* nA = has_next ? nxt.A : cA; const char* nB = has_next ? nxt.B : cB;
#pragma unroll 1
        for (int t = 0; t < nt; t += 2) {
            const bool last = (t == nt - 2);
            const char* a1 = cA + (size_t)(t + 1) * kstep;
            const char* a2 = last ? nA : cA + (size_t)(t + 2) * kstep; const char* b2 = last ? nB : cB + (size_t)(t + 2) * kstep;
            const char* a3 = a2 + kstep; const char* b3 = b2 + kstep;
            G8_LDB(B0, 0, 0); G8_SCHED; G8_LDA(At, 0, 0); G8_STAGE(G8_SA(1, 1), a1 + hstepA, voffA, r64A);
            G8_WAIT_L(8); G8_BAR; G8_WAIT_L(0); G8_MMA(0, 0, At, B0); G8_BAR; G8_SCHED;
            G8_LDB(B1, 0, 1); G8_STAGE(G8_SB(0, 0), b2, voffB, r64B);
            G8_BAR; G8_WAIT_L(0); G8_MMA(0, 1, At, B1); G8_BAR;
            G8_LDA(At, 0, 1); G8_STAGE(G8_SA(0, 0), a2, voffA, r64A);
            G8_BAR; G8_WAIT_L(0); G8_MMA(1, 0, At, B0); G8_BAR; G8_SCHED;
            G8_STAGE(G8_SB(0, 1), b2 + hstepB, voffB, r64B);
            G8_WAIT_V(6); G8_BAR; G8_MMA(1, 1, At, B1); G8_BAR;
            G8_LDB(B0, 1, 0); G8_SCHED; G8_LDA(At, 1, 0); G8_STAGE(G8_SA(0, 1), a2 + hstepA, voffA, r64A);
            G8_WAIT_L(8); G8_BAR; G8_WAIT_L(0); G8_MMA(0, 0, At, B0); G8_BAR; G8_SCHED;
            G8_LDB(B1, 1, 1); G8_STAGE(G8_SB(1, 0), b3, voffB, r64B);
            G8_BAR; G8_WAIT_L(0); G8_MMA(0, 1, At, B1); G8_BAR;
            G8_LDA(At, 1, 1); G8_STAGE(G8_SA(1, 0), a3, voffA, r64A);
            G8_BAR; G8_WAIT_L(0); G8_MMA(1, 0, At, B0); G8_BAR; G8_SCHED;
            G8_STAGE(G8_SB(1, 1), b3 + hstepB, voffB, r64B);
            G8_WAIT_V(6); G8_BAR; G8_MMA(1, 1, At, B1); G8_BAR;
        }
        if constexpr (!Epi::AFTER_DRAIN) E(acc, cur, wr, wc, fr, fq);
        if (!has_next) break;
#pragma unroll
        for (int a = 0; a < 2; ++a)
#pragma unroll
            for (int b = 0; b < 2; ++b)
#pragma unroll
                for (int m = 0; m < 4; ++m)
#pragma unroll
                    for (int n = 0; n < 2; ++n) acc[a][b][m][n] = (f32x4){0.f, 0.f, 0.f, 0.f};
        cur = nxt; cA = nA; cB = nB; ++ui;
    }
    G8_WAIT_V(0);
    if (wr == 0) G8_BAR;
    G8_BAR;
    if constexpr (Epi::AFTER_DRAIN) E.drained(C, acc, cur, wr, wc, fr, fq);
#undef G8_SA
#undef G8_SB
#undef G8_STAGE
#undef G8_GLDS
#undef G8_LDA
#undef G8_LDB
#undef G8_MMA
#undef G8_WAIT_V
#undef G8_WAIT_L
#undef G8_BAR
#undef G8_SCHED
}
struct TileSched {
    const char* A; const char* B; size_t tstepA, tstepB; int nM, nN, G, c;
    __device__ __forceinline__ bool next(int i, G8Unit& u) const {
        const int L = i * G + c; if (L >= nM * nN) return false;
        int pm, pn; unit_map(L, nM, nN, pm, pn);
        u.A = A + (size_t)pm * tstepA; u.B = B + (size_t)pn * tstepB; u.e0 = pm; u.e1 = pn; u.e2 = 0; u.e3 = 0; return true;
    }
};
struct EpiBf16 {
    static constexpr bool PERM = true, AFTER_DRAIN = false; G8_EPI_PLAIN
    bf16_t* O; int ldo;
    __device__ __forceinline__ void operator()(const f32x4 (&acc)[2][2][4][2], const G8Unit& u, int wr, int wc, int fr, int fq) const {
        const int row0 = u.e0 * 256 + wr * 64 + fr, col0 = u.e1 * 256 + wc * 32 + 8 * fq;
#pragma unroll
        for (int ai = 0; ai < 2; ++ai)
#pragma unroll
            for (int m = 0; m < 4; ++m) { bf16_t* rowp = O + (size_t)(row0 + ai * 128 + m * 16) * ldo + col0;
#pragma unroll
                for (int bj = 0; bj < 2; ++bj) { const f32x4 v0 = acc[ai][bj][m][0], v1 = acc[ai][bj][m][1];
                    *(u32x4*)(rowp + bj * 128) = (u32x4){pk2(v0.x, v0.y), pk2(v0.z, v0.w), pk2(v1.x, v1.y), pk2(v1.z, v1.w)}; } }
    }
};
struct EpiInProj {
    static constexpr bool PERM = true, AFTER_DRAIN = false; G8_EPI_PLAIN
    bf16_t* P; float* out; int L;
    __device__ __forceinline__ void operator()(const f32x4 (&acc)[2][2][4][2], const G8Unit& u, int wr, int wc, int fr, int fq) const {
        const int row0 = u.e0 * 256 + wr * 64 + fr, col0 = u.e1 * 256 + wc * 32 + 8 * fq;
        const bool ctx = u.e0 < 32;
#pragma unroll
        for (int bj = 0; bj < 2; ++bj) { const int col = col0 + bj * 128;
            int W = 0, cc = 0; size_t off = 0;
            if (ctx) {
                if (col >= COL_KA && col < COL_VA) { off = OFF_NAK; W = 256; cc = col - COL_KA; }
                else if (col >= COL_VA && col < COL_CQ) { off = OFF_NAV; W = 256; cc = col - COL_VA; }
                else if (col >= COL_CKV && col < COL_KR) { off = OFF_CKV; W = 128; cc = col - COL_CKV; }
                else if (col >= COL_KR && col < COL_QC) { off = OFF_KR; W = 32; cc = col - COL_KR; }
                else if (col >= COL_KC && col < COL_VC) { off = OFF_SWK; W = 128; cc = col - COL_KC; }
                else if (col >= COL_VC && col < COL_PD) { off = OFF_SWV; W = 128; cc = col - COL_VC; }
            }
            float* dbase = out + off + cc;
#pragma unroll
            for (int ai = 0; ai < 2; ++ai)
#pragma unroll
                for (int m = 0; m < 4; ++m) { const int row = row0 + ai * 128 + m * 16; const f32x4 v0 = acc[ai][bj][m][0], v1 = acc[ai][bj][m][1];
                    if (col < IN_DIM) *(u32x4*)(P + (size_t)row * LDP + col) = (u32x4){pk2(v0.x, v0.y), pk2(v0.z, v0.w), pk2(v1.x, v1.y), pk2(v1.z, v1.w)};
                    if (W) { float* dst = dbase + (size_t)(((row >> 8) * 2 + L) * 256 + (row & 255)) * W; *(f32x4*)dst = v0; *(f32x4*)(dst + 4) = v1; } }
        }
    }
};
__device__ __forceinline__ void phase2(const Params& p, Ctx& C, int L) {
    TileSched S{(const char*)(p.ws + WS_H), (const char*)(p.ws + WS_W + (size_t)L * W_LAYER + WO_IN), (size_t)256 * LDH * 2, (size_t)256 * LDW * 2, 48, 8, C.G, C.bid};
    EpiInProj E{(bf16_t*)(p.ws + WS_P), p.out, L};
    gemm8(C, DM, LDH, LDW, S, E);
}

__device__ __forceinline__ void rope_pair(bf16_t* p1, bf16_t* p2, float pos, float inv) {
    const float ang = pos * inv; float rev = ang * 0.15915494309189535f; rev -= floorf(rev);
    const float s = __builtin_amdgcn_sinf(rev), c = __builtin_amdgcn_cosf(rev);
    const float x1 = bf2f(*p1), x2 = bf2f(*p2);
    const unsigned o = pk2(x1 * c - x2 * s, x1 * s + x2 * c);
    *p1 = (bf16_t)(o & 0xffffu); *p2 = (bf16_t)(o >> 16);
}
__device__ __forceinline__ void phase3(const Params& p, Ctx& C, int L) {
    bf16_t* P = (bf16_t*)(p.ws + WS_P);
    {
        const int gw = C.bid * 8 + C.wid, NGW = C.G * 8;
        for (int t = gw; t < NLAT; t += NGW) {
            bf16_t* row = P + (size_t)(NCTX + t) * LDP; const int pos = t & 2047; const float prow = (float)(pos >> 6), pcol = (float)(pos & 63);
            for (int i = C.lane; i < 208; i += 64) {
                if (i < 16) { const int blk = i >> 3, f = i & 7; bf16_t* b = row + COL_KR + blk * 16 + f; rope_pair(b, b + 8, blk ? pcol : prow, exp2f(-(float)f * (13.287712379549449f / 8.0f))); }
                else { const int j = i - 16, head = j >> 5, blk = (j >> 4) & 1, f = j & 15;
                    bf16_t* b = row + COL_QC + head * 64 + blk * 32 + f; rope_pair(b, b + 16, blk ? pcol : prow, exp2f(-(float)f * (13.287712379549449f / 16.0f))); }
            }
        }
    }
    const int wr = C.wid >> 2, wc = C.wid & 3;
    LAS float* rs = (LAS float*)(C.lds + LDS_TAB);
    const unsigned char* wb = p.ws + WS_W + (size_t)L * W_LAYER;
    int R, Cc; stage_rc(C.wid * 1024 + C.lane * 16, R, Cc);
    const int Rb = (R & ~31) + perm32(R & 31);
    for (int u = C.bid; u < 96 * 7 + 4 * 4; u += C.G) {
        int pm, tn;
        if (u < 672) { pm = u / 7; tn = u % 7; } else { const int r = u - 672; pm = 96 + (r >> 2); tn = 3 + (r & 3); }
        const int which = tn >= 3, K = which ? 128 : 192, nkt = K / 64, ldb = which ? LDUKV : LDUQ, n0 = (which ? tn - 3 : tn) * 128;
        const bf16_t* A; int lda;
        if (pm < 96) { A = P + (size_t)pm * 128 * LDP + (which ? COL_CKV : COL_CQ); lda = LDP; }
        else { A = (const bf16_t*)(p.ws + WS_CKVC) + (size_t)(L * 512 + (pm - 96) * 128) * LDCKVC; lda = LDCKVC; }
        const bf16_t* B = (const bf16_t*)(wb + (which ? WO_UKV : WO_UQ)) + (size_t)n0 * ldb;
        for (int t = 0; t < nkt; ++t) { LAS unsigned char* base = C.lds + t * 32768 + C.wid * 1024;
            const bf16_t* a = A + (size_t)R * lda + Cc + t * 64; const bf16_t* bq = B + (size_t)Rb * ldb + Cc + t * 64;
            GLDS16(a, base); GLDS16(a + (size_t)64 * lda, base + 8192); GLDS16(bq, base + 16384); GLDS16(bq + (size_t)64 * ldb, base + 16384 + 8192); }
        VM_WAIT(); __syncthreads();
        { const int row = C.tid >> 2, part = C.tid & 3; float ss = 0.f;
            for (int c = part; c < K / 8; c += 4) { const int t = c >> 3, cc = (c & 7) * 8; const u32x4 q = *(const LAS u32x4*)(C.lds + t * 32768 + lds_byte(row, cc));
                ss += lo16(q.x) * lo16(q.x) + hi16(q.x) * hi16(q.x) + lo16(q.y) * lo16(q.y) + hi16(q.y) * hi16(q.y) + lo16(q.z) * lo16(q.z) + hi16(q.z) * hi16(q.z) + lo16(q.w) * lo16(q.w) + hi16(q.w) * hi16(q.w); }
            ss += __shfl_xor(ss, 1); ss += __shfl_xor(ss, 2);
            if (part == 0) rs[row] = __builtin_amdgcn_rsqf(ss / (float)K + EPS); }
        f32x4 acc[4][2]; ZERO_ACC(acc, 4, 2);
        for (int t = 0; t < nkt; ++t) gemm_compute<128, 128, 4, 2>(C, t, wr, wc, acc);
        __syncthreads();
        bf16_t* O; int ldo;
        if (pm < 96) { if (which) { O = (bf16_t*)(p.ws + WS_KVUP) + (size_t)pm * 128 * LDKV; ldo = LDKV; } else { O = (bf16_t*)(p.ws + WS_QUP) + (size_t)pm * 128 * LDQ; ldo = LDQ; } }
        else { O = (bf16_t*)(p.ws + WS_KVCUP) + (size_t)(L * 512 + (pm - 96) * 128) * LDKV; ldo = LDKV; }
#pragma unroll
        for (int m = 0; m < 4; ++m) { const int r = wr * 64 + m * 16 + C.fr; const float sc = rs[r]; const f32x4 v0 = acc[m][0] * sc, v1 = acc[m][1] * sc;
            *(u32x4*)(O + (size_t)r * ldo + n0 + wc * 32 + 8 * C.fq) = (u32x4){pk2(v0.x, v0.y), pk2(v0.z, v0.w), pk2(v1.x, v1.y), pk2(v1.z, v1.w)}; }
        __syncthreads();
    }
}

struct AttnSeg { const bf16_t* K; const bf16_t* K2; const bf16_t* V; int ldk, ldk2, ldv, n, tok0; };
struct AttnDesc { const bf16_t* Q; bf16_t* O; AttnSeg seg[2]; int ldq, ldo; float c1, m0, l0; int qtok0; int rope_q; };
typedef short v4i16_t __attribute__((ext_vector_type(4)));
__device__ __forceinline__ s16x4 vtr(const LAS unsigned char* p) { return __builtin_bit_cast(s16x4, __builtin_amdgcn_ds_read_tr16_b64_v4i16((LAS v4i16_t*)p)); }

template <int DQK, int KIND>
__device__ __forceinline__ void attn_unit(const Ctx& C, const AttnDesc& D, const LAS float* rpb) {
    constexpr int KROW = DQK * 2 + 16, VROW = 160, KBYTES = 64 * KROW, BUFB = KBYTES + 64 * VROW, CPK = DQK / 8, NKC = 64 * CPK;
    const int fr = C.fr, fq = C.fq, q = C.wid * 16 + fr;
    bf16x8 Qf[DQK / 32];
    const bf16_t* qrow = D.Q + (size_t)q * D.ldq;
#pragma unroll
    for (int s = 0; s < DQK / 32; ++s) Qf[s] = *(const bf16x8*)(qrow + s * 32 + fq * 8);
    const int qtok = D.qtok0 + q;
    if (DQK == 96 && D.rope_q) {
        bf16x8 mine = Qf[2], oth;
#pragma unroll
        for (int j = 0; j < 8; ++j) oth[j] = (short)__shfl_xor((int)mine[j], 16);
        const float pos = (fq < 2) ? (float)(qtok >> 6) : (float)(qtok & 63);
#pragma unroll
        for (int j = 0; j < 8; j += 2) {
            float o2[2];
#pragma unroll
            for (int e = 0; e < 2; ++e) {
                const float ang = pos * exp2f(-(float)(j + e) * (13.287712379549449f / 8.0f)); float rev = ang * 0.15915494309189535f; rev -= floorf(rev);
                const float sn = __builtin_amdgcn_sinf(rev), cs = __builtin_amdgcn_cosf(rev);
                const float a = bf2f((bf16_t)mine[j + e]), b = bf2f((bf16_t)oth[j + e]);
                o2[e] = (fq & 1) ? (b * sn + a * cs) : (a * cs - b * sn);
            }
            const unsigned pk = pk2(o2[0], o2[1]); Qf[2][j] = (short)(pk & 0xffffu); Qf[2][j + 1] = (short)(pk >> 16);
        }
    }
    float m = D.m0, l = D.l0 * (fq == 0 ? 1.0f : 0.0f);
    f32x4 Oa[4]; for (int d = 0; d < 4; ++d) Oa[d] = (f32x4){0.f, 0.f, 0.f, 0.f};
    int qrow_g = 0, qcol_g = 0, r0 = 0, cs0 = 0;
    if (KIND == 1) { qrow_g = qtok >> 6; qcol_g = qtok & 63; r0 = min(max(qrow_g - 4, 0), 24); cs0 = min(max(qcol_g - 8, 0), 48); }

    const int nt0 = D.seg[0].n >> 6, ntot = nt0 + (D.seg[1].n >> 6);
    u32x4 kreg[(NKC + 511) / 512], vreg;
    auto issue = [&](int t) {
        const AttnSeg& sg = (t < nt0) ? D.seg[0] : D.seg[1]; const int k0 = ((t < nt0) ? t : t - nt0) * 64;
#pragma unroll
        for (int i = 0; i < (NKC + 511) / 512; ++i) { const int c = C.tid + i * 512;
            if (c < NKC) { const int key = c / CPK, part = c % CPK;
                const bf16_t* src = (part < 8) ? sg.K + (size_t)(k0 + key) * sg.ldk + part * 8 : sg.K2 + (size_t)(k0 + key) * sg.ldk2 + (part - 8) * 8;
                kreg[i] = *(const u32x4*)src; } }
        { const int key = C.tid >> 3, part = C.tid & 7; vreg = *(const u32x4*)(sg.V + (size_t)(k0 + key) * sg.ldv + part * 8); }
    };
    auto commit = [&](int buf) {
        LAS unsigned char* kb = C.lds + buf * BUFB; LAS unsigned char* vb = kb + KBYTES;
#pragma unroll
        for (int i = 0; i < (NKC + 511) / 512; ++i) { const int c = C.tid + i * 512; if (c < NKC) { const int key = c / CPK, part = c % CPK; *(LAS u32x4*)(kb + key * KROW + part * 16) = kreg[i]; } }
        { const int key = C.tid >> 3, part = C.tid & 7; *(LAS u32x4*)(vb + key * VROW + part * 16) = vreg; }
    };
    issue(0);
    for (int t = 0; t < ntot; ++t) {
        const int buf = t & 1;
        commit(buf);
        __syncthreads();
        if (t + 1 < ntot) issue(t + 1);
        const LAS unsigned char* kb = C.lds + buf * BUFB; const LAS unsigned char* vb = kb + KBYTES;
        f32x4 s[4];
#pragma unroll
        for (int kg = 0; kg < 4; ++kg) {
            s[kg] = (f32x4){0.f, 0.f, 0.f, 0.f};
#pragma unroll
            for (int ks = 0; ks < DQK / 32; ++ks) { const bf16x8 Kf = *(const LAS bf16x8*)(kb + (kg * 16 + fr) * KROW + ks * 64 + fq * 16); s[kg] = __builtin_amdgcn_mfma_f32_16x16x32_bf16(Kf, Qf[ks], s[kg], 0, 0, 0); }
        }
        const bool seg1 = (t >= nt0);
        const int ktile0 = seg1 ? D.seg[1].tok0 + (t - nt0) * 64 : 0;
        float mx = -1e30f;
#pragma unroll
        for (int kg = 0; kg < 4; ++kg)
#pragma unroll
            for (int j = 0; j < 4; ++j) {
                float v = s[kg][j] * D.c1;
                if (KIND == 1 && seg1) { const int kt = ktile0 + kg * 16 + 4 * fq + j, krow = kt >> 6, kcol = kt & 63;
                    const bool ok = (krow >= r0) && (krow < r0 + 8) && (kcol >= cs0) && (kcol < cs0 + 16);
                    const int dr = min(max(krow - qrow_g + 7, 0), 14), dc = min(max(kcol - qcol_g + 15, 0), 30);
                    v = ok ? v + rpb[dr * 31 + dc] : -1e30f; }
                if (KIND == 2 && seg1) { const int kt = ktile0 + kg * 16 + 4 * fq + j; const int dd = kt - qtok; v = (dd <= 128 && dd >= -128) ? v : -1e30f; }
                s[kg][j] = v; mx = fmaxf(mx, v);
            }
        mx = qmax4(mx);
        const float mn = fmaxf(m, mx), alpha = __builtin_amdgcn_exp2f(m - mn); m = mn;
        float ps = 0.f;
#pragma unroll
        for (int kg = 0; kg < 4; ++kg)
#pragma unroll
            for (int j = 0; j < 4; ++j) { const float e = __builtin_amdgcn_exp2f(s[kg][j] - mn); s[kg][j] = e; ps += e; }
        l = l * alpha + ps;
#pragma unroll
        for (int d = 0; d < 4; ++d) Oa[d] = Oa[d] * alpha;
#pragma unroll
        for (int k2 = 0; k2 < 2; ++k2) {
            u32x4 pw; pw.x = pk2(s[2 * k2][0], s[2 * k2][1]); pw.y = pk2(s[2 * k2][2], s[2 * k2][3]); pw.z = pk2(s[2 * k2 + 1][0], s[2 * k2 + 1][1]); pw.w = pk2(s[2 * k2 + 1][2], s[2 * k2 + 1][3]);
            const bf16x8 Pf = __builtin_bit_cast(bf16x8, pw);
#pragma unroll
            for (int d = 0; d < 4; ++d) {
                const LAS unsigned char* a0 = vb + (32 * k2 + 4 * fq + (fr >> 2)) * VROW + (d * 16 + 4 * (fr & 3)) * 2;
                const s16x4 lo = vtr(a0), hi = vtr(a0 + 16 * VROW);
                const bf16x8 Vf = (bf16x8){lo[0], lo[1], lo[2], lo[3], hi[0], hi[1], hi[2], hi[3]};
                Oa[d] = __builtin_amdgcn_mfma_f32_16x16x32_bf16(Vf, Pf, Oa[d], 0, 0, 0);
            }
        }
    }
    l += __shfl_xor(l, 16); l += __shfl_xor(l, 32);
    const float inv = 1.0f / l;
    __syncthreads();
    { LAS unsigned char* st = C.lds + C.wid * 2048;
#pragma unroll
        for (int d = 0; d < 4; ++d) { const f32x4 v = Oa[d] * inv; *(LAS u32x2*)(st + fr * 128 + (d * 16 + 4 * fq) * 2) = (u32x2){pk2(v.x, v.y), pk2(v.z, v.w)}; }
        asm volatile("s_waitcnt lgkmcnt(0)" ::: "memory");
#pragma unroll
        for (int i = 0; i < 2; ++i) { const int row = i * 8 + (C.lane >> 3), ch = C.lane & 7; const u32x4 v = *(const LAS u32x4*)(st + row * 128 + ch * 16);
            *(u32x4*)(D.O + (size_t)(C.wid * 16 + row) * D.ldo + ch * 8) = v; }
    }
    __syncthreads();
}

__device__ __forceinline__ void pool_unit(const Params& p, Ctx& C, int L, int unit) {
    const bf16_t* P = (const bf16_t*)(p.ws + WS_P); bf16_t* BR = (bf16_t*)(p.ws + WS_BR);
    { int t_ = threadIdx.x; asm volatile("" : "+v"(t_)); C.tid = t_; C.lane = t_ & 63; C.wid = __builtin_amdgcn_readfirstlane(t_ >> 6); }
    const int T0 = unit * 64; int S0, Ls; if (T0 < NCTX) { S0 = T0 & ~255; Ls = 256; } else { S0 = NCTX + ((T0 - NCTX) & ~2047); Ls = 2048; }
    LAS float* dlt = (LAS float*)C.lds;
    LAS bf16_t* raw = (LAS bf16_t*)(C.lds + 66048);
    LAS float* Wl = (LAS float*)(C.lds + 66048);
    f32x4 wreg[8];
    { const f32x4* Wg = (const f32x4*)(p.in[25] + (size_t)L * 4 * 64 * 64);
#pragma unroll
        for (int i = 0; i < 8; ++i) wreg[i] = Wg[C.tid + i * 512]; }
    for (int i = C.tid; i < 80 * 32; i += 512) { const int r = i >> 5, c = i & 31; const int T = T0 - 8 + r;
        u32x4 v = (u32x4){0u, 0u, 0u, 0u}; if (T >= S0 && T < S0 + Ls) v = *(const u32x4*)(P + (size_t)T * LDP + COL_PD + c * 8);
        *(LAS u32x4*)(raw + r * 256 + c * 8) = v; }
    __syncthreads();
    for (int i = C.tid; i < 64 * 256; i += 512) { const int t = i >> 8, ch = i & 255, gi = ch >> 6; const int hw = 1 << gi, w = 2 << gi;
        const int tl = T0 - S0 + t; const int lo = max(tl - hw, 0), hi = min(tl - hw + w, Ls);
        float s = 0.f; for (int j = lo; j < hi; ++j) s += bf2f(raw[(j - (T0 - S0) + 8) * 256 + ch]);
        dlt[t * 257 + ch] = s / (float)(hi - lo) - bf2f(raw[(t + 8) * 256 + ch]); }
    __syncthreads();
#pragma unroll
    for (int i = 0; i < 8; ++i) ((LAS f32x4*)Wl)[C.tid + i * 512] = wreg[i];
    __syncthreads();
    { const int t = C.lane, gi = C.wid & 3, e0 = (C.wid >> 2) * 32;
        const LAS float* W = Wl + gi * 4096 + e0;
        float a[32];
#pragma unroll
        for (int e = 0; e < 32; ++e) a[e] = 0.f;
#pragma unroll 4
        for (int c = 0; c < 64; ++c) { const float d = dlt[t * 257 + gi * 64 + c];
#pragma unroll
            for (int e4 = 0; e4 < 8; ++e4) { const f32x4 w4 = *(const LAS f32x4*)(W + c * 64 + e4 * 4); a[e4 * 4] += d * w4.x; a[e4 * 4 + 1] += d * w4.y; a[e4 * 4 + 2] += d * w4.z; a[e4 * 4 + 3] += d * w4.w; } }
        const float* sc = p.in[26] + L * 256 + gi * 64 + e0;
        bf16_t* orow = BR + (size_t)(T0 + t) * LDH + 768 + gi * 64 + e0;
#pragma unroll
        for (int e = 0; e < 32; e += 8) *(u32x4*)(orow + e) = (u32x4){pk2(a[e] * sc[e], a[e + 1] * sc[e + 1]), pk2(a[e + 2] * sc[e + 2], a[e + 3] * sc[e + 3]), pk2(a[e + 4] * sc[e + 4], a[e + 5] * sc[e + 5]), pk2(a[e + 6] * sc[e + 6], a[e + 7] * sc[e + 7])};
    }
    __syncthreads();
}

__device__ __forceinline__ void phase4(const Params& p, Ctx& C, int L, int rep = 0) {
    const bf16_t* P = (const bf16_t*)(p.ws + WS_P); bf16_t* BR = (bf16_t*)(p.ws + WS_BR);
    const bf16_t* QUP = (const bf16_t*)(p.ws + WS_QUP); const bf16_t* KVUP = (const bf16_t*)(p.ws + WS_KVUP);
    const bf16_t* KVC = (const bf16_t*)(p.ws + WS_KVCUP) + (size_t)L * 512 * LDKV;
    const bf16_t* NAK = (const bf16_t*)(p.ws + WS_NACK) + (size_t)L * 512 * LDNAC; const bf16_t* NAV = (const bf16_t*)(p.ws + WS_NACV) + (size_t)L * 512 * LDNAC;
    const bf16_t* SWK = (const bf16_t*)(p.ws + WS_SWCK) + (size_t)L * 512 * LDSWC; const bf16_t* SWV = (const bf16_t*)(p.ws + WS_SWCV) + (size_t)L * 512 * LDSWC;
    const bf16_t* KRC = (const bf16_t*)(p.ws + WS_KRC) + (size_t)L * 512 * 32;
    unsigned* qhead = (unsigned*)(p.ws + WS_CTL) + CW_QUEUE + 64 * (L * 2 + rep);
    volatile LAS unsigned* bc = (volatile LAS unsigned*)(C.lds + LDS_CTL + 16);
    LAS float* rpb = (LAS float*)(C.lds + LDS_TAB);
    const float ATT_C1 = 0.125f * LOG2E, MLA_C1 = 0.10206207261596575f * LOG2E;
    for (;;) {
        if (C.tid == 0) bc[0] = atomicAdd(qhead, 1u);
        __syncthreads();
        const int u = __builtin_amdgcn_readfirstlane((int)bc[0]);
        __syncthreads();
        if (u >= 1344) break;
        AttnDesc D; D.rope_q = 0; D.m0 = -1e30f; D.l0 = 0.f; D.seg[1].K2 = nullptr; D.seg[0].K2 = nullptr; D.seg[0].ldk2 = 0; D.seg[1].ldk2 = 0; D.seg[0].tok0 = 0; D.seg[1].tok0 = 0;
        if (u < 128) {
            const int b = u >> 6, h = (u >> 4) & 3, qb = u & 15; const int T0 = NCTX + b * 2048;
            D.Q = QUP + (size_t)(T0 + qb * 128) * LDQ + h * 96; D.ldq = LDQ; D.O = BR + (size_t)(T0 + qb * 128) * LDH + 256 + h * 64; D.ldo = LDH;
            D.seg[0] = AttnSeg{KVC + (size_t)b * 256 * LDKV + h * 128, KRC + (size_t)b * 256 * 32, KVC + (size_t)b * 256 * LDKV + h * 128 + 64, LDKV, 32, LDKV, 256, 0};
            D.seg[1] = AttnSeg{KVUP + (size_t)T0 * LDKV + h * 128, P + (size_t)T0 * LDP + COL_KR, KVUP + (size_t)T0 * LDKV + h * 128 + 64, LDKV, LDP, LDKV, 2048, 0};
            D.c1 = MLA_C1; D.qtok0 = qb * 128; D.rope_q = 1;
#ifndef NO_A1
            attn_unit<96, 0>(C, D, rpb);
#endif
        } else if (u < 256) {
            const int v = u - 128, b = v >> 6, h = (v >> 4) & 3, rp = v & 15; const int T0 = NCTX + b * 2048;
            const int ra = 2 * rp, r0a = min(max(ra - 4, 0), 24), r0b = min(max(ra + 1 - 4, 0), 24);
            for (int i = C.tid; i < 15 * 31; i += 512) rpb[i] = p.in[19][(size_t)(L * 4 + h) * 465 + i] * LOG2E;
            D.Q = P + (size_t)(T0 + ra * 64) * LDP + COL_QA + h * 64; D.ldq = LDP; D.O = BR + (size_t)(T0 + ra * 64) * LDH + 0 + h * 64; D.ldo = LDH;
            D.seg[0] = AttnSeg{NAK + (size_t)b * 256 * LDNAC + h * 64, nullptr, NAV + (size_t)b * 256 * LDNAC + h * 64, LDNAC, 0, LDNAC, 256, 0};
            D.seg[1] = AttnSeg{P + (size_t)(T0 + r0a * 64) * LDP + COL_KA + h * 64, nullptr, P + (size_t)(T0 + r0a * 64) * LDP + COL_VA + h * 64, LDP, 0, LDP, (r0b + 8 - r0a) * 64, r0a * 64};
            D.c1 = ATT_C1; D.qtok0 = ra * 64;
            __syncthreads();
#ifndef NO_A2
            attn_unit<64, 1>(C, D, rpb);
#endif
        } else if (u < 384) {
            const int v = u - 256, b = v >> 6, h = (v >> 4) & 3, qb = v & 15; const int T0 = NCTX + b * 2048, kvh = h >> 1;
            const int klo = max(qb * 128 - 128, 0), khi = min(qb * 128 + 256, 2048);
            D.Q = P + (size_t)(T0 + qb * 128) * LDP + COL_QC + h * 64; D.ldq = LDP; D.O = BR + (size_t)(T0 + qb * 128) * LDH + 512 + h * 64; D.ldo = LDH;
            D.seg[0] = AttnSeg{SWK + (size_t)b * 256 * LDSWC + kvh * 64, nullptr, SWV + (size_t)b * 256 * LDSWC + kvh * 64, LDSWC, 0, LDSWC, 256, 0};
            D.seg[1] = AttnSeg{P + (size_t)(T0 + klo) * LDP + COL_KC + kvh * 64, nullptr, P + (size_t)(T0 + klo) * LDP + COL_VC + kvh * 64, LDP, 0, LDP, khi - klo, klo};
            D.c1 = ATT_C1; D.qtok0 = qb * 128; D.m0 = p.in[24][L * 4 + h] * LOG2E; D.l0 = 1.0f;
#ifndef NO_A3
            attn_unit<64, 2>(C, D, rpb);
#endif
        } else if (u >= 576) {
            const int v = u - 576, half = v & 1, kh = (v >> 1) % 12, b = (v >> 1) / 12, kind = kh >> 2, h = kh & 3; const int T0 = b * 256, Tq = T0 + half * 128;
            D.qtok0 = half * 128; D.seg[1].n = 0; D.seg[1].K = nullptr; D.seg[1].V = nullptr; D.seg[1].ldk = 0; D.seg[1].ldv = 0;
            if (kind == 0) {
                D.Q = P + (size_t)Tq * LDP + COL_QA + h * 64; D.ldq = LDP; D.O = BR + (size_t)Tq * LDH + h * 64; D.ldo = LDH;
                D.seg[0] = AttnSeg{P + (size_t)T0 * LDP + COL_KA + h * 64, nullptr, P + (size_t)T0 * LDP + COL_VA + h * 64, LDP, 0, LDP, 256, 0};
#ifndef NO_A4
                D.c1 = ATT_C1; attn_unit<64, 0>(C, D, rpb);
#endif
            } else if (kind == 1) {
                D.Q = QUP + (size_t)Tq * LDQ + h * 96; D.ldq = LDQ; D.O = BR + (size_t)Tq * LDH + 256 + h * 64; D.ldo = LDH;
                D.seg[0] = AttnSeg{KVUP + (size_t)T0 * LDKV + h * 128, P + (size_t)T0 * LDP + COL_KR, KVUP + (size_t)T0 * LDKV + h * 128 + 64, LDKV, LDP, LDKV, 256, 0};
#ifndef NO_A5
                D.c1 = MLA_C1; attn_unit<96, 0>(C, D, rpb);
#endif
            } else {
                const int kvh = h >> 1;
                D.Q = P + (size_t)Tq * LDP + COL_QC + h * 64; D.ldq = LDP; D.O = BR + (size_t)Tq * LDH + 512 + h * 64; D.ldo = LDH;
                D.seg[0] = AttnSeg{P + (size_t)T0 * LDP + COL_KC + kvh * 64, nullptr, P + (size_t)T0 * LDP + COL_VC + kvh * 64, LDP, 0, LDP, 256, 0};
#ifndef NO_A6
                D.c1 = ATT_C1; D.m0 = p.in[24][L * 4 + h] * LOG2E; D.l0 = 1.0f; attn_unit<64, 0>(C, D, rpb);
#endif
            }
        } else {
#ifndef NO_POOL
            pool_unit(p, C, L, u - 384);
#endif
        }
    }
}

__device__ __forceinline__ void phase5(const Params& p, Ctx& C, int L) {
    const char* H = (const char*)(p.ws + WS_H8); const char* BRp = (const char*)(p.ws + WS_BR);
    const unsigned char* wb = p.ws + WS_W + (size_t)L * W_LAYER;
    const char* Wg = (const char*)(wb + WO_GATE); const char* Wb = (const char*)(wb + WO_BR);
    bf16_t* MG = (bf16_t*)(p.ws + WS_MERGED);
    LAS float* bl = (LAS float*)(C.lds + 131072);
    { const float* bg = p.in[18] + (size_t)L * 4096; for (int i = C.tid; i < 1024; i += 512) ((LAS f32x4*)bl)[i] = ((const f32x4*)bg)[i]; }
    __syncthreads();
    const int wr = C.wid >> 2, wc = C.wid & 3;
    int R, Cc; stage_rc(C.wid * 1024 + C.lane * 16, R, Cc);
    const int Rb = (R & ~31) + perm32(R & 31);
    const unsigned offA = (unsigned)(R * LDH + Cc) * 2u, offBb = (unsigned)(Rb * LDWB + Cc) * 2u;
    const unsigned offA8 = (unsigned)(R * LD8 + Cc * 2), offBg = (unsigned)(Rb * LD8 + Cc * 2);
    constexpr int TPU = 48;
    const int nunits = (768 - C.bid + C.G - 1) / C.G, NT = nunits * TPU;
    if (nunits <= 0) return;
    int s_i = 0, s_t = 0; const char *sAh, *sAb, *sWg, *sWb;
#define SET_STAGE_UNIT(i_) do { int pm_, pn_; unit_map(C.bid + (i_) * C.G, 96, 8, pm_, pn_); sAh = H + (size_t)pm_ * 128 * LD8; sAb = BRp + (size_t)pm_ * 128 * LDH * 2; \
        sWg = Wg + (size_t)pn_ * 128 * LD8; sWb = Wb + (size_t)pn_ * 128 * LDWB * 2; } while (0)
#define STAGE_TILE(buf_) do { const int k_ = s_t / 12, w_ = s_t % 12; LAS unsigned char* base_ = C.lds + (buf_) * 32768 + C.wid * 1024; \
        if (w_ < 8) { const char* a_ = sAh + w_ * 128 + offA8; const char* b_ = sWg + (size_t)k_ * 1024 * LD8 + w_ * 128 + offBg; \
            GLDS16(a_, base_); GLDS16(a_ + 64 * LD8, base_ + 8192); GLDS16(b_, base_ + 16384); GLDS16(b_ + 64 * LD8, base_ + 16384 + 8192); } \
        else { const char* a_ = sAb + (k_ * 256 + (w_ - 8) * 64) * 2 + offA; const char* b_ = sWb + (size_t)k_ * 1024 * LDWB * 2 + (w_ - 8) * 128 + offBb; \
            GLDS16(a_, base_); GLDS16(a_ + 64 * LDH * 2, base_ + 8192); GLDS16(b_, base_ + 16384); GLDS16(b_ + 64 * LDWB * 2, base_ + 16384 + 8192); } \
        if (++s_t == TPU) { s_t = 0; ++s_i; if (s_i < nunits) SET_STAGE_UNIT(s_i); } } while (0)
    SET_STAGE_UNIT(0);
    STAGE_TILE(0); STAGE_TILE(1); STAGE_TILE(2);
    int c_i = 0, c_t = 0, pm, pn; unit_map(C.bid, 96, 8, pm, pn);
    f32x4 acc[4][2], mg[4][2]; u32x2 gp[4][2];
    ZERO_ACC(acc, 4, 2); ZERO_ACC(mg, 4, 2);
    asm volatile("s_waitcnt vmcnt(8)\n\ts_barrier" ::: "memory");
    if (wr == 1) asm volatile("s_barrier" ::: "memory");
    const int ao = lds_byte(wr * 64 + C.fr, C.fq * 8), bo = lds_byte(wc * 32 + C.fr, C.fq * 8);
#pragma unroll 1
    for (int gt = 0; gt < NT; ++gt) {
        STAGE_TILE((gt + 3) & 3);
        const LAS unsigned char* sa = C.lds + (gt & 3) * 32768; const LAS unsigned char* sb = sa + 16384;
        bf16x8 Af[2][4], Bf[2][2];
#pragma unroll
        for (int ks = 0; ks < 2; ++ks) {
#pragma unroll
            for (int n = 0; n < 2; ++n) Bf[ks][n] = *(const LAS bf16x8*)(sb + bo + n * 2048 + ks * 1024);
#pragma unroll
            for (int m = 0; m < 4; ++m) Af[ks][m] = *(const LAS bf16x8*)(sa + ao + m * 2048 + ks * 1024);
        }
        asm volatile("s_waitcnt vmcnt(8) lgkmcnt(0)\n\ts_barrier" ::: "memory");
        const int k = c_t / 12, w = c_t % 12;
        __builtin_amdgcn_s_setprio(1);
        if (w < 8) {
#pragma unroll
            for (int m = 0; m < 4; ++m)
#pragma unroll
                for (int n = 0; n < 2; ++n) { const u32x4 b0 = __builtin_bit_cast(u32x4, Bf[0][n]), b1 = __builtin_bit_cast(u32x4, Bf[1][n]), a0 = __builtin_bit_cast(u32x4, Af[0][m]), a1 = __builtin_bit_cast(u32x4, Af[1][m]);
                    const i32x8 bb = (i32x8){(int)b0.x, (int)b0.y, (int)b0.z, (int)b0.w, (int)b1.x, (int)b1.y, (int)b1.z, (int)b1.w}, aa = (i32x8){(int)a0.x, (int)a0.y, (int)a0.z, (int)a0.w, (int)a1.x, (int)a1.y, (int)a1.z, (int)a1.w};
                    acc[m][n] = __builtin_amdgcn_mfma_scale_f32_16x16x128_f8f6f4(bb, aa, acc[m][n], 0, 0, 0, 0, 0, 0); }
        } else {
#pragma unroll
            for (int ks = 0; ks < 2; ++ks)
#pragma unroll
                for (int m = 0; m < 4; ++m)
#pragma unroll
                    for (int n = 0; n < 2; ++n) acc[m][n] = __builtin_amdgcn_mfma_f32_16x16x32_bf16(Bf[ks][n], Af[ks][m], acc[m][n], 0, 0, 0);
        }
        __builtin_amdgcn_s_setprio(0);
        if (w == 7) {
#pragma unroll
            for (int n = 0; n < 2; ++n) { const f32x4 bv = *(const LAS f32x4*)(bl + k * 1024 + pn * 128 + wc * 32 + 8 * C.fq + 4 * n);
#pragma unroll
                for (int m = 0; m < 4; ++m) { const f32x4 v = acc[m][n] * 0.03125f + bv; gp[m][n] = (u32x2){pk2(sigmoidf_(v.x), sigmoidf_(v.y)), pk2(sigmoidf_(v.z), sigmoidf_(v.w))}; acc[m][n] = (f32x4){0.f, 0.f, 0.f, 0.f}; } }
        } else if (w == 11) {
#pragma unroll
            for (int m = 0; m < 4; ++m)
#pragma unroll
                for (int n = 0; n < 2; ++n) { const u32x2 g = gp[m][n]; const f32x4 gv = (f32x4){lo16(g.x), hi16(g.x), lo16(g.y), hi16(g.y)}; mg[m][n] += gv * acc[m][n]; acc[m][n] = (f32x4){0.f, 0.f, 0.f, 0.f}; }
            if (k == 3) {
#pragma unroll
                for (int m = 0; m < 4; ++m) { const int row = pm * 128 + wr * 64 + m * 16 + C.fr, col = pn * 128 + wc * 32 + 8 * C.fq; const f32x4 v0 = mg[m][0], v1 = mg[m][1];
                    *(u32x4*)(MG + (size_t)row * LDH + col) = (u32x4){pk2(v0.x, v0.y), pk2(v0.z, v0.w), pk2(v1.x, v1.y), pk2(v1.z, v1.w)};
                    mg[m][0] = (f32x4){0.f, 0.f, 0.f, 0.f}; mg[m][1] = (f32x4){0.f, 0.f, 0.f, 0.f}; }
            }
        }
        if (++c_t == TPU) { c_t = 0; ++c_i; if (c_i < nunits) unit_map(C.bid + c_i * C.G, 96, 8, pm, pn); }
        asm volatile("s_waitcnt lgkmcnt(0)\n\ts_barrier" ::: "memory");
    }
    if (wr == 0) asm volatile("s_barrier" ::: "memory");
    asm volatile("s_waitcnt vmcnt(0)" ::: "memory");
    __syncthreads();
#undef SET_STAGE_UNIT
#undef STAGE_TILE
}

__device__ __forceinline__ void gemm_bf16_phase(Ctx& C, const bf16_t* A, int lda, const bf16_t* Bt, int ldb, int K, bf16_t* O, int ldo, int nM, int nN) {
    TileSched S{(const char*)A, (const char*)Bt, (size_t)256 * lda * 2, (size_t)256 * ldb * 2, nM, nN, C.G, C.bid};
    EpiBf16 E{O, ldo};
    gemm8(C, K, lda, ldb, S, E);
}


struct RowSumSq {
    float* xbuf;
    unsigned* cnt;
    __device__ __forceinline__ void run(const Ctx& C, const f32x4 (&v)[2][2][4][2], int pm, int pn, int wr, int wc, int fr, int fq, float (&rs)[2][4]) const {
        LAS float* P = (LAS float*)C.lds;
        LAS float* S = (LAS float*)(C.lds + 4096);
#pragma unroll
        for (int ai = 0; ai < 2; ++ai)
#pragma unroll
            for (int m = 0; m < 4; ++m) { float s = 0.f;
#pragma unroll
                for (int bj = 0; bj < 2; ++bj)
#pragma unroll
                    for (int n = 0; n < 2; ++n) { const f32x4 x = v[ai][bj][m][n]; s += (x[0] * x[0] + x[1] * x[1]) + (x[2] * x[2] + x[3] * x[3]); }
                s += __shfl_xor(s, 16); s += __shfl_xor(s, 32);
                if (fq == 0) P[(ai * 128 + wr * 64 + m * 16 + fr) * 4 + wc] = s; }
        asm volatile("s_waitcnt lgkmcnt(0)" ::: "memory"); __builtin_amdgcn_s_barrier(); asm volatile("" ::: "memory");
        const int row = C.wid * 32 + (C.lane & 31);
        if (C.lane < 32) { const float t = (P[row * 4 + 0] + P[row * 4 + 1]) + (P[row * 4 + 2] + P[row * 4 + 3]);
            __hip_atomic_store(xbuf + ((size_t)(pm * 256 + row) * 4 + pn), t, __ATOMIC_RELAXED, __HIP_MEMORY_SCOPE_AGENT); }
        asm volatile("s_waitcnt vmcnt(0)" ::: "memory");
        if (C.lane == 0) __hip_atomic_fetch_add(cnt + 64 * pm, 1u, __ATOMIC_RELAXED, __HIP_MEMORY_SCOPE_AGENT);
        if (C.wid == 0) {
            unsigned spins = 0;
            while ((unsigned)__builtin_amdgcn_readfirstlane(__hip_atomic_load(cnt + 64 * pm, __ATOMIC_RELAXED, __HIP_MEMORY_SCOPE_AGENT)) < 32u) { __builtin_amdgcn_s_sleep(2); if (++spins > (1u << 22)) break; }
            __builtin_amdgcn_fence(__ATOMIC_ACQUIRE, "agent");
        }
        asm volatile("s_waitcnt vmcnt(0) lgkmcnt(0)" ::: "memory"); __builtin_amdgcn_s_barrier(); asm volatile("" ::: "memory");
        if (C.lane < 32) { const float* slot = xbuf + (size_t)(pm * 256 + row) * 4; float t = 0.f;
#pragma unroll
            for (int q = 0; q < 4; ++q) t += __hip_atomic_load(slot + q, __ATOMIC_RELAXED, __HIP_MEMORY_SCOPE_AGENT);
            S[row] = t; }
        asm volatile("s_waitcnt vmcnt(0) lgkmcnt(0)" ::: "memory"); __builtin_amdgcn_s_barrier(); asm volatile("" ::: "memory");
#pragma unroll
        for (int ai = 0; ai < 2; ++ai)
#pragma unroll
            for (int m = 0; m < 4; ++m) rs[ai][m] = S[ai * 128 + wr * 64 + m * 16 + fr];
        asm volatile("s_waitcnt lgkmcnt(0)" ::: "memory"); __builtin_amdgcn_s_barrier(); asm volatile("" ::: "memory");
    }
};
template <int MODE> struct EpiNormFused {
    static constexpr bool PERM = true, AFTER_DRAIN = true; G8_EPI_PLAIN
    const Params& p; int L;
    __device__ __forceinline__ void drained(const Ctx& C, f32x4 (&acc)[2][2][4][2], const G8Unit& u, int wr, int wc, int fr, int fq) const {
        const int pm = u.e0, pn = u.e1, cls = pm < 32 ? 0 : 1 + ((pm - 32) >> 3);
        unsigned* ctl = (unsigned*)(p.ws + WS_CTL);
        const float* modv = (const float*)(p.ws + WS_MODV);
        const float* mv = modv + (size_t)(L * 3 + cls) * 6144;
        float* Y = p.out + OFF_Y; bf16_t* H = (bf16_t*)(p.ws + WS_H);
        const float* gpost = (MODE == 0 ? p.in[13] : p.in[15]) + L * DM;
        const float* gate = mv + (MODE == 0 ? 2048 : 5120);
        const float* xpan = (MODE == 0 && L == 0) ? (pm < 32 ? p.in[0] + (size_t)pm * 256 * DM : p.in[1] + (size_t)(pm - 32) * 256 * DM) : Y + (size_t)pm * 256 * DM;
        float* ypan = Y + (size_t)pm * 256 * DM; bf16_t* hpan = H + (size_t)pm * 256 * LDH; unsigned char* h8pan = p.ws + WS_H8 + (size_t)pm * 256 * LD8;
        float rs[2][4];
        { RowSumSq X{(float*)(ctl + CW_XBUF), ctl + CW_SEAM + ((L * 2 + MODE) * 2 + 0) * 48 * 64}; X.run(C, acc, pm, pn, wr, wc, fr, fq, rs); }
#pragma unroll
        for (int ai = 0; ai < 2; ++ai)
#pragma unroll
            for (int m = 0; m < 4; ++m) rs[ai][m] = __builtin_amdgcn_rsqf(rs[ai][m] * (1.0f / DM) + EPS);
#pragma unroll
        for (int bj = 0; bj < 2; ++bj) { const int col = pn * 256 + bj * 128 + wc * 32 + 8 * fq;
            const f32x4 gp0 = *(const f32x4*)(gpost + col), gp1 = *(const f32x4*)(gpost + col + 4), g0 = *(const f32x4*)(gate + col), g1 = *(const f32x4*)(gate + col + 4);
#pragma unroll
            for (int ai = 0; ai < 2; ++ai)
#pragma unroll
                for (int m = 0; m < 4; ++m) { const int off = (ai * 128 + wr * 64 + m * 16 + fr) * DM + col;
                    const f32x4 x0 = *(const f32x4*)(xpan + off), x1 = *(const f32x4*)(xpan + off + 4);
                    acc[ai][bj][m][0] = x0 + g0 * (acc[ai][bj][m][0] * rs[ai][m] * gp0);
                    acc[ai][bj][m][1] = x1 + g1 * (acc[ai][bj][m][1] * rs[ai][m] * gp1);
                    asm volatile("" : "+v"(acc[ai][bj][m][0]), "+v"(acc[ai][bj][m][1]));
                    if (m & 1) asm volatile("" ::: "memory"); } }
        const bool second = (MODE == 0) || (L == 0);
        if (second) { RowSumSq X{(float*)(ctl + CW_XBUF) + 48 * 256 * 4, ctl + CW_SEAM + ((L * 2 + MODE) * 2 + 1) * 48 * 64}; X.run(C, acc, pm, pn, wr, wc, fr, fq, rs);
#pragma unroll
            for (int ai = 0; ai < 2; ++ai)
#pragma unroll
                for (int m = 0; m < 4; ++m) rs[ai][m] = __builtin_amdgcn_rsqf(rs[ai][m] * (1.0f / DM) + EPS); }
        const float* mvn = (MODE == 0) ? mv : modv + (size_t)(1 * 3 + cls) * 6144;
        const float* gpre = (MODE == 0) ? p.in[14] + L * DM : p.in[12] + DM;
        const float* scv = mvn + (MODE == 0 ? 4096 : 1024); const float* shv = mvn + (MODE == 0 ? 3072 : 0);
#pragma unroll
        for (int bj = 0; bj < 2; ++bj) { const int col = pn * 256 + bj * 128 + wc * 32 + 8 * fq;
            const f32x4 z = (f32x4){0.f, 0.f, 0.f, 0.f};
            f32x4 gg0 = z, gg1 = z, sa0 = z, sa1 = z, sb0 = z, sb1 = z;
            if (second) { gg0 = *(const f32x4*)(gpre + col); gg1 = *(const f32x4*)(gpre + col + 4); sa0 = *(const f32x4*)(scv + col) + 1.0f; sa1 = *(const f32x4*)(scv + col + 4) + 1.0f; sb0 = *(const f32x4*)(shv + col); sb1 = *(const f32x4*)(shv + col + 4); }
#pragma unroll
            for (int ai = 0; ai < 2; ++ai)
#pragma unroll
                for (int m = 0; m < 4; ++m) { const int rl = ai * 128 + wr * 64 + m * 16 + fr; const f32x4 v0 = acc[ai][bj][m][0], v1 = acc[ai][bj][m][1];
                    *(f32x4*)(ypan + rl * DM + col) = v0; *(f32x4*)(ypan + rl * DM + col + 4) = v1;
                    if (second) { const f32x4 h0 = v0 * rs[ai][m] * gg0 * sa0 + sb0, h1 = v1 * rs[ai][m] * gg1 * sa1 + sb1;
                        *(u32x4*)(hpan + rl * LDH + col) = (u32x4){pk2(h0.x, h0.y), pk2(h0.z, h0.w), pk2(h1.x, h1.y), pk2(h1.z, h1.w)};
                        if (MODE == 1) { int w0 = __builtin_amdgcn_cvt_pk_fp8_f32(h0.x, h0.y, 0, false); w0 = __builtin_amdgcn_cvt_pk_fp8_f32(h0.z, h0.w, w0, true);
                            int w1 = __builtin_amdgcn_cvt_pk_fp8_f32(h1.x, h1.y, 0, false); w1 = __builtin_amdgcn_cvt_pk_fp8_f32(h1.z, h1.w, w1, true);
                            *(u32x2*)(h8pan + rl * LD8 + col) = (u32x2){(unsigned)w0, (unsigned)w1}; } }
                    asm volatile("" ::: "memory"); } }
    }
};
template <int MODE> __device__ __forceinline__ void gemm_norm_phase(const Params& p, Ctx& C, int L, const bf16_t* A, int lda, const bf16_t* Bt, int ldb, int K) {
    TileSched S{(const char*)A, (const char*)Bt, (size_t)256 * lda * 2, (size_t)256 * ldb * 2, 48, 4, C.G, C.bid};
    EpiNormFused<MODE> E{p, L};
    gemm8(C, K, lda, ldb, S, E);
}

struct OneUnit { G8Unit u; __device__ __forceinline__ bool next(int i, G8Unit& o) const { if (i > 0) return false; o = u; return true; } };
struct EpiUpConv {
    static constexpr bool PERM = false, AFTER_DRAIN = true; G8_EPI_PLAIN
    bf16_t* ACT; const float* cw;
    __device__ __forceinline__ void drained(const Ctx& C, const f32x4 (&acc)[2][2][4][2], const G8Unit& u, int wr, int wc, int fr, int fq) const {
        constexpr int UROW = 528;
        const int Trow0 = u.e0, pn = u.e1, tpos0 = u.e2, Ls = u.e3;
#pragma unroll
        for (int ai = 0; ai < 2; ++ai)
#pragma unroll
            for (int m = 0; m < 4; ++m) { const int r = ai * 128 + wr * 64 + m * 16 + fr;
#pragma unroll
                for (int bj = 0; bj < 2; ++bj)
#pragma unroll
                    for (int n = 0; n < 2; ++n) { const int c = bj * 128 + wc * 32 + n * 16 + 4 * fq; const f32x4 v = acc[ai][bj][m][n]; *(LAS u32x2*)(C.lds + r * UROW + c * 2) = (u32x2){pk2(v.x, v.y), pk2(v.z, v.w)}; } }
        __syncthreads();
        {
            const int cc = C.tid & 15, rg = C.tid >> 4;
            const int f0 = pn * 128 + cc * 8;
            float wa[3][8], wg[3][8];
#pragma unroll
            for (int j = 0; j < 3; ++j)
#pragma unroll
                for (int e = 0; e < 8; ++e) { const bool ok = (f0 + e) < DFF; wa[j][e] = ok ? cw[j * 5504 + f0 + e] : 0.f; wg[j][e] = ok ? cw[j * 5504 + DFF + f0 + e] : 0.f; }
            for (int ps = 0; ps < 8; ++ps) {
                const int r = ps * 32 + rg, tpos = tpos0 + r;
                const bool valid = (r > 0 || tpos == 0) && (r < 255 || tpos == Ls - 1);
                if (!valid) continue;
                const bool hasl = tpos > 0, hasr = tpos < Ls - 1;
                const LAS unsigned char* base = C.lds + r * UROW + cc * 16;
                const u32x4 z = (u32x4){0u, 0u, 0u, 0u};
                const u32x4 a0 = hasl ? *(const LAS u32x4*)(base - UROW) : z, a1 = *(const LAS u32x4*)base, a2 = hasr ? *(const LAS u32x4*)(base + UROW) : z;
                const u32x4 g0 = hasl ? *(const LAS u32x4*)(base - UROW + 256) : z, g1 = *(const LAS u32x4*)(base + 256), g2 = hasr ? *(const LAS u32x4*)(base + UROW + 256) : z;
                float o[8];
#pragma unroll
                for (int e = 0; e < 8; ++e) {
                    const unsigned ua0 = a0[e >> 1], ua1 = a1[e >> 1], ua2 = a2[e >> 1], ug0 = g0[e >> 1], ug1 = g1[e >> 1], ug2 = g2[e >> 1];
                    const float xa0 = (e & 1) ? hi16(ua0) : lo16(ua0), xa1 = (e & 1) ? hi16(ua1) : lo16(ua1), xa2 = (e & 1) ? hi16(ua2) : lo16(ua2);
                    const float xg0 = (e & 1) ? hi16(ug0) : lo16(ug0), xg1 = (e & 1) ? hi16(ug1) : lo16(ug1), xg2 = (e & 1) ? hi16(ug2) : lo16(ug2);
                    const float av = xa0 * wa[0][e] + xa1 * wa[1][e] + xa2 * wa[2][e];
                    const float gv = xg0 * wg[0][e] + xg1 * wg[1][e] + xg2 * wg[2][e];
                    o[e] = siluf_(gv) * av;
                }
                *(u32x4*)(ACT + (size_t)(Trow0 + r) * LDACT + f0) = (u32x4){pk2(o[0], o[1]), pk2(o[2], o[3]), pk2(o[4], o[5]), pk2(o[6], o[7])};
            }
        }
        __syncthreads();
    }
};
__device__ __forceinline__ float dpp_ror1(float x) { return __int_as_float(__builtin_amdgcn_update_dpp(0, __float_as_int(x), 0x121, 0xf, 0xf, false)); }
__device__ __forceinline__ float dpp_ror15(float x) { return __int_as_float(__builtin_amdgcn_update_dpp(0, __float_as_int(x), 0x12F, 0xf, 0xf, false)); }
struct EpiUpConvReg {
    static constexpr bool PERM = true, AFTER_DRAIN = false; G8_EPI_PLAIN
    bf16_t* ACT; const float* cw; LAS unsigned* halo;
    __device__ __forceinline__ void operator()(const f32x4 (&acc)[2][2][4][2], const G8Unit& u, int wr, int wc, int fr_, int fq_) const {
        int fr = fr_, fq = fq_; asm volatile("" : "+v"(fr), "+v"(fq));
        const int Trow0 = u.e0, pn = u.e1, tpos0 = u.e2, Ls = u.e3;
        const int cl = wc * 32 + 8 * fq;
        unsigned xp[2][4][2][4];
#pragma unroll
        for (int ai = 0; ai < 2; ++ai)
#pragma unroll
            for (int m = 0; m < 4; ++m)
#pragma unroll
                for (int n = 0; n < 2; ++n)
#pragma unroll
                    for (int j = 0; j < 4; ++j) { xp[ai][m][n][j] = pk2(acc[ai][0][m][n][j], acc[ai][1][m][n][j]); asm volatile("" : "+v"(xp[ai][m][n][j])); }
#pragma unroll
        for (int ai = 0; ai < 2; ++ai) { const int b = ai * 2 + wr;
#pragma unroll
            for (int n = 0; n < 2; ++n) {
                if (fr == 0) *(LAS u32x4*)(halo + (b * 2 + 0) * 128 + cl + 4 * n) = (u32x4){xp[ai][0][n][0], xp[ai][0][n][1], xp[ai][0][n][2], xp[ai][0][n][3]};
                if (fr == 15) *(LAS u32x4*)(halo + (b * 2 + 1) * 128 + cl + 4 * n) = (u32x4){xp[ai][3][n][0], xp[ai][3][n][1], xp[ai][3][n][2], xp[ai][3][n][3]};
            } }
        LAS float* cwl = (LAS float*)(halo + 1024);
        int tx = threadIdx.x; asm volatile("" : "+v"(tx));
        if (tx < 192) { const int jp = tx >> 5, ch = tx & 31, f = pn * 128 + ch * 4;
            const f32x4 v = (f < DFF) ? *(const f32x4*)(cw + (jp >> 1) * 5504 + (jp & 1) * DFF + f) : (f32x4){0.f, 0.f, 0.f, 0.f};
            *(LAS f32x4*)(cwl + jp * 128 + ch * 4) = v; }
        asm volatile("s_waitcnt vmcnt(0) lgkmcnt(0)\n\ts_barrier" ::: "memory");
        asm volatile("s_barrier" ::: "memory");
        const int f0 = pn * 128 + cl;
        const int src_up = ((fq << 4) | ((fr + 15) & 15)) << 2, src_dn = ((fq << 4) | ((fr + 1) & 15)) << 2;
        const bool seq_first = (tpos0 == 0), seq_last = (tpos0 + 256 == Ls);
        u32x2 pk0[2][4];
#pragma unroll
        for (int n = 0; n < 2; ++n) {
            f32x2 w0[4], w1[4], w2[4];
            { const f32x4 a0 = *(const LAS f32x4*)(cwl + 0 * 128 + cl + 4 * n), g0 = *(const LAS f32x4*)(cwl + 1 * 128 + cl + 4 * n);
                const f32x4 a1 = *(const LAS f32x4*)(cwl + 2 * 128 + cl + 4 * n), g1 = *(const LAS f32x4*)(cwl + 3 * 128 + cl + 4 * n);
                const f32x4 a2 = *(const LAS f32x4*)(cwl + 4 * 128 + cl + 4 * n), g2 = *(const LAS f32x4*)(cwl + 5 * 128 + cl + 4 * n);
#pragma unroll
                for (int j = 0; j < 4; ++j) { w0[j] = (f32x2){a0[j], g0[j]}; w1[j] = (f32x2){a1[j], g1[j]}; w2[j] = (f32x2){a2[j], g2[j]}; } }
#pragma unroll
            for (int ai = 0; ai < 2; ++ai) { const int b = ai * 2 + wr;
                u32x4 hup = (u32x4){0u, 0u, 0u, 0u}, hdn = hup;
                if (b > 0) hup = *(const LAS u32x4*)(halo + ((b - 1) * 2 + 1) * 128 + cl + 4 * n);
                if (b < 3) hdn = *(const LAS u32x4*)(halo + ((b + 1) * 2 + 0) * 128 + cl + 4 * n);
#pragma unroll
                for (int m = 0; m < 4; ++m) {
                    const int r = ai * 128 + wr * 64 + m * 16 + fr;
                    float o[4];
#pragma unroll
                    for (int j = 0; j < 4; ++j) {
                        const unsigned xc = xp[ai][m][n][j];
                        const unsigned pv = (m > 0) ? xp[ai][m > 0 ? m - 1 : 0][n][j] : hup[j], nv = (m < 3) ? xp[ai][m < 3 ? m + 1 : 3][n][j] : hdn[j];
                        unsigned upk = (unsigned)__builtin_amdgcn_update_dpp(0, (int)(fr == 15 ? pv : xc), 0x121, 0xf, 0xf, false);
                        unsigned dnk = (unsigned)__builtin_amdgcn_update_dpp(0, (int)(fr == 0 ? nv : xc), 0x12F, 0xf, 0xf, false);
                        if (ai == 0 && m == 0) { if (seq_first && r == 0) upk = 0u; }
                        if (ai == 1 && m == 3) { if (seq_last && r == 255) dnk = 0u; }
                        const f32x2 c2 = (f32x2){lo16(upk), hi16(upk)} * w0[j] + (f32x2){lo16(xc), hi16(xc)} * w1[j] + (f32x2){lo16(dnk), hi16(dnk)} * w2[j];
                        o[j] = siluf_(c2.y) * c2.x;
                    }
                    const u32x2 pkn = (u32x2){pk2(o[0], o[1]), pk2(o[2], o[3])};
                    if (n == 0) pk0[ai][m] = pkn;
                    else {
                        bool valid = true;
                        if (ai == 0 && m == 0) valid = (r > 0) || seq_first;
                        if (ai == 1 && m == 3) valid = (r < 255) || seq_last;
                        if (valid) *(u32x4*)(ACT + (size_t)(Trow0 + r) * LDACT + f0) = (u32x4){pk0[ai][m].x, pk0[ai][m].y, pkn.x, pkn.y};
                    }
                }
            }
        }
    }
};
struct UpSched {
    const char* H; const char* Wu; int G, c;
    __device__ __forceinline__ bool next(int i, G8Unit& u) const {
        const int Lu = i * G + c; if (Lu >= 50 * 22) return false;
        int mt, pn; unit_map(Lu, 50, 22, mt, pn);
        int Trow0, tpos0, Ls;
        if (mt < 32) { Trow0 = mt * 256; tpos0 = 0; Ls = 256; }
        else { const int v = mt - 32, b = v / 9, j = v % 9; tpos0 = (j < 8) ? 254 * j : 1792; Trow0 = NCTX + b * 2048 + tpos0; Ls = 2048; }
        u.A = H + (size_t)Trow0 * LDH * 2; u.B = Wu + (size_t)pn * 256 * LDW * 2; u.e0 = Trow0; u.e1 = pn; u.e2 = tpos0; u.e3 = Ls; return true;
    }
};
__device__ __forceinline__ void phase8(const Params& p, Ctx& C, int L) {
    UpSched S{(const char*)(p.ws + WS_H), (const char*)(p.ws + WS_W + (size_t)L * W_LAYER + WO_UP), C.G, C.bid};
    EpiUpConvReg E{(bf16_t*)(p.ws + WS_ACT), p.in[30] + (size_t)L * 3 * 5504, (LAS unsigned*)(C.lds + 131072)};
    gemm8(C, DM, LDH, LDW, S, E);
}

__global__ void __launch_bounds__(512, 2) mega_fwd(Params p) {
    extern __shared__ __attribute__((aligned(16))) unsigned char lds_raw[];
    Ctx C; C.lds = (LAS unsigned char*)lds_raw;
#define FRESH() do { int t_ = threadIdx.x; asm volatile("" : "+v"(t_)); C.tid = t_; C.lane = t_ & 63; C.wid = __builtin_amdgcn_readfirstlane(t_ >> 6); C.fr = C.lane & 15; C.fq = C.lane >> 4; } while (0)
    FRESH();
    C.G = gridDim.x; C.bid = blockIdx.x;
    if (C.tid < 16) ((LAS unsigned*)(C.lds + LDS_CTL))[C.tid] = 0u;
    __syncthreads();
    XcdBarrier bar = xcd_barrier_post((unsigned*)(p.ws + WS_CTL) + CW_BAR, (volatile LAS unsigned*)(C.lds + LDS_CTL));
#define GRID_BAR() do { xcd_barrier(bar); FRESH(); } while (0)
#ifndef PH
#define PH 0xffff
#endif
#ifndef DUP
#define DUP 0
#endif
    if (PH & 1) phase0(p, C); GRID_BAR();
    if (DUP & 1) { phase0(p, C); GRID_BAR(); }
    if (PH & 2) phase1(p, C); GRID_BAR();
    if (DUP & 2) { phase1(p, C); GRID_BAR(); }
#pragma unroll 1
    for (int L = 0; L < 2; ++L) {
        if (PH & 4) phase2(p, C, L); GRID_BAR();
        if (DUP & 4) { phase2(p, C, L); GRID_BAR(); }
        if (PH & 8) phase3(p, C, L); GRID_BAR();
        if (PH & 16) phase4(p, C, L); GRID_BAR();
        if (DUP & 16) { phase4(p, C, L, 1); GRID_BAR(); }
        if (PH & 32) phase5(p, C, L); GRID_BAR();
        if (DUP & 32) { phase5(p, C, L); GRID_BAR(); }
        gemm_norm_phase<0>(p, C, L, (const bf16_t*)(p.ws + WS_MERGED), LDH, (const bf16_t*)(p.ws + WS_W + (size_t)L * W_LAYER + WO_OUT), LDW, DM); GRID_BAR();
        if (PH & 256) phase8(p, C, L); GRID_BAR();
        if (DUP & 256) { phase8(p, C, L); GRID_BAR(); }
        gemm_norm_phase<1>(p, C, L, (const bf16_t*)(p.ws + WS_ACT), LDACT, (const bf16_t*)(p.ws + WS_W + (size_t)L * W_LAYER + WO_DOWN), LDWD, DFFP);
        if (L == 0) GRID_BAR();
    }
}

extern "C" void kernel_launch(void* const* d_in, const int* in_sizes, int n_in, void* d_out, int out_size, void* d_ws, size_t ws_size, hipStream_t stream) {
    static int grid = 0;
    if (grid == 0) {
        if (n_in != 32 || ws_size < WS_END) { fprintf(stderr, "kernel_launch: unexpected n_in %d / ws %zu\n", n_in, ws_size); grid = -1; return; }
        int dev = 0, cus = 0;
        if (hipGetDevice(&dev) != hipSuccess || hipDeviceGetAttribute(&cus, hipDeviceAttributeMultiprocessorCount, dev) != hipSuccess) { grid = -1; return; }
        if (hipFuncSetAttribute((const void*)mega_fwd, hipFuncAttributeMaxDynamicSharedMemorySize, LDS_BYTES) != hipSuccess) { fprintf(stderr, "kernel_launch: hipFuncSetAttribute failed\n"); grid = -1; return; }
        grid = cus;
    }
    if (grid < 0) return;
    (void)hipMemsetAsync((char*)d_ws + WS_CTL, 0, (size_t)(CW_SEAM + 384 * 64) * 4, stream);
    Params a{};
    for (int i = 0; i < 32; ++i) a.in[i] = (const float*)d_in[i];
    a.out = (float*)d_out; a.ws = (unsigned char*)d_ws;
    hipLaunchKernelGGL(mega_fwd, dim3(grid), dim3(512), LDS_BYTES, stream, a);
}
```

```cpp
#include <hip/hip_runtime.h>
#include <cstdio>
#include <cstdint>

#define LAS __attribute__((address_space(3)))
typedef unsigned short bf16_t;
typedef short bf16x8 __attribute__((ext_vector_type(8)));
typedef short s16x4 __attribute__((ext_vector_type(4)));
typedef float f32x4 __attribute__((ext_vector_type(4)));
typedef float f32x2 __attribute__((ext_vector_type(2)));
typedef unsigned u32x4 __attribute__((ext_vector_type(4)));
typedef unsigned u32x2 __attribute__((ext_vector_type(2)));
typedef __bf16 bf16x2_t __attribute__((ext_vector_type(2)));
#define LOG2E_ 1.4426950408889634f
typedef long lx2 __attribute__((ext_vector_type(2)));
typedef int i32x8 __attribute__((ext_vector_type(8)));
typedef int i32x4 __attribute__((ext_vector_type(4)));

constexpr int DM = 1024, NCTX = 8192, NLAT = 4096, NTOK = 12288;
constexpr int INP = 2048, IN_DIM = 1888, DFF = 2752, DFFP = 2816, NUP = 5632;
constexpr int LD8 = 1152;
constexpr int LDH = 1088, LDP = 1984, LDACT = 2880, LDQ = 448, LDKV = 576, LDW = 1088, LDWB = 320, LDWD = 2880, LDUQ = 192, LDUKV = 192, LDNAC = 320, LDSWC = 192, LDCKVC = 192, LDBK = 4160;
constexpr int COL_QA = 0, COL_KA = 256, COL_VA = 512, COL_CQ = 768, COL_CKV = 960, COL_KR = 1088, COL_QC = 1120, COL_KC = 1376, COL_VC = 1504, COL_PD = 1632;
constexpr float EPS = 1e-6f;
constexpr float LOG2E = 1.4426950408889634f;
constexpr size_t OFF_Y = 0, OFF_NAK = 12582912, OFF_NAV = 16777216, OFF_CKV = 20971520, OFF_KR = 23068672, OFF_SWK = 23592960, OFF_SWV = 25690112;

constexpr size_t MiB = 1u << 20;
constexpr size_t WS_CTL = 0, CTL_BYTES = 1 * MiB;
constexpr size_t WS_MODV = 1 * MiB;
constexpr size_t WS_NACK = 2 * MiB;
constexpr size_t WS_NACV = WS_NACK + 640 * 1024;
constexpr size_t WS_SWCK = WS_NACV + 640 * 1024;
constexpr size_t WS_SWCV = WS_SWCK + 384 * 1024;
constexpr size_t WS_CKVC = WS_SWCV + 384 * 1024;
constexpr size_t WS_KRC = WS_CKVC + 384 * 1024;
constexpr size_t WS_KVCUP = WS_KRC + 64 * 1024;
static_assert(WS_KVCUP + (size_t)2 * 512 * LDKV * 2 <= 6 * MiB, "cache region");
constexpr size_t WS_W = 6 * MiB, W_LAYER = 36 * MiB + 512 * 1024;
constexpr size_t WO_IN = 0, WO_GATE = 4 * MiB + 512 * 1024, WO_BR = 13 * MiB, WO_OUT = 15 * MiB + 512 * 1024, WO_UP = 18 * MiB, WO_DOWN = 30 * MiB, WO_UQ = 35 * MiB + 768 * 1024, WO_UKV = 36 * MiB;
static_assert((size_t)2048 * LDW * 2 <= WO_GATE && WO_GATE + (size_t)4096 * LDW * 2 <= WO_BR && WO_BR + (size_t)4096 * LDWB * 2 <= WO_OUT && WO_OUT + (size_t)1024 * LDW * 2 <= WO_UP && WO_UP + (size_t)NUP * LDW * 2 <= WO_DOWN && WO_DOWN + (size_t)1024 * LDWD * 2 <= WO_UQ && WO_UQ + (size_t)512 * LDUQ * 2 <= WO_UKV && WO_UKV + (size_t)512 * LDUKV * 2 <= W_LAYER, "weight map");
constexpr size_t WS_X1 = 79 * MiB;
constexpr size_t WS_H8 = WS_X1;
constexpr size_t WS_H = 127 * MiB;
constexpr size_t WS_P = 153 * MiB;
constexpr size_t WS_BK = 93 * MiB;
constexpr size_t WS_MERGED = 226 * MiB;
constexpr size_t WS_BR = 200 * MiB;
constexpr size_t WS_O = WS_BR;
constexpr size_t WS_QUP = 226 * MiB;
constexpr size_t WS_KVUP = 237 * MiB;
constexpr size_t WS_ACT = WS_P;
constexpr size_t WS_END = 252 * MiB;
static_assert((size_t)NTOK * LD8 <= (size_t)NTOK * DM * 4 && (size_t)4096 * LD8 <= WO_BR - WO_GATE, "fp8 buffers");
static_assert(WS_W + 2 * W_LAYER <= WS_X1 && WS_X1 + (size_t)NTOK * DM * 4 <= WS_H && WS_H + (size_t)NTOK * LDH * 2 <= WS_P && WS_P + (size_t)NTOK * LDP * 2 <= WS_BR && WS_BR + (size_t)NTOK * LDH * 2 <= WS_QUP
              && WS_QUP + (size_t)NTOK * LDQ * 2 <= WS_KVUP && WS_KVUP + (size_t)NTOK * LDKV * 2 <= WS_END && WS_ACT + (size_t)NTOK * LDACT * 2 <= WS_QUP
              && WS_H8 + (size_t)NTOK * LD8 <= WS_BK && WS_BK + (size_t)NTOK * LDBK * 2 <= WS_BR && WS_MERGED + (size_t)NTOK * LDH * 2 <= WS_END, "workspace map");
constexpr int CW_BAR = 1024;
constexpr int CW_QUEUE = 8192;
constexpr int CW_SEAM = 16384;
constexpr int CW_XBUF = 65536;

constexpr int LDS_CTL = 147456, LDS_TAB = LDS_CTL + 64, LDS_BYTES = LDS_TAB + 4096;

struct Params { const float* in[32]; float* out; unsigned char* ws; };

__device__ __forceinline__ float bf2f(bf16_t b) { return __uint_as_float((unsigned)b << 16); }
__device__ __forceinline__ unsigned pk2(float lo, float hi) { f32x2 v = {lo, hi}; bf16x2_t b = __builtin_convertvector(v, bf16x2_t); return __builtin_bit_cast(unsigned, b); }
__device__ __forceinline__ float lo16(unsigned u) { return __uint_as_float(u << 16); }
__device__ __forceinline__ float hi16(unsigned u) { return __uint_as_float(u & 0xffff0000u); }
__device__ __forceinline__ float wave_sum(float v) {
#pragma unroll
    for (int o = 1; o < 64; o <<= 1) v += __shfl_xor(v, o);
    return v;
}
__device__ __forceinline__ float qmax4(float x) {
    const auto a = __builtin_amdgcn_permlane16_swap(__float_as_uint(x), __float_as_uint(x), false, false); x = fmaxf(__uint_as_float(a[0]), __uint_as_float(a[1]));
    const auto b = __builtin_amdgcn_permlane32_swap(__float_as_uint(x), __float_as_uint(x), false, false); return fmaxf(__uint_as_float(b[0]), __uint_as_float(b[1]));
}
__device__ __forceinline__ float sigmoidf_(float x) { return __builtin_amdgcn_rcpf(1.0f + __builtin_amdgcn_exp2f(x * -LOG2E_)); }
__device__ __forceinline__ float siluf_(float x) { return x * __builtin_amdgcn_rcpf(1.0f + __builtin_amdgcn_exp2f(x * -LOG2E_)); }
#define VM_WAIT_UNUSED_()
#define VM_WAIT() asm volatile("s_waitcnt vmcnt(0)" ::: "memory")

#define XB_TMO      128
#define XB_XCNT(j)  (256  + 64 * (j))
#define XB_XSUB(j)  (1280 + 64 * (j))
#define XB_XGEN(j)  (2304 + 64 * (j))
#define XB_TOP      3328
#define XB_TOPGEN   3392
#define XCD_BAR_WORDS 3456
#define XB_SPIN_CAP (1u << 22)
__device__ __forceinline__ unsigned xb_ld(unsigned* p)              { return __hip_atomic_load(p, __ATOMIC_RELAXED, __HIP_MEMORY_SCOPE_AGENT); }
__device__ __forceinline__ unsigned xb_add(unsigned* p, unsigned v) { return __hip_atomic_fetch_add(p, v, __ATOMIC_RELAXED, __HIP_MEMORY_SCOPE_AGENT); }
__device__ __forceinline__ unsigned xb_xcc_id() { return (unsigned)__builtin_amdgcn_s_getreg((3 << 11) | 20) & 0xFu; }
#define XB_SPIN(cond, bar) do { unsigned _sp = 0; while (cond) { __builtin_amdgcn_s_sleep(1); \
    if ((++_sp & 255u) == 0u) { if (xb_ld(&(bar)[XB_TMO])) break; if (_sp > XB_SPIN_CAP) { atomicAdd(&(bar)[XB_TMO], 1u); break; } } } } while (0)
struct XcdBarrier { unsigned* bar; unsigned x; volatile LAS unsigned* st; };
__device__ __forceinline__ XcdBarrier xcd_barrier_post(unsigned* bar, volatile LAS unsigned* st) {
    XcdBarrier b; b.bar = bar; b.x = xb_xcc_id(); b.st = st;
    if (threadIdx.x == 0) (void)xb_add(&bar[XB_XCNT(b.x)], 1u);
    return b;
}
__device__ __forceinline__ void xcd_barrier_complete(unsigned* bar, unsigned x, unsigned& nloc, unsigned& nx) {
    const unsigned G = gridDim.x * gridDim.y * gridDim.z;
    unsigned sum, cnt, mine, sp = 0u;
    for (;;) {
        sum = 0u; cnt = 0u; mine = 0u;
#pragma unroll
        for (unsigned j = 0; j < 16; ++j) { const unsigned c = xb_ld(&bar[XB_XCNT(j)]); sum += c; cnt += (c > 0u) ? 1u : 0u; mine = (j == x) ? c : mine; }
        if (sum == G) break;
        __builtin_amdgcn_s_sleep(1);
        if ((++sp & 255u) == 0u) { if (xb_ld(&bar[XB_TMO])) break; if (sp > XB_SPIN_CAP) { atomicAdd(&bar[XB_TMO], 1u); break; } }
    }
    nloc = mine > 0u ? mine : 1u; nx = cnt > 0u ? cnt : 1u;
}
__device__ __forceinline__ void xcd_barrier(const XcdBarrier& b) {
    asm volatile("s_waitcnt vmcnt(0)" ::: "memory");
    __syncthreads();
    if (threadIdx.x == 0) {
        unsigned* bar = b.bar; unsigned bx = b.x; asm volatile("" : "+s"(bar), "+s"(bx));
        __builtin_amdgcn_s_waitcnt(0);
        unsigned nloc = b.st[0], nx = b.st[1];
        if (nloc == 0u) { xcd_barrier_complete(bar, bx, nloc, nx); b.st[0] = nloc; b.st[1] = nx; }
        const unsigned old = xb_add(&bar[XB_XSUB(bx)], 1u);
        const unsigned gen = old / nloc;
        if (old + 1u == (gen + 1u) * nloc) {
            __builtin_amdgcn_fence(__ATOMIC_RELEASE, "agent");
            asm volatile("s_waitcnt vmcnt(0)" ::: "memory");
            const unsigned og = xb_add(&bar[XB_TOP], 1u);
            const unsigned tg = og / nx;
            if (og + 1u == (tg + 1u) * nx) xb_add(&bar[XB_TOPGEN], 1u);
            else XB_SPIN(xb_ld(&bar[XB_TOPGEN]) == tg, bar);
            __builtin_amdgcn_fence(__ATOMIC_ACQUIRE, "agent");
            xb_add(&bar[XB_XGEN(bx)], 1u);
            asm volatile("s_waitcnt vmcnt(0)" ::: "memory");
        } else {
            XB_SPIN(xb_ld(&bar[XB_XGEN(bx)]) == gen, bar);
            __builtin_amdgcn_fence(__ATOMIC_ACQUIRE, "agent");
            asm volatile("s_waitcnt vmcnt(0)" ::: "memory");
        }
    }
    __syncthreads();
}

struct Ctx {
    LAS unsigned char* lds;
    int tid, lane, wid, fr, fq;
    int G, bid;
};

__device__ __forceinline__ int tok_cls(int T) { return T < NCTX ? 0 : 1 + ((T - NCTX) >> 11); }
__device__ __forceinline__ const float* x_in_row(const Params& p, int T) { return T < NCTX ? p.in[0] + (size_t)T * DM : p.in[1] + (size_t)(T - NCTX) * DM; }

__device__ __forceinline__ void p0_item(const float* W, int ldw, int k0, int n0, const float* kscale, bf16_t* WT, int ldt, int dst_row0, LAS float* scr, int lane) {
    float ld[32];
#pragma unroll
    for (int i = 0; i < 32; ++i) { const int kk = 2 * i + (lane >> 5); ld[i] = W[(size_t)(k0 + kk) * ldw + n0 + (lane & 31)]; }
#pragma unroll
    for (int i = 0; i < 32; ++i) { const int kk = 2 * i + (lane >> 5); float v = ld[i]; if (kscale) v *= kscale[k0 + kk]; scr[kk * 33 + (lane & 31)] = v; }
    asm volatile("s_waitcnt lgkmcnt(0)" ::: "memory");
    const int c = lane & 7;
#pragma unroll
    for (int j = 0; j < 4; ++j) { const int n = (lane >> 3) + 8 * j; const LAS float* s = scr + (8 * c) * 33 + n;
        u32x4 o; o.x = pk2(s[0 * 33], s[1 * 33]); o.y = pk2(s[2 * 33], s[3 * 33]); o.z = pk2(s[4 * 33], s[5 * 33]); o.w = pk2(s[6 * 33], s[7 * 33]);
        *(u32x4*)(WT + (size_t)(dst_row0 + n) * ldt + k0 + 8 * c) = o; }
    asm volatile("s_waitcnt lgkmcnt(0)" ::: "memory");
}
__device__ __forceinline__ void p0_item8(const float* W, int ldw, int k0, int n0, float scale, unsigned char* WT, int ldt, int dst_row0, LAS float* scr, int lane) {
    float ld[32];
#pragma unroll
    for (int i = 0; i < 32; ++i) { const int kk = 2 * i + (lane >> 5); ld[i] = W[(size_t)(k0 + kk) * ldw + n0 + (lane & 31)]; }
#pragma unroll
    for (int i = 0; i < 32; ++i) { const int kk = 2 * i + (lane >> 5); scr[kk * 33 + (lane & 31)] = ld[i] * scale; }
    asm volatile("s_waitcnt lgkmcnt(0)" ::: "memory");
    const int c = lane & 7;
#pragma unroll
    for (int j = 0; j < 4; ++j) { const int n = (lane >> 3) + 8 * j; const LAS float* s = scr + (8 * c) * 33 + n;
        int w0 = __builtin_amdgcn_cvt_pk_fp8_f32(s[0 * 33], s[1 * 33], 0, false); w0 = __builtin_amdgcn_cvt_pk_fp8_f32(s[2 * 33], s[3 * 33], w0, true);
        int w1 = __builtin_amdgcn_cvt_pk_fp8_f32(s[4 * 33], s[5 * 33], 0, false); w1 = __builtin_amdgcn_cvt_pk_fp8_f32(s[6 * 33], s[7 * 33], w1, true);
        *(u32x2*)(WT + (size_t)(dst_row0 + n) * ldt + k0 + 8 * c) = (u32x2){(unsigned)w0, (unsigned)w1}; }
    asm volatile("s_waitcnt lgkmcnt(0)" ::: "memory");
}
constexpr int IT_IN = 16 * 59, IT_GATE = 16 * 128, IT_BR = 4 * 4 * 32, IT_OUT = 16 * 32, IT_UP = 16 * 172, IT_DOWN = 43 * 32, IT_UQ = 3 * 12, IT_UKV = 2 * 16;
constexpr int IT_LAYER = IT_IN + IT_GATE + IT_BR + IT_OUT + IT_UP + IT_DOWN + IT_UQ + IT_UKV;

__device__ __forceinline__ void zero_bf16(bf16_t* p, size_t n8, int gtid, int gthreads) {
    for (size_t i = gtid; i < n8; i += gthreads) ((u32x4*)p)[i] = (u32x4){0u, 0u, 0u, 0u};
}

__device__ __forceinline__ void phase0(const Params& p, Ctx& C) {
    LAS float* scr = (LAS float*)(C.lds + C.wid * 16384);
    const int gw = C.bid * 8 + C.wid, NGW = C.G * 8;
    for (int it = gw; it < 2 * IT_LAYER; it += NGW) {
        const int L = it / IT_LAYER; int r = it % IT_LAYER;
        unsigned char* wb = p.ws + WS_W + (size_t)L * W_LAYER;
        if (r < IT_IN) { const int kb = r / 59, nb = r % 59; p0_item(p.in[16] + (size_t)L * 1024 * 1888, 1888, kb * 64, nb * 32, nullptr, (bf16_t*)(wb + WO_IN), LDW, nb * 32, scr, C.lane); continue; } r -= IT_IN;
        if (r < IT_GATE) { const int kb = r / 128, nb = r % 128; p0_item8(p.in[17] + (size_t)L * 1024 * 4096, 4096, kb * 64, nb * 32, 32.0f, (unsigned char*)(wb + WO_GATE), LD8, nb * 32, scr, C.lane); continue; } r -= IT_GATE;
        if (r < IT_BR) { const int k = r / 128, rr = r % 128, kb = rr / 32, nb = rr % 32; p0_item(p.in[27] + (size_t)(L * 4 + k) * 256 * 1024, 1024, kb * 64, nb * 32, nullptr, (bf16_t*)(wb + WO_BR) + (size_t)k * 1024 * LDWB, LDWB, nb * 32, scr, C.lane); continue; } r -= IT_BR;
        if (r < IT_OUT) { const int kb = r / 32, nb = r % 32; p0_item(p.in[28] + (size_t)L * 1024 * 1024, 1024, kb * 64, nb * 32, nullptr, (bf16_t*)(wb + WO_OUT), LDW, nb * 32, scr, C.lane); continue; } r -= IT_OUT;
        if (r < IT_UP) { const int kb = r / 172, nb = r % 172; const int n0 = nb * 32, part = n0 / DFF, j0 = n0 % DFF; const int drow = (j0 >> 7) * 256 + part * 128 + (j0 & 127);
            p0_item(p.in[29] + (size_t)L * 1024 * 5504, 5504, kb * 64, n0, nullptr, (bf16_t*)(wb + WO_UP), LDW, drow, scr, C.lane); continue; } r -= IT_UP;
        if (r < IT_DOWN) { const int kb = r / 32, nb = r % 32; p0_item(p.in[31] + (size_t)L * DFF * 1024, 1024, kb * 64, nb * 32, nullptr, (bf16_t*)(wb + WO_DOWN), LDWD, nb * 32, scr, C.lane); continue; } r -= IT_DOWN;
        if (r < IT_UQ) { const int kb = r / 12, nb = r % 12; p0_item(p.in[21] + (size_t)L * 192 * 384, 384, kb * 64, nb * 32, p.in[20] + L * 192, (bf16_t*)(wb + WO_UQ), LDUQ, nb * 32, scr, C.lane); continue; } r -= IT_UQ;
        { const int kb = r / 16, nb = r % 16; p0_item(p.in[23] + (size_t)L * 128 * 512, 512, kb * 64, nb * 32, p.in[22] + L * 128, (bf16_t*)(wb + WO_UKV), LDUKV, nb * 32, scr, C.lane); }
    }
    const int gtid = C.bid * 512 + C.tid, gth = C.G * 512;
    for (int L = 0; L < 2; ++L) {
        unsigned char* wb = p.ws + WS_W + (size_t)L * W_LAYER;
        zero_bf16((bf16_t*)(wb + WO_IN) + (size_t)IN_DIM * LDW, (size_t)(INP - IN_DIM) * LDW / 8, gtid, gth);
        zero_bf16((bf16_t*)(wb + WO_UP) + (size_t)(21 * 256 + 64) * LDW, (size_t)64 * LDW / 8, gtid, gth);
        zero_bf16((bf16_t*)(wb + WO_UP) + (size_t)(21 * 256 + 128 + 64) * LDW, (size_t)64 * LDW / 8, gtid, gth);
        zero_bf16((bf16_t*)(wb + WO_UQ) + (size_t)384 * LDUQ, (size_t)128 * LDUQ / 8, gtid, gth);
        for (int i = gtid; i < 1024 * 8; i += gth) { const int row = i >> 3, c = i & 7; *(u32x4*)((bf16_t*)(wb + WO_DOWN) + (size_t)row * LDWD + DFF + c * 8) = (u32x4){0u, 0u, 0u, 0u}; }
    }
    __syncthreads();
    LAS float* sv = (LAS float*)(C.lds);
    LAS float* part = (LAS float*)(C.lds + 16384);
    for (int i = C.tid; i < 3 * 1024; i += 512) { const int cls = i >> 10, k = i & 1023; const float v = cls == 0 ? p.in[9][k] : p.in[8][(cls - 1) * 1024 + k]; sv[i] = siluf_(v); }
    __syncthreads();
    float* modv = (float*)(p.ws + WS_MODV);
    for (int it = C.bid; it < 2 * 96; it += C.G) {
        const int L = it / 96, col = (it % 96) * 64 + C.lane;
        const float* w = p.in[10] + (size_t)L * 1024 * 6144 + col;
        float a0 = 0.f, a1 = 0.f, a2 = 0.f;
#pragma unroll 8
        for (int kk = 0; kk < 128; ++kk) { const int k = C.wid * 128 + kk; const float wv = w[(size_t)k * 6144]; a0 += sv[k] * wv; a1 += sv[1024 + k] * wv; a2 += sv[2048 + k] * wv; }
        part[(C.wid * 3 + 0) * 64 + C.lane] = a0; part[(C.wid * 3 + 1) * 64 + C.lane] = a1; part[(C.wid * 3 + 2) * 64 + C.lane] = a2;
        __syncthreads();
        if (C.tid < 192) { const int cls = C.tid >> 6, l = C.tid & 63; float s = 0.f;
#pragma unroll
            for (int w8 = 0; w8 < 8; ++w8) s += part[(w8 * 3 + cls) * 64 + l];
            const int cc = (it % 96) * 64 + l;
            modv[((size_t)L * 3 + cls) * 6144 + cc] = s + p.in[11][(size_t)L * 6144 + cc]; }
        __syncthreads();
    }
}

__device__ __forceinline__ void row_norm_mod(const f32x4 (&v)[4], const float* g, const float* sc, const float* sh, bf16_t* orow, int lane, unsigned char* o8 = nullptr) {
    float ss = 0.f;
#pragma unroll
    for (int j = 0; j < 4; ++j) ss += (v[j].x * v[j].x + v[j].y * v[j].y) + (v[j].z * v[j].z + v[j].w * v[j].w);
    const float rstd = 1.0f / sqrtf(wave_sum(ss) * (1.0f / DM) + EPS);
#pragma unroll
    for (int j = 0; j < 4; ++j) {
        const f32x4 gg = ((const f32x4*)g)[lane + 64 * j], s1 = ((const f32x4*)sc)[lane + 64 * j], s0 = ((const f32x4*)sh)[lane + 64 * j];
        const f32x4 y = v[j] * rstd * gg * (s1 + 1.0f) + s0;
        u32x2 o; o.x = pk2(y.x, y.y); o.y = pk2(y.z, y.w);
        ((u32x2*)orow)[lane + 64 * j] = o;
        if (o8) { int w8 = __builtin_amdgcn_cvt_pk_fp8_f32(y.x, y.y, 0, false); w8 = __builtin_amdgcn_cvt_pk_fp8_f32(y.z, y.w, w8, true); ((int*)o8)[lane + 64 * j] = w8; }
    }
}
__device__ __forceinline__ void load_row_bf16(const bf16_t* r, f32x4 (&v)[4], int lane) {
#pragma unroll
    for (int j = 0; j < 4; ++j) { const u32x2 u = ((const u32x2*)r)[lane + 64 * j]; v[j] = (f32x4){lo16(u.x), hi16(u.x), lo16(u.y), hi16(u.y)}; }
}

__device__ __forceinline__ void phase1(const Params& p, Ctx& C) {
    const int gw = C.bid * 8 + C.wid, NGW = C.G * 8;
    const float* modv = (const float*)(p.ws + WS_MODV);
    bf16_t* H = (bf16_t*)(p.ws + WS_H);
    for (int T = gw; T < NTOK; T += NGW) {
        const float* xr = x_in_row(p, T); f32x4 v[4];
#pragma unroll
        for (int j = 0; j < 4; ++j) v[j] = ((const f32x4*)xr)[C.lane + 64 * j];
        const float* mv = modv + (size_t)(0 * 3 + tok_cls(T)) * 6144;
        row_norm_mod(v, p.in[12], mv + 1024, mv, H + (size_t)T * LDH, C.lane, p.ws + WS_H8 + (size_t)T * LD8);
    }
    const int gtid = C.bid * 512 + C.tid, gth = C.G * 512;
    bf16_t* nak = (bf16_t*)(p.ws + WS_NACK); bf16_t* nav = (bf16_t*)(p.ws + WS_NACV);
    for (int i = gtid; i < 2 * 2 * 256 * 256 / 4; i += gth) {
        const int e = i * 4, w = e & 255, t = (e >> 8) & 255, L = (e >> 16) & 1, b = e >> 17;
        const size_t d = ((size_t)(L * 2 + b) * 256 + t) * LDNAC + w;
        const f32x4 a = *(const f32x4*)(p.in[2] + e), c = *(const f32x4*)(p.in[3] + e);
        *(u32x2*)(nak + d) = (u32x2){pk2(a.x, a.y), pk2(a.z, a.w)}; *(u32x2*)(nav + d) = (u32x2){pk2(c.x, c.y), pk2(c.z, c.w)};
    }
    bf16_t* swk = (bf16_t*)(p.ws + WS_SWCK); bf16_t* swv = (bf16_t*)(p.ws + WS_SWCV); bf16_t* ckv = (bf16_t*)(p.ws + WS_CKVC);
    for (int i = gtid; i < 2 * 2 * 256 * 128 / 4; i += gth) {
        const int e = i * 4, w = e & 127, t = (e >> 7) & 255, L = (e >> 15) & 1, b = e >> 16;
        const size_t d = ((size_t)(L * 2 + b) * 256 + t) * LDSWC + w, d2 = ((size_t)(L * 2 + b) * 256 + t) * LDCKVC + w;
        const f32x4 a = *(const f32x4*)(p.in[6] + e), c = *(const f32x4*)(p.in[7] + e), m = *(const f32x4*)(p.in[4] + e);
        *(u32x2*)(swk + d) = (u32x2){pk2(a.x, a.y), pk2(a.z, a.w)}; *(u32x2*)(swv + d) = (u32x2){pk2(c.x, c.y), pk2(c.z, c.w)};
        *(u32x2*)(ckv + d2) = (u32x2){pk2(m.x, m.y), pk2(m.z, m.w)};
    }
    bf16_t* krc = (bf16_t*)(p.ws + WS_KRC);
    for (int i = gtid; i < 2 * 2 * 256 * 32 / 4; i += gth) {
        const int e = i * 4, w = e & 31, t = (e >> 5) & 255, L = (e >> 13) & 1, b = e >> 14;
        const size_t d = ((size_t)(L * 2 + b) * 256 + t) * 32 + w;
        const f32x4 a = *(const f32x4*)(p.in[5] + e);
        *(u32x2*)(krc + d) = (u32x2){pk2(a.x, a.y), pk2(a.z, a.w)};
    }
}

__device__ __forceinline__ void phase7(const Params& p, Ctx& C, int L) {
    const int gw = C.bid * 8 + C.wid, NGW = C.G * 8;
    const float* modv = (const float*)(p.ws + WS_MODV);
    const bf16_t* O = (const bf16_t*)(p.ws + WS_O); float* X1 = p.out + OFF_Y; bf16_t* H = (bf16_t*)(p.ws + WS_H);
    const float* gpost = p.in[13] + L * DM; const float* gpre = p.in[14] + L * DM;
    for (int T = gw; T < NTOK; T += NGW) {
        const float* xr = (L == 0) ? x_in_row(p, T) : p.out + OFF_Y + (size_t)T * DM;
        const float* mv = modv + (size_t)(L * 3 + tok_cls(T)) * 6144;
        f32x4 o[4]; load_row_bf16(O + (size_t)T * LDH, o, C.lane);
        float ss = 0.f;
#pragma unroll
        for (int j = 0; j < 4; ++j) ss += (o[j].x * o[j].x + o[j].y * o[j].y) + (o[j].z * o[j].z + o[j].w * o[j].w);
        const float rstd = 1.0f / sqrtf(wave_sum(ss) * (1.0f / DM) + EPS);
        f32x4 x1[4];
#pragma unroll
        for (int j = 0; j < 4; ++j) {
            const f32x4 xv = ((const f32x4*)xr)[C.lane + 64 * j], gp = ((const f32x4*)gpost)[C.lane + 64 * j], g1 = ((const f32x4*)(mv + 2048))[C.lane + 64 * j];
            x1[j] = xv + g1 * (o[j] * rstd * gp);
            ((f32x4*)(X1 + (size_t)T * DM))[C.lane + 64 * j] = x1[j];
        }
        row_norm_mod(x1, gpre, mv + 4096, mv + 3072, H + (size_t)T * LDH, C.lane);
    }
}
__device__ __forceinline__ void phase10(const Params& p, Ctx& C, int L) {
    const int gw = C.bid * 8 + C.wid, NGW = C.G * 8;
    const float* modv = (const float*)(p.ws + WS_MODV);
    const float* X1 = p.out + OFF_Y; bf16_t* H = (bf16_t*)(p.ws + WS_H);
    const float* gpost = p.in[15] + L * DM;
    for (int T = gw; T < NTOK; T += NGW) {
        const float* mv = modv + (size_t)(L * 3 + tok_cls(T)) * 6144;
        f32x4 f[4]; load_row_bf16(H + (size_t)T * LDH, f, C.lane);
        float ss = 0.f;
#pragma unroll
        for (int j = 0; j < 4; ++j) ss += (f[j].x * f[j].x + f[j].y * f[j].y) + (f[j].z * f[j].z + f[j].w * f[j].w);
        const float rstd = 1.0f / sqrtf(wave_sum(ss) * (1.0f / DM) + EPS);
        f32x4 y[4];
#pragma unroll
        for (int j = 0; j < 4; ++j) {
            const f32x4 xv = ((const f32x4*)(X1 + (size_t)T * DM))[C.lane + 64 * j], gp = ((const f32x4*)gpost)[C.lane + 64 * j], g2 = ((const f32x4*)(mv + 5120))[C.lane + 64 * j];
            y[j] = xv + g2 * (f[j] * rstd * gp);
            ((f32x4*)(p.out + OFF_Y + (size_t)T * DM))[C.lane + 64 * j] = y[j];
        }
        if (L == 0) { const float* mv1 = modv + (size_t)(1 * 3 + tok_cls(T)) * 6144; row_norm_mod(y, p.in[12] + DM, mv1 + 1024, mv1, H + (size_t)T * LDH, C.lane, p.ws + WS_H8 + (size_t)T * LD8); }
    }
}

__device__ __forceinline__ int lds_byte(int r, int c) { const int st = (r >> 4) * 2 + (c >> 5), ob = (r & 15) * 64 + (c & 31) * 2; return st * 1024 + (ob ^ (((ob >> 9) & 1) << 5)); }
__device__ __forceinline__ void stage_rc(int b, int& R, int& Cc) { const int st = b >> 10, sb = b & 1023, swz = sb ^ (((sb >> 9) & 1) << 5); R = (st >> 1) * 16 + swz / 64; Cc = (st & 1) * 32 + (swz % 64) / 2; }
#define GLDS16(gp, lp) __builtin_amdgcn_global_load_lds((const unsigned*)(gp), (LAS unsigned*)(lp), 16, 0, 0)

template <int TM, int TN> struct GemmStage {
    static constexpr int STAGE = (TM + TN) * 128;
    int offA, offB;
    int lda, ldb;
    __device__ __forceinline__ void init(const Ctx& C, int lda_, int ldb_) { int R, Cc; stage_rc(C.wid * 1024 + C.lane * 16, R, Cc); lda = lda_; ldb = ldb_; offA = R * lda + Cc; offB = R * ldb + Cc; }
    __device__ __forceinline__ void stage(const Ctx& C, int buf, const bf16_t* a, const bf16_t* b) const {
        LAS unsigned char* base = C.lds + buf * STAGE + C.wid * 1024;
#pragma unroll
        for (int i = 0; i < TM / 64; ++i) GLDS16(a + offA + (size_t)i * 64 * lda, base + i * 8192);
#pragma unroll
        for (int i = 0; i < TN / 64; ++i) GLDS16(b + offB + (size_t)i * 64 * ldb, base + TM * 128 + i * 8192);
    }
};
template <int TM, int TN, int MF, int NF>
__device__ __forceinline__ void gemm_compute(const Ctx& C, int buf, int wr, int wc, f32x4 (&acc)[MF][NF]) {
    constexpr int STAGE = (TM + TN) * 128;
    LAS unsigned char* sa = C.lds + buf * STAGE; LAS unsigned char* sb = sa + TM * 128;
#pragma unroll
    for (int ks = 0; ks < 2; ++ks) {
        bf16x8 Af[MF], Bf[NF];
        const int ao = lds_byte(wr * MF * 16 + C.fr, ks * 32 + C.fq * 8), bo = lds_byte(wc * NF * 16 + C.fr, ks * 32 + C.fq * 8);
#pragma unroll
        for (int m = 0; m < MF; ++m) Af[m] = *(const LAS bf16x8*)(sa + ao + m * 2048);
#pragma unroll
        for (int n = 0; n < NF; ++n) Bf[n] = *(const LAS bf16x8*)(sb + bo + n * 2048);
#pragma unroll
        for (int m = 0; m < MF; ++m)
#pragma unroll
            for (int n = 0; n < NF; ++n) acc[m][n] = __builtin_amdgcn_mfma_f32_16x16x32_bf16(Bf[n], Af[m], acc[m][n], 0, 0, 0);
        __builtin_amdgcn_sched_barrier(0);
    }
}
template <int TM, int TN, int MF, int NF>
__device__ __forceinline__ void gemm_kloop(const Ctx& C, const GemmStage<TM, TN>& S, const bf16_t* A, const bf16_t* B, int nt, int wr, int wc, f32x4 (&acc)[MF][NF]) {
    S.stage(C, 0, A, B); VM_WAIT(); __syncthreads();
    for (int t = 0; t < nt; ++t) {
        const int cur = t & 1;
        if (t + 1 < nt) S.stage(C, cur ^ 1, A + (t + 1) * 64, B + (t + 1) * 64);
        gemm_compute<TM, TN, MF, NF>(C, cur, wr, wc, acc);
        VM_WAIT(); __syncthreads();
    }
}
__device__ __forceinline__ void unit_map(int u, int nM, int nN, int& pm, int& pn) {
    const int nwg = nM * nN; int wgid = u;
    { const int q = nwg / 8, r = nwg % 8, xcd = wgid % 8, off = wgid / 8; wgid = (xcd < r ? xcd * (q + 1) : r * (q + 1) + (xcd - r) * q) + off; }
    const int nig = 8 * nN, gid = wgid / nig, fm = gid * 8, gsz = (nM - fm) < 8 ? (nM - fm) : 8;
    pm = fm + ((wgid % nig) % gsz); pn = (wgid % nig) / gsz;
}
#define ZERO_ACC(acc, MF, NF) _Pragma("unroll") for (int m_ = 0; m_ < MF; ++m_) _Pragma("unroll") for (int n_ = 0; n_ < NF; ++n_) acc[m_][n_] = (f32x4){0.f, 0.f, 0.f, 0.f}


struct G8Unit { const char* A; const char* B; int e0, e1, e2, e3; };
__device__ __forceinline__ int perm32(int rho) { const int n = rho >> 4, i = rho & 15; return 8 * (i >> 2) + 4 * n + (i & 3); }
__device__ __forceinline__ i32x8 cat8(bf16x8 a, bf16x8 b) { return __builtin_shufflevector(__builtin_bit_cast(i32x4, a), __builtin_bit_cast(i32x4, b), 0, 1, 2, 3, 4, 5, 6, 7); }
#define G8_EPI_PLAIN static constexpr bool FP8 = false; static constexpr int HROWS_B = 128; static __device__ __forceinline__ int brow(int R) { return PERM ? ((R & ~31) + perm32(R & 31)) : R; }
template <class Epi, class Sched>
__device__ __forceinline__ void gemm8(const Ctx& C, int K, int lda, int ldb, const Sched& S, const Epi& E) {
    constexpr int HTB = 16384;
    LAS unsigned char* lds = C.lds;
    const int tid = C.tid, wid = C.wid, lane = C.lane, wr = wid >> 2, wc = wid & 3, fr = lane & 15, fq = lane >> 4;
    const int nt = K / 64;
    unsigned voffA, voffB;
    { int R, Cc; stage_rc(tid * 16, R, Cc); voffA = (unsigned)(R * lda + Cc) * 2u; voffB = (unsigned)(Epi::brow(R) * ldb + Cc) * 2u; }
    const size_t kstep = 128;
    const size_t hstepA = (size_t)128 * lda * 2, hstepB = (size_t)Epi::HROWS_B * ldb * 2;
    const size_t r64A = (size_t)64 * lda * 2, r64B = (size_t)(Epi::brow(64) - Epi::brow(0)) * ldb * 2;
    const unsigned ldsw = (unsigned)(size_t)lds + (unsigned)wid * 1024u;
    const int aoff = lds_byte(wr * 64 + fr, fq * 8), boff = lds_byte(wc * 32 + fr, fq * 8);
#define G8_SA(b, h) (((b) * 2 + (h)) * HTB)
#define G8_SB(b, h) ((4 + (b) * 2 + (h)) * HTB)
#define G8_GLDS(vo, sb, la) asm volatile("s_mov_b32 m0, %2\n\ts_nop 0\n\tglobal_load_lds_dwordx4 %0, %1" :: "v"(vo), "s"(sb), "s"(la) : "memory", "m0")
#define G8_STAGE(bufoff, gbase, voff, r64) do { const char* _g = (const char*)(gbase); const unsigned _l = ldsw + (unsigned)(bufoff); G8_GLDS(voff, _g, _l); \
        const char* _g2 = _g + (r64); G8_GLDS(voff, _g2, _l + 8192u); } while (0)
#define G8_LDA(dst, b, h) do { _Pragma("unroll") for (int m = 0; m < 4; ++m) _Pragma("unroll") for (int k = 0; k < 2; ++k) dst[m][k] = *(const LAS bf16x8*)(lds + G8_SA(b, h) + aoff + m * 2048 + k * 1024); } while (0)
#define G8_LDB(dst, b, h) do { _Pragma("unroll") for (int n = 0; n < 2; ++n) _Pragma("unroll") for (int k = 0; k < 2; ++k) dst[n][k] = *(const LAS bf16x8*)(lds + G8_SB(b, h) + boff + n * 2048 + k * 1024); } while (0)
#define G8_MMA(ai, bj, At, Bt) do { __builtin_amdgcn_s_setprio(1); _Pragma("unroll") for (int m = 0; m < 4; ++m) _Pragma("unroll") for (int n = 0; n < 2; ++n) { \
        if constexpr (Epi::FP8) acc[ai][bj][m][n] = __builtin_amdgcn_mfma_scale_f32_16x16x128_f8f6f4(cat8(Bt[n][0], Bt[n][1]), cat8(At[m][0], At[m][1]), acc[ai][bj][m][n], 0, 0, 0, 0, 0, 0); \
        else { _Pragma("unroll") for (int k = 0; k < 2; ++k) acc[ai][bj][m][n] = __builtin_amdgcn_mfma_f32_16x16x32_bf16(Bt[n][k], At[m][k], acc[ai][bj][m][n], 0, 0, 0); } } \
        __builtin_amdgcn_s_setprio(0); } while (0)
#define G8_WAIT_V(n) asm volatile("s_waitcnt vmcnt(" #n ")" ::: "memory")
#define G8_WAIT_L(n) asm volatile("s_waitcnt lgkmcnt(" #n ")" ::: "memory")
#define G8_BAR __builtin_amdgcn_s_barrier()
#define G8_SCHED __builtin_amdgcn_sched_barrier(0)
    G8Unit cur, nxt; int ui = 0;
    if (!S.next(0, cur)) return;
    f32x4 acc[2][2][4][2];
#pragma unroll
    for (int a = 0; a < 2; ++a)
#pragma unroll
        for (int b = 0; b < 2; ++b)
#pragma unroll
            for (int m = 0; m < 4; ++m)
#pragma unroll
                for (int n = 0; n < 2; ++n) acc[a][b][m][n] = (f32x4){0.f, 0.f, 0.f, 0.f};
    bf16x8 At[4][2], B0[2][2], B1[2][2];
    const char* cA = cur.A; const char* cB = cur.B;
    G8_STAGE(G8_SB(0, 0), cB, voffB, r64B); G8_STAGE(G8_SA(0, 0), cA, voffA, r64A); G8_STAGE(G8_SB(0, 1), cB + hstepB, voffB, r64B); G8_STAGE(G8_SA(0, 1), cA + hstepA, voffA, r64A);
    if (wr == 1) G8_BAR;
    G8_WAIT_V(4); G8_BAR;
    G8_STAGE(G8_SB(1, 0), cB + kstep, voffB, r64B); G8_STAGE(G8_SA(1, 0), cA + kstep, voffA, r64A); G8_STAGE(G8_SB(1, 1), cB + hstepB + kstep, voffB, r64B);
    G8_WAIT_V(6); G8_BAR;
    for (;;) {
        const bool has_next = S.next(ui + 1, nxt);
        const char* nA = has_next ? nxt.A : cA; const char* nB = has_next ? nxt.B : cB;
#pragma unroll 1
        for (int t = 0; t < nt; t += 2) {
            const bool last = (t == nt - 2);
            const char* a1 = cA + (size_t)(t + 1) * kstep;
            const char* a2 = last ? nA : cA + (size_t)(t + 2) * kstep; const char* b2 = last ? nB : cB + (size_t)(t + 2) * kstep;
            const char* a3 = a2 + kstep; const char* b3 = b2 + kstep;
            G8_LDB(B0, 0, 0); G8_SCHED; G8_LDA(At, 0, 0); G8_STAGE(G8_SA(1, 1), a1 + hstepA, voffA, r64A);
            G8_WAIT_L(8); G8_BAR; G8_WAIT_L(0); G8_MMA(0, 0, At, B0); G8_BAR; G8_SCHED;
            G8_LDB(B1, 0, 1); G8_STAGE(G8_SB(0, 0), b2, voffB, r64B);
            G8_BAR; G8_WAIT_L(0); G8_MMA(0, 1, At, B1); G8_BAR;
            G8_LDA(At, 0, 1); G8_STAGE(G8_SA(0, 0), a2, voffA, r64A);
            G8_BAR; G8_WAIT_L(0); G8_MMA(1, 0, At, B0); G8_BAR; G8_SCHED;
            G8_STAGE(G8_SB(0, 1), b2 + hstepB, voffB, r64B);
            G8_WAIT_V(6); G8_BAR; G8_MMA(1, 1, At, B1); G8_BAR;
            G8_LDB(B0, 1, 0); G8_SCHED; G8_LDA(At, 1, 0); G8_STAGE(G8_SA(0, 1), a2 + hstepA, voffA, r64A);
            G8_WAIT_L(8); G8_BAR; G8_WAIT_L(0); G8_MMA(0, 0, At, B0); G8_BAR; G8_SCHED;
            G8_LDB(B1, 1, 1); G8_STAGE(G8_SB(1, 0), b3, voffB, r64B);
            G8_BAR; G8_WAIT_L(0); G8_MMA(0, 1, At, B1); G8_BAR;
            G8_LDA(At, 1, 1); G8_STAGE(G8_SA(1, 0), a3, voffA, r64A);
            G8_BAR; G8_WAIT_L(0); G8_MMA(1, 0, At, B0); G8_BAR; G8_SCHED;
            G8_STAGE(G8_SB(1, 1), b3 + hstepB, voffB, r64B);
            G8_WAIT_V(6); G8_BAR; G8_MMA(1, 1, At, B1); G8_BAR;
        }
        if constexpr (!Epi::AFTER_DRAIN) E(acc, cur, wr, wc, fr, fq);
        if (!has_next) break;
#pragma unroll
        for (int a = 0; a < 2; ++a)
#pragma unroll
            for (int b = 0; b < 2; ++b)
#pragma unroll
                for (int m = 0; m < 4; ++m)
#pragma unroll
                    for (int n = 0; n < 2; ++n) acc[a][b][m][n] = (f32x4){0.f, 0.f, 0.f, 0.f};
        cur = nxt; cA = nA; cB = nB; ++ui;
    }
    G8_WAIT_V(0);
    if (wr == 0) G8_BAR;
    G8_BAR;
    if constexpr (Epi::AFTER_DRAIN) E.drained(C, acc, cur, wr, wc, fr, fq);
#undef G8_SA
#undef G8_SB
#undef G8_STAGE
#undef G8_GLDS
#undef G8_LDA
#undef G8_LDB
#undef G8_MMA
#undef G8_WAIT_V
#undef G8_WAIT_L
#undef G8_BAR
#undef G8_SCHED
}
struct TileSched {
    const char* A; const char* B; size_t tstepA, tstepB; int nM, nN, G, c;
    __device__ __forceinline__ bool next(int i, G8Unit& u) const {
        const int L = i * G + c; if (L >= nM * nN) return false;
        int pm, pn; unit_map(L, nM, nN, pm, pn);
        u.A = A + (size_t)pm * tstepA; u.B = B + (size_t)pn * tstepB; u.e0 = pm; u.e1 = pn; u.e2 = 0; u.e3 = 0; return true;
    }
};
struct EpiBf16 {
    static constexpr bool PERM = true, AFTER_DRAIN = false; G8_EPI_PLAIN
    bf16_t* O; int ldo;
    __device__ __forceinline__ void operator()(const f32x4 (&acc)[2][2][4][2], const G8Unit& u, int wr, int wc, int fr, int fq) const {
        const int row0 = u.e0 * 256 + wr * 64 + fr, col0 = u.e1 * 256 + wc * 32 + 8 * fq;
#pragma unroll
        for (int ai = 0; ai < 2; ++ai)
#pragma unroll
            for (int m = 0; m < 4; ++m) { bf16_t* rowp = O + (size_t)(row0 + ai * 128 + m * 16) * ldo + col0;
#pragma unroll
                for (int bj = 0; bj < 2; ++bj) { const f32x4 v0 = acc[ai][bj][m][0], v1 = acc[ai][bj][m][1];
                    *(u32x4*)(rowp + bj * 128) = (u32x4){pk2(v0.x, v0.y), pk2(v0.z, v0.w), pk2(v1.x, v1.y), pk2(v1.z, v1.w)}; } }
    }
};
struct EpiInProj {
    static constexpr bool PERM = true, AFTER_DRAIN = false; G8_EPI_PLAIN
    bf16_t* P; float* out; int L;
    __device__ __forceinline__ void operator()(const f32x4 (&acc)[2][2][4][2], const G8Unit& u, int wr, int wc, int fr, int fq) const {
        const int row0 = u.e0 * 256 + wr * 64 + fr, col0 = u.e1 * 256 + wc * 32 + 8 * fq;
        const bool ctx = u.e0 < 32;
#pragma unroll
        for (int bj = 0; bj < 2; ++bj) { const int col = col0 + bj * 128;
            int W = 0, cc = 0; size_t off = 0;
            if (ctx) {
                if (col >= COL_KA && col < COL_VA) { off = OFF_NAK; W = 256; cc = col - COL_KA; }
                else if (col >= COL_VA && col < COL_CQ) { off = OFF_NAV; W = 256; cc = col - COL_VA; }
                else if (col >= COL_CKV && col < COL_KR) { off = OFF_CKV; W = 128; cc = col - COL_CKV; }
                else if (col >= COL_KR && col < COL_QC) { off = OFF_KR; W = 32; cc = col - COL_KR; }
                else if (col >= COL_KC && col < COL_VC) { off = OFF_SWK; W = 128; cc = col - COL_KC; }
                else if (col >= COL_VC && col < COL_PD) { off = OFF_SWV; W = 128; cc = col - COL_VC; }
            }
            float* dbase = out + off + cc;
#pragma unroll
            for (int ai = 0; ai < 2; ++ai)
#pragma unroll
                for (int m = 0; m < 4; ++m) { const int row = row0 + ai * 128 + m * 16; const f32x4 v0 = acc[ai][bj][m][0], v1 = acc[ai][bj][m][1];
                    if (col < IN_DIM) *(u32x4*)(P + (size_t)row * LDP + col) = (u32x4){pk2(v0.x, v0.y), pk2(v0.z, v0.w), pk2(v1.x, v1.y), pk2(v1.z, v1.w)};
                    if (W) { float* dst = dbase + (size_t)(((row >> 8) * 2 + L) * 256 + (row & 255)) * W; *(f32x4*)dst = v0; *(f32x4*)(dst + 4) = v1; } }
        }
    }
};
__device__ __forceinline__ void phase2(const Params& p, Ctx& C, int L) {
    TileSched S{(const char*)(p.ws + WS_H), (const char*)(p.ws + WS_W + (size_t)L * W_LAYER + WO_IN), (size_t)256 * LDH * 2, (size_t)256 * LDW * 2, 48, 8, C.G, C.bid};
    EpiInProj E{(bf16_t*)(p.ws + WS_P), p.out, L};
    gemm8(C, DM, LDH, LDW, S, E);
}

__device__ __forceinline__ void rope_pair(bf16_t* p1, bf16_t* p2, float pos, float inv) {
    const float ang = pos * inv; float rev = ang * 0.15915494309189535f; rev -= floorf(rev);
    const float s = __builtin_amdgcn_sinf(rev), c = __builtin_amdgcn_cosf(rev);
    const float x1 = bf2f(*p1), x2 = bf2f(*p2);
    const unsigned o = pk2(x1 * c - x2 * s, x1 * s + x2 * c);
    *p1 = (bf16_t)(o & 0xffffu); *p2 = (bf16_t)(o >> 16);
}
__device__ __forceinline__ void phase3(const Params& p, Ctx& C, int L) {
    bf16_t* P = (bf16_t*)(p.ws + WS_P);
    {
        const int gw = C.bid * 8 + C.wid, NGW = C.G * 8;
        for (int t = gw; t < NLAT; t += NGW) {
            bf16_t* row = P + (size_t)(NCTX + t) * LDP; const int pos = t & 2047; const float prow = (float)(pos >> 6), pcol = (float)(pos & 63);
            for (int i = C.lane; i < 208; i += 64) {
                if (i < 16) { const int blk = i >> 3, f = i & 7; bf16_t* b = row + COL_KR + blk * 16 + f; rope_pair(b, b + 8, blk ? pcol : prow, exp2f(-(float)f * (13.287712379549449f / 8.0f))); }
                else { const int j = i - 16, head = j >> 5, blk = (j >> 4) & 1, f = j & 15;
                    bf16_t* b = row + COL_QC + head * 64 + blk * 32 + f; rope_pair(b, b + 16, blk ? pcol : prow, exp2f(-(float)f * (13.287712379549449f / 16.0f))); }
            }
        }
    }
    const int wr = C.wid >> 2, wc = C.wid & 3;
    LAS float* rs = (LAS float*)(C.lds + LDS_TAB);
    const unsigned char* wb = p.ws + WS_W + (size_t)L * W_LAYER;
    int R, Cc; stage_rc(C.wid * 1024 + C.lane * 16, R, Cc);
    const int Rb = (R & ~31) + perm32(R & 31);
    for (int u = C.bid; u < 96 * 7 + 4 * 4; u += C.G) {
        int pm, tn;
        if (u < 672) { pm = u / 7; tn = u % 7; } else { const int r = u - 672; pm = 96 + (r >> 2); tn = 3 + (r & 3); }
        const int which = tn >= 3, K = which ? 128 : 192, nkt = K / 64, ldb = which ? LDUKV : LDUQ, n0 = (which ? tn - 3 : tn) * 128;
        const bf16_t* A; int lda;
        if (pm < 96) { A = P + (size_t)pm * 128 * LDP + (which ? COL_CKV : COL_CQ); lda = LDP; }
        else { A = (const bf16_t*)(p.ws + WS_CKVC) + (size_t)(L * 512 + (pm - 96) * 128) * LDCKVC; lda = LDCKVC; }
        const bf16_t* B = (const bf16_t*)(wb + (which ? WO_UKV : WO_UQ)) + (size_t)n0 * ldb;
        for (int t = 0; t < nkt; ++t) { LAS unsigned char* base = C.lds + t * 32768 + C.wid * 1024;
            const bf16_t* a = A + (size_t)R * lda + Cc + t * 64; const bf16_t* bq = B + (size_t)Rb * ldb + Cc + t * 64;
            GLDS16(a, base); GLDS16(a + (size_t)64 * lda, base + 8192); GLDS16(bq, base + 16384); GLDS16(bq + (size_t)64 * ldb, base + 16384 + 8192); }
        VM_WAIT(); __syncthreads();
        { const int row = C.tid >> 2, part = C.tid & 3; float ss = 0.f;
            for (int c = part; c < K / 8; c += 4) { const int t = c >> 3, cc = (c & 7) * 8; const u32x4 q = *(const LAS u32x4*)(C.lds + t * 32768 + lds_byte(row, cc));
                ss += lo16(q.x) * lo16(q.x) + hi16(q.x) * hi16(q.x) + lo16(q.y) * lo16(q.y) + hi16(q.y) * hi16(q.y) + lo16(q.z) * lo16(q.z) + hi16(q.z) * hi16(q.z) + lo16(q.w) * lo16(q.w) + hi16(q.w) * hi16(q.w); }
            ss += __shfl_xor(ss, 1); ss += __shfl_xor(ss, 2);
            if (part == 0) rs[row] = __builtin_amdgcn_rsqf(ss / (float)K + EPS); }
        f32x4 acc[4][2]; ZERO_ACC(acc, 4, 2);
        for (int t = 0; t < nkt; ++t) gemm_compute<128, 128, 4, 2>(C, t, wr, wc, acc);
        __syncthreads();
        bf16_t* O; int ldo;
        if (pm < 96) { if (which) { O = (bf16_t*)(p.ws + WS_KVUP) + (size_t)pm * 128 * LDKV; ldo = LDKV; } else { O = (bf16_t*)(p.ws + WS_QUP) + (size_t)pm * 128 * LDQ; ldo = LDQ; } }
        else { O = (bf16_t*)(p.ws + WS_KVCUP) + (size_t)(L * 512 + (pm - 96) * 128) * LDKV; ldo = LDKV; }
#pragma unroll
        for (int m = 0; m < 4; ++m) { const int r = wr * 64 + m * 16 + C.fr; const float sc = rs[r]; const f32x4 v0 = acc[m][0] * sc, v1 = acc[m][1] * sc;
            *(u32x4*)(O + (size_t)r * ldo + n0 + wc * 32 + 8 * C.fq) = (u32x4){pk2(v0.x, v0.y), pk2(v0.z, v0.w), pk2(v1.x, v1.y), pk2(v1.z, v1.w)}; }
        __syncthreads();
    }
}

struct AttnSeg { const bf16_t* K; const bf16_t* K2; const bf16_t* V; int ldk, ldk2, ldv, n, tok0; };
struct AttnDesc { const bf16_t* Q; bf16_t* O; AttnSeg seg[2]; int ldq, ldo; float c1, m0, l0; int qtok0; int rope_q; };
typedef short v4i16_t __attribute__((ext_vector_type(4)));
__device__ __forceinline__ s16x4 vtr(const LAS unsigned char* p) { return __builtin_bit_cast(s16x4, __builtin_amdgcn_ds_read_tr16_b64_v4i16((LAS v4i16_t*)p)); }

template <int DQK, int KIND>
__device__ __forceinline__ void attn_unit(const Ctx& C, const AttnDesc& D, const LAS float* rpb) {
    constexpr int KROW = DQK * 2 + 16, VROW = 160, KBYTES = 64 * KROW, BUFB = KBYTES + 64 * VROW, CPK = DQK / 8, NKC = 64 * CPK;
    const int fr = C.fr, fq = C.fq, q = C.wid * 16 + fr;
    bf16x8 Qf[DQK / 32];
    const bf16_t* qrow = D.Q + (size_t)q * D.ldq;
#pragma unroll
    for (int s = 0; s < DQK / 32; ++s) Qf[s] = *(const bf16x8*)(qrow + s * 32 + fq * 8);
    const int qtok = D.qtok0 + q;
    if (DQK == 96 && D.rope_q) {
        bf16x8 mine = Qf[2], oth;
#pragma unroll
        for (int j = 0; j < 8; ++j) oth[j] = (short)__shfl_xor((int)mine[j], 16);
        const float pos = (fq < 2) ? (float)(qtok >> 6) : (float)(qtok & 63);
#pragma unroll
        for (int j = 0; j < 8; j += 2) {
            float o2[2];
#pragma unroll
            for (int e = 0; e < 2; ++e) {
                const float ang = pos * exp2f(-(float)(j + e) * (13.287712379549449f / 8.0f)); float rev = ang * 0.15915494309189535f; rev -= floorf(rev);
                const float sn = __builtin_amdgcn_sinf(rev), cs = __builtin_amdgcn_cosf(rev);
                const float a = bf2f((bf16_t)mine[j + e]), b = bf2f((bf16_t)oth[j + e]);
                o2[e] = (fq & 1) ? (b * sn + a * cs) : (a * cs - b * sn);
            }
            const unsigned pk = pk2(o2[0], o2[1]); Qf[2][j] = (short)(pk & 0xffffu); Qf[2][j + 1] = (short)(pk >> 16);
        }
    }
    float m = D.m0, l = D.l0 * (fq == 0 ? 1.0f : 0.0f);
    f32x4 Oa[4]; for (int d = 0; d < 4; ++d) Oa[d] = (f32x4){0.f, 0.f, 0.f, 0.f};
    int qrow_g = 0, qcol_g = 0, r0 = 0, cs0 = 0;
    if (KIND == 1) { qrow_g = qtok >> 6; qcol_g = qtok & 63; r0 = min(max(qrow_g - 4, 0), 24); cs0 = min(max(qcol_g - 8, 0), 48); }

    const int nt0 = D.seg[0].n >> 6, ntot = nt0 + (D.seg[1].n >> 6);
    u32x4 kreg[(NKC + 511) / 512], vreg;
    auto issue = [&](int t) {
        const AttnSeg& sg = (t < nt0) ? D.seg[0] : D.seg[1]; const int k0 = ((t < nt0) ? t : t - nt0) * 64;
#pragma unroll
        for (int i = 0; i < (NKC + 511) / 512; ++i) { const int c = C.tid + i * 512;
            if (c < NKC) { const int key = c / CPK, part = c % CPK;
                const bf16_t* src = (part < 8) ? sg.K + (size_t)(k0 + key) * sg.ldk + part * 8 : sg.K2 + (size_t)(k0 + key) * sg.ldk2 + (part - 8) * 8;
                kreg[i] = *(const u32x4*)src; } }
        { const int key = C.tid >> 3, part = C.tid & 7; vreg = *(const u32x4*)(sg.V + (size_t)(k0 + key) * sg.ldv + part * 8); }
    };
    auto commit = [&](int buf) {
        LAS unsigned char* kb = C.lds + buf * BUFB; LAS unsigned char* vb = kb + KBYTES;
#pragma unroll
        for (int i = 0; i < (NKC + 511) / 512; ++i) { const int c = C.tid + i * 512; if (c < NKC) { const int key = c / CPK, part = c % CPK; *(LAS u32x4*)(kb + key * KROW + part * 16) = kreg[i]; } }
        { const int key = C.tid >> 3, part = C.tid & 7; *(LAS u32x4*)(vb + key * VROW + part * 16) = vreg; }
    };
    issue(0);
    for (int t = 0; t < ntot; ++t) {
        const int buf = t & 1;
        commit(buf);
        __syncthreads();
        if (t + 1 < ntot) issue(t + 1);
        const LAS unsigned char* kb = C.lds + buf * BUFB; const LAS unsigned char* vb = kb + KBYTES;
        f32x4 s[4];
#pragma unroll
        for (int kg = 0; kg < 4; ++kg) {
            s[kg] = (f32x4){0.f, 0.f, 0.f, 0.f};
#pragma unroll
            for (int ks = 0; ks < DQK / 32; ++ks) { const bf16x8 Kf = *(const LAS bf16x8*)(kb + (kg * 16 + fr) * KROW + ks * 64 + fq * 16); s[kg] = __builtin_amdgcn_mfma_f32_16x16x32_bf16(Kf, Qf[ks], s[kg], 0, 0, 0); }
        }
        const bool seg1 = (t >= nt0);
        const int ktile0 = seg1 ? D.seg[1].tok0 + (t - nt0) * 64 : 0;
        float mx = -1e30f;
#pragma unroll
        for (int kg = 0; kg < 4; ++kg)
#pragma unroll
            for (int j = 0; j < 4; ++j) {
                float v = s[kg][j] * D.c1;
                if (KIND == 1 && seg1) { const int kt = ktile0 + kg * 16 + 4 * fq + j, krow = kt >> 6, kcol = kt & 63;
                    const bool ok = (krow >= r0) && (krow < r0 + 8) && (kcol >= cs0) && (kcol < cs0 + 16);
                    const int dr = min(max(krow - qrow_g + 7, 0), 14), dc = min(max(kcol - qcol_g + 15, 0), 30);
                    v = ok ? v + rpb[dr * 31 + dc] : -1e30f; }
                if (KIND == 2 && seg1) { const int kt = ktile0 + kg * 16 + 4 * fq + j; const int dd = kt - qtok; v = (dd <= 128 && dd >= -128) ? v : -1e30f; }
                s[kg][j] = v; mx = fmaxf(mx, v);
            }
        mx = qmax4(mx);
        const float mn = fmaxf(m, mx), alpha = __builtin_amdgcn_exp2f(m - mn); m = mn;
        float ps = 0.f;
#pragma unroll
        for (int kg = 0; kg < 4; ++kg)
#pragma unroll
            for (int j = 0; j < 4; ++j) { const float e = __builtin_amdgcn_exp2f(s[kg][j] - mn); s[kg][j] = e; ps += e; }
        l = l * alpha + ps;
#pragma unroll
        for (int d = 0; d < 4; ++d) Oa[d] = Oa[d] * alpha;
#pragma unroll
        for (int k2 = 0; k2 < 2; ++k2) {
            u32x4 pw; pw.x = pk2(s[2 * k2][0], s[2 * k2][1]); pw.y = pk2(s[2 * k2][2], s[2 * k2][3]); pw.z = pk2(s[2 * k2 + 1][0], s[2 * k2 + 1][1]); pw.w = pk2(s[2 * k2 + 1][2], s[2 * k2 + 1][3]);
            const bf16x8 Pf = __builtin_bit_cast(bf16x8, pw);
#pragma unroll
            for (int d = 0; d < 4; ++d) {
                const LAS unsigned char* a0 = vb + (32 * k2 + 4 * fq + (fr >> 2)) * VROW + (d * 16 + 4 * (fr & 3)) * 2;
                const s16x4 lo = vtr(a0), hi = vtr(a0 + 16 * VROW);
                const bf16x8 Vf = (bf16x8){lo[0], lo[1], lo[2], lo[3], hi[0], hi[1], hi[2], hi[3]};
                Oa[d] = __builtin_amdgcn_mfma_f32_16x16x32_bf16(Vf, Pf, Oa[d], 0, 0, 0);
            }
        }
    }
    l += __shfl_xor(l, 16); l += __shfl_xor(l, 32);
    const float inv = 1.0f / l;
    __syncthreads();
    { LAS unsigned char* st = C.lds + C.wid * 2048;
#pragma unroll
        for (int d = 0; d < 4; ++d) { const f32x4 v = Oa[d] * inv; *(LAS u32x2*)(st + fr * 128 + (d * 16 + 4 * fq) * 2) = (u32x2){pk2(v.x, v.y), pk2(v.z, v.w)}; }
        asm volatile("s_waitcnt lgkmcnt(0)" ::: "memory");
#pragma unroll
        for (int i = 0; i < 2; ++i) { const int row = i * 8 + (C.lane >> 3), ch = C.lane & 7; const u32x4 v = *(const LAS u32x4*)(st + row * 128 + ch * 16);
            *(u32x4*)(D.O + (size_t)(C.wid * 16 + row) * D.ldo + ch * 8) = v; }
    }
    __syncthreads();
}

__device__ __forceinline__ void pool_unit(const Params& p, Ctx& C, int L, int unit) {
    const bf16_t* P = (const bf16_t*)(p.ws + WS_P); bf16_t* BR = (bf16_t*)(p.ws + WS_BR);
    { int t_ = threadIdx.x; asm volatile("" : "+v"(t_)); C.tid = t_; C.lane = t_ & 63; C.wid = __builtin_amdgcn_readfirstlane(t_ >> 6); }
    const int T0 = unit * 64; int S0, Ls; if (T0 < NCTX) { S0 = T0 & ~255; Ls = 256; } else { S0 = NCTX + ((T0 - NCTX) & ~2047); Ls = 2048; }
    LAS float* dlt = (LAS float*)C.lds;
    LAS bf16_t* raw = (LAS bf16_t*)(C.lds + 66048);
    LAS float* Wl = (LAS float*)(C.lds + 66048);
    f32x4 wreg[8];
    { const f32x4* Wg = (const f32x4*)(p.in[25] + (size_t)L * 4 * 64 * 64);
#pragma unroll
        for (int i = 0; i < 8; ++i) wreg[i] = Wg[C.tid + i * 512]; }
    for (int i = C.tid; i < 80 * 32; i += 512) { const int r = i >> 5, c = i & 31; const int T = T0 - 8 + r;
        u32x4 v = (u32x4){0u, 0u, 0u, 0u}; if (T >= S0 && T < S0 + Ls) v = *(const u32x4*)(P + (size_t)T * LDP + COL_PD + c * 8);
        *(LAS u32x4*)(raw + r * 256 + c * 8) = v; }
    __syncthreads();
    for (int i = C.tid; i < 64 * 256; i += 512) { const int t = i >> 8, ch = i & 255, gi = ch >> 6; const int hw = 1 << gi, w = 2 << gi;
        const int tl = T0 - S0 + t; const int lo = max(tl - hw, 0), hi = min(tl - hw + w, Ls);
        float s = 0.f; for (int j = lo; j < hi; ++j) s += bf2f(raw[(j - (T0 - S0) + 8) * 256 + ch]);
        dlt[t * 257 + ch] = s / (float)(hi - lo) - bf2f(raw[(t + 8) * 256 + ch]); }
    __syncthreads();
#pragma unroll
    for (int i = 0; i < 8; ++i) ((LAS f32x4*)Wl)[C.tid + i * 512] = wreg[i];
    __syncthreads();
    { const int t = C.lane, gi = C.wid & 3, e0 = (C.wid >> 2) * 32;
        const LAS float* W = Wl + gi * 4096 + e0;
        float a[32];
#pragma unroll
        for (int e = 0; e < 32; ++e) a[e] = 0.f;
#pragma unroll 4
        for (int c = 0; c < 64; ++c) { const float d = dlt[t * 257 + gi * 64 + c];
#pragma unroll
            for (int e4 = 0; e4 < 8; ++e4) { const f32x4 w4 = *(const LAS f32x4*)(W + c * 64 + e4 * 4); a[e4 * 4] += d * w4.x; a[e4 * 4 + 1] += d * w4.y; a[e4 * 4 + 2] += d * w4.z; a[e4 * 4 + 3] += d * w4.w; } }
        const float* sc = p.in[26] + L * 256 + gi * 64 + e0;
        bf16_t* orow = BR + (size_t)(T0 + t) * LDH + 768 + gi * 64 + e0;
#pragma unroll
        for (int e = 0; e < 32; e += 8) *(u32x4*)(orow + e) = (u32x4){pk2(a[e] * sc[e], a[e + 1] * sc[e + 1]), pk2(a[e + 2] * sc[e + 2], a[e + 3] * sc[e + 3]), pk2(a[e + 4] * sc[e + 4], a[e + 5] * sc[e + 5]), pk2(a[e + 6] * sc[e + 6], a[e + 7] * sc[e + 7])};
    }
    __syncthreads();
}

__device__ __forceinline__ void phase4(const Params& p, Ctx& C, int L, int rep = 0) {
    const bf16_t* P = (const bf16_t*)(p.ws + WS_P); bf16_t* BR = (bf16_t*)(p.ws + WS_BR);
    const bf16_t* QUP = (const bf16_t*)(p.ws + WS_QUP); const bf16_t* KVUP = (const bf16_t*)(p.ws + WS_KVUP);
    const bf16_t* KVC = (const bf16_t*)(p.ws + WS_KVCUP) + (size_t)L * 512 * LDKV;
    const bf16_t* NAK = (const bf16_t*)(p.ws + WS_NACK) + (size_t)L * 512 * LDNAC; const bf16_t* NAV = (const bf16_t*)(p.ws + WS_NACV) + (size_t)L * 512 * LDNAC;
    const bf16_t* SWK = (const bf16_t*)(p.ws + WS_SWCK) + (size_t)L * 512 * LDSWC; const bf16_t* SWV = (const bf16_t*)(p.ws + WS_SWCV) + (size_t)L * 512 * LDSWC;
    const bf16_t* KRC = (const bf16_t*)(p.ws + WS_KRC) + (size_t)L * 512 * 32;
    unsigned* qhead = (unsigned*)(p.ws + WS_CTL) + CW_QUEUE + 64 * (L * 2 + rep);
    volatile LAS unsigned* bc = (volatile LAS unsigned*)(C.lds + LDS_CTL + 16);
    LAS float* rpb = (LAS float*)(C.lds + LDS_TAB);
    const float ATT_C1 = 0.125f * LOG2E, MLA_C1 = 0.10206207261596575f * LOG2E;
    for (;;) {
        if (C.tid == 0) bc[0] = atomicAdd(qhead, 1u);
        __syncthreads();
        const int u = __builtin_amdgcn_readfirstlane((int)bc[0]);
        __syncthreads();
        if (u >= 1344) break;
        AttnDesc D; D.rope_q = 0; D.m0 = -1e30f; D.l0 = 0.f; D.seg[1].K2 = nullptr; D.seg[0].K2 = nullptr; D.seg[0].ldk2 = 0; D.seg[1].ldk2 = 0; D.seg[0].tok0 = 0; D.seg[1].tok0 = 0;
        if (u < 128) {
            const int b = u >> 6, h = (u >> 4) & 3, qb = u & 15; const int T0 = NCTX + b * 2048;
            D.Q = QUP + (size_t)(T0 + qb * 128) * LDQ + h * 96; D.ldq = LDQ; D.O = BR + (size_t)(T0 + qb * 128) * LDH + 256 + h * 64; D.ldo = LDH;
            D.seg[0] = AttnSeg{KVC + (size_t)b * 256 * LDKV + h * 128, KRC + (size_t)b * 256 * 32, KVC + (size_t)b * 256 * LDKV + h * 128 + 64, LDKV, 32, LDKV, 256, 0};
            D.seg[1] = AttnSeg{KVUP + (size_t)T0 * LDKV + h * 128, P + (size_t)T0 * LDP + COL_KR, KVUP + (size_t)T0 * LDKV + h * 128 + 64, LDKV, LDP, LDKV, 2048, 0};
            D.c1 = MLA_C1; D.qtok0 = qb * 128; D.rope_q = 1;
#ifndef NO_A1
            attn_unit<96, 0>(C, D, rpb);
#endif
        } else if (u < 256) {
            const int v = u - 128, b = v >> 6, h = (v >> 4) & 3, rp = v & 15; const int T0 = NCTX + b * 2048;
            const int ra = 2 * rp, r0a = min(max(ra - 4, 0), 24), r0b = min(max(ra + 1 - 4, 0), 24);
            for (int i = C.tid; i < 15 * 31; i += 512) rpb[i] = p.in[19][(size_t)(L * 4 + h) * 465 + i] * LOG2E;
            D.Q = P + (size_t)(T0 + ra * 64) * LDP + COL_QA + h * 64; D.ldq = LDP; D.O = BR + (size_t)(T0 + ra * 64) * LDH + 0 + h * 64; D.ldo = LDH;
            D.seg[0] = AttnSeg{NAK + (size_t)b * 256 * LDNAC + h * 64, nullptr, NAV + (size_t)b * 256 * LDNAC + h * 64, LDNAC, 0, LDNAC, 256, 0};
            D.seg[1] = AttnSeg{P + (size_t)(T0 + r0a * 64) * LDP + COL_KA + h * 64, nullptr, P + (size_t)(T0 + r0a * 64) * LDP + COL_VA + h * 64, LDP, 0, LDP, (r0b + 8 - r0a) * 64, r0a * 64};
            D.c1 = ATT_C1; D.qtok0 = ra * 64;
            __syncthreads();
#ifndef NO_A2
            attn_unit<64, 1>(C, D, rpb);
#endif
        } else if (u < 384) {
            const int v = u - 256, b = v >> 6, h = (v >> 4) & 3, qb = v & 15; const int T0 = NCTX + b * 2048, kvh = h >> 1;
            const int klo = max(qb * 128 - 128, 0), khi = min(qb * 128 + 256, 2048);
            D.Q = P + (size_t)(T0 + qb * 128) * LDP + COL_QC + h * 64; D.ldq = LDP; D.O = BR + (size_t)(T0 + qb * 128) * LDH + 512 + h * 64; D.ldo = LDH;
            D.seg[0] = AttnSeg{SWK + (size_t)b * 256 * LDSWC + kvh * 64, nullptr, SWV + (size_t)b * 256 * LDSWC + kvh * 64, LDSWC, 0, LDSWC, 256, 0};
            D.seg[1] = AttnSeg{P + (size_t)(T0 + klo) * LDP + COL_KC + kvh * 64, nullptr, P + (size_t)(T0 + klo) * LDP + COL_VC + kvh * 64, LDP, 0, LDP, khi - klo, klo};
            D.c1 = ATT_C1; D.qtok0 = qb * 128; D.m0 = p.in[24][L * 4 + h] * LOG2E; D.l0 = 1.0f;
#ifndef NO_A3
            attn_unit<64, 2>(C, D, rpb);
#endif
        } else if (u >= 576) {
            const int v = u - 576, half = v & 1, kh = (v >> 1) % 12, b = (v >> 1) / 12, kind = kh >> 2, h = kh & 3; const int T0 = b * 256, Tq = T0 + half * 128;
            D.qtok0 = half * 128; D.seg[1].n = 0; D.seg[1].K = nullptr; D.seg[1].V = nullptr; D.seg[1].ldk = 0; D.seg[1].ldv = 0;
            if (kind == 0) {
                D.Q = P + (size_t)Tq * LDP + COL_QA + h * 64; D.ldq = LDP; D.O = BR + (size_t)Tq * LDH + h * 64; D.ldo = LDH;
                D.seg[0] = AttnSeg{P + (size_t)T0 * LDP + COL_KA + h * 64, nullptr, P + (size_t)T0 * LDP + COL_VA + h * 64, LDP, 0, LDP, 256, 0};
#ifndef NO_A4
                D.c1 = ATT_C1; attn_unit<64, 0>(C, D, rpb);
#endif
            } else if (kind == 1) {
                D.Q = QUP + (size_t)Tq * LDQ + h * 96; D.ldq = LDQ; D.O = BR + (size_t)Tq * LDH + 256 + h * 64; D.ldo = LDH;
                D.seg[0] = AttnSeg{KVUP + (size_t)T0 * LDKV + h * 128, P + (size_t)T0 * LDP + COL_KR, KVUP + (size_t)T0 * LDKV + h * 128 + 64, LDKV, LDP, LDKV, 256, 0};
#ifndef NO_A5
                D.c1 = MLA_C1; attn_unit<96, 0>(C, D, rpb);
#endif
            } else {
                const int kvh = h >> 1;
                D.Q = P + (size_t)Tq * LDP + COL_QC + h * 64; D.ldq = LDP; D.O = BR + (size_t)Tq * LDH + 512 + h * 64; D.ldo = LDH;
                D.seg[0] = AttnSeg{P + (size_t)T0 * LDP + COL_KC + kvh * 64, nullptr, P + (size_t)T0 * LDP + COL_VC + kvh * 64, LDP, 0, LDP, 256, 0};
#ifndef NO_A6
                D.c1 = ATT_C1; D.m0 = p.in[24][L * 4 + h] * LOG2E; D.l0 = 1.0f; attn_unit<64, 0>(C, D, rpb);
#endif
            }
        } else {
#ifndef NO_POOL
            pool_unit(p, C, L, u - 384);
#endif
        }
    }
}

struct BrSched {
    const char* BR; const char* Wb; int G, c;
    __device__ __forceinline__ bool next(int i, G8Unit& u) const {
        const int Lu = i * G + c; if (Lu >= 48 * 16) return false;
        int pm, q; unit_map(Lu, 48, 16, pm, q);
        u.A = BR + (size_t)pm * 256 * LDH * 2 + (q >> 2) * 512; u.B = Wb + (size_t)q * 256 * LDWB * 2; u.e0 = pm; u.e1 = q; u.e2 = 0; u.e3 = 0; return true;
    }
};
__device__ __forceinline__ void phase5a(const Params& p, Ctx& C, int L) {
    BrSched S{(const char*)(p.ws + WS_BR), (const char*)(p.ws + WS_W + (size_t)L * W_LAYER + WO_BR), C.G, C.bid};
    EpiBf16 E{(bf16_t*)(p.ws + WS_BK), LDBK};
    gemm8(C, 256, LDH, LDWB, S, E);
}
struct EpiGate {
    static constexpr bool PERM = false, AFTER_DRAIN = false, FP8 = true; static constexpr int HROWS_B = 2048;
    static __device__ __forceinline__ int brow(int R) { return ((R >> 4) & 1) * 1024 + (R >> 5) * 16 + (R & 15); }
    const bf16_t* BK; bf16_t* MG; const float* bg;
    __device__ __forceinline__ void operator()(const f32x4 (&acc)[2][2][4][2], const G8Unit& u, int wr, int wc, int fr_, int fq_) const {
        int fr = fr_, fq = fq_; asm volatile("" : "+v"(fr), "+v"(fq));
        const int xw = u.e1 * 64 + wc * 16;
#define SPIN_(ptr) asm volatile("" : "+s"(ptr))
        const char* bkb = (const char*)BK + ((size_t)(u.e0 * 256 + wr * 64) * LDBK + xw) * 2;
        char* mgb = (char*)MG + ((size_t)(u.e0 * 256 + wr * 64) * LDH + xw) * 2;
        const unsigned lob = (unsigned)(fr * LDBK + 4 * fq) * 2u, lom = (unsigned)(fr * LDH + 4 * fq) * 2u, lof = (unsigned)fq * 16u;
        f32x4 bias[4];
#pragma unroll
        for (int k = 0; k < 4; ++k) { const char* bp = (const char*)(bg + k * 1024 + xw); SPIN_(bp); bias[k] = *(const f32x4*)(bp + lof) * -LOG2E_; }
#pragma unroll
        for (int ai = 0; ai < 2; ++ai) {
            u32x2 b[4][4];
#pragma unroll
            for (int m = 0; m < 4; ++m) {
                const char* r01 = bkb + (size_t)(ai * 128 + m * 16) * LDBK * 2; SPIN_(r01);
                const char* r23 = r01 + 4096; SPIN_(r23);
                b[m][0] = *(const u32x2*)(r01 + lob); b[m][1] = *(const u32x2*)(r01 + lob + 2048);
                b[m][2] = *(const u32x2*)(r23 + lob); b[m][3] = *(const u32x2*)(r23 + lob + 2048); }
#pragma unroll
            for (int m = 0; m < 4; ++m) {
                f32x4 sum = (f32x4){0.f, 0.f, 0.f, 0.f};
#pragma unroll
                for (int k = 0; k < 4; ++k) { const f32x4 t = acc[ai][k >> 1][m][k & 1] * (-LOG2E_ * 0.03125f) + bias[k];
                    const f32x4 e = (f32x4){__builtin_amdgcn_exp2f(t.x), __builtin_amdgcn_exp2f(t.y), __builtin_amdgcn_exp2f(t.z), __builtin_amdgcn_exp2f(t.w)} + 1.0f;
                    const f32x4 g = (f32x4){__builtin_amdgcn_rcpf(e.x), __builtin_amdgcn_rcpf(e.y), __builtin_amdgcn_rcpf(e.z), __builtin_amdgcn_rcpf(e.w)};
                    sum += g * (f32x4){lo16(b[m][k].x), hi16(b[m][k].x), lo16(b[m][k].y), hi16(b[m][k].y)}; }
                char* mp = mgb + (size_t)(ai * 128 + m * 16) * LDH * 2; SPIN_(mp);
                *(u32x2*)(mp + lom) = (u32x2){pk2(sum.x, sum.y), pk2(sum.z, sum.w)};
            }
            asm volatile("" ::: "memory");
        }
#undef SPIN_
    }
};
__device__ __forceinline__ void phase5b(const Params& p, Ctx& C, int L) {
    TileSched S{(const char*)(p.ws + WS_H8), (const char*)(p.ws + WS_W + (size_t)L * W_LAYER + WO_GATE), (size_t)256 * LD8, (size_t)64 * LD8, 48, 16, C.G, C.bid};
    EpiGate E{(const bf16_t*)(p.ws + WS_BK), (bf16_t*)(p.ws + WS_MERGED), p.in[18] + (size_t)L * 4096};
    gemm8(C, 512, LD8 / 2, LD8 / 2, S, E);
}

__device__ __forceinline__ void gemm_bf16_phase(Ctx& C, const bf16_t* A, int lda, const bf16_t* Bt, int ldb, int K, bf16_t* O, int ldo, int nM, int nN) {
    TileSched S{(const char*)A, (const char*)Bt, (size_t)256 * lda * 2, (size_t)256 * ldb * 2, nM, nN, C.G, C.bid};
    EpiBf16 E{O, ldo};
    gemm8(C, K, lda, ldb, S, E);
}


struct RowSumSq {
    float* xbuf;
    unsigned* cnt;
    __device__ __forceinline__ void run(const Ctx& C, const f32x4 (&v)[2][2][4][2], int pm, int pn, int wr, int wc, int fr, int fq, float (&rs)[2][4]) const {
        LAS float* P = (LAS float*)C.lds;
        LAS float* S = (LAS float*)(C.lds + 4096);
#pragma unroll
        for (int ai = 0; ai < 2; ++ai)
#pragma unroll
            for (int m = 0; m < 4; ++m) { float s = 0.f;
#pragma unroll
                for (int bj = 0; bj < 2; ++bj)
#pragma unroll
                    for (int n = 0; n < 2; ++n) { const f32x4 x = v[ai][bj][m][n]; s += (x[0] * x[0] + x[1] * x[1]) + (x[2] * x[2] + x[3] * x[3]); }
                s += __shfl_xor(s, 16); s += __shfl_xor(s, 32);
                if (fq == 0) P[(ai * 128 + wr * 64 + m * 16 + fr) * 4 + wc] = s; }
        asm volatile("s_waitcnt lgkmcnt(0)" ::: "memory"); __builtin_amdgcn_s_barrier(); asm volatile("" ::: "memory");
        const int row = C.wid * 32 + (C.lane & 31);
        if (C.lane < 32) { const float t = (P[row * 4 + 0] + P[row * 4 + 1]) + (P[row * 4 + 2] + P[row * 4 + 3]);
            __hip_atomic_store(xbuf + ((size_t)(pm * 256 + row) * 4 + pn), t, __ATOMIC_RELAXED, __HIP_MEMORY_SCOPE_AGENT); }
        asm volatile("s_waitcnt vmcnt(0)" ::: "memory");
        if (C.lane == 0) __hip_atomic_fetch_add(cnt + 64 * pm, 1u, __ATOMIC_RELAXED, __HIP_MEMORY_SCOPE_AGENT);
        if (C.wid == 0) {
            unsigned spins = 0;
            while ((unsigned)__builtin_amdgcn_readfirstlane(__hip_atomic_load(cnt + 64 * pm, __ATOMIC_RELAXED, __HIP_MEMORY_SCOPE_AGENT)) < 32u) { __builtin_amdgcn_s_sleep(2); if (++spins > (1u << 22)) break; }
            __builtin_amdgcn_fence(__ATOMIC_ACQUIRE, "agent");
        }
        asm volatile("s_waitcnt vmcnt(0) lgkmcnt(0)" ::: "memory"); __builtin_amdgcn_s_barrier(); asm volatile("" ::: "memory");
        if (C.lane < 32) { const float* slot = xbuf + (size_t)(pm * 256 + row) * 4; float t = 0.f;
#pragma unroll
            for (int q = 0; q < 4; ++q) t += __hip_atomic_load(slot + q, __ATOMIC_RELAXED, __HIP_MEMORY_SCOPE_AGENT);
            S[row] = t; }
        asm volatile("s_waitcnt vmcnt(0) lgkmcnt(0)" ::: "memory"); __builtin_amdgcn_s_barrier(); asm volatile("" ::: "memory");
#pragma unroll
        for (int ai = 0; ai < 2; ++ai)
#pragma unroll
            for (int m = 0; m < 4; ++m) rs[ai][m] = S[ai * 128 + wr * 64 + m * 16 + fr];
        asm volatile("s_waitcnt lgkmcnt(0)" ::: "memory"); __builtin_amdgcn_s_barrier(); asm volatile("" ::: "memory");
    }
};
template <int MODE> struct EpiNormFused {
    static constexpr bool PERM = true, AFTER_DRAIN = true; G8_EPI_PLAIN
    const Params& p; int L;
    __device__ __forceinline__ void drained(const Ctx& C, f32x4 (&acc)[2][2][4][2], const G8Unit& u, int wr, int wc, int fr, int fq) const {
        const int pm = u.e0, pn = u.e1, cls = pm < 32 ? 0 : 1 + ((pm - 32) >> 3);
        unsigned* ctl = (unsigned*)(p.ws + WS_CTL);
        const float* modv = (const float*)(p.ws + WS_MODV);
        const float* mv = modv + (size_t)(L * 3 + cls) * 6144;
        float* Y = p.out + OFF_Y; bf16_t* H = (bf16_t*)(p.ws + WS_H);
        const float* gpost = (MODE == 0 ? p.in[13] : p.in[15]) + L * DM;
        const float* gate = mv + (MODE == 0 ? 2048 : 5120);
        const float* xpan = (MODE == 0 && L == 0) ? (pm < 32 ? p.in[0] + (size_t)pm * 256 * DM : p.in[1] + (size_t)(pm - 32) * 256 * DM) : Y + (size_t)pm * 256 * DM;
        float* ypan = Y + (size_t)pm * 256 * DM; bf16_t* hpan = H + (size_t)pm * 256 * LDH; unsigned char* h8pan = p.ws + WS_H8 + (size_t)pm * 256 * LD8;
        float rs[2][4];
        { RowSumSq X{(float*)(ctl + CW_XBUF), ctl + CW_SEAM + ((L * 2 + MODE) * 2 + 0) * 48 * 64}; X.run(C, acc, pm, pn, wr, wc, fr, fq, rs); }
#pragma unroll
        for (int ai = 0; ai < 2; ++ai)
#pragma unroll
            for (int m = 0; m < 4; ++m) rs[ai][m] = __builtin_amdgcn_rsqf(rs[ai][m] * (1.0f / DM) + EPS);
#pragma unroll
        for (int bj = 0; bj < 2; ++bj) { const int col = pn * 256 + bj * 128 + wc * 32 + 8 * fq;
            const f32x4 gp0 = *(const f32x4*)(gpost + col), gp1 = *(const f32x4*)(gpost + col + 4), g0 = *(const f32x4*)(gate + col), g1 = *(const f32x4*)(gate + col + 4);
#pragma unroll
            for (int ai = 0; ai < 2; ++ai)
#pragma unroll
                for (int m = 0; m < 4; ++m) { const int off = (ai * 128 + wr * 64 + m * 16 + fr) * DM + col;
                    const f32x4 x0 = *(const f32x4*)(xpan + off), x1 = *(const f32x4*)(xpan + off + 4);
                    acc[ai][bj][m][0] = x0 + g0 * (acc[ai][bj][m][0] * rs[ai][m] * gp0);
                    acc[ai][bj][m][1] = x1 + g1 * (acc[ai][bj][m][1] * rs[ai][m] * gp1);
                    asm volatile("" : "+v"(acc[ai][bj][m][0]), "+v"(acc[ai][bj][m][1]));
                    if (m & 1) asm volatile("" ::: "memory"); } }
        const bool second = (MODE == 0) || (L == 0);
        if (second) { RowSumSq X{(float*)(ctl + CW_XBUF) + 48 * 256 * 4, ctl + CW_SEAM + ((L * 2 + MODE) * 2 + 1) * 48 * 64}; X.run(C, acc, pm, pn, wr, wc, fr, fq, rs);
#pragma unroll
            for (int ai = 0; ai < 2; ++ai)
#pragma unroll
                for (int m = 0; m < 4; ++m) rs[ai][m] = __builtin_amdgcn_rsqf(rs[ai][m] * (1.0f / DM) + EPS); }
        const float* mvn = (MODE == 0) ? mv : modv + (size_t)(1 * 3 + cls) * 6144;
        const float* gpre = (MODE == 0) ? p.in[14] + L * DM : p.in[12] + DM;
        const float* scv = mvn + (MODE == 0 ? 4096 : 1024); const float* shv = mvn + (MODE == 0 ? 3072 : 0);
#pragma unroll
        for (int bj = 0; bj < 2; ++bj) { const int col = pn * 256 + bj * 128 + wc * 32 + 8 * fq;
            const f32x4 z = (f32x4){0.f, 0.f, 0.f, 0.f};
            f32x4 gg0 = z, gg1 = z, sa0 = z, sa1 = z, sb0 = z, sb1 = z;
            if (second) { gg0 = *(const f32x4*)(gpre + col); gg1 = *(const f32x4*)(gpre + col + 4); sa0 = *(const f32x4*)(scv + col) + 1.0f; sa1 = *(const f32x4*)(scv + col + 4) + 1.0f; sb0 = *(const f32x4*)(shv + col); sb1 = *(const f32x4*)(shv + col + 4); }
#pragma unroll
            for (int ai = 0; ai < 2; ++ai)
#pragma unroll
                for (int m = 0; m < 4; ++m) { const int rl = ai * 128 + wr * 64 + m * 16 + fr; const f32x4 v0 = acc[ai][bj][m][0], v1 = acc[ai][bj][m][1];
                    *(f32x4*)(ypan + rl * DM + col) = v0; *(f32x4*)(ypan + rl * DM + col + 4) = v1;
                    if (second) { const f32x4 h0 = v0 * rs[ai][m] * gg0 * sa0 + sb0, h1 = v1 * rs[ai][m] * gg1 * sa1 + sb1;
                        *(u32x4*)(hpan + rl * LDH + col) = (u32x4){pk2(h0.x, h0.y), pk2(h0.z, h0.w), pk2(h1.x, h1.y), pk2(h1.z, h1.w)};
                        if (MODE == 1) { int w0 = __builtin_amdgcn_cvt_pk_fp8_f32(h0.x, h0.y, 0, false); w0 = __builtin_amdgcn_cvt_pk_fp8_f32(h0.z, h0.w, w0, true);
                            int w1 = __builtin_amdgcn_cvt_pk_fp8_f32(h1.x, h1.y, 0, false); w1 = __builtin_amdgcn_cvt_pk_fp8_f32(h1.z, h1.w, w1, true);
                            *(u32x2*)(h8pan + rl * LD8 + col) = (u32x2){(unsigned)w0, (unsigned)w1}; } }
                    asm volatile("" ::: "memory"); } }
    }
};
template <int MODE> __device__ __forceinline__ void gemm_norm_phase(const Params& p, Ctx& C, int L, const bf16_t* A, int lda, const bf16_t* Bt, int ldb, int K) {
    TileSched S{(const char*)A, (const char*)Bt, (size_t)256 * lda * 2, (size_t)256 * ldb * 2, 48, 4, C.G, C.bid};
    EpiNormFused<MODE> E{p, L};
    gemm8(C, K, lda, ldb, S, E);
}

struct OneUnit { G8Unit u; __device__ __forceinline__ bool next(int i, G8Unit& o) const { if (i > 0) return false; o = u; return true; } };
struct EpiUpConv {
    static constexpr bool PERM = false, AFTER_DRAIN = true; G8_EPI_PLAIN
    bf16_t* ACT; const float* cw;
    __device__ __forceinline__ void drained(const Ctx& C, const f32x4 (&acc)[2][2][4][2], const G8Unit& u, int wr, int wc, int fr, int fq) const {
        constexpr int UROW = 528;
        const int Trow0 = u.e0, pn = u.e1, tpos0 = u.e2, Ls = u.e3;
#pragma unroll
        for (int ai = 0; ai < 2; ++ai)
#pragma unroll
            for (int m = 0; m < 4; ++m) { const int r = ai * 128 + wr * 64 + m * 16 + fr;
#pragma unroll
                for (int bj = 0; bj < 2; ++bj)
#pragma unroll
                    for (int n = 0; n < 2; ++n) { const int c = bj * 128 + wc * 32 + n * 16 + 4 * fq; const f32x4 v = acc[ai][bj][m][n]; *(LAS u32x2*)(C.lds + r * UROW + c * 2) = (u32x2){pk2(v.x, v.y), pk2(v.z, v.w)}; } }
        __syncthreads();
        {
            const int cc = C.tid & 15, rg = C.tid >> 4;
            const int f0 = pn * 128 + cc * 8;
            float wa[3][8], wg[3][8];
#pragma unroll
            for (int j = 0; j < 3; ++j)
#pragma unroll
                for (int e = 0; e < 8; ++e) { const bool ok = (f0 + e) < DFF; wa[j][e] = ok ? cw[j * 5504 + f0 + e] : 0.f; wg[j][e] = ok ? cw[j * 5504 + DFF + f0 + e] : 0.f; }
            for (int ps = 0; ps < 8; ++ps) {
                const int r = ps * 32 + rg, tpos = tpos0 + r;
                const bool valid = (r > 0 || tpos == 0) && (r < 255 || tpos == Ls - 1);
                if (!valid) continue;
                const bool hasl = tpos > 0, hasr = tpos < Ls - 1;
                const LAS unsigned char* base = C.lds + r * UROW + cc * 16;
                const u32x4 z = (u32x4){0u, 0u, 0u, 0u};
                const u32x4 a0 = hasl ? *(const LAS u32x4*)(base - UROW) : z, a1 = *(const LAS u32x4*)base, a2 = hasr ? *(const LAS u32x4*)(base + UROW) : z;
                const u32x4 g0 = hasl ? *(const LAS u32x4*)(base - UROW + 256) : z, g1 = *(const LAS u32x4*)(base + 256), g2 = hasr ? *(const LAS u32x4*)(base + UROW + 256) : z;
                float o[8];
#pragma unroll
                for (int e = 0; e < 8; ++e) {
                    const unsigned ua0 = a0[e >> 1], ua1 = a1[e >> 1], ua2 = a2[e >> 1], ug0 = g0[e >> 1], ug1 = g1[e >> 1], ug2 = g2[e >> 1];
                    const float xa0 = (e & 1) ? hi16(ua0) : lo16(ua0), xa1 = (e & 1) ? hi16(ua1) : lo16(ua1), xa2 = (e & 1) ? hi16(ua2) : lo16(ua2);
                    const float xg0 = (e & 1) ? hi16(ug0) : lo16(ug0), xg1 = (e & 1) ? hi16(ug1) : lo16(ug1), xg2 = (e & 1) ? hi16(ug2) : lo16(ug2);
                    const float av = xa0 * wa[0][e] + xa1 * wa[1][e] + xa2 * wa[2][e];
                    const float gv = xg0 * wg[0][e] + xg1 * wg[1][e] + xg2 * wg[2][e];
                    o[e] = siluf_(gv) * av;
                }
                *(u32x4*)(ACT + (size_t)(Trow0 + r) * LDACT + f0) = (u32x4){pk2(o[0], o[1]), pk2(o[2], o[3]), pk2(o[4], o[5]), pk2(o[6], o[7])};
            }
        }
        __syncthreads();
    }
};
__device__ __forceinline__ float dpp_ror1(float x) { return __int_as_float(__builtin_amdgcn_update_dpp(0, __float_as_int(x), 0x121, 0xf, 0xf, false)); }
__device__ __forceinline__ float dpp_ror15(float x) { return __int_as_float(__builtin_amdgcn_update_dpp(0, __float_as_int(x), 0x12F, 0xf, 0xf, false)); }
struct EpiUpConvReg {
    static constexpr bool PERM = true, AFTER_DRAIN = false; G8_EPI_PLAIN
    bf16_t* ACT; const float* cw; LAS unsigned* halo;
    __device__ __forceinline__ void operator()(const f32x4 (&acc)[2][2][4][2], const G8Unit& u, int wr, int wc, int fr_, int fq_) const {
        int fr = fr_, fq = fq_; asm volatile("" : "+v"(fr), "+v"(fq));
        const int Trow0 = u.e0, pn = u.e1, tpos0 = u.e2, Ls = u.e3;
        const int cl = wc * 32 + 8 * fq;
        unsigned xp[2][4][2][4];
#pragma unroll
        for (int ai = 0; ai < 2; ++ai)
#pragma unroll
            for (int m = 0; m < 4; ++m)
#pragma unroll
                for (int n = 0; n < 2; ++n)
#pragma unroll
                    for (int j = 0; j < 4; ++j) { xp[ai][m][n][j] = pk2(acc[ai][0][m][n][j], acc[ai][1][m][n][j]); asm volatile("" : "+v"(xp[ai][m][n][j])); }
#pragma unroll
        for (int ai = 0; ai < 2; ++ai) { const int b = ai * 2 + wr;
#pragma unroll
            for (int n = 0; n < 2; ++n) {
                if (fr == 0) *(LAS u32x4*)(halo + (b * 2 + 0) * 128 + cl + 4 * n) = (u32x4){xp[ai][0][n][0], xp[ai][0][n][1], xp[ai][0][n][2], xp[ai][0][n][3]};
                if (fr == 15) *(LAS u32x4*)(halo + (b * 2 + 1) * 128 + cl + 4 * n) = (u32x4){xp[ai][3][n][0], xp[ai][3][n][1], xp[ai][3][n][2], xp[ai][3][n][3]};
            } }
        LAS float* cwl = (LAS float*)(halo + 1024);
        int tx = threadIdx.x; asm volatile("" : "+v"(tx));
        if (tx < 192) { const int jp = tx >> 5, ch = tx & 31, f = pn * 128 + ch * 4;
            const f32x4 v = (f < DFF) ? *(const f32x4*)(cw + (jp >> 1) * 5504 + (jp & 1) * DFF + f) : (f32x4){0.f, 0.f, 0.f, 0.f};
            *(LAS f32x4*)(cwl + jp * 128 + ch * 4) = v; }
        asm volatile("s_waitcnt vmcnt(0) lgkmcnt(0)\n\ts_barrier" ::: "memory");
        asm volatile("s_barrier" ::: "memory");
        const int f0 = pn * 128 + cl;
        const int src_up = ((fq << 4) | ((fr + 15) & 15)) << 2, src_dn = ((fq << 4) | ((fr + 1) & 15)) << 2;
        const bool seq_first = (tpos0 == 0), seq_last = (tpos0 + 256 == Ls);
        u32x2 pk0[2][4];
#pragma unroll
        for (int n = 0; n < 2; ++n) {
            f32x2 w0[4], w1[4], w2[4];
            { const f32x4 a0 = *(const LAS f32x4*)(cwl + 0 * 128 + cl + 4 * n), g0 = *(const LAS f32x4*)(cwl + 1 * 128 + cl + 4 * n);
                const f32x4 a1 = *(const LAS f32x4*)(cwl + 2 * 128 + cl + 4 * n), g1 = *(const LAS f32x4*)(cwl + 3 * 128 + cl + 4 * n);
                const f32x4 a2 = *(const LAS f32x4*)(cwl + 4 * 128 + cl + 4 * n), g2 = *(const LAS f32x4*)(cwl + 5 * 128 + cl + 4 * n);
#pragma unroll
                for (int j = 0; j < 4; ++j) { w0[j] = (f32x2){a0[j], g0[j]}; w1[j] = (f32x2){a1[j], g1[j]}; w2[j] = (f32x2){a2[j], g2[j]}; } }
#pragma unroll
            for (int ai = 0; ai < 2; ++ai) { const int b = ai * 2 + wr;
                u32x4 hup = (u32x4){0u, 0u, 0u, 0u}, hdn = hup;
                if (b > 0) hup = *(const LAS u32x4*)(halo + ((b - 1) * 2 + 1) * 128 + cl + 4 * n);
                if (b < 3) hdn = *(const LAS u32x4*)(halo + ((b + 1) * 2 + 0) * 128 + cl + 4 * n);
#pragma unroll
                for (int m = 0; m < 4; ++m) {
                    const int r = ai * 128 + wr * 64 + m * 16 + fr;
                    float o[4];
#pragma unroll
                    for (int j = 0; j < 4; ++j) {
                        const unsigned xc = xp[ai][m][n][j];
                        const unsigned pv = (m > 0) ? xp[ai][m > 0 ? m - 1 : 0][n][j] : hup[j], nv = (m < 3) ? xp[ai][m < 3 ? m + 1 : 3][n][j] : hdn[j];
                        unsigned upk = (unsigned)__builtin_amdgcn_update_dpp(0, (int)(fr == 15 ? pv : xc), 0x121, 0xf, 0xf, false);
                        unsigned dnk = (unsigned)__builtin_amdgcn_update_dpp(0, (int)(fr == 0 ? nv : xc), 0x12F, 0xf, 0xf, false);
                        if (ai == 0 && m == 0) { if (seq_first && r == 0) upk = 0u; }
                        if (ai == 1 && m == 3) { if (seq_last && r == 255) dnk = 0u; }
                        const f32x2 c2 = (f32x2){lo16(upk), hi16(upk)} * w0[j] + (f32x2){lo16(xc), hi16(xc)} * w1[j] + (f32x2){lo16(dnk), hi16(dnk)} * w2[j];
                        o[j] = siluf_(c2.y) * c2.x;
                    }
                    const u32x2 pkn = (u32x2){pk2(o[0], o[1]), pk2(o[2], o[3])};
                    if (n == 0) pk0[ai][m] = pkn;
                    else {
                        bool valid = true;
                        if (ai == 0 && m == 0) valid = (r > 0) || seq_first;
                        if (ai == 1 && m == 3) valid = (r < 255) || seq_last;
                        if (valid) *(u32x4*)(ACT + (size_t)(Trow0 + r) * LDACT + f0) = (u32x4){pk0[ai][m].x, pk0[ai][m].y, pkn.x, pkn.y};
                    }
                }
            }
        }
    }
};
struct UpSched {
    const char* H; const char* Wu; int G, c;
    __device__ __forceinline__ bool next(int i, G8Unit& u) const {
        const int Lu = i * G + c; if (Lu >= 50 * 22) return false;
        int mt, pn; unit_map(Lu, 50, 22, mt, pn);
        int Trow0, tpos0, Ls;
        if (mt < 32) { Trow0 = mt * 256; tpos0 = 0; Ls = 256; }
        else { const int v = mt - 32, b = v / 9, j = v % 9; tpos0 = (j < 8) ? 254 * j : 1792; Trow0 = NCTX + b * 2048 + tpos0; Ls = 2048; }
        u.A = H + (size_t)Trow0 * LDH * 2; u.B = Wu + (size_t)pn * 256 * LDW * 2; u.e0 = Trow0; u.e1 = pn; u.e2 = tpos0; u.e3 = Ls; return true;
    }
};
__device__ __forceinline__ void phase8(const Params& p, Ctx& C, int L) {
    UpSched S{(const char*)(p.ws + WS_H), (const char*)(p.ws + WS_W + (size_t)L * W_LAYER + WO_UP), C.G, C.bid};
    EpiUpConvReg E{(bf16_t*)(p.ws + WS_ACT), p.in[30] + (size_t)L * 3 * 5504, (LAS unsigned*)(C.lds + 131072)};
    gemm8(C, DM, LDH, LDW, S, E);
}

__global__ void __launch_bounds__(512, 2) mega_fwd(Params p) {
    extern __shared__ __attribute__((aligned(16))) unsigned char lds_raw[];
    Ctx C; C.lds = (LAS unsigned char*)lds_raw;
#define FRESH() do { int t_ = threadIdx.x; asm volatile("" : "+v"(t_)); C.tid = t_; C.lane = t_ & 63; C.wid = __builtin_amdgcn_readfirstlane(t_ >> 6); C.fr = C.lane & 15; C.fq = C.lane >> 4; } while (0)
    FRESH();
    C.G = gridDim.x; C.bid = blockIdx.x;
    if (C.tid < 16) ((LAS unsigned*)(C.lds + LDS_CTL))[C.tid] = 0u;
    __syncthreads();
    XcdBarrier bar = xcd_barrier_post((unsigned*)(p.ws + WS_CTL) + CW_BAR, (volatile LAS unsigned*)(C.lds + LDS_CTL));
#define GRID_BAR() do { xcd_barrier(bar); FRESH(); } while (0)
#ifndef PH
#define PH 0xffff
#endif
#ifndef DUP
#define DUP 0
#endif
    if (PH & 1) phase0(p, C); GRID_BAR();
    if (DUP & 1) { phase0(p, C); GRID_BAR(); }
    if (PH & 2) phase1(p, C); GRID_BAR();
    if (DUP & 2) { phase1(p, C); GRID_BAR(); }
#pragma unroll 1
    for (int L = 0; L < 2; ++L) {
        if (PH & 4) phase2(p, C, L); GRID_BAR();
        if (DUP & 4) { phase2(p, C, L); GRID_BAR(); }
        if (PH & 8) phase3(p, C, L); GRID_BAR();
        if (PH & 16) phase4(p, C, L); GRID_BAR();
        if (DUP & 16) { phase4(p, C, L, 1); GRID_BAR(); }
        if (PH & 32) phase5a(p, C, L); GRID_BAR();
        if (DUP & 32) { phase5a(p, C, L); GRID_BAR(); }
        if (PH & 64) phase5b(p, C, L); GRID_BAR();
        if (DUP & 64) { phase5b(p, C, L); GRID_BAR(); }
        gemm_norm_phase<0>(p, C, L, (const bf16_t*)(p.ws + WS_MERGED), LDH, (const bf16_t*)(p.ws + WS_W + (size_t)L * W_LAYER + WO_OUT), LDW, DM); GRID_BAR();
        if (PH & 256) phase8(p, C, L); GRID_BAR();
        if (DUP & 256) { phase8(p, C, L); GRID_BAR(); }
        gemm_norm_phase<1>(p, C, L, (const bf16_t*)(p.ws + WS_ACT), LDACT, (const bf16_t*)(p.ws + WS_W + (size_t)L * W_LAYER + WO_DOWN), LDWD, DFFP);
        if (L == 0) GRID_BAR();
    }
}

extern "C" void kernel_launch(void* const* d_in, const int* in_sizes, int n_in, void* d_out, int out_size, void* d_ws, size_t ws_size, hipStream_t stream) {
    static int grid = 0;
    if (grid == 0) {
        if (n_in != 32 || ws_size < WS_END) { fprintf(stderr, "kernel_launch: unexpected n_in %d / ws %zu\n", n_in, ws_size); grid = -1; return; }
        int dev = 0, cus = 0;
        if (hipGetDevice(&dev) != hipSuccess || hipDeviceGetAttribute(&cus, hipDeviceAttributeMultiprocessorCount, dev) != hipSuccess) { grid = -1; return; }
        if (hipFuncSetAttribute((const void*)mega_fwd, hipFuncAttributeMaxDynamicSharedMemorySize, LDS_BYTES) != hipSuccess) { fprintf(stderr, "kernel_launch: hipFuncSetAttribute failed\n"); grid = -1; return; }
        grid = cus;
    }
    if (grid < 0) return;
    (void)hipMemsetAsync((char*)d_ws + WS_CTL, 0, (size_t)(CW_SEAM + 384 * 64) * 4, stream);
    Params a{};
    for (int i = 0; i < 32; ++i) a.in[i] = (const float*)d_in[i];
    a.out = (float*)d_out; a.ws = (unsigned char*)d_ws;
    hipLaunchKernelGGL(mega_fwd, dim3(grid), dim3(512), LDS_BYTES, stream, a);
}
```

```cpp
#include <hip/hip_runtime.h>
#include <cstdio>
#include <cstdint>

#define LAS __attribute__((address_space(3)))
typedef unsigned short bf16_t;
typedef short bf16x8 __attribute__((ext_vector_type(8)));
typedef short s16x4 __attribute__((ext_vector_type(4)));
typedef float f32x4 __attribute__((ext_vector_type(4)));
typedef float f32x2 __attribute__((ext_vector_type(2)));
typedef unsigned u32x4 __attribute__((ext_vector_type(4)));
typedef unsigned u32x2 __attribute__((ext_vector_type(2)));
typedef __bf16 bf16x2_t __attribute__((ext_vector_type(2)));
#define LOG2E_ 1.4426950408889634f
typedef long lx2 __attribute__((ext_vector_type(2)));
typedef int i32x8 __attribute__((ext_vector_type(8)));
typedef int i32x4 __attribute__((ext_vector_type(4)));

constexpr int DM = 1024, NCTX = 8192, NLAT = 4096, NTOK = 12288;
constexpr int INP = 2048, IN_DIM = 1888, DFF = 2752, DFFP = 2816, NUP = 5632;
constexpr int LD8 = 1152;
constexpr int LDH = 1088, LDP = 1984, LDACT = 2880, LDQ = 448, LDKV = 576, LDW = 1088, LDWB = 320, LDWD = 2880, LDUQ = 192, LDUKV = 192, LDNAC = 320, LDSWC = 192, LDCKVC = 192, LDBK = 4160;
constexpr int COL_QA = 0, COL_KA = 256, COL_VA = 512, COL_CQ = 768, COL_CKV = 960, COL_KR = 1088, COL_QC = 1120, COL_KC = 1376, COL_VC = 1504, COL_PD = 1632;
constexpr float EPS = 1e-6f;
constexpr float LOG2E = 1.4426950408889634f;
constexpr size_t OFF_Y = 0, OFF_NAK = 12582912, OFF_NAV = 16777216, OFF_CKV = 20971520, OFF_KR = 23068672, OFF_SWK = 23592960, OFF_SWV = 25690112;

constexpr size_t MiB = 1u << 20;
constexpr size_t WS_CTL = 0, CTL_BYTES = 1 * MiB;
constexpr size_t WS_MODV = 1 * MiB;
constexpr size_t WS_NACK = 2 * MiB;
constexpr size_t WS_NACV = WS_NACK + 640 * 1024;
constexpr size_t WS_SWCK = WS_NACV + 640 * 1024;
constexpr size_t WS_SWCV = WS_SWCK + 384 * 1024;
constexpr size_t WS_CKVC = WS_SWCV + 384 * 1024;
constexpr size_t WS_KRC = WS_CKVC + 384 * 1024;
constexpr size_t WS_KVCUP = WS_KRC + 64 * 1024;
static_assert(WS_KVCUP + (size_t)2 * 512 * LDKV * 2 <= 6 * MiB, "cache region");
constexpr size_t WS_W = 6 * MiB, W_LAYER = 36 * MiB + 512 * 1024;
constexpr size_t WO_IN = 0, WO_GATE = 4 * MiB + 512 * 1024, WO_BR = 13 * MiB, WO_OUT = 15 * MiB + 512 * 1024, WO_UP = 18 * MiB, WO_DOWN = 30 * MiB, WO_UQ = 35 * MiB + 768 * 1024, WO_UKV = 36 * MiB;
static_assert((size_t)2048 * LDW * 2 <= WO_GATE && WO_GATE + (size_t)4096 * LDW * 2 <= WO_BR && WO_BR + (size_t)4096 * LDWB * 2 <= WO_OUT && WO_OUT + (size_t)1024 * LDW * 2 <= WO_UP && WO_UP + (size_t)NUP * LDW * 2 <= WO_DOWN && WO_DOWN + (size_t)1024 * LDWD * 2 <= WO_UQ && WO_UQ + (size_t)512 * LDUQ * 2 <= WO_UKV && WO_UKV + (size_t)512 * LDUKV * 2 <= W_LAYER, "weight map");
constexpr size_t WS_X1 = 79 * MiB;
constexpr size_t WS_H8 = WS_X1;
constexpr size_t WS_H = 127 * MiB;
constexpr size_t WS_P = 153 * MiB;
constexpr size_t WS_BK = 93 * MiB;
constexpr size_t WS_MERGED = 226 * MiB;
constexpr size_t WS_BR = 200 * MiB;
constexpr size_t WS_O = WS_BR;
constexpr size_t WS_QUP = 226 * MiB;
constexpr size_t WS_KVUP = 237 * MiB;
constexpr size_t WS_ACT = WS_P;
constexpr size_t WS_END = 252 * MiB;
static_assert((size_t)NTOK * LD8 <= (size_t)NTOK * DM * 4 && (size_t)4096 * LD8 <= WO_BR - WO_GATE, "fp8 buffers");
static_assert(WS_W + 2 * W_LAYER <= WS_X1 && WS_X1 + (size_t)NTOK * DM * 4 <= WS_H && WS_H + (size_t)NTOK * LDH * 2 <= WS_P && WS_P + (size_t)NTOK * LDP * 2 <= WS_BR && WS_BR + (size_t)NTOK * LDH * 2 <= WS_QUP
              && WS_QUP + (size_t)NTOK * LDQ * 2 <= WS_KVUP && WS_KVUP + (size_t)NTOK * LDKV * 2 <= WS_END && WS_ACT + (size_t)NTOK * LDACT * 2 <= WS_QUP
              && WS_H8 + (size_t)NTOK * LD8 <= WS_BK && WS_BK + (size_t)NTOK * LDBK * 2 <= WS_BR && WS_MERGED + (size_t)NTOK * LDH * 2 <= WS_END, "workspace map");
constexpr int CW_BAR = 1024;
constexpr int CW_QUEUE = 8192;
constexpr int CW_SEAM = 16384;
constexpr int CW_XBUF = 65536;

constexpr int LDS_CTL = 147456, LDS_TAB = LDS_CTL + 64, LDS_BYTES = LDS_TAB + 4096;

struct Params { const float* in[32]; float* out; unsigned char* ws; };

__device__ __forceinline__ float bf2f(bf16_t b) { return __uint_as_float((unsigned)b << 16); }
__device__ __forceinline__ unsigned pk2(float lo, float hi) { f32x2 v = {lo, hi}; bf16x2_t b = __builtin_convertvector(v, bf16x2_t); return __builtin_bit_cast(unsigned, b); }
__device__ __forceinline__ float lo16(unsigned u) { return __uint_as_float(u << 16); }
__device__ __forceinline__ float hi16(unsigned u) { return __uint_as_float(u & 0xffff0000u); }
__device__ __forceinline__ float wave_sum(float v) {
#pragma unroll
    for (int o = 1; o < 64; o <<= 1) v += __shfl_xor(v, o);
    return v;
}
__device__ __forceinline__ float qmax4(float x) {
    const auto a = __builtin_amdgcn_permlane16_swap(__float_as_uint(x), __float_as_uint(x), false, false); x = fmaxf(__uint_as_float(a[0]), __uint_as_float(a[1]));
    const auto b = __builtin_amdgcn_permlane32_swap(__float_as_uint(x), __float_as_uint(x), false, false); return fmaxf(__uint_as_float(b[0]), __uint_as_float(b[1]));
}
__device__ __forceinline__ float sigmoidf_(float x) { return __builtin_amdgcn_rcpf(1.0f + __builtin_amdgcn_exp2f(x * -LOG2E_)); }
__device__ __forceinline__ float siluf_(float x) { return x * __builtin_amdgcn_rcpf(1.0f + __builtin_amdgcn_exp2f(x * -LOG2E_)); }
#define VM_WAIT_UNUSED_()
#define VM_WAIT() asm volatile("s_waitcnt vmcnt(0)" ::: "memory")

#define XB_TMO      128
#define XB_XCNT(j)  (256  + 64 * (j))
#define XB_XSUB(j)  (1280 + 64 * (j))
#define XB_XGEN(j)  (2304 + 64 * (j))
#define XB_TOP      3328
#define XB_TOPGEN   3392
#define XCD_BAR_WORDS 3456
#define XB_SPIN_CAP (1u << 22)
__device__ __forceinline__ unsigned xb_ld(unsigned* p)              { return __hip_atomic_load(p, __ATOMIC_RELAXED, __HIP_MEMORY_SCOPE_AGENT); }
__device__ __forceinline__ unsigned xb_add(unsigned* p, unsigned v) { return __hip_atomic_fetch_add(p, v, __ATOMIC_RELAXED, __HIP_MEMORY_SCOPE_AGENT); }
__device__ __forceinline__ unsigned xb_xcc_id() { return (unsigned)__builtin_amdgcn_s_getreg((3 << 11) | 20) & 0xFu; }
#define XB_SPIN(cond, bar) do { unsigned _sp = 0; while (cond) { __builtin_amdgcn_s_sleep(1); \
    if ((++_sp & 255u) == 0u) { if (xb_ld(&(bar)[XB_TMO])) break; if (_sp > XB_SPIN_CAP) { atomicAdd(&(bar)[XB_TMO], 1u); break; } } } } while (0)
struct XcdBarrier { unsigned* bar; unsigned x; volatile LAS unsigned* st; };
__device__ __forceinline__ XcdBarrier xcd_barrier_post(unsigned* bar, volatile LAS unsigned* st) {
    XcdBarrier b; b.bar = bar; b.x = xb_xcc_id(); b.st = st;
    if (threadIdx.x == 0) (void)xb_add(&bar[XB_XCNT(b.x)], 1u);
    return b;
}
__device__ __forceinline__ void xcd_barrier_complete(unsigned* bar, unsigned x, unsigned& nloc, unsigned& nx) {
    const unsigned G = gridDim.x * gridDim.y * gridDim.z;
    unsigned sum, cnt, mine, sp = 0u;
    for (;;) {
        sum = 0u; cnt = 0u; mine = 0u;
#pragma unroll
        for (unsigned j = 0; j < 16; ++j) { const unsigned c = xb_ld(&bar[XB_XCNT(j)]); sum += c; cnt += (c > 0u) ? 1u : 0u; mine = (j == x) ? c : mine; }
        if (sum == G) break;
        __builtin_amdgcn_s_sleep(1);
        if ((++sp & 255u) == 0u) { if (xb_ld(&bar[XB_TMO])) break; if (sp > XB_SPIN_CAP) { atomicAdd(&bar[XB_TMO], 1u); break; } }
    }
    nloc = mine > 0u ? mine : 1u; nx = cnt > 0u ? cnt : 1u;
}
__device__ __forceinline__ void xcd_barrier(const XcdBarrier& b, int tid) {
    asm volatile("s_waitcnt vmcnt(0)" ::: "memory");
    __syncthreads();
    if (tid == 0) {
        unsigned* bar = b.bar; unsigned bx = b.x; asm volatile("" : "+s"(bar), "+s"(bx));
        __builtin_amdgcn_s_waitcnt(0);
        unsigned nloc = b.st[0], nx = b.st[1];
        if (nloc == 0u) { xcd_barrier_complete(bar, bx, nloc, nx); b.st[0] = nloc; b.st[1] = nx; }
        const unsigned old = xb_add(&bar[XB_XSUB(bx)], 1u);
        const unsigned gen = old / nloc;
        if (old + 1u == (gen + 1u) * nloc) {
            __builtin_amdgcn_fence(__ATOMIC_RELEASE, "agent");
            asm volatile("s_waitcnt vmcnt(0)" ::: "memory");
            const unsigned og = xb_add(&bar[XB_TOP], 1u);
            const unsigned tg = og / nx;
            if (og + 1u == (tg + 1u) * nx) xb_add(&bar[XB_TOPGEN], 1u);
            else XB_SPIN(xb_ld(&bar[XB_TOPGEN]) == tg, bar);
            __builtin_amdgcn_fence(__ATOMIC_ACQUIRE, "agent");
            xb_add(&bar[XB_XGEN(bx)], 1u);
            asm volatile("s_waitcnt vmcnt(0)" ::: "memory");
        } else {
            XB_SPIN(xb_ld(&bar[XB_XGEN(bx)]) == gen, bar);
            __builtin_amdgcn_fence(__ATOMIC_ACQUIRE, "agent");
            asm volatile("s_waitcnt vmcnt(0)" ::: "memory");
        }
    }
    __syncthreads();
}

struct Ctx {
    LAS unsigned char* lds;
    int tid, lane, wid, fr, fq;
    int G, bid;
    int ws;
};
__device__ __forceinline__ int hw_lane() { int l; asm volatile("v_mbcnt_lo_u32_b32 %0, -1, 0\n\tv_mbcnt_hi_u32_b32 %0, -1, %0" : "=v"(l)); return l; }
#define CTX_FRESH(C) do { int w_ = (C).ws, g_ = (C).G, b_ = (C).bid; asm volatile("" : "+s"(w_), "+s"(g_), "+s"(b_)); (C).G = g_; (C).bid = b_; const int l_ = hw_lane(); (C).lane = l_; (C).wid = __builtin_amdgcn_readfirstlane(w_); (C).tid = (C).wid * 64 + l_; (C).fr = l_ & 15; (C).fq = l_ >> 4; } while (0)

__device__ __forceinline__ int tok_cls(int T) { return T < NCTX ? 0 : 1 + ((T - NCTX) >> 11); }
__device__ __forceinline__ const float* x_in_row(const Params& p, int T) { return T < NCTX ? p.in[0] + (size_t)T * DM : p.in[1] + (size_t)(T - NCTX) * DM; }

__device__ __forceinline__ void p0_item(const float* W, int ldw, int k0, int n0, const float* kscale, bf16_t* WT, int ldt, int dst_row0, LAS float* scr, int lane) {
    float ld[32];
#pragma unroll
    for (int i = 0; i < 32; ++i) { const int kk = 2 * i + (lane >> 5); ld[i] = W[(size_t)(k0 + kk) * ldw + n0 + (lane & 31)]; }
#pragma unroll
    for (int i = 0; i < 32; ++i) { const int kk = 2 * i + (lane >> 5); float v = ld[i]; if (kscale) v *= kscale[k0 + kk]; scr[kk * 33 + (lane & 31)] = v; }
    asm volatile("s_waitcnt lgkmcnt(0)" ::: "memory");
    const int c = lane & 7;
#pragma unroll
    for (int j = 0; j < 4; ++j) { const int n = (lane >> 3) + 8 * j; const LAS float* s = scr + (8 * c) * 33 + n;
        u32x4 o; o.x = pk2(s[0 * 33], s[1 * 33]); o.y = pk2(s[2 * 33], s[3 * 33]); o.z = pk2(s[4 * 33], s[5 * 33]); o.w = pk2(s[6 * 33], s[7 * 33]);
        *(u32x4*)(WT + (size_t)(dst_row0 + n) * ldt + k0 + 8 * c) = o; }
    asm volatile("s_waitcnt lgkmcnt(0)" ::: "memory");
}
__device__ __forceinline__ void p0_item8(const float* W, int ldw, int k0, int n0, float scale, unsigned char* WT, int ldt, int dst_row0, LAS float* scr, int lane) {
    float ld[32];
#pragma unroll
    for (int i = 0; i < 32; ++i) { const int kk = 2 * i + (lane >> 5); ld[i] = W[(size_t)(k0 + kk) * ldw + n0 + (lane & 31)]; }
#pragma unroll
    for (int i = 0; i < 32; ++i) { const int kk = 2 * i + (lane >> 5); scr[kk * 33 + (lane & 31)] = ld[i] * scale; }
    asm volatile("s_waitcnt lgkmcnt(0)" ::: "memory");
    const int c = lane & 7;
#pragma unroll
    for (int j = 0; j < 4; ++j) { const int n = (lane >> 3) + 8 * j; const LAS float* s = scr + (8 * c) * 33 + n;
        int w0 = __builtin_amdgcn_cvt_pk_fp8_f32(s[0 * 33], s[1 * 33], 0, false); w0 = __builtin_amdgcn_cvt_pk_fp8_f32(s[2 * 33], s[3 * 33], w0, true);
        int w1 = __builtin_amdgcn_cvt_pk_fp8_f32(s[4 * 33], s[5 * 33], 0, false); w1 = __builtin_amdgcn_cvt_pk_fp8_f32(s[6 * 33], s[7 * 33], w1, true);
        *(u32x2*)(WT + (size_t)(dst_row0 + n) * ldt + k0 + 8 * c) = (u32x2){(unsigned)w0, (unsigned)w1}; }
    asm volatile("s_waitcnt lgkmcnt(0)" ::: "memory");
}
constexpr int IT_IN = 16 * 59, IT_GATE = 16 * 128, IT_BR = 4 * 4 * 32, IT_OUT = 16 * 32, IT_UP = 16 * 172, IT_DOWN = 43 * 32, IT_UQ = 3 * 12, IT_UKV = 2 * 16;
constexpr int IT_LAYER = IT_IN + IT_GATE + IT_BR + IT_OUT + IT_UP + IT_DOWN + IT_UQ + IT_UKV;

__device__ __forceinline__ void zero_bf16(bf16_t* p, size_t n8, int gtid, int gthreads) {
    for (size_t i = gtid; i < n8; i += gthreads) ((u32x4*)p)[i] = (u32x4){0u, 0u, 0u, 0u};
}

__device__ __forceinline__ void phase0(const Params& p, Ctx& C) {
    LAS float* scr = (LAS float*)(C.lds + C.wid * 16384);
    const int gw = C.bid * 8 + C.wid, NGW = C.G * 8;
    for (int it = gw; it < 2 * IT_LAYER; it += NGW) {
        const int L = it / IT_LAYER; int r = it % IT_LAYER;
        unsigned char* wb = p.ws + WS_W + (size_t)L * W_LAYER;
        if (r < IT_IN) { const int kb = r / 59, nb = r % 59; p0_item(p.in[16] + (size_t)L * 1024 * 1888, 1888, kb * 64, nb * 32, nullptr, (bf16_t*)(wb + WO_IN), LDW, nb * 32, scr, C.lane); continue; } r -= IT_IN;
        if (r < IT_GATE) { const int kb = r / 128, nb = r % 128; p0_item8(p.in[17] + (size_t)L * 1024 * 4096, 4096, kb * 64, nb * 32, 32.0f, (unsigned char*)(wb + WO_GATE), LD8, nb * 32, scr, C.lane); continue; } r -= IT_GATE;
        if (r < IT_BR) { const int k = r / 128, rr = r % 128, kb = rr / 32, nb = rr % 32; p0_item(p.in[27] + (size_t)(L * 4 + k) * 256 * 1024, 1024, kb * 64, nb * 32, nullptr, (bf16_t*)(wb + WO_BR) + (size_t)k * 1024 * LDWB, LDWB, nb * 32, scr, C.lane); continue; } r -= IT_BR;
        if (r < IT_OUT) { const int kb = r / 32, nb = r % 32; p0_item(p.in[28] + (size_t)L * 1024 * 1024, 1024, kb * 64, nb * 32, nullptr, (bf16_t*)(wb + WO_OUT), LDW, nb * 32, scr, C.lane); continue; } r -= IT_OUT;
        if (r < IT_UP) { const int kb = r / 172, nb = r % 172; const int n0 = nb * 32, part = n0 / DFF, j0 = n0 % DFF; const int drow = (j0 >> 7) * 256 + part * 128 + (j0 & 127);
            p0_item(p.in[29] + (size_t)L * 1024 * 5504, 5504, kb * 64, n0, nullptr, (bf16_t*)(wb + WO_UP), LDW, drow, scr, C.lane); continue; } r -= IT_UP;
        if (r < IT_DOWN) { const int kb = r / 32, nb = r % 32; p0_item(p.in[31] + (size_t)L * DFF * 1024, 1024, kb * 64, nb * 32, nullptr, (bf16_t*)(wb + WO_DOWN), LDWD, nb * 32, scr, C.lane); continue; } r -= IT_DOWN;
        if (r < IT_UQ) { const int kb = r / 12, nb = r % 12; p0_item(p.in[21] + (size_t)L * 192 * 384, 384, kb * 64, nb * 32, p.in[20] + L * 192, (bf16_t*)(wb + WO_UQ), LDUQ, nb * 32, scr, C.lane); continue; } r -= IT_UQ;
        { const int kb = r / 16, nb = r % 16; p0_item(p.in[23] + (size_t)L * 128 * 512, 512, kb * 64, nb * 32, p.in[22] + L * 128, (bf16_t*)(wb + WO_UKV), LDUKV, nb * 32, scr, C.lane); }
    }
    const int gtid = C.bid * 512 + C.tid, gth = C.G * 512;
    for (int L = 0; L < 2; ++L) {
        unsigned char* wb = p.ws + WS_W + (size_t)L * W_LAYER;
        zero_bf16((bf16_t*)(wb + WO_IN) + (size_t)IN_DIM * LDW, (size_t)(INP - IN_DIM) * LDW / 8, gtid, gth);
        zero_bf16((bf16_t*)(wb + WO_UP) + (size_t)(21 * 256 + 64) * LDW, (size_t)64 * LDW / 8, gtid, gth);
        zero_bf16((bf16_t*)(wb + WO_UP) + (size_t)(21 * 256 + 128 + 64) * LDW, (size_t)64 * LDW / 8, gtid, gth);
        zero_bf16((bf16_t*)(wb + WO_UQ) + (size_t)384 * LDUQ, (size_t)128 * LDUQ / 8, gtid, gth);
        for (int i = gtid; i < 1024 * 8; i += gth) { const int row = i >> 3, c = i & 7; *(u32x4*)((bf16_t*)(wb + WO_DOWN) + (size_t)row * LDWD + DFF + c * 8) = (u32x4){0u, 0u, 0u, 0u}; }
    }
    __syncthreads();
    LAS float* sv = (LAS float*)(C.lds);
    LAS float* part = (LAS float*)(C.lds + 16384);
    for (int i = C.tid; i < 3 * 1024; i += 512) { const int cls = i >> 10, k = i & 1023; const float v = cls == 0 ? p.in[9][k] : p.in[8][(cls - 1) * 1024 + k]; sv[i] = siluf_(v); }
    __syncthreads();
    float* modv = (float*)(p.ws + WS_MODV);
    for (int it = C.bid; it < 2 * 96; it += C.G) {
        const int L = it / 96, col = (it % 96) * 64 + C.lane;
        const float* w = p.in[10] + (size_t)L * 1024 * 6144 + col;
        float a0 = 0.f, a1 = 0.f, a2 = 0.f;
#pragma unroll 8
        for (int kk = 0; kk < 128; ++kk) { const int k = C.wid * 128 + kk; const float wv = w[(size_t)k * 6144]; a0 += sv[k] * wv; a1 += sv[1024 + k] * wv; a2 += sv[2048 + k] * wv; }
        part[(C.wid * 3 + 0) * 64 + C.lane] = a0; part[(C.wid * 3 + 1) * 64 + C.lane] = a1; part[(C.wid * 3 + 2) * 64 + C.lane] = a2;
        __syncthreads();
        if (C.tid < 192) { const int cls = C.tid >> 6, l = C.tid & 63; float s = 0.f;
#pragma unroll
            for (int w8 = 0; w8 < 8; ++w8) s += part[(w8 * 3 + cls) * 64 + l];
            const int cc = (it % 96) * 64 + l;
            modv[((size_t)L * 3 + cls) * 6144 + cc] = s + p.in[11][(size_t)L * 6144 + cc]; }
        __syncthreads();
    }
}

__device__ __forceinline__ void row_norm_mod(const f32x4 (&v)[4], const float* g, const float* sc, const float* sh, bf16_t* orow, int lane, unsigned char* o8 = nullptr) {
    float ss = 0.f;
#pragma unroll
    for (int j = 0; j < 4; ++j) ss += (v[j].x * v[j].x + v[j].y * v[j].y) + (v[j].z * v[j].z + v[j].w * v[j].w);
    const float rstd = 1.0f / sqrtf(wave_sum(ss) * (1.0f / DM) + EPS);
#pragma unroll
    for (int j = 0; j < 4; ++j) {
        const f32x4 gg = ((const f32x4*)g)[lane + 64 * j], s1 = ((const f32x4*)sc)[lane + 64 * j], s0 = ((const f32x4*)sh)[lane + 64 * j];
        const f32x4 y = v[j] * rstd * gg * (s1 + 1.0f) + s0;
        u32x2 o; o.x = pk2(y.x, y.y); o.y = pk2(y.z, y.w);
        ((u32x2*)orow)[lane + 64 * j] = o;
        if (o8) { int w8 = __builtin_amdgcn_cvt_pk_fp8_f32(y.x, y.y, 0, false); w8 = __builtin_amdgcn_cvt_pk_fp8_f32(y.z, y.w, w8, true); ((int*)o8)[lane + 64 * j] = w8; }
    }
}
__device__ __forceinline__ void load_row_bf16(const bf16_t* r, f32x4 (&v)[4], int lane) {
#pragma unroll
    for (int j = 0; j < 4; ++j) { const u32x2 u = ((const u32x2*)r)[lane + 64 * j]; v[j] = (f32x4){lo16(u.x), hi16(u.x), lo16(u.y), hi16(u.y)}; }
}

__device__ __forceinline__ void phase1(const Params& p, Ctx& C) {
    const int gw = C.bid * 8 + C.wid, NGW = C.G * 8;
    const float* modv = (const float*)(p.ws + WS_MODV);
    bf16_t* H = (bf16_t*)(p.ws + WS_H);
    for (int T = gw; T < NTOK; T += NGW) {
        const float* xr = x_in_row(p, T); f32x4 v[4];
#pragma unroll
        for (int j = 0; j < 4; ++j) v[j] = ((const f32x4*)xr)[C.lane + 64 * j];
        const float* mv = modv + (size_t)(0 * 3 + tok_cls(T)) * 6144;
        row_norm_mod(v, p.in[12], mv + 1024, mv, H + (size_t)T * LDH, C.lane, p.ws + WS_H8 + (size_t)T * LD8);
    }
    const int gtid = C.bid * 512 + C.tid, gth = C.G * 512;
    bf16_t* nak = (bf16_t*)(p.ws + WS_NACK); bf16_t* nav = (bf16_t*)(p.ws + WS_NACV);
    for (int i = gtid; i < 2 * 2 * 256 * 256 / 4; i += gth) {
        const int e = i * 4, w = e & 255, t = (e >> 8) & 255, L = (e >> 16) & 1, b = e >> 17;
        const size_t d = ((size_t)(L * 2 + b) * 256 + t) * LDNAC + w;
        const f32x4 a = *(const f32x4*)(p.in[2] + e), c = *(const f32x4*)(p.in[3] + e);
        *(u32x2*)(nak + d) = (u32x2){pk2(a.x, a.y), pk2(a.z, a.w)}; *(u32x2*)(nav + d) = (u32x2){pk2(c.x, c.y), pk2(c.z, c.w)};
    }
    bf16_t* swk = (bf16_t*)(p.ws + WS_SWCK); bf16_t* swv = (bf16_t*)(p.ws + WS_SWCV); bf16_t* ckv = (bf16_t*)(p.ws + WS_CKVC);
    for (int i = gtid; i < 2 * 2 * 256 * 128 / 4; i += gth) {
        const int e = i * 4, w = e & 127, t = (e >> 7) & 255, L = (e >> 15) & 1, b = e >> 16;
        const size_t d = ((size_t)(L * 2 + b) * 256 + t) * LDSWC + w, d2 = ((size_t)(L * 2 + b) * 256 + t) * LDCKVC + w;
        const f32x4 a = *(const f32x4*)(p.in[6] + e), c = *(const f32x4*)(p.in[7] + e), m = *(const f32x4*)(p.in[4] + e);
        *(u32x2*)(swk + d) = (u32x2){pk2(a.x, a.y), pk2(a.z, a.w)}; *(u32x2*)(swv + d) = (u32x2){pk2(c.x, c.y), pk2(c.z, c.w)};
        *(u32x2*)(ckv + d2) = (u32x2){pk2(m.x, m.y), pk2(m.z, m.w)};
    }
    bf16_t* krc = (bf16_t*)(p.ws + WS_KRC);
    for (int i = gtid; i < 2 * 2 * 256 * 32 / 4; i += gth) {
        const int e = i * 4, w = e & 31, t = (e >> 5) & 255, L = (e >> 13) & 1, b = e >> 14;
        const size_t d = ((size_t)(L * 2 + b) * 256 + t) * 32 + w;
        const f32x4 a = *(const f32x4*)(p.in[5] + e);
        *(u32x2*)(krc + d) = (u32x2){pk2(a.x, a.y), pk2(a.z, a.w)};
    }
}

__device__ __forceinline__ void phase7(const Params& p, Ctx& C, int L) {
    const int gw = C.bid * 8 + C.wid, NGW = C.G * 8;
    const float* modv = (const float*)(p.ws + WS_MODV);
    const bf16_t* O = (const bf16_t*)(p.ws + WS_O); float* X1 = p.out + OFF_Y; bf16_t* H = (bf16_t*)(p.ws + WS_H);
    const float* gpost = p.in[13] + L * DM; const float* gpre = p.in[14] + L * DM;
    for (int T = gw; T < NTOK; T += NGW) {
        const float* xr = (L == 0) ? x_in_row(p, T) : p.out + OFF_Y + (size_t)T * DM;
        const float* mv = modv + (size_t)(L * 3 + tok_cls(T)) * 6144;
        f32x4 o[4]; load_row_bf16(O + (size_t)T * LDH, o, C.lane);
        float ss = 0.f;
#pragma unroll
        for (int j = 0; j < 4; ++j) ss += (o[j].x * o[j].x + o[j].y * o[j].y) + (o[j].z * o[j].z + o[j].w * o[j].w);
        const float rstd = 1.0f / sqrtf(wave_sum(ss) * (1.0f / DM) + EPS);
        f32x4 x1[4];
#pragma unroll
        for (int j = 0; j < 4; ++j) {
            const f32x4 xv = ((const f32x4*)xr)[C.lane + 64 * j], gp = ((const f32x4*)gpost)[C.lane + 64 * j], g1 = ((const f32x4*)(mv + 2048))[C.lane + 64 * j];
            x1[j] = xv + g1 * (o[j] * rstd * gp);
            ((f32x4*)(X1 + (size_t)T * DM))[C.lane + 64 * j] = x1[j];
        }
        row_norm_mod(x1, gpre, mv + 4096, mv + 3072, H + (size_t)T * LDH, C.lane);
    }
}
__device__ __forceinline__ void phase10(const Params& p, Ctx& C, int L) {
    const int gw = C.bid * 8 + C.wid, NGW = C.G * 8;
    const float* modv = (const float*)(p.ws + WS_MODV);
    const float* X1 = p.out + OFF_Y; bf16_t* H = (bf16_t*)(p.ws + WS_H);
    const float* gpost = p.in[15] + L * DM;
    for (int T = gw; T < NTOK; T += NGW) {
        const float* mv = modv + (size_t)(L * 3 + tok_cls(T)) * 6144;
        f32x4 f[4]; load_row_bf16(H + (size_t)T * LDH, f, C.lane);
        float ss = 0.f;
#pragma unroll
        for (int j = 0; j < 4; ++j) ss += (f[j].x * f[j].x + f[j].y * f[j].y) + (f[j].z * f[j].z + f[j].w * f[j].w);
        const float rstd = 1.0f / sqrtf(wave_sum(ss) * (1.0f / DM) + EPS);
        f32x4 y[4];
#pragma unroll
        for (int j = 0; j < 4; ++j) {
            const f32x4 xv = ((const f32x4*)(X1 + (size_t)T * DM))[C.lane + 64 * j], gp = ((const f32x4*)gpost)[C.lane + 64 * j], g2 = ((const f32x4*)(mv + 5120))[C.lane + 64 * j];
            y[j] = xv + g2 * (f[j] * rstd * gp);
            ((f32x4*)(p.out + OFF_Y + (size_t)T * DM))[C.lane + 64 * j] = y[j];
        }
        if (L == 0) { const float* mv1 = modv + (size_t)(1 * 3 + tok_cls(T)) * 6144; row_norm_mod(y, p.in[12] + DM, mv1 + 1024, mv1, H + (size_t)T * LDH, C.lane, p.ws + WS_H8 + (size_t)T * LD8); }
    }
}

__device__ __forceinline__ int lds_byte(int r, int c) { const int st = (r >> 4) * 2 + (c >> 5), ob = (r & 15) * 64 + (c & 31) * 2; return st * 1024 + (ob ^ (((ob >> 9) & 1) << 5)); }
__device__ __forceinline__ void stage_rc(int b, int& R, int& Cc) { const int st = b >> 10, sb = b & 1023, swz = sb ^ (((sb >> 9) & 1) << 5); R = (st >> 1) * 16 + swz / 64; Cc = (st & 1) * 32 + (swz % 64) / 2; }
#define GLDS16(gp, lp) __builtin_amdgcn_global_load_lds((const unsigned*)(gp), (LAS unsigned*)(lp), 16, 0, 0)

template <int TM, int TN> struct GemmStage {
    static constexpr int STAGE = (TM + TN) * 128;
    int offA, offB;
    int lda, ldb;
    __device__ __forceinline__ void init(const Ctx& C, int lda_, int ldb_) { int R, Cc; stage_rc(C.wid * 1024 + C.lane * 16, R, Cc); lda = lda_; ldb = ldb_; offA = R * lda + Cc; offB = R * ldb + Cc; }
    __device__ __forceinline__ void stage(const Ctx& C, int buf, const bf16_t* a, const bf16_t* b) const {
        LAS unsigned char* base = C.lds + buf * STAGE + C.wid * 1024;
#pragma unroll
        for (int i = 0; i < TM / 64; ++i) GLDS16(a + offA + (size_t)i * 64 * lda, base + i * 8192);
#pragma unroll
        for (int i = 0; i < TN / 64; ++i) GLDS16(b + offB + (size_t)i * 64 * ldb, base + TM * 128 + i * 8192);
    }
};
template <int TM, int TN, int MF, int NF>
__device__ __forceinline__ void gemm_compute(const Ctx& C, int buf, int wr, int wc, f32x4 (&acc)[MF][NF]) {
    constexpr int STAGE = (TM + TN) * 128;
    LAS unsigned char* sa = C.lds + buf * STAGE; LAS unsigned char* sb = sa + TM * 128;
#pragma unroll
    for (int ks = 0; ks < 2; ++ks) {
        bf16x8 Af[MF], Bf[NF];
        const int ao = lds_byte(wr * MF * 16 + C.fr, ks * 32 + C.fq * 8), bo = lds_byte(wc * NF * 16 + C.fr, ks * 32 + C.fq * 8);
#pragma unroll
        for (int m = 0; m < MF; ++m) Af[m] = *(const LAS bf16x8*)(sa + ao + m * 2048);
#pragma unroll
        for (int n = 0; n < NF; ++n) Bf[n] = *(const LAS bf16x8*)(sb + bo + n * 2048);
#pragma unroll
        for (int m = 0; m < MF; ++m)
#pragma unroll
            for (int n = 0; n < NF; ++n) acc[m][n] = __builtin_amdgcn_mfma_f32_16x16x32_bf16(Bf[n], Af[m], acc[m][n], 0, 0, 0);
        __builtin_amdgcn_sched_barrier(0);
    }
}
template <int TM, int TN, int MF, int NF>
__device__ __forceinline__ void gemm_kloop(const Ctx& C, const GemmStage<TM, TN>& S, const bf16_t* A, const bf16_t* B, int nt, int wr, int wc, f32x4 (&acc)[MF][NF]) {
    S.stage(C, 0, A, B); VM_WAIT(); __syncthreads();
    for (int t = 0; t < nt; ++t) {
        const int cur = t & 1;
        if (t + 1 < nt) S.stage(C, cur ^ 1, A + (t + 1) * 64, B + (t + 1) * 64);
        gemm_compute<TM, TN, MF, NF>(C, cur, wr, wc, acc);
        VM_WAIT(); __syncthreads();
    }
}
__device__ __forceinline__ void unit_map(int u, int nM, int nN, int& pm, int& pn) {
    const int nwg = nM * nN; int wgid = u;
    { const int q = nwg / 8, r = nwg % 8, xcd = wgid % 8, off = wgid / 8; wgid = (xcd < r ? xcd * (q + 1) : r * (q + 1) + (xcd - r) * q) + off; }
    const int nig = 8 * nN, gid = wgid / nig, fm = gid * 8, gsz = (nM - fm) < 8 ? (nM - fm) : 8;
    pm = fm + ((wgid % nig) % gsz); pn = (wgid % nig) / gsz;
}
#define ZERO_ACC(acc, MF, NF) _Pragma("unroll") for (int m_ = 0; m_ < MF; ++m_) _Pragma("unroll") for (int n_ = 0; n_ < NF; ++n_) acc[m_][n_] = (f32x4){0.f, 0.f, 0.f, 0.f}


struct G8Unit { const char* A; const char* B; int e0, e1, e2, e3; };
__device__ __forceinline__ int perm32(int rho) { const int n = rho >> 4, i = rho & 15; return 8 * (i >> 2) + 4 * n + (i & 3); }
__device__ __forceinline__ i32x8 cat8(bf16x8 a, bf16x8 b) { return __builtin_shufflevector(__builtin_bit_cast(i32x4, a), __builtin_bit_cast(i32x4, b), 0, 1, 2, 3, 4, 5, 6, 7); }
#define G8_EPI_PLAIN static __device__ __forceinline__ f32x4 init(const G8Unit&, int, int, int, int) { return (f32x4){0.f, 0.f, 0.f, 0.f}; } static constexpr bool FP8 = false; static constexpr int HROWS_B = 128; static __device__ __forceinline__ int brow(int R) { return PERM ? ((R & ~31) + perm32(R & 31)) : R; }
template <class Epi, class Sched>
__device__ __forceinline__ void gemm8(const Ctx& C, int K, int lda, int ldb, const Sched& S, const Epi& E) {
    constexpr int HTB = 16384;
    LAS unsigned char* lds = C.lds;
    const int tid = C.tid, wid = C.wid, lane = C.lane, wr = wid >> 2, wc = wid & 3, fr = lane & 15, fq = lane >> 4;
    const int nt = K / 64;
    unsigned voffA, voffB;
    { int R, Cc; stage_rc(tid * 16, R, Cc); voffA = (unsigned)(R * lda + Cc) * 2u; voffB = (unsigned)(Epi::brow(R) * ldb + Cc) * 2u; }
    const size_t kstep = 128;
    const size_t hstepA = (size_t)128 * lda * 2, hstepB = (size_t)Epi::HROWS_B * ldb * 2;
    const size_t r64A = (size_t)64 * lda * 2, r64B = (size_t)(Epi::brow(64) - Epi::brow(0)) * ldb * 2;
    const unsigned ldsw = (unsigned)__builtin_amdgcn_readfirstlane((int)((unsigned)(size_t)lds + (unsigned)wid * 1024u));
    const int aoff = lds_byte(wr * 64 + fr, fq * 8), boff = lds_byte(wc * 32 + fr, fq * 8);
#define G8_SA(b, h) (((b) * 2 + (h)) * HTB)
#define G8_SB(b, h) ((4 + (b) * 2 + (h)) * HTB)
#define G8_GLDS(vo, sb, la) asm volatile("s_mov_b32 m0, %2\n\ts_nop 0\n\tglobal_load_lds_dwordx4 %0, %1" :: "v"(vo), "s"(sb), "s"(la) : "memory", "m0")
#define G8_STAGE(bufoff, gbase, voff, r64) do { const char* _g = (const char*)(gbase); const unsigned _l = ldsw + (unsigned)(bufoff); G8_GLDS(voff, _g, _l); \
        const char* _g2 = _g + (r64); G8_GLDS(voff, _g2, _l + 8192u); } while (0)
#define G8_LDA(dst, b, h) do { _Pragma("unroll") for (int m = 0; m < 4; ++m) _Pragma("unroll") for (int k = 0; k < 2; ++k) dst[m][k] = *(const LAS bf16x8*)(lds + G8_SA(b, h) + aoff + m * 2048 + k * 1024); } while (0)
#define G8_LDB(dst, b, h) do { _Pragma("unroll") for (int n = 0; n < 2; ++n) _Pragma("unroll") for (int k = 0; k < 2; ++k) dst[n][k] = *(const LAS bf16x8*)(lds + G8_SB(b, h) + boff + n * 2048 + k * 1024); } while (0)
#define G8_MMA(ai, bj, At, Bt) do { __builtin_amdgcn_s_setprio(1); _Pragma("unroll") for (int m = 0; m < 4; ++m) _Pragma("unroll") for (int n = 0; n < 2; ++n) { \
        if constexpr (Epi::FP8) acc[ai][bj][m][n] = __builtin_amdgcn_mfma_scale_f32_16x16x128_f8f6f4(cat8(Bt[n][0], Bt[n][1]), cat8(At[m][0], At[m][1]), acc[ai][bj][m][n], 0, 0, 0, 0, 0, 0); \
        else { _Pragma("unroll") for (int k = 0; k < 2; ++k) acc[ai][bj][m][n] = __builtin_amdgcn_mfma_f32_16x16x32_bf16(Bt[n][k], At[m][k], acc[ai][bj][m][n], 0, 0, 0); } } \
        __builtin_amdgcn_s_setprio(0); } while (0)
#define G8_WAIT_V(n) asm volatile("s_waitcnt vmcnt(" #n ")" ::: "memory")
#define G8_WAIT_L(n) asm volatile("s_waitcnt lgkmcnt(" #n ")" ::: "memory")
#define G8_BAR __builtin_amdgcn_s_barrier()
#define G8_SCHED __builtin_amdgcn_sched_barrier(0)
    G8Unit cur, nxt; int ui = 0;
    if (!S.next(0, cur)) return;
    f32x4 acc[2][2][4][2];
#pragma unroll
    for (int a = 0; a < 2; ++a)
#pragma unroll
        for (int b = 0; b < 2; ++b)
#pragma unroll
            for (int m = 0; m < 4; ++m)
#pragma unroll
                for (int n = 0; n < 2; ++n) acc[a][b][m][n] = E.init(cur, b, n, wc, fq);
    bf16x8 At[4][2], B0[2][2], B1[2][2];
    const char* cA = cur.A; const char* cB = cur.B;
    G8_STAGE(G8_SB(0, 0), cB, voffB, r64B); G8_STAGE(G8_SA(0, 0), cA, voffA, r64A); G8_STAGE(G8_SB(0, 1), cB + hstepB, voffB, r64B); G8_STAGE(G8_SA(0, 1), cA + hstepA, voffA, r64A);
    if (wr == 1) G8_BAR;
    G8_WAIT_V(4); G8_BAR;
    G8_STAGE(G8_SB(1, 0), cB + kstep, voffB, r64B); G8_STAGE(G8_SA(1, 0), cA + kstep, voffA, r64A); G8_STAGE(G8_SB(1, 1), cB + hstepB + kstep, voffB, r64B);
    G8_WAIT_V(6); G8_BAR;
    for (;;) {
        const bool has_next = S.next(ui + 1, nxt);
        const char* nA = has_next ? nxt.A : cA; const char* nB = has_next ? nxt.B : cB;
#pragma unroll 1
        for (int t = 0; t < nt; t += 2) {
            const bool last = (t == nt - 2);
            const char* a1 = cA + (size_t)(t + 1) * kstep;
            const char* a2 = last ? nA : cA + (size_t)(t + 2) * kstep; const char* b2 = last ? nB : cB + (size_t)(t + 2) * kstep;
            const char* a3 = a2 + kstep; const char* b3 = b2 + kstep;
            G8_LDB(B0, 0, 0); G8_SCHED; G8_LDA(At, 0, 0); G8_STAGE(G8_SA(1, 1), a1 + hstepA, voffA, r64A);
            G8_WAIT_L(8); G8_BAR; G8_WAIT_L(0); G8_MMA(0, 0, At, B0); G8_BAR; G8_SCHED;
            G8_LDB(B1, 0, 1); G8_STAGE(G8_SB(0, 0), b2, voffB, r64B);
            G8_BAR; G8_WAIT_L(0); G8_MMA(0, 1, At, B1); G8_BAR;
            G8_LDA(At, 0, 1); G8_STAGE(G8_SA(0, 0), a2, voffA, r64A);
            G8_BAR; G8_WAIT_L(0); G8_MMA(1, 0, At, B0); G8_BAR; G8_SCHED;
            G8_STAGE(G8_SB(0, 1), b2 + hstepB, voffB, r64B);
            G8_WAIT_V(6); G8_BAR; G8_MMA(1, 1, At, B1); G8_BAR;
            G8_LDB(B0, 1, 0); G8_SCHED; G8_LDA(At, 1, 0); G8_STAGE(G8_SA(0, 1), a2 + hstepA, voffA, r64A);
            G8_WAIT_L(8); G8_BAR; G8_WAIT_L(0); G8_MMA(0, 0, At, B0); G8_BAR; G8_SCHED;
            G8_LDB(B1, 1, 1); G8_STAGE(G8_SB(1, 0), b3, voffB, r64B);
            G8_BAR; G8_WAIT_L(0); G8_MMA(0, 1, At, B1); G8_BAR;
            G8_LDA(At, 1, 1); G8_STAGE(G8_SA(1, 0), a3, voffA, r64A);
            G8_BAR; G8_WAIT_L(0); G8_MMA(1, 0, At, B0); G8_BAR; G8_SCHED;
            G8_STAGE(G8_SB(1, 1), b3 + hstepB, voffB, r64B);
            G8_WAIT_V(6); G8_BAR; G8_MMA(1, 1, At, B1); G8_BAR;
        }
        if constexpr (!Epi::AFTER_DRAIN) E(acc, cur, wr, wc, fr, fq);
        if (!has_next) break;
#pragma unroll
        for (int a = 0; a < 2; ++a)
#pragma unroll
            for (int b = 0; b < 2; ++b)
#pragma unroll
                for (int m = 0; m < 4; ++m)
#pragma unroll
                    for (int n = 0; n < 2; ++n) acc[a][b][m][n] = E.init(nxt, b, n, wc, fq);
        cur = nxt; cA = nA; cB = nB; ++ui;
    }
    G8_WAIT_V(0);
    if (wr == 0) G8_BAR;
    G8_BAR;
    if constexpr (Epi::AFTER_DRAIN) E.drained(C, acc, cur, wr, wc, fr, fq);
#undef G8_SA
#undef G8_SB
#undef G8_STAGE
#undef G8_GLDS
#undef G8_LDA
#undef G8_LDB
#undef G8_MMA
#undef G8_WAIT_V
#undef G8_WAIT_L
#undef G8_BAR
#undef G8_SCHED
}
struct TileSched {
    const char* A; const char* B; size_t tstepA, tstepB; int nM, nN, G, c;
    __device__ __forceinline__ bool next(int i, G8Unit& u) const {
        const int L = i * G + c; if (L >= nM * nN) return false;
        int pm, pn; unit_map(L, nM, nN, pm, pn);
        u.A = A + (size_t)pm * tstepA; u.B = B + (size_t)pn * tstepB; u.e0 = pm; u.e1 = pn; u.e2 = 0; u.e3 = 0; return true;
    }
};
struct EpiBf16 {
    static constexpr bool PERM = true, AFTER_DRAIN = false; G8_EPI_PLAIN
    bf16_t* O; int ldo;
    __device__ __forceinline__ void operator()(const f32x4 (&acc)[2][2][4][2], const G8Unit& u, int wr, int wc, int fr, int fq) const {
        const int row0 = u.e0 * 256 + wr * 64 + fr, col0 = u.e1 * 256 + wc * 32 + 8 * fq;
#pragma unroll
        for (int ai = 0; ai < 2; ++ai)
#pragma unroll
            for (int m = 0; m < 4; ++m) { bf16_t* rowp = O + (size_t)(row0 + ai * 128 + m * 16) * ldo + col0;
#pragma unroll
                for (int bj = 0; bj < 2; ++bj) { const f32x4 v0 = acc[ai][bj][m][0], v1 = acc[ai][bj][m][1];
                    *(u32x4*)(rowp + bj * 128) = (u32x4){pk2(v0.x, v0.y), pk2(v0.z, v0.w), pk2(v1.x, v1.y), pk2(v1.z, v1.w)}; } }
    }
};
struct EpiInProj {
    static constexpr bool PERM = true, AFTER_DRAIN = false; G8_EPI_PLAIN
    bf16_t* P; float* out; int L;
    __device__ __forceinline__ void operator()(const f32x4 (&acc)[2][2][4][2], const G8Unit& u, int wr, int wc, int fr, int fq) const {
        const int row0 = u.e0 * 256 + wr * 64 + fr, col0 = u.e1 * 256 + wc * 32 + 8 * fq;
        const bool ctx = u.e0 < 32;
#pragma unroll
        for (int bj = 0; bj < 2; ++bj) { const int col = col0 + bj * 128;
            int W = 0, cc = 0; size_t off = 0;
            if (ctx) {
                if (col >= COL_KA && col < COL_VA) { off = OFF_NAK; W = 256; cc = col - COL_KA; }
                else if (col >= COL_VA && col < COL_CQ) { off = OFF_NAV; W = 256; cc = col - COL_VA; }
                else if (col >= COL_CKV && col < COL_KR) { off = OFF_CKV; W = 128; cc = col - COL_CKV; }
                else if (col >= COL_KR && col < COL_QC) { off = OFF_KR; W = 32; cc = col - COL_KR; }
                else if (col >= COL_KC && col < COL_VC) { off = OFF_SWK; W = 128; cc = col - COL_KC; }
                else if (col >= COL_VC && col < COL_PD) { off = OFF_SWV; W = 128; cc = col - COL_VC; }
            }
            float* dbase = out + off + cc;
#pragma unroll
            for (int ai = 0; ai < 2; ++ai)
#pragma unroll
                for (int m = 0; m < 4; ++m) { const int row = row0 + ai * 128 + m * 16; const f32x4 v0 = acc[ai][bj][m][0], v1 = acc[ai][bj][m][1];
                    if (col < IN_DIM) *(u32x4*)(P + (size_t)row * LDP + col) = (u32x4){pk2(v0.x, v0.y), pk2(v0.z, v0.w), pk2(v1.x, v1.y), pk2(v1.z, v1.w)};
                    if (W) { float* dst = dbase + (size_t)(((row >> 8) * 2 + L) * 256 + (row & 255)) * W; *(f32x4*)dst = v0; *(f32x4*)(dst + 4) = v1; } }
        }
    }
};
__device__ __forceinline__ void phase2(const Params& p, Ctx& C, int L) {
    TileSched S{(const char*)(p.ws + WS_H), (const char*)(p.ws + WS_W + (size_t)L * W_LAYER + WO_IN), (size_t)256 * LDH * 2, (size_t)256 * LDW * 2, 48, 8, C.G, C.bid};
    EpiInProj E{(bf16_t*)(p.ws + WS_P), p.out, L};
    gemm8(C, DM, LDH, LDW, S, E);
}

__device__ __forceinline__ void rope_pair(bf16_t* p1, bf16_t* p2, float pos, float inv) {
    const float ang = pos * inv; float rev = ang * 0.15915494309189535f; rev -= floorf(rev);
    const float s = __builtin_amdgcn_sinf(rev), c = __builtin_amdgcn_cosf(rev);
    const float x1 = bf2f(*p1), x2 = bf2f(*p2);
    const unsigned o = pk2(x1 * c - x2 * s, x1 * s + x2 * c);
    *p1 = (bf16_t)(o & 0xffffu); *p2 = (bf16_t)(o >> 16);
}
__device__ __forceinline__ void phase3(const Params& p, Ctx& C, int L) {
    bf16_t* P = (bf16_t*)(p.ws + WS_P);
    {
        const int gw = C.bid * 8 + C.wid, NGW = C.G * 8;
        for (int t = gw; t < NLAT; t += NGW) {
            bf16_t* row = P + (size_t)(NCTX + t) * LDP; const int pos = t & 2047; const float prow = (float)(pos >> 6), pcol = (float)(pos & 63);
            for (int i = C.lane; i < 208; i += 64) {
                if (i < 16) { const int blk = i >> 3, f = i & 7; bf16_t* b = row + COL_KR + blk * 16 + f; rope_pair(b, b + 8, blk ? pcol : prow, exp2f(-(float)f * (13.287712379549449f / 8.0f))); }
                else { const int j = i - 16, head = j >> 5, blk = (j >> 4) & 1, f = j & 15;
                    bf16_t* b = row + COL_QC + head * 64 + blk * 32 + f; rope_pair(b, b + 16, blk ? pcol : prow, exp2f(-(float)f * (13.287712379549449f / 16.0f))); }
            }
        }
    }
    const int wr = C.wid >> 2, wc = C.wid & 3;
    LAS float* rs = (LAS float*)(C.lds + LDS_TAB);
    const unsigned char* wb = p.ws + WS_W + (size_t)L * W_LAYER;
    int R, Cc; stage_rc(C.wid * 1024 + C.lane * 16, R, Cc);
    const int Rb = (R & ~31) + perm32(R & 31);
    for (int u = C.bid; u < 96 * 7 + 4 * 4; u += C.G) {
        int pm, tn;
        if (u < 672) { pm = u / 7; tn = u % 7; } else { const int r = u - 672; pm = 96 + (r >> 2); tn = 3 + (r & 3); }
        const int which = tn >= 3, K = which ? 128 : 192, nkt = K / 64, ldb = which ? LDUKV : LDUQ, n0 = (which ? tn - 3 : tn) * 128;
        const bf16_t* A; int lda;
        if (pm < 96) { A = P + (size_t)pm * 128 * LDP + (which ? COL_CKV : COL_CQ); lda = LDP; }
        else { A = (const bf16_t*)(p.ws + WS_CKVC) + (size_t)(L * 512 + (pm - 96) * 128) * LDCKVC; lda = LDCKVC; }
        const bf16_t* B = (const bf16_t*)(wb + (which ? WO_UKV : WO_UQ)) + (size_t)n0 * ldb;
        for (int t = 0; t < nkt; ++t) { LAS unsigned char* base = C.lds + t * 32768 + C.wid * 1024;
            const bf16_t* a = A + (size_t)R * lda + Cc + t * 64; const bf16_t* bq = B + (size_t)Rb * ldb + Cc + t * 64;
            GLDS16(a, base); GLDS16(a + (size_t)64 * lda, base + 8192); GLDS16(bq, base + 16384); GLDS16(bq + (size_t)64 * ldb, base + 16384 + 8192); }
        VM_WAIT(); __syncthreads();
        { const int row = C.tid >> 2, part = C.tid & 3; float ss = 0.f;
            for (int c = part; c < K / 8; c += 4) { const int t = c >> 3, cc = (c & 7) * 8; const u32x4 q = *(const LAS u32x4*)(C.lds + t * 32768 + lds_byte(row, cc));
                ss += lo16(q.x) * lo16(q.x) + hi16(q.x) * hi16(q.x) + lo16(q.y) * lo16(q.y) + hi16(q.y) * hi16(q.y) + lo16(q.z) * lo16(q.z) + hi16(q.z) * hi16(q.z) + lo16(q.w) * lo16(q.w) + hi16(q.w) * hi16(q.w); }
            ss += __shfl_xor(ss, 1); ss += __shfl_xor(ss, 2);
            if (part == 0) rs[row] = __builtin_amdgcn_rsqf(ss / (float)K + EPS); }
        f32x4 acc[4][2]; ZERO_ACC(acc, 4, 2);
        for (int t = 0; t < nkt; ++t) gemm_compute<128, 128, 4, 2>(C, t, wr, wc, acc);
        __syncthreads();
        bf16_t* O; int ldo;
        if (pm < 96) { if (which) { O = (bf16_t*)(p.ws + WS_KVUP) + (size_t)pm * 128 * LDKV; ldo = LDKV; } else { O = (bf16_t*)(p.ws + WS_QUP) + (size_t)pm * 128 * LDQ; ldo = LDQ; } }
        else { O = (bf16_t*)(p.ws + WS_KVCUP) + (size_t)(L * 512 + (pm - 96) * 128) * LDKV; ldo = LDKV; }
#pragma unroll
        for (int m = 0; m < 4; ++m) { const int r = wr * 64 + m * 16 + C.fr; const float sc = rs[r]; const f32x4 v0 = acc[m][0] * sc, v1 = acc[m][1] * sc;
            *(u32x4*)(O + (size_t)r * ldo + n0 + wc * 32 + 8 * C.fq) = (u32x4){pk2(v0.x, v0.y), pk2(v0.z, v0.w), pk2(v1.x, v1.y), pk2(v1.z, v1.w)}; }
        __syncthreads();
    }
}

struct AttnSeg { const bf16_t* K; const bf16_t* K2; const bf16_t* V; int ldk, ldk2, ldv, n, tok0; };
struct AttnDesc { const bf16_t* Q; bf16_t* O; AttnSeg seg[2]; int ldq, ldo; float c1, m0, l0; int qtok0; int rope_q; };
typedef short v4i16_t __attribute__((ext_vector_type(4)));
__device__ __forceinline__ s16x4 vtr(const LAS unsigned char* p) { return __builtin_bit_cast(s16x4, __builtin_amdgcn_ds_read_tr16_b64_v4i16((LAS v4i16_t*)p)); }

template <int DQK, int KIND>
__device__ __forceinline__ void attn_unit(const Ctx& C, const AttnDesc& D, const LAS float* rpb) {
    constexpr int KROW = DQK * 2 + 16, VROW = 160, KBYTES = 64 * KROW, BUFB = KBYTES + 64 * VROW, CPK = DQK / 8, NKC = 64 * CPK;
    const int fr = C.fr, fq = C.fq, q = C.wid * 16 + fr;
    bf16x8 Qf[DQK / 32];
    const bf16_t* qrow = D.Q + (size_t)q * D.ldq;
#pragma unroll
    for (int s = 0; s < DQK / 32; ++s) Qf[s] = *(const bf16x8*)(qrow + s * 32 + fq * 8);
    const int qtok = D.qtok0 + q;
    if (DQK == 96 && D.rope_q) {
        bf16x8 mine = Qf[2], oth;
#pragma unroll
        for (int j = 0; j < 8; ++j) oth[j] = (short)__shfl_xor((int)mine[j], 16);
        const float pos = (fq < 2) ? (float)(qtok >> 6) : (float)(qtok & 63);
#pragma unroll
        for (int j = 0; j < 8; j += 2) {
            float o2[2];
#pragma unroll
            for (int e = 0; e < 2; ++e) {
                const float ang = pos * exp2f(-(float)(j + e) * (13.287712379549449f / 8.0f)); float rev = ang * 0.15915494309189535f; rev -= floorf(rev);
                const float sn = __builtin_amdgcn_sinf(rev), cs = __builtin_amdgcn_cosf(rev);
                const float a = bf2f((bf16_t)mine[j + e]), b = bf2f((bf16_t)oth[j + e]);
                o2[e] = (fq & 1) ? (b * sn + a * cs) : (a * cs - b * sn);
            }
            const unsigned pk = pk2(o2[0], o2[1]); Qf[2][j] = (short)(pk & 0xffffu); Qf[2][j + 1] = (short)(pk >> 16);
        }
    }
    float m = D.m0, l = D.l0 * (fq == 0 ? 1.0f : 0.0f);
    f32x4 Oa[4]; for (int d = 0; d < 4; ++d) Oa[d] = (f32x4){0.f, 0.f, 0.f, 0.f};
    int qrow_g = 0, qcol_g = 0, r0 = 0, cs0 = 0;
    if (KIND == 1) { qrow_g = qtok >> 6; qcol_g = qtok & 63; r0 = min(max(qrow_g - 4, 0), 24); cs0 = min(max(qcol_g - 8, 0), 48); }

    const int nt0 = D.seg[0].n >> 6, ntot = nt0 + (D.seg[1].n >> 6);
    u32x4 kreg[(NKC + 511) / 512], vreg;
    auto issue = [&](int t) {
        const AttnSeg& sg = (t < nt0) ? D.seg[0] : D.seg[1]; const int k0 = ((t < nt0) ? t : t - nt0) * 64;
#pragma unroll
        for (int i = 0; i < (NKC + 511) / 512; ++i) { const int c = C.tid + i * 512;
            if (c < NKC) { const int key = c / CPK, part = c % CPK;
                const bf16_t* src = (part < 8) ? sg.K + (size_t)(k0 + key) * sg.ldk + part * 8 : sg.K2 + (size_t)(k0 + key) * sg.ldk2 + (part - 8) * 8;
                kreg[i] = *(const u32x4*)src; } }
        { const int key = C.tid >> 3, part = C.tid & 7; vreg = *(const u32x4*)(sg.V + (size_t)(k0 + key) * sg.ldv + part * 8); }
    };
    auto commit = [&](int buf) {
        LAS unsigned char* kb = C.lds + buf * BUFB; LAS unsigned char* vb = kb + KBYTES;
#pragma unroll
        for (int i = 0; i < (NKC + 511) / 512; ++i) { const int c = C.tid + i * 512; if (c < NKC) { const int key = c / CPK, part = c % CPK; *(LAS u32x4*)(kb + key * KROW + part * 16) = kreg[i]; } }
        { const int key = C.tid >> 3, part = C.tid & 7; *(LAS u32x4*)(vb + key * VROW + part * 16) = vreg; }
    };
    issue(0);
    for (int t = 0; t < ntot; ++t) {
        const int buf = t & 1;
        commit(buf);
        __syncthreads();
        if (t + 1 < ntot) issue(t + 1);
        const LAS unsigned char* kb = C.lds + buf * BUFB; const LAS unsigned char* vb = kb + KBYTES;
        f32x4 s[4];
#pragma unroll
        for (int kg = 0; kg < 4; ++kg) {
            s[kg] = (f32x4){0.f, 0.f, 0.f, 0.f};
#pragma unroll
            for (int ks = 0; ks < DQK / 32; ++ks) { const bf16x8 Kf = *(const LAS bf16x8*)(kb + (kg * 16 + fr) * KROW + ks * 64 + fq * 16); s[kg] = __builtin_amdgcn_mfma_f32_16x16x32_bf16(Kf, Qf[ks], s[kg], 0, 0, 0); }
        }
        const bool seg1 = (t >= nt0);
        const int ktile0 = seg1 ? D.seg[1].tok0 + (t - nt0) * 64 : 0;
        float mx = -1e30f;
#pragma unroll
        for (int kg = 0; kg < 4; ++kg)
#pragma unroll
            for (int j = 0; j < 4; ++j) {
                float v = s[kg][j] * D.c1;
                if (KIND == 1 && seg1) { const int kt = ktile0 + kg * 16 + 4 * fq + j, krow = kt >> 6, kcol = kt & 63;
                    const bool ok = (krow >= r0) && (krow < r0 + 8) && (kcol >= cs0) && (kcol < cs0 + 16);
                    const int dr = min(max(krow - qrow_g + 7, 0), 14), dc = min(max(kcol - qcol_g + 15, 0), 30);
                    v = ok ? v + rpb[dr * 31 + dc] : -1e30f; }
                if (KIND == 2 && seg1) { const int kt = ktile0 + kg * 16 + 4 * fq + j; const int dd = kt - qtok; v = (dd <= 128 && dd >= -128) ? v : -1e30f; }
                s[kg][j] = v; mx = fmaxf(mx, v);
            }
        mx = qmax4(mx);
        const float mn = fmaxf(m, mx), alpha = __builtin_amdgcn_exp2f(m - mn); m = mn;
        float ps = 0.f;
#pragma unroll
        for (int kg = 0; kg < 4; ++kg)
#pragma unroll
            for (int j = 0; j < 4; ++j) { const float e = __builtin_amdgcn_exp2f(s[kg][j] - mn); s[kg][j] = e; ps += e; }
        l = l * alpha + ps;
#pragma unroll
        for (int d = 0; d < 4; ++d) Oa[d] = Oa[d] * alpha;
#pragma unroll
        for (int k2 = 0; k2 < 2; ++k2) {
            u32x4 pw; pw.x = pk2(s[2 * k2][0], s[2 * k2][1]); pw.y = pk2(s[2 * k2][2], s[2 * k2][3]); pw.z = pk2(s[2 * k2 + 1][0], s[2 * k2 + 1][1]); pw.w = pk2(s[2 * k2 + 1][2], s[2 * k2 + 1][3]);
            const bf16x8 Pf = __builtin_bit_cast(bf16x8, pw);
#pragma unroll
            for (int d = 0; d < 4; ++d) {
                const LAS unsigned char* a0 = vb + (32 * k2 + 4 * fq + (fr >> 2)) * VROW + (d * 16 + 4 * (fr & 3)) * 2;
                const s16x4 lo = vtr(a0), hi = vtr(a0 + 16 * VROW);
                const bf16x8 Vf = (bf16x8){lo[0], lo[1], lo[2], lo[3], hi[0], hi[1], hi[2], hi[3]};
                Oa[d] = __builtin_amdgcn_mfma_f32_16x16x32_bf16(Vf, Pf, Oa[d], 0, 0, 0);
            }
        }
    }
    l += __shfl_xor(l, 16); l += __shfl_xor(l, 32);
    const float inv = 1.0f / l;
    __syncthreads();
    { LAS unsigned char* st = C.lds + C.wid * 2048;
#pragma unroll
        for (int d = 0; d < 4; ++d) { const f32x4 v = Oa[d] * inv; *(LAS u32x2*)(st + fr * 128 + (d * 16 + 4 * fq) * 2) = (u32x2){pk2(v.x, v.y), pk2(v.z, v.w)}; }
        asm volatile("s_waitcnt lgkmcnt(0)" ::: "memory");
#pragma unroll
        for (int i = 0; i < 2; ++i) { const int row = i * 8 + (C.lane >> 3), ch = C.lane & 7; const u32x4 v = *(const LAS u32x4*)(st + row * 128 + ch * 16);
            *(u32x4*)(D.O + (size_t)(C.wid * 16 + row) * D.ldo + ch * 8) = v; }
    }
    __syncthreads();
}

__device__ __forceinline__ void pool_unit(const Params& p, Ctx& C, int L, int unit) {
    const bf16_t* P = (const bf16_t*)(p.ws + WS_P); bf16_t* BR = (bf16_t*)(p.ws + WS_BR);
    CTX_FRESH(C);
    const int T0 = unit * 64; int S0, Ls; if (T0 < NCTX) { S0 = T0 & ~255; Ls = 256; } else { S0 = NCTX + ((T0 - NCTX) & ~2047); Ls = 2048; }
    LAS float* dlt = (LAS float*)C.lds;
    LAS bf16_t* raw = (LAS bf16_t*)(C.lds + 66048);
    LAS float* Wl = (LAS float*)(C.lds + 66048);
    f32x4 wreg[8];
    { const f32x4* Wg = (const f32x4*)(p.in[25] + (size_t)L * 4 * 64 * 64);
#pragma unroll
        for (int i = 0; i < 8; ++i) wreg[i] = Wg[C.tid + i * 512]; }
    for (int i = C.tid; i < 80 * 32; i += 512) { const int r = i >> 5, c = i & 31; const int T = T0 - 8 + r;
        u32x4 v = (u32x4){0u, 0u, 0u, 0u}; if (T >= S0 && T < S0 + Ls) v = *(const u32x4*)(P + (size_t)T * LDP + COL_PD + c * 8);
        *(LAS u32x4*)(raw + r * 256 + c * 8) = v; }
    __syncthreads();
    for (int i = C.tid; i < 64 * 256; i += 512) { const int t = i >> 8, ch = i & 255, gi = ch >> 6; const int hw = 1 << gi, w = 2 << gi;
        const int tl = T0 - S0 + t; const int lo = max(tl - hw, 0), hi = min(tl - hw + w, Ls);
        float s = 0.f; for (int j = lo; j < hi; ++j) s += bf2f(raw[(j - (T0 - S0) + 8) * 256 + ch]);
        dlt[t * 257 + ch] = s / (float)(hi - lo) - bf2f(raw[(t + 8) * 256 + ch]); }
    __syncthreads();
#pragma unroll
    for (int i = 0; i < 8; ++i) ((LAS f32x4*)Wl)[C.tid + i * 512] = wreg[i];
    __syncthreads();
    { const int t = C.lane, gi = C.wid & 3, e0 = (C.wid >> 2) * 32;
        const LAS float* W = Wl + gi * 4096 + e0;
        float a[32];
#pragma unroll
        for (int e = 0; e < 32; ++e) a[e] = 0.f;
#pragma unroll 4
        for (int c = 0; c < 64; ++c) { const float d = dlt[t * 257 + gi * 64 + c];
#pragma unroll
            for (int e4 = 0; e4 < 8; ++e4) { const f32x4 w4 = *(const LAS f32x4*)(W + c * 64 + e4 * 4); a[e4 * 4] += d * w4.x; a[e4 * 4 + 1] += d * w4.y; a[e4 * 4 + 2] += d * w4.z; a[e4 * 4 + 3] += d * w4.w; } }
        const float* sc = p.in[26] + L * 256 + gi * 64 + e0;
        bf16_t* orow = BR + (size_t)(T0 + t) * LDH + 768 + gi * 64 + e0;
#pragma unroll
        for (int e = 0; e < 32; e += 8) *(u32x4*)(orow + e) = (u32x4){pk2(a[e] * sc[e], a[e + 1] * sc[e + 1]), pk2(a[e + 2] * sc[e + 2], a[e + 3] * sc[e + 3]), pk2(a[e + 4] * sc[e + 4], a[e + 5] * sc[e + 5]), pk2(a[e + 6] * sc[e + 6], a[e + 7] * sc[e + 7])};
    }
    __syncthreads();
}

__device__ __forceinline__ void phase4(const Params& p, Ctx& C, int L, int rep = 0) {
    const bf16_t* P = (const bf16_t*)(p.ws + WS_P); bf16_t* BR = (bf16_t*)(p.ws + WS_BR);
    const bf16_t* QUP = (const bf16_t*)(p.ws + WS_QUP); const bf16_t* KVUP = (const bf16_t*)(p.ws + WS_KVUP);
    const bf16_t* KVC = (const bf16_t*)(p.ws + WS_KVCUP) + (size_t)L * 512 * LDKV;
    const bf16_t* NAK = (const bf16_t*)(p.ws + WS_NACK) + (size_t)L * 512 * LDNAC; const bf16_t* NAV = (const bf16_t*)(p.ws + WS_NACV) + (size_t)L * 512 * LDNAC;
    const bf16_t* SWK = (const bf16_t*)(p.ws + WS_SWCK) + (size_t)L * 512 * LDSWC; const bf16_t* SWV = (const bf16_t*)(p.ws + WS_SWCV) + (size_t)L * 512 * LDSWC;
    const bf16_t* KRC = (const bf16_t*)(p.ws + WS_KRC) + (size_t)L * 512 * 32;
    unsigned* qhead = (unsigned*)(p.ws + WS_CTL) + CW_QUEUE + 64 * (L * 2 + rep);
    volatile LAS unsigned* bc = (volatile LAS unsigned*)(C.lds + LDS_CTL + 16);
    LAS float* rpb = (LAS float*)(C.lds + LDS_TAB);
    const float ATT_C1 = 0.125f * LOG2E, MLA_C1 = 0.10206207261596575f * LOG2E;
    for (;;) {
        if (C.tid == 0) bc[0] = atomicAdd(qhead, 1u);
        __syncthreads();
        const int u = __builtin_amdgcn_readfirstlane((int)bc[0]);
        __syncthreads();
        if (u >= 1344) break;
        AttnDesc D; D.rope_q = 0; D.m0 = -1e30f; D.l0 = 0.f; D.seg[1].K2 = nullptr; D.seg[0].K2 = nullptr; D.seg[0].ldk2 = 0; D.seg[1].ldk2 = 0; D.seg[0].tok0 = 0; D.seg[1].tok0 = 0;
        if (u < 128) {
            const int b = u >> 6, h = (u >> 4) & 3, qb = u & 15; const int T0 = NCTX + b * 2048;
            D.Q = QUP + (size_t)(T0 + qb * 128) * LDQ + h * 96; D.ldq = LDQ; D.O = BR + (size_t)(T0 + qb * 128) * LDH + 256 + h * 64; D.ldo = LDH;
            D.seg[0] = AttnSeg{KVC + (size_t)b * 256 * LDKV + h * 128, KRC + (size_t)b * 256 * 32, KVC + (size_t)b * 256 * LDKV + h * 128 + 64, LDKV, 32, LDKV, 256, 0};
            D.seg[1] = AttnSeg{KVUP + (size_t)T0 * LDKV + h * 128, P + (size_t)T0 * LDP + COL_KR, KVUP + (size_t)T0 * LDKV + h * 128 + 64, LDKV, LDP, LDKV, 2048, 0};
            D.c1 = MLA_C1; D.qtok0 = qb * 128; D.rope_q = 1;
#ifndef NO_A1
            attn_unit<96, 0>(C, D, rpb);
#endif
        } else if (u < 256) {
            const int v = u - 128, b = v >> 6, h = (v >> 4) & 3, rp = v & 15; const int T0 = NCTX + b * 2048;
            const int ra = 2 * rp, r0a = min(max(ra - 4, 0), 24), r0b = min(max(ra + 1 - 4, 0), 24);
            for (int i = C.tid; i < 15 * 31; i += 512) rpb[i] = p.in[19][(size_t)(L * 4 + h) * 465 + i] * LOG2E;
            D.Q = P + (size_t)(T0 + ra * 64) * LDP + COL_QA + h * 64; D.ldq = LDP; D.O = BR + (size_t)(T0 + ra * 64) * LDH + 0 + h * 64; D.ldo = LDH;
            D.seg[0] = AttnSeg{NAK + (size_t)b * 256 * LDNAC + h * 64, nullptr, NAV + (size_t)b * 256 * LDNAC + h * 64, LDNAC, 0, LDNAC, 256, 0};
            D.seg[1] = AttnSeg{P + (size_t)(T0 + r0a * 64) * LDP + COL_KA + h * 64, nullptr, P + (size_t)(T0 + r0a * 64) * LDP + COL_VA + h * 64, LDP, 0, LDP, (r0b + 8 - r0a) * 64, r0a * 64};
            D.c1 = ATT_C1; D.qtok0 = ra * 64;
            __syncthreads();
#ifndef NO_A2
            attn_unit<64, 1>(C, D, rpb);
#endif
        } else if (u < 384) {
            const int v = u - 256, b = v >> 6, h = (v >> 4) & 3, qb = v & 15; const int T0 = NCTX + b * 2048, kvh = h >> 1;
            const int klo = max(qb * 128 - 128, 0), khi = min(qb * 128 + 256, 2048);
            D.Q = P + (size_t)(T0 + qb * 128) * LDP + COL_QC + h * 64; D.ldq = LDP; D.O = BR + (size_t)(T0 + qb * 128) * LDH + 512 + h * 64; D.ldo = LDH;
            D.seg[0] = AttnSeg{SWK + (size_t)b * 256 * LDSWC + kvh * 64, nullptr, SWV + (size_t)b * 256 * LDSWC + kvh * 64, LDSWC, 0, LDSWC, 256, 0};
            D.seg[1] = AttnSeg{P + (size_t)(T0 + klo) * LDP + COL_KC + kvh * 64, nullptr, P + (size_t)(T0 + klo) * LDP + COL_VC + kvh * 64, LDP, 0, LDP, khi - klo, klo};
            D.c1 = ATT_C1; D.qtok0 = qb * 128; D.m0 = p.in[24][L * 4 + h] * LOG2E; D.l0 = 1.0f;
#ifndef NO_A3
            attn_unit<64, 2>(C, D, rpb);
#endif
        } else if (u >= 576) {
            const int v = u - 576, half = v & 1, kh = (v >> 1) % 12, b = (v >> 1) / 12, kind = kh >> 2, h = kh & 3; const int T0 = b * 256, Tq = T0 + half * 128;
            D.qtok0 = half * 128; D.seg[1].n = 0; D.seg[1].K = nullptr; D.seg[1].V = nullptr; D.seg[1].ldk = 0; D.seg[1].ldv = 0;
            if (kind == 0) {
                D.Q = P + (size_t)Tq * LDP + COL_QA + h * 64; D.ldq = LDP; D.O = BR + (size_t)Tq * LDH + h * 64; D.ldo = LDH;
                D.seg[0] = AttnSeg{P + (size_t)T0 * LDP + COL_KA + h * 64, nullptr, P + (size_t)T0 * LDP + COL_VA + h * 64, LDP, 0, LDP, 256, 0};
#ifndef NO_A4
                D.c1 = ATT_C1; attn_unit<64, 0>(C, D, rpb);
#endif
            } else if (kind == 1) {
                D.Q = QUP + (size_t)Tq * LDQ + h * 96; D.ldq = LDQ; D.O = BR + (size_t)Tq * LDH + 256 + h * 64; D.ldo = LDH;
                D.seg[0] = AttnSeg{KVUP + (size_t)T0 * LDKV + h * 128, P + (size_t)T0 * LDP + COL_KR, KVUP + (size_t)T0 * LDKV + h * 128 + 64, LDKV, LDP, LDKV, 256, 0};
#ifndef NO_A5
                D.c1 = MLA_C1; attn_unit<96, 0>(C, D, rpb);
#endif
            } else {
                const int kvh = h >> 1;
                D.Q = P + (size_t)Tq * LDP + COL_QC + h * 64; D.ldq = LDP; D.O = BR + (size_t)Tq * LDH + 512 + h * 64; D.ldo = LDH;
                D.seg[0] = AttnSeg{P + (size_t)T0 * LDP + COL_KC + kvh * 64, nullptr, P + (size_t)T0 * LDP + COL_VC + kvh * 64, LDP, 0, LDP, 256, 0};
#ifndef NO_A6
                D.c1 = ATT_C1; D.m0 = p.in[24][L * 4 + h] * LOG2E; D.l0 = 1.0f; attn_unit<64, 0>(C, D, rpb);
#endif
            }
        } else {
#ifndef NO_POOL
            pool_unit(p, C, L, u - 384);
#endif
        }
    }
}

struct BrSched {
    const char* BR; const char* Wb; int G, c;
    __device__ __forceinline__ bool next(int i, G8Unit& u) const {
        const int Lu = i * G + c; if (Lu >= 48 * 16) return false;
        int pm, q; unit_map(Lu, 48, 16, pm, q);
        u.A = BR + (size_t)pm * 256 * LDH * 2 + (q >> 2) * 512; u.B = Wb + (size_t)q * 256 * LDWB * 2; u.e0 = pm; u.e1 = q; u.e2 = 0; u.e3 = 0; return true;
    }
};
__device__ __forceinline__ void phase5a(const Params& p, Ctx& C, int L) {
    BrSched S{(const char*)(p.ws + WS_BR), (const char*)(p.ws + WS_W + (size_t)L * W_LAYER + WO_BR), C.G, C.bid};
    EpiBf16 E{(bf16_t*)(p.ws + WS_BK), LDBK};
    gemm8(C, 256, LDH, LDWB, S, E);
}
struct EpiGate {
    static constexpr bool PERM = false, AFTER_DRAIN = false, FP8 = true; static constexpr int HROWS_B = 2048;
    static __device__ __forceinline__ int brow(int R) { return ((R >> 4) & 1) * 1024 + (R >> 5) * 16 + (R & 15); }
    const bf16_t* BK; bf16_t* MG; const LAS float* bl;
    __device__ __forceinline__ f32x4 init(const G8Unit& u, int bj, int n, int wc, int fq) const { return *(const LAS f32x4*)(bl + (2 * bj + n) * 1024 + u.e1 * 64 + wc * 16 + 4 * fq); }
    __device__ __forceinline__ void operator()(const f32x4 (&acc)[2][2][4][2], const G8Unit& u, int wr, int wc, int fr_, int fq_) const {
        const int ln = hw_lane(), fr = ln & 15, fq = ln >> 4;
        const int xw = u.e1 * 64 + wc * 16;
#define SPIN_(ptr) asm volatile("" : "+s"(ptr))
        const char* bkb = (const char*)BK + ((size_t)(u.e0 * 256 + wr * 64) * LDBK + xw) * 2;
        char* mgb = (char*)MG + ((size_t)(u.e0 * 256 + wr * 64) * LDH + xw) * 2;
        const unsigned lob = (unsigned)(fr * LDBK + 4 * fq) * 2u, lom = (unsigned)(fr * LDH + 4 * fq) * 2u;
        __builtin_amdgcn_sched_barrier(0);
#pragma unroll
        for (int am = 0; am < 8; am += 2) {
            const int rr = (am >> 2) * 128 + (am & 3) * 16;
            u32x2 b[2][4];
#pragma unroll
            for (int m = 0; m < 2; ++m) {
                const char* r01 = bkb + (size_t)(rr + m * 16) * LDBK * 2; SPIN_(r01);
                const char* r23 = r01 + 4096; SPIN_(r23);
                b[m][0] = *(const u32x2*)(r01 + lob); b[m][1] = *(const u32x2*)(r01 + lob + 2048);
                b[m][2] = *(const u32x2*)(r23 + lob); b[m][3] = *(const u32x2*)(r23 + lob + 2048); }
#pragma unroll
            for (int m = 0; m < 2; ++m) {
                f32x4 sum = (f32x4){0.f, 0.f, 0.f, 0.f};
#pragma unroll
                for (int k = 0; k < 4; ++k) { const f32x4 t = acc[am >> 2][k >> 1][(am & 3) + m][k & 1] * (-LOG2E_ * 0.03125f);
                    const f32x4 e = (f32x4){__builtin_amdgcn_exp2f(t.x), __builtin_amdgcn_exp2f(t.y), __builtin_amdgcn_exp2f(t.z), __builtin_amdgcn_exp2f(t.w)} + 1.0f;
                    const f32x4 g = (f32x4){__builtin_amdgcn_rcpf(e.x), __builtin_amdgcn_rcpf(e.y), __builtin_amdgcn_rcpf(e.z), __builtin_amdgcn_rcpf(e.w)};
                    sum += g * (f32x4){lo16(b[m][k].x), hi16(b[m][k].x), lo16(b[m][k].y), hi16(b[m][k].y)}; }
                char* mp = mgb + (size_t)(rr + m * 16) * LDH * 2; SPIN_(mp);
                *(u32x2*)(mp + lom) = (u32x2){pk2(sum.x, sum.y), pk2(sum.z, sum.w)};
            }
            __builtin_amdgcn_sched_barrier(0);
        }
#undef SPIN_
    }
};
__device__ __forceinline__ void phase5b(const Params& p, Ctx& C, int L) {
    TileSched S{(const char*)(p.ws + WS_H8), (const char*)(p.ws + WS_W + (size_t)L * W_LAYER + WO_GATE), (size_t)256 * LD8, (size_t)64 * LD8, 48, 16, C.G, C.bid};
    LAS float* bl = (LAS float*)(C.lds + 131072);
    { const float* bg = p.in[18] + (size_t)L * 4096; for (int i = C.tid; i < 1024; i += 512) ((LAS f32x4*)bl)[i] = ((const f32x4*)bg)[i] * 32.0f; }
    __syncthreads();
    EpiGate E{(const bf16_t*)(p.ws + WS_BK), (bf16_t*)(p.ws + WS_MERGED), bl};
    gemm8(C, 512, LD8 / 2, LD8 / 2, S, E);
}

__device__ __forceinline__ void gemm_bf16_phase(Ctx& C, const bf16_t* A, int lda, const bf16_t* Bt, int ldb, int K, bf16_t* O, int ldo, int nM, int nN) {
    TileSched S{(const char*)A, (const char*)Bt, (size_t)256 * lda * 2, (size_t)256 * ldb * 2, nM, nN, C.G, C.bid};
    EpiBf16 E{O, ldo};
    gemm8(C, K, lda, ldb, S, E);
}


struct RowSumSq {
    float* xbuf;
    unsigned* cnt;
    __device__ __forceinline__ void run(const Ctx& C, const f32x4 (&v)[2][2][4][2], int pm, int pn, int wr, int wc, int fr, int fq, float (&rs)[2][4]) const {
        LAS float* P = (LAS float*)C.lds;
        LAS float* S = (LAS float*)(C.lds + 4096);
#pragma unroll
        for (int ai = 0; ai < 2; ++ai)
#pragma unroll
            for (int m = 0; m < 4; ++m) { float s = 0.f;
#pragma unroll
                for (int bj = 0; bj < 2; ++bj)
#pragma unroll
                    for (int n = 0; n < 2; ++n) { const f32x4 x = v[ai][bj][m][n]; s += (x[0] * x[0] + x[1] * x[1]) + (x[2] * x[2] + x[3] * x[3]); }
                s += __shfl_xor(s, 16); s += __shfl_xor(s, 32);
                if (fq == 0) P[(ai * 128 + wr * 64 + m * 16 + fr) * 4 + wc] = s; }
        asm volatile("s_waitcnt lgkmcnt(0)" ::: "memory"); __builtin_amdgcn_s_barrier(); asm volatile("" ::: "memory");
        const int row = C.wid * 32 + (C.lane & 31);
        if (C.lane < 32) { const float t = (P[row * 4 + 0] + P[row * 4 + 1]) + (P[row * 4 + 2] + P[row * 4 + 3]);
            __hip_atomic_store(xbuf + ((size_t)(pm * 256 + row) * 4 + pn), t, __ATOMIC_RELAXED, __HIP_MEMORY_SCOPE_AGENT); }
        asm volatile("s_waitcnt vmcnt(0)" ::: "memory");
        if (C.lane == 0) __hip_atomic_fetch_add(cnt + 64 * pm, 1u, __ATOMIC_RELAXED, __HIP_MEMORY_SCOPE_AGENT);
        if (C.wid == 0) {
            unsigned spins = 0;
            while ((unsigned)__builtin_amdgcn_readfirstlane(__hip_atomic_load(cnt + 64 * pm, __ATOMIC_RELAXED, __HIP_MEMORY_SCOPE_AGENT)) < 32u) { __builtin_amdgcn_s_sleep(2); if (++spins > (1u << 22)) break; }
            __builtin_amdgcn_fence(__ATOMIC_ACQUIRE, "agent");
        }
        asm volatile("s_waitcnt vmcnt(0) lgkmcnt(0)" ::: "memory"); __builtin_amdgcn_s_barrier(); asm volatile("" ::: "memory");
        if (C.lane < 32) { const float* slot = xbuf + (size_t)(pm * 256 + row) * 4; float t = 0.f;
#pragma unroll
            for (int q = 0; q < 4; ++q) t += __hip_atomic_load(slot + q, __ATOMIC_RELAXED, __HIP_MEMORY_SCOPE_AGENT);
            S[row] = t; }
        asm volatile("s_waitcnt vmcnt(0) lgkmcnt(0)" ::: "memory"); __builtin_amdgcn_s_barrier(); asm volatile("" ::: "memory");
#pragma unroll
        for (int ai = 0; ai < 2; ++ai)
#pragma unroll
            for (int m = 0; m < 4; ++m) rs[ai][m] = S[ai * 128 + wr * 64 + m * 16 + fr];
        asm volatile("s_waitcnt lgkmcnt(0)" ::: "memory"); __builtin_amdgcn_s_barrier(); asm volatile("" ::: "memory");
    }
};
template <int MODE> struct EpiNormFused {
    static constexpr bool PERM = true, AFTER_DRAIN = true; G8_EPI_PLAIN
    const Params& p; int L;
    __device__ __forceinline__ void drained(const Ctx& C, f32x4 (&acc)[2][2][4][2], const G8Unit& u, int wr, int wc, int fr, int fq) const {
        const int pm = u.e0, pn = u.e1, cls = pm < 32 ? 0 : 1 + ((pm - 32) >> 3);
        unsigned* ctl = (unsigned*)(p.ws + WS_CTL);
        const float* modv = (const float*)(p.ws + WS_MODV);
        const float* mv = modv + (size_t)(L * 3 + cls) * 6144;
        float* Y = p.out + OFF_Y; bf16_t* H = (bf16_t*)(p.ws + WS_H);
        const float* gpost = (MODE == 0 ? p.in[13] : p.in[15]) + L * DM;
        const float* gate = mv + (MODE == 0 ? 2048 : 5120);
        const float* xpan = (MODE == 0 && L == 0) ? (pm < 32 ? p.in[0] + (size_t)pm * 256 * DM : p.in[1] + (size_t)(pm - 32) * 256 * DM) : Y + (size_t)pm * 256 * DM;
        float* ypan = Y + (size_t)pm * 256 * DM; bf16_t* hpan = H + (size_t)pm * 256 * LDH; unsigned char* h8pan = p.ws + WS_H8 + (size_t)pm * 256 * LD8;
        float rs[2][4];
        { RowSumSq X{(float*)(ctl + CW_XBUF), ctl + CW_SEAM + ((L * 2 + MODE) * 2 + 0) * 48 * 64}; X.run(C, acc, pm, pn, wr, wc, fr, fq, rs); }
#pragma unroll
        for (int ai = 0; ai < 2; ++ai)
#pragma unroll
            for (int m = 0; m < 4; ++m) rs[ai][m] = __builtin_amdgcn_rsqf(rs[ai][m] * (1.0f / DM) + EPS);
#pragma unroll
        for (int bj = 0; bj < 2; ++bj) { const int col = pn * 256 + bj * 128 + wc * 32 + 8 * fq;
            const f32x4 gp0 = *(const f32x4*)(gpost + col), gp1 = *(const f32x4*)(gpost + col + 4), g0 = *(const f32x4*)(gate + col), g1 = *(const f32x4*)(gate + col + 4);
#pragma unroll
            for (int ai = 0; ai < 2; ++ai)
#pragma unroll
                for (int m = 0; m < 4; ++m) { const int off = (ai * 128 + wr * 64 + m * 16 + fr) * DM + col;
                    const f32x4 x0 = *(const f32x4*)(xpan + off), x1 = *(const f32x4*)(xpan + off + 4);
                    acc[ai][bj][m][0] = x0 + g0 * (acc[ai][bj][m][0] * rs[ai][m] * gp0);
                    acc[ai][bj][m][1] = x1 + g1 * (acc[ai][bj][m][1] * rs[ai][m] * gp1);
                    asm volatile("" : "+v"(acc[ai][bj][m][0]), "+v"(acc[ai][bj][m][1]));
                    if (m & 1) asm volatile("" ::: "memory"); } }
        const bool second = (MODE == 0) || (L == 0);
        if (second) { RowSumSq X{(float*)(ctl + CW_XBUF) + 48 * 256 * 4, ctl + CW_SEAM + ((L * 2 + MODE) * 2 + 1) * 48 * 64}; X.run(C, acc, pm, pn, wr, wc, fr, fq, rs);
#pragma unroll
            for (int ai = 0; ai < 2; ++ai)
#pragma unroll
                for (int m = 0; m < 4; ++m) rs[ai][m] = __builtin_amdgcn_rsqf(rs[ai][m] * (1.0f / DM) + EPS); }
        const float* mvn = (MODE == 0) ? mv : modv + (size_t)(1 * 3 + cls) * 6144;
        const float* gpre = (MODE == 0) ? p.in[14] + L * DM : p.in[12] + DM;
        const float* scv = mvn + (MODE == 0 ? 4096 : 1024); const float* shv = mvn + (MODE == 0 ? 3072 : 0);
#pragma unroll
        for (int bj = 0; bj < 2; ++bj) { const int col = pn * 256 + bj * 128 + wc * 32 + 8 * fq;
            const f32x4 z = (f32x4){0.f, 0.f, 0.f, 0.f};
            f32x4 gg0 = z, gg1 = z, sa0 = z, sa1 = z, sb0 = z, sb1 = z;
            if (second) { gg0 = *(const f32x4*)(gpre + col); gg1 = *(const f32x4*)(gpre + col + 4); sa0 = *(const f32x4*)(scv + col) + 1.0f; sa1 = *(const f32x4*)(scv + col + 4) + 1.0f; sb0 = *(const f32x4*)(shv + col); sb1 = *(const f32x4*)(shv + col + 4); }
#pragma unroll
            for (int ai = 0; ai < 2; ++ai)
#pragma unroll
                for (int m = 0; m < 4; ++m) { const int rl = ai * 128 + wr * 64 + m * 16 + fr; const f32x4 v0 = acc[ai][bj][m][0], v1 = acc[ai][bj][m][1];
                    *(f32x4*)(ypan + rl * DM + col) = v0; *(f32x4*)(ypan + rl * DM + col + 4) = v1;
                    if (second) { const f32x4 h0 = v0 * rs[ai][m] * gg0 * sa0 + sb0, h1 = v1 * rs[ai][m] * gg1 * sa1 + sb1;
                        *(u32x4*)(hpan + rl * LDH + col) = (u32x4){pk2(h0.x, h0.y), pk2(h0.z, h0.w), pk2(h1.x, h1.y), pk2(h1.z, h1.w)};
                        if (MODE == 1) { int w0 = __builtin_amdgcn_cvt_pk_fp8_f32(h0.x, h0.y, 0, false); w0 = __builtin_amdgcn_cvt_pk_fp8_f32(h0.z, h0.w, w0, true);
                            int w1 = __builtin_amdgcn_cvt_pk_fp8_f32(h1.x, h1.y, 0, false); w1 = __builtin_amdgcn_cvt_pk_fp8_f32(h1.z, h1.w, w1, true);
                            *(u32x2*)(h8pan + rl * LD8 + col) = (u32x2){(unsigned)w0, (unsigned)w1}; } }
                    asm volatile("" ::: "memory"); } }
    }
};
template <int MODE> __device__ __forceinline__ void gemm_norm_phase(const Params& p, Ctx& C, int L, const bf16_t* A, int lda, const bf16_t* Bt, int ldb, int K) {
    TileSched S{(const char*)A, (const char*)Bt, (size_t)256 * lda * 2, (size_t)256 * ldb * 2, 48, 4, C.G, C.bid};
    EpiNormFused<MODE> E{p, L};
    gemm8(C, K, lda, ldb, S, E);
}

struct OneUnit { G8Unit u; __device__ __forceinline__ bool next(int i, G8Unit& o) const { if (i > 0) return false; o = u; return true; } };
struct EpiUpConv {
    static constexpr bool PERM = false, AFTER_DRAIN = true; G8_EPI_PLAIN
    bf16_t* ACT; const float* cw;
    __device__ __forceinline__ void drained(const Ctx& C, const f32x4 (&acc)[2][2][4][2], const G8Unit& u, int wr, int wc, int fr, int fq) const {
        constexpr int UROW = 528;
        const int Trow0 = u.e0, pn = u.e1, tpos0 = u.e2, Ls = u.e3;
#pragma unroll
        for (int ai = 0; ai < 2; ++ai)
#pragma unroll
            for (int m = 0; m < 4; ++m) { const int r = ai * 128 + wr * 64 + m * 16 + fr;
#pragma unroll
                for (int bj = 0; bj < 2; ++bj)
#pragma unroll
                    for (int n = 0; n < 2; ++n) { const int c = bj * 128 + wc * 32 + n * 16 + 4 * fq; const f32x4 v = acc[ai][bj][m][n]; *(LAS u32x2*)(C.lds + r * UROW + c * 2) = (u32x2){pk2(v.x, v.y), pk2(v.z, v.w)}; } }
        __syncthreads();
        {
            const int cc = C.tid & 15, rg = C.tid >> 4;
            const int f0 = pn * 128 + cc * 8;
            float wa[3][8], wg[3][8];
#pragma unroll
            for (int j = 0; j < 3; ++j)
#pragma unroll
                for (int e = 0; e < 8; ++e) { const bool ok = (f0 + e) < DFF; wa[j][e] = ok ? cw[j * 5504 + f0 + e] : 0.f; wg[j][e] = ok ? cw[j * 5504 + DFF + f0 + e] : 0.f; }
            for (int ps = 0; ps < 8; ++ps) {
                const int r = ps * 32 + rg, tpos = tpos0 + r;
                const bool valid = (r > 0 || tpos == 0) && (r < 255 || tpos == Ls - 1);
                if (!valid) continue;
                const bool hasl = tpos > 0, hasr = tpos < Ls - 1;
                const LAS unsigned char* base = C.lds + r * UROW + cc * 16;
                const u32x4 z = (u32x4){0u, 0u, 0u, 0u};
                const u32x4 a0 = hasl ? *(const LAS u32x4*)(base - UROW) : z, a1 = *(const LAS u32x4*)base, a2 = hasr ? *(const LAS u32x4*)(base + UROW) : z;
                const u32x4 g0 = hasl ? *(const LAS u32x4*)(base - UROW + 256) : z, g1 = *(const LAS u32x4*)(base + 256), g2 = hasr ? *(const LAS u32x4*)(base + UROW + 256) : z;
                float o[8];
#pragma unroll
                for (int e = 0; e < 8; ++e) {
                    const unsigned ua0 = a0[e >> 1], ua1 = a1[e >> 1], ua2 = a2[e >> 1], ug0 = g0[e >> 1], ug1 = g1[e >> 1], ug2 = g2[e >> 1];
                    const float xa0 = (e & 1) ? hi16(ua0) : lo16(ua0), xa1 = (e & 1) ? hi16(ua1) : lo16(ua1), xa2 = (e & 1) ? hi16(ua2) : lo16(ua2);
                    const float xg0 = (e & 1) ? hi16(ug0) : lo16(ug0), xg1 = (e & 1) ? hi16(ug1) : lo16(ug1), xg2 = (e & 1) ? hi16(ug2) : lo16(ug2);
                    const float av = xa0 * wa[0][e] + xa1 * wa[1][e] + xa2 * wa[2][e];
                    const float gv = xg0 * wg[0][e] + xg1 * wg[1][e] + xg2 * wg[2][e];
                    o[e] = siluf_(gv) * av;
                }
                *(u32x4*)(ACT + (size_t)(Trow0 + r) * LDACT + f0) = (u32x4){pk2(o[0], o[1]), pk2(o[2], o[3]), pk2(o[4], o[5]), pk2(o[6], o[7])};
            }
        }
        __syncthreads();
    }
};
__device__ __forceinline__ float dpp_ror1(float x) { return __int_as_float(__builtin_amdgcn_update_dpp(0, __float_as_int(x), 0x121, 0xf, 0xf, false)); }
__device__ __forceinline__ float dpp_ror15(float x) { return __int_as_float(__builtin_amdgcn_update_dpp(0, __float_as_int(x), 0x12F, 0xf, 0xf, false)); }
struct EpiUpConvReg {
    static constexpr bool PERM = true, AFTER_DRAIN = false; G8_EPI_PLAIN
    bf16_t* ACT; const float* cw; LAS unsigned* halo;
    __device__ __forceinline__ void operator()(const f32x4 (&acc)[2][2][4][2], const G8Unit& u, int wr, int wc, int fr_, int fq_) const {
        int fr = fr_, fq = fq_; asm volatile("" : "+v"(fr), "+v"(fq));
        const int Trow0 = u.e0, pn = u.e1, tpos0 = u.e2, Ls = u.e3;
        const int cl = wc * 32 + 8 * fq;
        unsigned xp[2][4][2][4];
#pragma unroll
        for (int ai = 0; ai < 2; ++ai)
#pragma unroll
            for (int m = 0; m < 4; ++m)
#pragma unroll
                for (int n = 0; n < 2; ++n)
#pragma unroll
                    for (int j = 0; j < 4; ++j) { xp[ai][m][n][j] = pk2(acc[ai][0][m][n][j], acc[ai][1][m][n][j]); asm volatile("" : "+v"(xp[ai][m][n][j])); }
#pragma unroll
        for (int ai = 0; ai < 2; ++ai) { const int b = ai * 2 + wr;
#pragma unroll
            for (int n = 0; n < 2; ++n) {
                if (fr == 0) *(LAS u32x4*)(halo + (b * 2 + 0) * 128 + cl + 4 * n) = (u32x4){xp[ai][0][n][0], xp[ai][0][n][1], xp[ai][0][n][2], xp[ai][0][n][3]};
                if (fr == 15) *(LAS u32x4*)(halo + (b * 2 + 1) * 128 + cl + 4 * n) = (u32x4){xp[ai][3][n][0], xp[ai][3][n][1], xp[ai][3][n][2], xp[ai][3][n][3]};
            } }
        LAS float* cwl = (LAS float*)(halo + 1024);
        const int tx = (wr * 4 + wc) * 64 + fq * 16 + fr;
        if (tx < 192) { const int jp = tx >> 5, ch = tx & 31, f = pn * 128 + ch * 4;
            const f32x4 v = (f < DFF) ? *(const f32x4*)(cw + (jp >> 1) * 5504 + (jp & 1) * DFF + f) : (f32x4){0.f, 0.f, 0.f, 0.f};
            *(LAS f32x4*)(cwl + jp * 128 + ch * 4) = v; }
        asm volatile("s_waitcnt vmcnt(0) lgkmcnt(0)\n\ts_barrier" ::: "memory");
        asm volatile("s_barrier" ::: "memory");
        const int f0 = pn * 128 + cl;
        const int src_up = ((fq << 4) | ((fr + 15) & 15)) << 2, src_dn = ((fq << 4) | ((fr + 1) & 15)) << 2;
        const bool seq_first = (tpos0 == 0), seq_last = (tpos0 + 256 == Ls);
        u32x2 pk0[2][4];
#pragma unroll
        for (int n = 0; n < 2; ++n) {
            f32x2 w0[4], w1[4], w2[4];
            { const f32x4 a0 = *(const LAS f32x4*)(cwl + 0 * 128 + cl + 4 * n), g0 = *(const LAS f32x4*)(cwl + 1 * 128 + cl + 4 * n);
                const f32x4 a1 = *(const LAS f32x4*)(cwl + 2 * 128 + cl + 4 * n), g1 = *(const LAS f32x4*)(cwl + 3 * 128 + cl + 4 * n);
                const f32x4 a2 = *(const LAS f32x4*)(cwl + 4 * 128 + cl + 4 * n), g2 = *(const LAS f32x4*)(cwl + 5 * 128 + cl + 4 * n);
#pragma unroll
                for (int j = 0; j < 4; ++j) { w0[j] = (f32x2){a0[j], g0[j]}; w1[j] = (f32x2){a1[j], g1[j]}; w2[j] = (f32x2){a2[j], g2[j]}; } }
#pragma unroll
            for (int ai = 0; ai < 2; ++ai) { const int b = ai * 2 + wr;
                u32x4 hup = (u32x4){0u, 0u, 0u, 0u}, hdn = hup;
                if (b > 0) hup = *(const LAS u32x4*)(halo + ((b - 1) * 2 + 1) * 128 + cl + 4 * n);
                if (b < 3) hdn = *(const LAS u32x4*)(halo + ((b + 1) * 2 + 0) * 128 + cl + 4 * n);
#pragma unroll
                for (int m = 0; m < 4; ++m) {
                    const int r = ai * 128 + wr * 64 + m * 16 + fr;
                    float o[4];
#pragma unroll
                    for (int j = 0; j < 4; ++j) {
                        const unsigned xc = xp[ai][m][n][j];
                        const unsigned pv = (m > 0) ? xp[ai][m > 0 ? m - 1 : 0][n][j] : hup[j], nv = (m < 3) ? xp[ai][m < 3 ? m + 1 : 3][n][j] : hdn[j];
                        unsigned upk = (unsigned)__builtin_amdgcn_update_dpp(0, (int)(fr == 15 ? pv : xc), 0x121, 0xf, 0xf, false);
                        unsigned dnk = (unsigned)__builtin_amdgcn_update_dpp(0, (int)(fr == 0 ? nv : xc), 0x12F, 0xf, 0xf, false);
                        if (ai == 0 && m == 0) { if (seq_first && r == 0) upk = 0u; }
                        if (ai == 1 && m == 3) { if (seq_last && r == 255) dnk = 0u; }
                        const f32x2 c2 = (f32x2){lo16(upk), hi16(upk)} * w0[j] + (f32x2){lo16(xc), hi16(xc)} * w1[j] + (f32x2){lo16(dnk), hi16(dnk)} * w2[j];
                        o[j] = siluf_(c2.y) * c2.x;
                    }
                    const u32x2 pkn = (u32x2){pk2(o[0], o[1]), pk2(o[2], o[3])};
                    if (n == 0) pk0[ai][m] = pkn;
                    else {
                        bool valid = true;
                        if (ai == 0 && m == 0) valid = (r > 0) || seq_first;
                        if (ai == 1 && m == 3) valid = (r < 255) || seq_last;
                        if (valid) *(u32x4*)(ACT + (size_t)(Trow0 + r) * LDACT + f0) = (u32x4){pk0[ai][m].x, pk0[ai][m].y, pkn.x, pkn.y};
                    }
                }
            }
        }
    }
};
struct UpSched {
    const char* H; const char* Wu; int G, c;
    __device__ __forceinline__ bool next(int i, G8Unit& u) const {
        const int Lu = i * G + c; if (Lu >= 50 * 22) return false;
        int mt, pn; unit_map(Lu, 50, 22, mt, pn);
        int Trow0, tpos0, Ls;
        if (mt < 32) { Trow0 = mt * 256; tpos0 = 0; Ls = 256; }
        else { const int v = mt - 32, b = v / 9, j = v % 9; tpos0 = (j < 8) ? 254 * j : 1792; Trow0 = NCTX + b * 2048 + tpos0; Ls = 2048; }
        u.A = H + (size_t)Trow0 * LDH * 2; u.B = Wu + (size_t)pn * 256 * LDW * 2; u.e0 = Trow0; u.e1 = pn; u.e2 = tpos0; u.e3 = Ls; return true;
    }
};
__device__ __forceinline__ void phase8(const Params& p, Ctx& C, int L) {
    UpSched S{(const char*)(p.ws + WS_H), (const char*)(p.ws + WS_W + (size_t)L * W_LAYER + WO_UP), C.G, C.bid};
    EpiUpConvReg E{(bf16_t*)(p.ws + WS_ACT), p.in[30] + (size_t)L * 3 * 5504, (LAS unsigned*)(C.lds + 131072)};
    gemm8(C, DM, LDH, LDW, S, E);
}

__global__ void __launch_bounds__(512, 2) mega_fwd(Params p) {
    extern __shared__ __attribute__((aligned(16))) unsigned char lds_raw[];
    Ctx C; C.lds = (LAS unsigned char*)lds_raw;
    C.ws = __builtin_amdgcn_readfirstlane((int)(threadIdx.x >> 6)); C.G = gridDim.x; C.bid = blockIdx.x;
#define FRESH() CTX_FRESH(C)
    FRESH();
    if (C.tid < 16) ((LAS unsigned*)(C.lds + LDS_CTL))[C.tid] = 0u;
    __syncthreads();
    XcdBarrier bar = xcd_barrier_post((unsigned*)(p.ws + WS_CTL) + CW_BAR, (volatile LAS unsigned*)(C.lds + LDS_CTL));
#define GRID_BAR() do { xcd_barrier(bar, C.tid); FRESH(); } while (0)
#ifndef PH
#define PH 0xffff
#endif
#ifndef DUP
#define DUP 0
#endif
    if (PH & 1) phase0(p, C); GRID_BAR();
    if (DUP & 1) { phase0(p, C); GRID_BAR(); }
    if (PH & 2) phase1(p, C); GRID_BAR();
    if (DUP & 2) { phase1(p, C); GRID_BAR(); }
#pragma unroll 1
    for (int L = 0; L < 2; ++L) {
        if (PH & 4) phase2(p, C, L); GRID_BAR();
        if (DUP & 4) { phase2(p, C, L); GRID_BAR(); }
        if (PH & 8) phase3(p, C, L); GRID_BAR();
        if (PH & 16) phase4(p, C, L); GRID_BAR();
        if (DUP & 16) { phase4(p, C, L, 1); GRID_BAR(); }
        if (PH & 32) phase5a(p, C, L); GRID_BAR();
        if (DUP & 32) { phase5a(p, C, L); GRID_BAR(); }
        if (PH & 64) phase5b(p, C, L); GRID_BAR();
        if (DUP & 64) { phase5b(p, C, L); GRID_BAR(); }
        gemm_norm_phase<0>(p, C, L, (const bf16_t*)(p.ws + WS_MERGED), LDH, (const bf16_t*)(p.ws + WS_W + (size_t)L * W_LAYER + WO_OUT), LDW, DM); GRID_BAR();
        if (PH & 256) phase8(p, C, L); GRID_BAR();
        if (DUP & 256) { phase8(p, C, L); GRID_BAR(); }
        gemm_norm_phase<1>(p, C, L, (const bf16_t*)(p.ws + WS_ACT), LDACT, (const bf16_t*)(p.ws + WS_W + (size_t)L * W_LAYER + WO_DOWN), LDWD, DFFP);
        if (L == 0) GRID_BAR();
    }
}

extern "C" void kernel_launch(void* const* d_in, const int* in_sizes, int n_in, void* d_out, int out_size, void* d_ws, size_t ws_size, hipStream_t stream) {
    static int grid = 0;
    if (grid == 0) {
        if (n_in != 32 || ws_size < WS_END) { fprintf(stderr, "kernel_launch: unexpected n_in %d / ws %zu\n", n_in, ws_size); grid = -1; return; }
        int dev = 0, cus = 0;
        if (hipGetDevice(&dev) != hipSuccess || hipDeviceGetAttribute(&cus, hipDeviceAttributeMultiprocessorCount, dev) != hipSuccess) { grid = -1; return; }
        if (hipFuncSetAttribute((const void*)mega_fwd, hipFuncAttributeMaxDynamicSharedMemorySize, LDS_BYTES) != hipSuccess) { fprintf(stderr, "kernel_launch: hipFuncSetAttribute failed\n"); grid = -1; return; }
        grid = cus;
    }
    if (grid < 0) return;
    (void)hipMemsetAsync((char*)d_ws + WS_CTL, 0, (size_t)(CW_SEAM + 384 * 64) * 4, stream);
    Params a{};
    for (int i = 0; i < 32; ++i) a.in[i] = (const float*)d_in[i];
    a.out = (float*)d_out; a.ws = (unsigned char*)d_ws;
    hipLaunchKernelGGL(mega_fwd, dim3(grid), dim3(512), LDS_BYTES, stream, a);
}
```

```cpp
#include <hip/hip_runtime.h>
#include <cstdio>
#include <cstdint>

#define LAS __attribute__((address_space(3)))
#define GAS __attribute__((address_space(1)))
typedef unsigned short bf16_t;
typedef short bf16x8 __attribute__((ext_vector_type(8)));
typedef short s16x4 __attribute__((ext_vector_type(4)));
typedef float f32x4 __attribute__((ext_vector_type(4)));
typedef float f32x2 __attribute__((ext_vector_type(2)));
typedef unsigned u32x4 __attribute__((ext_vector_type(4)));
typedef unsigned u32x2 __attribute__((ext_vector_type(2)));
typedef __bf16 bf16x2_t __attribute__((ext_vector_type(2)));
#define LOG2E_ 1.4426950408889634f
typedef long lx2 __attribute__((ext_vector_type(2)));
typedef int i32x8 __attribute__((ext_vector_type(8)));
typedef int i32x4 __attribute__((ext_vector_type(4)));

constexpr int DM = 1024, NCTX = 8192, NLAT = 4096, NTOK = 12288;
constexpr int INP = 2048, IN_DIM = 1888, DFF = 2752, DFFP = 2816, NUP = 5632;
constexpr int LD8 = 1152;
constexpr int LDH = 1088, LDP = 1984, LDACT = 2880, LDQ = 448, LDKV = 576, LDW = 1088, LDWB = 320, LDWD = 2880, LDUQ = 192, LDUKV = 192, LDNAC = 320, LDSWC = 192, LDCKVC = 192, LDBK = 4160;
constexpr int COL_QA = 0, COL_KA = 256, COL_VA = 512, COL_CQ = 768, COL_CKV = 960, COL_KR = 1088, COL_QC = 1120, COL_KC = 1376, COL_VC = 1504, COL_PD = 1632;
constexpr float EPS = 1e-6f;
constexpr float LOG2E = 1.4426950408889634f;
constexpr size_t OFF_Y = 0, OFF_NAK = 12582912, OFF_NAV = 16777216, OFF_CKV = 20971520, OFF_KR = 23068672, OFF_SWK = 23592960, OFF_SWV = 25690112;

constexpr size_t MiB = 1u << 20;
constexpr size_t WS_CTL = 0, CTL_BYTES = 1 * MiB;
constexpr size_t WS_MODV = 1 * MiB;
constexpr size_t WS_NACK = 2 * MiB;
constexpr size_t WS_NACV = WS_NACK + 640 * 1024;
constexpr size_t WS_SWCK = WS_NACV + 640 * 1024;
constexpr size_t WS_SWCV = WS_SWCK + 384 * 1024;
constexpr size_t WS_CKVC = WS_SWCV + 384 * 1024;
constexpr size_t WS_KRC = WS_CKVC + 384 * 1024;
constexpr size_t WS_KVCUP = WS_KRC + 64 * 1024;
static_assert(WS_KVCUP + (size_t)2 * 512 * LDKV * 2 <= 6 * MiB, "cache region");
constexpr size_t WS_W = 6 * MiB, W_LAYER = 36 * MiB + 512 * 1024;
constexpr size_t WO_IN = 0, WO_GATE = 4 * MiB + 512 * 1024, WO_BR = 13 * MiB, WO_OUT = 15 * MiB + 512 * 1024, WO_UP = 18 * MiB, WO_DOWN = 30 * MiB, WO_UQ = 35 * MiB + 768 * 1024, WO_UKV = 36 * MiB;
static_assert((size_t)2048 * LDW * 2 <= WO_GATE && WO_GATE + (size_t)4096 * LDW * 2 <= WO_BR && WO_BR + (size_t)4096 * LDWB * 2 <= WO_OUT && WO_OUT + (size_t)1024 * LDW * 2 <= WO_UP && WO_UP + (size_t)NUP * LDW * 2 <= WO_DOWN && WO_DOWN + (size_t)1024 * LDWD * 2 <= WO_UQ && WO_UQ + (size_t)512 * LDUQ * 2 <= WO_UKV && WO_UKV + (size_t)512 * LDUKV * 2 <= W_LAYER, "weight map");
constexpr size_t WS_X1 = 79 * MiB;
constexpr size_t WS_H8 = WS_X1;
constexpr size_t WS_H = 127 * MiB;
constexpr size_t WS_P = 153 * MiB;
constexpr size_t WS_BK = 93 * MiB;
constexpr size_t WS_MERGED = 226 * MiB;
constexpr size_t WS_BR = 200 * MiB;
constexpr size_t WS_O = WS_BR;
constexpr size_t WS_QUP = 226 * MiB;
constexpr size_t WS_KVUP = 237 * MiB;
constexpr size_t WS_ACT = WS_P;
constexpr size_t WS_END = 252 * MiB;
static_assert((size_t)NTOK * LD8 <= (size_t)NTOK * DM * 4 && (size_t)4096 * LD8 <= WO_BR - WO_GATE, "fp8 buffers");
static_assert(WS_W + 2 * W_LAYER <= WS_X1 && WS_X1 + (size_t)NTOK * DM * 4 <= WS_H && WS_H + (size_t)NTOK * LDH * 2 <= WS_P && WS_P + (size_t)NTOK * LDP * 2 <= WS_BR && WS_BR + (size_t)NTOK * LDH * 2 <= WS_QUP
              && WS_QUP + (size_t)NTOK * LDQ * 2 <= WS_KVUP && WS_KVUP + (size_t)NTOK * LDKV * 2 <= WS_END && WS_ACT + (size_t)NTOK * LDACT * 2 <= WS_QUP
              && WS_H8 + (size_t)NTOK * LD8 <= WS_BK && WS_BK + (size_t)NTOK * LDBK * 2 <= WS_BR && WS_MERGED + (size_t)NTOK * LDH * 2 <= WS_END, "workspace map");
constexpr int CW_BAR = 1024;
constexpr int CW_QUEUE = 8192;
constexpr int CW_SEAM = 16384;
constexpr int CW_XBUF = 65536;

constexpr int LDS_CTL = 147456, LDS_TAB = LDS_CTL + 64, LDS_BYTES = LDS_TAB + 4096;

struct Params { const float* in[32]; float* out; unsigned char* ws; };

__device__ __forceinline__ float bf2f(bf16_t b) { return __uint_as_float((unsigned)b << 16); }
__device__ __forceinline__ unsigned pk2(float lo, float hi) { f32x2 v = {lo, hi}; bf16x2_t b = __builtin_convertvector(v, bf16x2_t); return __builtin_bit_cast(unsigned, b); }
__device__ __forceinline__ float lo16(unsigned u) { return __uint_as_float(u << 16); }
__device__ __forceinline__ float hi16(unsigned u) { return __uint_as_float(u & 0xffff0000u); }
__device__ __forceinline__ float wave_sum(float v) {
#pragma unroll
    for (int o = 1; o < 64; o <<= 1) v += __shfl_xor(v, o);
    return v;
}
__device__ __forceinline__ float qmax4(float x) {
    const auto a = __builtin_amdgcn_permlane16_swap(__float_as_uint(x), __float_as_uint(x), false, false); x = fmaxf(__uint_as_float(a[0]), __uint_as_float(a[1]));
    const auto b = __builtin_amdgcn_permlane32_swap(__float_as_uint(x), __float_as_uint(x), false, false); return fmaxf(__uint_as_float(b[0]), __uint_as_float(b[1]));
}
__device__ __forceinline__ float sigmoidf_(float x) { return __builtin_amdgcn_rcpf(1.0f + __builtin_amdgcn_exp2f(x * -LOG2E_)); }
__device__ __forceinline__ float siluf_(float x) { return x * __builtin_amdgcn_rcpf(1.0f + __builtin_amdgcn_exp2f(x * -LOG2E_)); }
#define VM_WAIT_UNUSED_()
#define VM_WAIT() asm volatile("s_waitcnt vmcnt(0)" ::: "memory")

#define XB_TMO      128
#define XB_XCNT(j)  (256  + 64 * (j))
#define XB_XSUB(j)  (1280 + 64 * (j))
#define XB_XGEN(j)  (2304 + 64 * (j))
#define XB_TOP      3328
#define XB_TOPGEN   3392
#define XCD_BAR_WORDS 3456
#define XB_SPIN_CAP (1u << 22)
__device__ __forceinline__ unsigned xb_ld(unsigned* p)              { return __hip_atomic_load(p, __ATOMIC_RELAXED, __HIP_MEMORY_SCOPE_AGENT); }
__device__ __forceinline__ unsigned xb_add(unsigned* p, unsigned v) { return __hip_atomic_fetch_add(p, v, __ATOMIC_RELAXED, __HIP_MEMORY_SCOPE_AGENT); }
__device__ __forceinline__ unsigned xb_xcc_id() { return (unsigned)__builtin_amdgcn_s_getreg((3 << 11) | 20) & 0xFu; }
#define XB_SPIN(cond, bar) do { unsigned _sp = 0; while (cond) { __builtin_amdgcn_s_sleep(1); \
    if ((++_sp & 255u) == 0u) { if (xb_ld(&(bar)[XB_TMO])) break; if (_sp > XB_SPIN_CAP) { atomicAdd(&(bar)[XB_TMO], 1u); break; } } } } while (0)
struct XcdBarrier { unsigned* bar; unsigned x; volatile LAS unsigned* st; };
__device__ __forceinline__ XcdBarrier xcd_barrier_post(unsigned* bar, volatile LAS unsigned* st) {
    XcdBarrier b; b.bar = bar; b.x = xb_xcc_id(); b.st = st;
    if (threadIdx.x == 0) (void)xb_add(&bar[XB_XCNT(b.x)], 1u);
    return b;
}
__device__ __forceinline__ void xcd_barrier_complete(unsigned* bar, unsigned x, unsigned& nloc, unsigned& nx) {
    const unsigned G = gridDim.x * gridDim.y * gridDim.z;
    unsigned sum, cnt, mine, sp = 0u;
    for (;;) {
        sum = 0u; cnt = 0u; mine = 0u;
#pragma unroll
        for (unsigned j = 0; j < 16; ++j) { const unsigned c = xb_ld(&bar[XB_XCNT(j)]); sum += c; cnt += (c > 0u) ? 1u : 0u; mine = (j == x) ? c : mine; }
        if (sum == G) break;
        __builtin_amdgcn_s_sleep(1);
        if ((++sp & 255u) == 0u) { if (xb_ld(&bar[XB_TMO])) break; if (sp > XB_SPIN_CAP) { atomicAdd(&bar[XB_TMO], 1u); break; } }
    }
    nloc = mine > 0u ? mine : 1u; nx = cnt > 0u ? cnt : 1u;
}
__device__ __forceinline__ void xcd_barrier(const XcdBarrier& b, int tid) {
    asm volatile("s_waitcnt vmcnt(0)" ::: "memory");
    __syncthreads();
    if (tid == 0) {
        unsigned* bar = b.bar; unsigned bx = b.x; asm volatile("" : "+s"(bar), "+s"(bx));
        __builtin_amdgcn_s_waitcnt(0);
        unsigned nloc = b.st[0], nx = b.st[1];
        if (nloc == 0u) { xcd_barrier_complete(bar, bx, nloc, nx); b.st[0] = nloc; b.st[1] = nx; }
        const unsigned old = xb_add(&bar[XB_XSUB(bx)], 1u);
        const unsigned gen = old / nloc;
        if (old + 1u == (gen + 1u) * nloc) {
            __builtin_amdgcn_fence(__ATOMIC_RELEASE, "agent");
            asm volatile("s_waitcnt vmcnt(0)" ::: "memory");
            const unsigned og = xb_add(&bar[XB_TOP], 1u);
            const unsigned tg = og / nx;
            if (og + 1u == (tg + 1u) * nx) xb_add(&bar[XB_TOPGEN], 1u);
            else XB_SPIN(xb_ld(&bar[XB_TOPGEN]) == tg, bar);
            __builtin_amdgcn_fence(__ATOMIC_ACQUIRE, "agent");
            xb_add(&bar[XB_XGEN(bx)], 1u);
            asm volatile("s_waitcnt vmcnt(0)" ::: "memory");
        } else {
            XB_SPIN(xb_ld(&bar[XB_XGEN(bx)]) == gen, bar);
            __builtin_amdgcn_fence(__ATOMIC_ACQUIRE, "agent");
            asm volatile("s_waitcnt vmcnt(0)" ::: "memory");
        }
    }
    __syncthreads();
}

struct Ctx {
    LAS unsigned char* lds;
    int tid, lane, wid, fr, fq;
    int G, bid;
    int ws;
};
__device__ __forceinline__ int hw_lane() { int l; asm volatile("v_mbcnt_lo_u32_b32 %0, -1, 0\n\tv_mbcnt_hi_u32_b32 %0, -1, %0" : "=v"(l)); return l; }
#define CTX_FRESH(C) do { int w_ = (C).ws, g_ = (C).G, b_ = (C).bid; asm volatile("" : "+s"(w_), "+s"(g_), "+s"(b_)); (C).G = g_; (C).bid = b_; const int l_ = hw_lane(); (C).lane = l_; (C).wid = __builtin_amdgcn_readfirstlane(w_); (C).tid = (C).wid * 64 + l_; (C).fr = l_ & 15; (C).fq = l_ >> 4; } while (0)

__device__ __forceinline__ int tok_cls(int T) { return T < NCTX ? 0 : 1 + ((T - NCTX) >> 11); }
__device__ __forceinline__ const float* x_in_row(const Params& p, int T) { return T < NCTX ? p.in[0] + (size_t)T * DM : p.in[1] + (size_t)(T - NCTX) * DM; }

__device__ __forceinline__ void p0_item(const float* W, int ldw, int k0, int n0, const float* kscale, bf16_t* WT, int ldt, int dst_row0, LAS float* scr, int lane) {
    float ld[32];
#pragma unroll
    for (int i = 0; i < 32; ++i) { const int kk = 2 * i + (lane >> 5); ld[i] = W[(size_t)(k0 + kk) * ldw + n0 + (lane & 31)]; }
#pragma unroll
    for (int i = 0; i < 32; ++i) { const int kk = 2 * i + (lane >> 5); float v = ld[i]; if (kscale) v *= kscale[k0 + kk]; scr[kk * 33 + (lane & 31)] = v; }
    asm volatile("s_waitcnt lgkmcnt(0)" ::: "memory");
    const int c = lane & 7;
#pragma unroll
    for (int j = 0; j < 4; ++j) { const int n = (lane >> 3) + 8 * j; const LAS float* s = scr + (8 * c) * 33 + n;
        u32x4 o; o.x = pk2(s[0 * 33], s[1 * 33]); o.y = pk2(s[2 * 33], s[3 * 33]); o.z = pk2(s[4 * 33], s[5 * 33]); o.w = pk2(s[6 * 33], s[7 * 33]);
        *(u32x4*)(WT + (size_t)(dst_row0 + n) * ldt + k0 + 8 * c) = o; }
    asm volatile("s_waitcnt lgkmcnt(0)" ::: "memory");
}
__device__ __forceinline__ void p0_item8(const float* W, int ldw, int k0, int n0, float scale, unsigned char* WT, int ldt, int dst_row0, LAS float* scr, int lane) {
    float ld[32];
#pragma unroll
    for (int i = 0; i < 32; ++i) { const int kk = 2 * i + (lane >> 5); ld[i] = W[(size_t)(k0 + kk) * ldw + n0 + (lane & 31)]; }
#pragma unroll
    for (int i = 0; i < 32; ++i) { const int kk = 2 * i + (lane >> 5); scr[kk * 33 + (lane & 31)] = ld[i] * scale; }
    asm volatile("s_waitcnt lgkmcnt(0)" ::: "memory");
    const int c = lane & 7;
#pragma unroll
    for (int j = 0; j < 4; ++j) { const int n = (lane >> 3) + 8 * j; const LAS float* s = scr + (8 * c) * 33 + n;
        int w0 = __builtin_amdgcn_cvt_pk_fp8_f32(s[0 * 33], s[1 * 33], 0, false); w0 = __builtin_amdgcn_cvt_pk_fp8_f32(s[2 * 33], s[3 * 33], w0, true);
        int w1 = __builtin_amdgcn_cvt_pk_fp8_f32(s[4 * 33], s[5 * 33], 0, false); w1 = __builtin_amdgcn_cvt_pk_fp8_f32(s[6 * 33], s[7 * 33], w1, true);
        *(u32x2*)(WT + (size_t)(dst_row0 + n) * ldt + k0 + 8 * c) = (u32x2){(unsigned)w0, (unsigned)w1}; }
    asm volatile("s_waitcnt lgkmcnt(0)" ::: "memory");
}
constexpr int IT_IN = 16 * 59, IT_GATE = 16 * 128, IT_BR = 4 * 4 * 32, IT_OUT = 16 * 32, IT_UP = 16 * 172, IT_DOWN = 43 * 32, IT_UQ = 3 * 12, IT_UKV = 2 * 16;
constexpr int IT_LAYER = IT_IN + IT_GATE + IT_BR + IT_OUT + IT_UP + IT_DOWN + IT_UQ + IT_UKV;

__device__ __forceinline__ void zero_bf16(bf16_t* p, size_t n8, int gtid, int gthreads) {
    for (size_t i = gtid; i < n8; i += gthreads) ((u32x4*)p)[i] = (u32x4){0u, 0u, 0u, 0u};
}

__device__ __forceinline__ void phase0(const Params& p, Ctx& C) {
    LAS float* scr = (LAS float*)(C.lds + C.wid * 16384);
    const int gw = C.bid * 8 + C.wid, NGW = C.G * 8;
    for (int it = gw; it < 2 * IT_LAYER; it += NGW) {
        const int L = it / IT_LAYER; int r = it % IT_LAYER;
        unsigned char* wb = p.ws + WS_W + (size_t)L * W_LAYER;
        if (r < IT_IN) { const int kb = r / 59, nb = r % 59; p0_item(p.in[16] + (size_t)L * 1024 * 1888, 1888, kb * 64, nb * 32, nullptr, (bf16_t*)(wb + WO_IN), LDW, nb * 32, scr, C.lane); continue; } r -= IT_IN;
        if (r < IT_GATE) { const int kb = r / 128, nb = r % 128; p0_item8(p.in[17] + (size_t)L * 1024 * 4096, 4096, kb * 64, nb * 32, 32.0f, (unsigned char*)(wb + WO_GATE), LD8, nb * 32, scr, C.lane); continue; } r -= IT_GATE;
        if (r < IT_BR) { const int k = r / 128, rr = r % 128, kb = rr / 32, nb = rr % 32; p0_item(p.in[27] + (size_t)(L * 4 + k) * 256 * 1024, 1024, kb * 64, nb * 32, nullptr, (bf16_t*)(wb + WO_BR) + (size_t)k * 1024 * LDWB, LDWB, nb * 32, scr, C.lane); continue; } r -= IT_BR;
        if (r < IT_OUT) { const int kb = r / 32, nb = r % 32; p0_item(p.in[28] + (size_t)L * 1024 * 1024, 1024, kb * 64, nb * 32, nullptr, (bf16_t*)(wb + WO_OUT), LDW, nb * 32, scr, C.lane); continue; } r -= IT_OUT;
        if (r < IT_UP) { const int kb = r / 172, nb = r % 172; const int n0 = nb * 32, part = n0 / DFF, j0 = n0 % DFF; const int drow = (j0 >> 7) * 256 + part * 128 + (j0 & 127);
            p0_item(p.in[29] + (size_t)L * 1024 * 5504, 5504, kb * 64, n0, nullptr, (bf16_t*)(wb + WO_UP), LDW, drow, scr, C.lane); continue; } r -= IT_UP;
        if (r < IT_DOWN) { const int kb = r / 32, nb = r % 32; p0_item(p.in[31] + (size_t)L * DFF * 1024, 1024, kb * 64, nb * 32, nullptr, (bf16_t*)(wb + WO_DOWN), LDWD, nb * 32, scr, C.lane); continue; } r -= IT_DOWN;
        if (r < IT_UQ) { const int kb = r / 12, nb = r % 12; p0_item(p.in[21] + (size_t)L * 192 * 384, 384, kb * 64, nb * 32, p.in[20] + L * 192, (bf16_t*)(wb + WO_UQ), LDUQ, nb * 32, scr, C.lane); continue; } r -= IT_UQ;
        { const int kb = r / 16, nb = r % 16; p0_item(p.in[23] + (size_t)L * 128 * 512, 512, kb * 64, nb * 32, p.in[22] + L * 128, (bf16_t*)(wb + WO_UKV), LDUKV, nb * 32, scr, C.lane); }
    }
    const int gtid = C.bid * 512 + C.tid, gth = C.G * 512;
    for (int L = 0; L < 2; ++L) {
        unsigned char* wb = p.ws + WS_W + (size_t)L * W_LAYER;
        zero_bf16((bf16_t*)(wb + WO_IN) + (size_t)IN_DIM * LDW, (size_t)(INP - IN_DIM) * LDW / 8, gtid, gth);
        zero_bf16((bf16_t*)(wb + WO_UP) + (size_t)(21 * 256 + 64) * LDW, (size_t)64 * LDW / 8, gtid, gth);
        zero_bf16((bf16_t*)(wb + WO_UP) + (size_t)(21 * 256 + 128 + 64) * LDW, (size_t)64 * LDW / 8, gtid, gth);
        zero_bf16((bf16_t*)(wb + WO_UQ) + (size_t)384 * LDUQ, (size_t)128 * LDUQ / 8, gtid, gth);
        for (int i = gtid; i < 1024 * 8; i += gth) { const int row = i >> 3, c = i & 7; *(u32x4*)((bf16_t*)(wb + WO_DOWN) + (size_t)row * LDWD + DFF + c * 8) = (u32x4){0u, 0u, 0u, 0u}; }
    }
    __syncthreads();
    LAS float* sv = (LAS float*)(C.lds);
    LAS float* part = (LAS float*)(C.lds + 16384);
    for (int i = C.tid; i < 3 * 1024; i += 512) { const int cls = i >> 10, k = i & 1023; const float v = cls == 0 ? p.in[9][k] : p.in[8][(cls - 1) * 1024 + k]; sv[i] = siluf_(v); }
    __syncthreads();
    float* modv = (float*)(p.ws + WS_MODV);
    for (int it = C.bid; it < 2 * 96; it += C.G) {
        const int L = it / 96, col = (it % 96) * 64 + C.lane;
        const float* w = p.in[10] + (size_t)L * 1024 * 6144 + col;
        float a0 = 0.f, a1 = 0.f, a2 = 0.f;
#pragma unroll 8
        for (int kk = 0; kk < 128; ++kk) { const int k = C.wid * 128 + kk; const float wv = w[(size_t)k * 6144]; a0 += sv[k] * wv; a1 += sv[1024 + k] * wv; a2 += sv[2048 + k] * wv; }
        part[(C.wid * 3 + 0) * 64 + C.lane] = a0; part[(C.wid * 3 + 1) * 64 + C.lane] = a1; part[(C.wid * 3 + 2) * 64 + C.lane] = a2;
        __syncthreads();
        if (C.tid < 192) { const int cls = C.tid >> 6, l = C.tid & 63; float s = 0.f;
#pragma unroll
            for (int w8 = 0; w8 < 8; ++w8) s += part[(w8 * 3 + cls) * 64 + l];
            const int cc = (it % 96) * 64 + l;
            modv[((size_t)L * 3 + cls) * 6144 + cc] = s + p.in[11][(size_t)L * 6144 + cc]; }
        __syncthreads();
    }
}

__device__ __forceinline__ void row_norm_mod(const f32x4 (&v)[4], const float* g, const float* sc, const float* sh, bf16_t* orow, int lane, unsigned char* o8 = nullptr) {
    float ss = 0.f;
#pragma unroll
    for (int j = 0; j < 4; ++j) ss += (v[j].x * v[j].x + v[j].y * v[j].y) + (v[j].z * v[j].z + v[j].w * v[j].w);
    const float rstd = 1.0f / sqrtf(wave_sum(ss) * (1.0f / DM) + EPS);
#pragma unroll
    for (int j = 0; j < 4; ++j) {
        const f32x4 gg = ((const f32x4*)g)[lane + 64 * j], s1 = ((const f32x4*)sc)[lane + 64 * j], s0 = ((const f32x4*)sh)[lane + 64 * j];
        const f32x4 y = v[j] * rstd * gg * (s1 + 1.0f) + s0;
        u32x2 o; o.x = pk2(y.x, y.y); o.y = pk2(y.z, y.w);
        ((u32x2*)orow)[lane + 64 * j] = o;
        if (o8) { int w8 = __builtin_amdgcn_cvt_pk_fp8_f32(y.x, y.y, 0, false); w8 = __builtin_amdgcn_cvt_pk_fp8_f32(y.z, y.w, w8, true); ((int*)o8)[lane + 64 * j] = w8; }
    }
}
__device__ __forceinline__ void load_row_bf16(const bf16_t* r, f32x4 (&v)[4], int lane) {
#pragma unroll
    for (int j = 0; j < 4; ++j) { const u32x2 u = ((const u32x2*)r)[lane + 64 * j]; v[j] = (f32x4){lo16(u.x), hi16(u.x), lo16(u.y), hi16(u.y)}; }
}

__device__ __forceinline__ void phase1(const Params& p, Ctx& C) {
    const int gw = C.bid * 8 + C.wid, NGW = C.G * 8;
    const float* modv = (const float*)(p.ws + WS_MODV);
    bf16_t* H = (bf16_t*)(p.ws + WS_H);
    for (int T = gw; T < NTOK; T += NGW) {
        const float* xr = x_in_row(p, T); f32x4 v[4];
#pragma unroll
        for (int j = 0; j < 4; ++j) v[j] = ((const f32x4*)xr)[C.lane + 64 * j];
        const float* mv = modv + (size_t)(0 * 3 + tok_cls(T)) * 6144;
        row_norm_mod(v, p.in[12], mv + 1024, mv, H + (size_t)T * LDH, C.lane, p.ws + WS_H8 + (size_t)T * LD8);
    }
    const int gtid = C.bid * 512 + C.tid, gth = C.G * 512;
    bf16_t* nak = (bf16_t*)(p.ws + WS_NACK); bf16_t* nav = (bf16_t*)(p.ws + WS_NACV);
    for (int i = gtid; i < 2 * 2 * 256 * 256 / 4; i += gth) {
        const int e = i * 4, w = e & 255, t = (e >> 8) & 255, L = (e >> 16) & 1, b = e >> 17;
        const size_t d = ((size_t)(L * 2 + b) * 256 + t) * LDNAC + w;
        const f32x4 a = *(const f32x4*)(p.in[2] + e), c = *(const f32x4*)(p.in[3] + e);
        *(u32x2*)(nak + d) = (u32x2){pk2(a.x, a.y), pk2(a.z, a.w)}; *(u32x2*)(nav + d) = (u32x2){pk2(c.x, c.y), pk2(c.z, c.w)};
    }
    bf16_t* swk = (bf16_t*)(p.ws + WS_SWCK); bf16_t* swv = (bf16_t*)(p.ws + WS_SWCV); bf16_t* ckv = (bf16_t*)(p.ws + WS_CKVC);
    for (int i = gtid; i < 2 * 2 * 256 * 128 / 4; i += gth) {
        const int e = i * 4, w = e & 127, t = (e >> 7) & 255, L = (e >> 15) & 1, b = e >> 16;
        const size_t d = ((size_t)(L * 2 + b) * 256 + t) * LDSWC + w, d2 = ((size_t)(L * 2 + b) * 256 + t) * LDCKVC + w;
        const f32x4 a = *(const f32x4*)(p.in[6] + e), c = *(const f32x4*)(p.in[7] + e), m = *(const f32x4*)(p.in[4] + e);
        *(u32x2*)(swk + d) = (u32x2){pk2(a.x, a.y), pk2(a.z, a.w)}; *(u32x2*)(swv + d) = (u32x2){pk2(c.x, c.y), pk2(c.z, c.w)};
        *(u32x2*)(ckv + d2) = (u32x2){pk2(m.x, m.y), pk2(m.z, m.w)};
    }
    bf16_t* krc = (bf16_t*)(p.ws + WS_KRC);
    for (int i = gtid; i < 2 * 2 * 256 * 32 / 4; i += gth) {
        const int e = i * 4, w = e & 31, t = (e >> 5) & 255, L = (e >> 13) & 1, b = e >> 14;
        const size_t d = ((size_t)(L * 2 + b) * 256 + t) * 32 + w;
        const f32x4 a = *(const f32x4*)(p.in[5] + e);
        *(u32x2*)(krc + d) = (u32x2){pk2(a.x, a.y), pk2(a.z, a.w)};
    }
}

__device__ __forceinline__ void phase7(const Params& p, Ctx& C, int L) {
    const int gw = C.bid * 8 + C.wid, NGW = C.G * 8;
    const float* modv = (const float*)(p.ws + WS_MODV);
    const bf16_t* O = (const bf16_t*)(p.ws + WS_O); float* X1 = p.out + OFF_Y; bf16_t* H = (bf16_t*)(p.ws + WS_H);
    const float* gpost = p.in[13] + L * DM; const float* gpre = p.in[14] + L * DM;
    for (int T = gw; T < NTOK; T += NGW) {
        const float* xr = (L == 0) ? x_in_row(p, T) : p.out + OFF_Y + (size_t)T * DM;
        const float* mv = modv + (size_t)(L * 3 + tok_cls(T)) * 6144;
        f32x4 o[4]; load_row_bf16(O + (size_t)T * LDH, o, C.lane);
        float ss = 0.f;
#pragma unroll
        for (int j = 0; j < 4; ++j) ss += (o[j].x * o[j].x + o[j].y * o[j].y) + (o[j].z * o[j].z + o[j].w * o[j].w);
        const float rstd = 1.0f / sqrtf(wave_sum(ss) * (1.0f / DM) + EPS);
        f32x4 x1[4];
#pragma unroll
        for (int j = 0; j < 4; ++j) {
            const f32x4 xv = ((const f32x4*)xr)[C.lane + 64 * j], gp = ((const f32x4*)gpost)[C.lane + 64 * j], g1 = ((const f32x4*)(mv + 2048))[C.lane + 64 * j];
            x1[j] = xv + g1 * (o[j] * rstd * gp);
            ((f32x4*)(X1 + (size_t)T * DM))[C.lane + 64 * j] = x1[j];
        }
        row_norm_mod(x1, gpre, mv + 4096, mv + 3072, H + (size_t)T * LDH, C.lane);
    }
}
__device__ __forceinline__ void phase10(const Params& p, Ctx& C, int L) {
    const int gw = C.bid * 8 + C.wid, NGW = C.G * 8;
    const float* modv = (const float*)(p.ws + WS_MODV);
    const float* X1 = p.out + OFF_Y; bf16_t* H = (bf16_t*)(p.ws + WS_H);
    const float* gpost = p.in[15] + L * DM;
    for (int T = gw; T < NTOK; T += NGW) {
        const float* mv = modv + (size_t)(L * 3 + tok_cls(T)) * 6144;
        f32x4 f[4]; load_row_bf16(H + (size_t)T * LDH, f, C.lane);
        float ss = 0.f;
#pragma unroll
        for (int j = 0; j < 4; ++j) ss += (f[j].x * f[j].x + f[j].y * f[j].y) + (f[j].z * f[j].z + f[j].w * f[j].w);
        const float rstd = 1.0f / sqrtf(wave_sum(ss) * (1.0f / DM) + EPS);
        f32x4 y[4];
#pragma unroll
        for (int j = 0; j < 4; ++j) {
            const f32x4 xv = ((const f32x4*)(X1 + (size_t)T * DM))[C.lane + 64 * j], gp = ((const f32x4*)gpost)[C.lane + 64 * j], g2 = ((const f32x4*)(mv + 5120))[C.lane + 64 * j];
            y[j] = xv + g2 * (f[j] * rstd * gp);
            ((f32x4*)(p.out + OFF_Y + (size_t)T * DM))[C.lane + 64 * j] = y[j];
        }
        if (L == 0) { const float* mv1 = modv + (size_t)(1 * 3 + tok_cls(T)) * 6144; row_norm_mod(y, p.in[12] + DM, mv1 + 1024, mv1, H + (size_t)T * LDH, C.lane, p.ws + WS_H8 + (size_t)T * LD8); }
    }
}

__device__ __forceinline__ int lds_byte(int r, int c) { const int st = (r >> 4) * 2 + (c >> 5), ob = (r & 15) * 64 + (c & 31) * 2; return st * 1024 + (ob ^ (((ob >> 9) & 1) << 5)); }
__device__ __forceinline__ void stage_rc(int b, int& R, int& Cc) { const int st = b >> 10, sb = b & 1023, swz = sb ^ (((sb >> 9) & 1) << 5); R = (st >> 1) * 16 + swz / 64; Cc = (st & 1) * 32 + (swz % 64) / 2; }
#define GLDS16(gp, lp) __builtin_amdgcn_global_load_lds((const unsigned*)(gp), (LAS unsigned*)(lp), 16, 0, 0)

template <int TM, int TN> struct GemmStage {
    static constexpr int STAGE = (TM + TN) * 128;
    int offA, offB;
    int lda, ldb;
    __device__ __forceinline__ void init(const Ctx& C, int lda_, int ldb_) { int R, Cc; stage_rc(C.wid * 1024 + C.lane * 16, R, Cc); lda = lda_; ldb = ldb_; offA = R * lda + Cc; offB = R * ldb + Cc; }
    __device__ __forceinline__ void stage(const Ctx& C, int buf, const bf16_t* a, const bf16_t* b) const {
        LAS unsigned char* base = C.lds + buf * STAGE + C.wid * 1024;
#pragma unroll
        for (int i = 0; i < TM / 64; ++i) GLDS16(a + offA + (size_t)i * 64 * lda, base + i * 8192);
#pragma unroll
        for (int i = 0; i < TN / 64; ++i) GLDS16(b + offB + (size_t)i * 64 * ldb, base + TM * 128 + i * 8192);
    }
};
template <int TM, int TN, int MF, int NF>
__device__ __forceinline__ void gemm_compute(const Ctx& C, int buf, int wr, int wc, f32x4 (&acc)[MF][NF]) {
    constexpr int STAGE = (TM + TN) * 128;
    LAS unsigned char* sa = C.lds + buf * STAGE; LAS unsigned char* sb = sa + TM * 128;
#pragma unroll
    for (int ks = 0; ks < 2; ++ks) {
        bf16x8 Af[MF], Bf[NF];
        const int ao = lds_byte(wr * MF * 16 + C.fr, ks * 32 + C.fq * 8), bo = lds_byte(wc * NF * 16 + C.fr, ks * 32 + C.fq * 8);
#pragma unroll
        for (int m = 0; m < MF; ++m) Af[m] = *(const LAS bf16x8*)(sa + ao + m * 2048);
#pragma unroll
        for (int n = 0; n < NF; ++n) Bf[n] = *(const LAS bf16x8*)(sb + bo + n * 2048);
#pragma unroll
        for (int m = 0; m < MF; ++m)
#pragma unroll
            for (int n = 0; n < NF; ++n) acc[m][n] = __builtin_amdgcn_mfma_f32_16x16x32_bf16(Bf[n], Af[m], acc[m][n], 0, 0, 0);
        __builtin_amdgcn_sched_barrier(0);
    }
}
template <int TM, int TN, int MF, int NF>
__device__ __forceinline__ void gemm_kloop(const Ctx& C, const GemmStage<TM, TN>& S, const bf16_t* A, const bf16_t* B, int nt, int wr, int wc, f32x4 (&acc)[MF][NF]) {
    S.stage(C, 0, A, B); VM_WAIT(); __syncthreads();
    for (int t = 0; t < nt; ++t) {
        const int cur = t & 1;
        if (t + 1 < nt) S.stage(C, cur ^ 1, A + (t + 1) * 64, B + (t + 1) * 64);
        gemm_compute<TM, TN, MF, NF>(C, cur, wr, wc, acc);
        VM_WAIT(); __syncthreads();
    }
}
__device__ __forceinline__ void unit_map(int u, int nM, int nN, int& pm, int& pn) {
    const int nwg = nM * nN; int wgid = u;
    { const int q = nwg / 8, r = nwg % 8, xcd = wgid % 8, off = wgid / 8; wgid = (xcd < r ? xcd * (q + 1) : r * (q + 1) + (xcd - r) * q) + off; }
    const int nig = 8 * nN, gid = wgid / nig, fm = gid * 8, gsz = (nM - fm) < 8 ? (nM - fm) : 8;
    pm = fm + ((wgid % nig) % gsz); pn = (wgid % nig) / gsz;
}
#define ZERO_ACC(acc, MF, NF) _Pragma("unroll") for (int m_ = 0; m_ < MF; ++m_) _Pragma("unroll") for (int n_ = 0; n_ < NF; ++n_) acc[m_][n_] = (f32x4){0.f, 0.f, 0.f, 0.f}


struct G8Unit { const char* A; const char* B; int e0, e1, e2, e3; };
__device__ __forceinline__ int perm32(int rho) { const int n = rho >> 4, i = rho & 15; return 8 * (i >> 2) + 4 * n + (i & 3); }
__device__ __forceinline__ i32x8 cat8(bf16x8 a, bf16x8 b) { return __builtin_shufflevector(__builtin_bit_cast(i32x4, a), __builtin_bit_cast(i32x4, b), 0, 1, 2, 3, 4, 5, 6, 7); }
#define G8_EPI_PLAIN static __device__ __forceinline__ f32x4 init(const G8Unit&, int, int, int, int) { return (f32x4){0.f, 0.f, 0.f, 0.f}; } static constexpr bool FP8 = false; static constexpr int HROWS_B = 128; static __device__ __forceinline__ int brow(int R) { return PERM ? ((R & ~31) + perm32(R & 31)) : R; }
template <class Epi, class Sched>
__device__ __forceinline__ void gemm8(const Ctx& C, int K, int lda, int ldb, const Sched& S, const Epi& E) {
    constexpr int HTB = 16384;
    LAS unsigned char* lds = C.lds;
    const int tid = C.tid, wid = C.wid, lane = C.lane, wr = wid >> 2, wc = wid & 3, fr = lane & 15, fq = lane >> 4;
    const int nt = K / 64;
    unsigned voffA, voffB;
    { int R, Cc; stage_rc(tid * 16, R, Cc); voffA = (unsigned)(R * lda + Cc) * 2u; voffB = (unsigned)(Epi::brow(R) * ldb + Cc) * 2u; }
    const size_t kstep = 128;
    const size_t hstepA = (size_t)128 * lda * 2, hstepB = (size_t)Epi::HROWS_B * ldb * 2;
    const size_t r64A = (size_t)64 * lda * 2, r64B = (size_t)(Epi::brow(64) - Epi::brow(0)) * ldb * 2;
    const unsigned ldsw = (unsigned)__builtin_amdgcn_readfirstlane((int)((unsigned)(size_t)lds + (unsigned)wid * 1024u));
    const int aoff = lds_byte(wr * 64 + fr, fq * 8), boff = lds_byte(wc * 32 + fr, fq * 8);
#define G8_SA(b, h) (((b) * 2 + (h)) * HTB)
#define G8_SB(b, h) ((4 + (b) * 2 + (h)) * HTB)
#define G8_GLDS(vo, sb, la) asm volatile("s_mov_b32 m0, %2\n\ts_nop 0\n\tglobal_load_lds_dwordx4 %0, %1" :: "v"(vo), "s"(sb), "s"(la) : "memory", "m0")
#define G8_STAGE(bufoff, gbase, voff, r64) do { const char* _g = (const char*)(gbase); const unsigned _l = ldsw + (unsigned)(bufoff); G8_GLDS(voff, _g, _l); \
        const char* _g2 = _g + (r64); G8_GLDS(voff, _g2, _l + 8192u); } while (0)
#define G8_LDA(dst, b, h) do { _Pragma("unroll") for (int m = 0; m < 4; ++m) _Pragma("unroll") for (int k = 0; k < 2; ++k) dst[m][k] = *(const LAS bf16x8*)(lds + G8_SA(b, h) + aoff + m * 2048 + k * 1024); } while (0)
#define G8_LDB(dst, b, h) do { _Pragma("unroll") for (int n = 0; n < 2; ++n) _Pragma("unroll") for (int k = 0; k < 2; ++k) dst[n][k] = *(const LAS bf16x8*)(lds + G8_SB(b, h) + boff + n * 2048 + k * 1024); } while (0)
#define G8_MMA(ai, bj, At, Bt) do { __builtin_amdgcn_s_setprio(1); _Pragma("unroll") for (int m = 0; m < 4; ++m) _Pragma("unroll") for (int n = 0; n < 2; ++n) { \
        if constexpr (Epi::FP8) acc[ai][bj][m][n] = __builtin_amdgcn_mfma_scale_f32_16x16x128_f8f6f4(cat8(Bt[n][0], Bt[n][1]), cat8(At[m][0], At[m][1]), acc[ai][bj][m][n], 0, 0, 0, 0, 0, 0); \
        else { _Pragma("unroll") for (int k = 0; k < 2; ++k) acc[ai][bj][m][n] = __builtin_amdgcn_mfma_f32_16x16x32_bf16(Bt[n][k], At[m][k], acc[ai][bj][m][n], 0, 0, 0); } } \
        __builtin_amdgcn_s_setprio(0); } while (0)
#define G8_WAIT_V(n) asm volatile("s_waitcnt vmcnt(" #n ")" ::: "memory")
#define G8_WAIT_L(n) asm volatile("s_waitcnt lgkmcnt(" #n ")" ::: "memory")
#define G8_BAR __builtin_amdgcn_s_barrier()
#define G8_SCHED __builtin_amdgcn_sched_barrier(0)
    G8Unit cur, nxt; int ui = 0;
    if (!S.next(0, cur)) return;
    f32x4 acc[2][2][4][2];
#pragma unroll
    for (int a = 0; a < 2; ++a)
#pragma unroll
        for (int b = 0; b < 2; ++b)
#pragma unroll
            for (int m = 0; m < 4; ++m)
#pragma unroll
                for (int n = 0; n < 2; ++n) acc[a][b][m][n] = E.init(cur, b, n, wc, fq);
    bf16x8 At[4][2], B0[2][2], B1[2][2];
    const char* cA = cur.A; const char* cB = cur.B;
    G8_STAGE(G8_SB(0, 0), cB, voffB, r64B); G8_STAGE(G8_SA(0, 0), cA, voffA, r64A); G8_STAGE(G8_SB(0, 1), cB + hstepB, voffB, r64B); G8_STAGE(G8_SA(0, 1), cA + hstepA, voffA, r64A);
    if (wr == 1) G8_BAR;
    G8_WAIT_V(4); G8_BAR;
    G8_STAGE(G8_SB(1, 0), cB + kstep, voffB, r64B); G8_STAGE(G8_SA(1, 0), cA + kstep, voffA, r64A); G8_STAGE(G8_SB(1, 1), cB + hstepB + kstep, voffB, r64B);
    G8_WAIT_V(6); G8_BAR;
    for (;;) {
        const bool has_next = S.next(ui + 1, nxt);
        const char* nA = has_next ? nxt.A : cA; const char* nB = has_next ? nxt.B : cB;
#pragma unroll 1
        for (int t = 0; t < nt; t += 2) {
            const bool last = (t == nt - 2);
            const char* a1 = cA + (size_t)(t + 1) * kstep;
            const char* a2 = last ? nA : cA + (size_t)(t + 2) * kstep; const char* b2 = last ? nB : cB + (size_t)(t + 2) * kstep;
            const char* a3 = a2 + kstep; const char* b3 = b2 + kstep;
            G8_LDB(B0, 0, 0); G8_SCHED; G8_LDA(At, 0, 0); G8_STAGE(G8_SA(1, 1), a1 + hstepA, voffA, r64A);
            G8_WAIT_L(8); G8_BAR; G8_WAIT_L(0); G8_MMA(0, 0, At, B0); G8_BAR; G8_SCHED;
            G8_LDB(B1, 0, 1); G8_STAGE(G8_SB(0, 0), b2, voffB, r64B);
            G8_BAR; G8_WAIT_L(0); G8_MMA(0, 1, At, B1); G8_BAR;
            G8_LDA(At, 0, 1); G8_STAGE(G8_SA(0, 0), a2, voffA, r64A);
            G8_BAR; G8_WAIT_L(0); G8_MMA(1, 0, At, B0); G8_BAR; G8_SCHED;
            G8_STAGE(G8_SB(0, 1), b2 + hstepB, voffB, r64B);
            G8_WAIT_V(6); G8_BAR; G8_MMA(1, 1, At, B1); G8_BAR;
            G8_LDB(B0, 1, 0); G8_SCHED; G8_LDA(At, 1, 0); G8_STAGE(G8_SA(0, 1), a2 + hstepA, voffA, r64A);
            G8_WAIT_L(8); G8_BAR; G8_WAIT_L(0); G8_MMA(0, 0, At, B0); G8_BAR; G8_SCHED;
            G8_LDB(B1, 1, 1); G8_STAGE(G8_SB(1, 0), b3, voffB, r64B);
            G8_BAR; G8_WAIT_L(0); G8_MMA(0, 1, At, B1); G8_BAR;
            G8_LDA(At, 1, 1); G8_STAGE(G8_SA(1, 0), a3, voffA, r64A);
            G8_BAR; G8_WAIT_L(0); G8_MMA(1, 0, At, B0); G8_BAR; G8_SCHED;
            G8_STAGE(G8_SB(1, 1), b3 + hstepB, voffB, r64B);
            G8_WAIT_V(6); G8_BAR; G8_MMA(1, 1, At, B1); G8_BAR;
        }
        if constexpr (!Epi::AFTER_DRAIN) E(acc, cur, wr, wc, fr, fq);
        if (!has_next) break;
#pragma unroll
        for (int a = 0; a < 2; ++a)
#pragma unroll
            for (int b = 0; b < 2; ++b)
#pragma unroll
                for (int m = 0; m < 4; ++m)
#pragma unroll
                    for (int n = 0; n < 2; ++n) acc[a][b][m][n] = E.init(nxt, b, n, wc, fq);
        cur = nxt; cA = nA; cB = nB; ++ui;
    }
    G8_WAIT_V(0);
    if (wr == 0) G8_BAR;
    G8_BAR;
    if constexpr (Epi::AFTER_DRAIN) E.drained(C, acc, cur, wr, wc, fr, fq);
#undef G8_SA
#undef G8_SB
#undef G8_STAGE
#undef G8_GLDS
#undef G8_LDA
#undef G8_LDB
#undef G8_MMA
#undef G8_WAIT_V
#undef G8_WAIT_L
#undef G8_BAR
#undef G8_SCHED
}
struct TileSched {
    const char* A; const char* B; size_t tstepA, tstepB; int nM, nN, G, c;
    __device__ __forceinline__ bool next(int i, G8Unit& u) const {
        const int L = i * G + c; if (L >= nM * nN) return false;
        int pm, pn; unit_map(L, nM, nN, pm, pn);
        u.A = A + (size_t)pm * tstepA; u.B = B + (size_t)pn * tstepB; u.e0 = pm; u.e1 = pn; u.e2 = 0; u.e3 = 0; return true;
    }
};
struct EpiBf16 {
    static constexpr bool PERM = true, AFTER_DRAIN = false; G8_EPI_PLAIN
    bf16_t* O; int ldo;
    __device__ __forceinline__ void operator()(const f32x4 (&acc)[2][2][4][2], const G8Unit& u, int wr, int wc, int fr, int fq) const {
        const int row0 = u.e0 * 256 + wr * 64 + fr, col0 = u.e1 * 256 + wc * 32 + 8 * fq;
#pragma unroll
        for (int ai = 0; ai < 2; ++ai)
#pragma unroll
            for (int m = 0; m < 4; ++m) { bf16_t* rowp = O + (size_t)(row0 + ai * 128 + m * 16) * ldo + col0;
#pragma unroll
                for (int bj = 0; bj < 2; ++bj) { const f32x4 v0 = acc[ai][bj][m][0], v1 = acc[ai][bj][m][1];
                    *(u32x4*)(rowp + bj * 128) = (u32x4){pk2(v0.x, v0.y), pk2(v0.z, v0.w), pk2(v1.x, v1.y), pk2(v1.z, v1.w)}; } }
    }
};
struct EpiInProj {
    static constexpr bool PERM = true, AFTER_DRAIN = false; G8_EPI_PLAIN
    bf16_t* P; float* out; int L;
    __device__ __forceinline__ void operator()(const f32x4 (&acc)[2][2][4][2], const G8Unit& u, int wr, int wc, int fr, int fq) const {
        const int row0 = u.e0 * 256 + wr * 64 + fr, col0 = u.e1 * 256 + wc * 32 + 8 * fq;
        const bool ctx = u.e0 < 32;
#pragma unroll
        for (int bj = 0; bj < 2; ++bj) { const int col = col0 + bj * 128;
            int W = 0, cc = 0; size_t off = 0;
            if (ctx) {
                if (col >= COL_KA && col < COL_VA) { off = OFF_NAK; W = 256; cc = col - COL_KA; }
                else if (col >= COL_VA && col < COL_CQ) { off = OFF_NAV; W = 256; cc = col - COL_VA; }
                else if (col >= COL_CKV && col < COL_KR) { off = OFF_CKV; W = 128; cc = col - COL_CKV; }
                else if (col >= COL_KR && col < COL_QC) { off = OFF_KR; W = 32; cc = col - COL_KR; }
                else if (col >= COL_KC && col < COL_VC) { off = OFF_SWK; W = 128; cc = col - COL_KC; }
                else if (col >= COL_VC && col < COL_PD) { off = OFF_SWV; W = 128; cc = col - COL_VC; }
            }
            float* dbase = out + off + cc;
#pragma unroll
            for (int ai = 0; ai < 2; ++ai)
#pragma unroll
                for (int m = 0; m < 4; ++m) { const int row = row0 + ai * 128 + m * 16; const f32x4 v0 = acc[ai][bj][m][0], v1 = acc[ai][bj][m][1];
                    if (col < IN_DIM) *(u32x4*)(P + (size_t)row * LDP + col) = (u32x4){pk2(v0.x, v0.y), pk2(v0.z, v0.w), pk2(v1.x, v1.y), pk2(v1.z, v1.w)};
                    if (W) { float* dst = dbase + (size_t)(((row >> 8) * 2 + L) * 256 + (row & 255)) * W; *(f32x4*)dst = v0; *(f32x4*)(dst + 4) = v1; } }
        }
    }
};
__device__ __forceinline__ void phase2(const Params& p, Ctx& C, int L) {
    TileSched S{(const char*)(p.ws + WS_H), (const char*)(p.ws + WS_W + (size_t)L * W_LAYER + WO_IN), (size_t)256 * LDH * 2, (size_t)256 * LDW * 2, 48, 8, C.G, C.bid};
    EpiInProj E{(bf16_t*)(p.ws + WS_P), p.out, L};
    gemm8(C, DM, LDH, LDW, S, E);
}

__device__ __forceinline__ void rope_pair(bf16_t* p1, bf16_t* p2, float pos, float inv) {
    const float ang = pos * inv; float rev = ang * 0.15915494309189535f; rev -= floorf(rev);
    const float s = __builtin_amdgcn_sinf(rev), c = __builtin_amdgcn_cosf(rev);
    const float x1 = bf2f(*p1), x2 = bf2f(*p2);
    const unsigned o = pk2(x1 * c - x2 * s, x1 * s + x2 * c);
    *p1 = (bf16_t)(o & 0xffffu); *p2 = (bf16_t)(o >> 16);
}
__device__ __forceinline__ void phase3(const Params& p, Ctx& C, int L) {
    bf16_t* P = (bf16_t*)(p.ws + WS_P);
    {
        const int gw = C.bid * 8 + C.wid, NGW = C.G * 8;
        for (int t = gw; t < NLAT; t += NGW) {
            bf16_t* row = P + (size_t)(NCTX + t) * LDP; const int pos = t & 2047; const float prow = (float)(pos >> 6), pcol = (float)(pos & 63);
            for (int i = C.lane; i < 208; i += 64) {
                if (i < 16) { const int blk = i >> 3, f = i & 7; bf16_t* b = row + COL_KR + blk * 16 + f; rope_pair(b, b + 8, blk ? pcol : prow, exp2f(-(float)f * (13.287712379549449f / 8.0f))); }
                else { const int j = i - 16, head = j >> 5, blk = (j >> 4) & 1, f = j & 15;
                    bf16_t* b = row + COL_QC + head * 64 + blk * 32 + f; rope_pair(b, b + 16, blk ? pcol : prow, exp2f(-(float)f * (13.287712379549449f / 16.0f))); }
            }
        }
    }
    const int wr = C.wid >> 2, wc = C.wid & 3;
    LAS float* rs = (LAS float*)(C.lds + LDS_TAB);
    const unsigned char* wb = p.ws + WS_W + (size_t)L * W_LAYER;
    int R, Cc; stage_rc(C.wid * 1024 + C.lane * 16, R, Cc);
    const int Rb = (R & ~31) + perm32(R & 31);
    for (int u = C.bid; u < 96 * 7 + 4 * 4; u += C.G) {
        int pm, tn;
        if (u < 672) { pm = u / 7; tn = u % 7; } else { const int r = u - 672; pm = 96 + (r >> 2); tn = 3 + (r & 3); }
        const int which = tn >= 3, K = which ? 128 : 192, nkt = K / 64, ldb = which ? LDUKV : LDUQ, n0 = (which ? tn - 3 : tn) * 128;
        const bf16_t* A; int lda;
        if (pm < 96) { A = P + (size_t)pm * 128 * LDP + (which ? COL_CKV : COL_CQ); lda = LDP; }
        else { A = (const bf16_t*)(p.ws + WS_CKVC) + (size_t)(L * 512 + (pm - 96) * 128) * LDCKVC; lda = LDCKVC; }
        const bf16_t* B = (const bf16_t*)(wb + (which ? WO_UKV : WO_UQ)) + (size_t)n0 * ldb;
        for (int t = 0; t < nkt; ++t) { LAS unsigned char* base = C.lds + t * 32768 + C.wid * 1024;
            const bf16_t* a = A + (size_t)R * lda + Cc + t * 64; const bf16_t* bq = B + (size_t)Rb * ldb + Cc + t * 64;
            GLDS16(a, base); GLDS16(a + (size_t)64 * lda, base + 8192); GLDS16(bq, base + 16384); GLDS16(bq + (size_t)64 * ldb, base + 16384 + 8192); }
        VM_WAIT(); __syncthreads();
        { const int row = C.tid >> 2, part = C.tid & 3; float ss = 0.f;
            for (int c = part; c < K / 8; c += 4) { const int t = c >> 3, cc = (c & 7) * 8; const u32x4 q = *(const LAS u32x4*)(C.lds + t * 32768 + lds_byte(row, cc));
                ss += lo16(q.x) * lo16(q.x) + hi16(q.x) * hi16(q.x) + lo16(q.y) * lo16(q.y) + hi16(q.y) * hi16(q.y) + lo16(q.z) * lo16(q.z) + hi16(q.z) * hi16(q.z) + lo16(q.w) * lo16(q.w) + hi16(q.w) * hi16(q.w); }
            ss += __shfl_xor(ss, 1); ss += __shfl_xor(ss, 2);
            if (part == 0) rs[row] = __builtin_amdgcn_rsqf(ss / (float)K + EPS); }
        f32x4 acc[4][2]; ZERO_ACC(acc, 4, 2);
        for (int t = 0; t < nkt; ++t) gemm_compute<128, 128, 4, 2>(C, t, wr, wc, acc);
        __syncthreads();
        bf16_t* O; int ldo;
        if (pm < 96) { if (which) { O = (bf16_t*)(p.ws + WS_KVUP) + (size_t)pm * 128 * LDKV; ldo = LDKV; } else { O = (bf16_t*)(p.ws + WS_QUP) + (size_t)pm * 128 * LDQ; ldo = LDQ; } }
        else { O = (bf16_t*)(p.ws + WS_KVCUP) + (size_t)(L * 512 + (pm - 96) * 128) * LDKV; ldo = LDKV; }
#pragma unroll
        for (int m = 0; m < 4; ++m) { const int r = wr * 64 + m * 16 + C.fr; const float sc = rs[r]; const f32x4 v0 = acc[m][0] * sc, v1 = acc[m][1] * sc;
            *(u32x4*)(O + (size_t)r * ldo + n0 + wc * 32 + 8 * C.fq) = (u32x4){pk2(v0.x, v0.y), pk2(v0.z, v0.w), pk2(v1.x, v1.y), pk2(v1.z, v1.w)}; }
        __syncthreads();
    }
}

struct AttnSeg { const bf16_t* K; const bf16_t* K2; const bf16_t* V; int ldk, ldk2, ldv, n, tok0; };
struct AttnDesc { const bf16_t* Q; bf16_t* O; AttnSeg seg[2]; int ldq, ldo; float c1, m0, l0; int qtok0; int rope_q; };
typedef short v4i16_t __attribute__((ext_vector_type(4)));
__device__ __forceinline__ s16x4 vtr(const LAS unsigned char* p) { return __builtin_bit_cast(s16x4, __builtin_amdgcn_ds_read_tr16_b64_v4i16((LAS v4i16_t*)p)); }

template <int DQK, int KIND>
__device__ __forceinline__ void attn_unit(const Ctx& C, const AttnDesc& D, const LAS float* rpb) {
    constexpr int KROW = DQK * 2 + 16, VROW = 160, KBYTES = 64 * KROW, BUFB = KBYTES + 64 * VROW, CPK = DQK / 8, NKC = 64 * CPK;
    const int fr = C.fr, fq = C.fq, q = C.wid * 16 + fr;
    bf16x8 Qf[DQK / 32];
    const bf16_t* qrow = D.Q + (size_t)q * D.ldq;
#pragma unroll
    for (int s = 0; s < DQK / 32; ++s) Qf[s] = *(const bf16x8*)(qrow + s * 32 + fq * 8);
    const int qtok = D.qtok0 + q;
    if (DQK == 96 && D.rope_q) {
        bf16x8 mine = Qf[2], oth;
#pragma unroll
        for (int j = 0; j < 8; ++j) oth[j] = (short)__shfl_xor((int)mine[j], 16);
        const float pos = (fq < 2) ? (float)(qtok >> 6) : (float)(qtok & 63);
#pragma unroll
        for (int j = 0; j < 8; j += 2) {
            float o2[2];
#pragma unroll
            for (int e = 0; e < 2; ++e) {
                const float ang = pos * exp2f(-(float)(j + e) * (13.287712379549449f / 8.0f)); float rev = ang * 0.15915494309189535f; rev -= floorf(rev);
                const float sn = __builtin_amdgcn_sinf(rev), cs = __builtin_amdgcn_cosf(rev);
                const float a = bf2f((bf16_t)mine[j + e]), b = bf2f((bf16_t)oth[j + e]);
                o2[e] = (fq & 1) ? (b * sn + a * cs) : (a * cs - b * sn);
            }
            const unsigned pk = pk2(o2[0], o2[1]); Qf[2][j] = (short)(pk & 0xffffu); Qf[2][j + 1] = (short)(pk >> 16);
        }
    }
    float m = D.m0, l = D.l0 * (fq == 0 ? 1.0f : 0.0f);
    f32x4 Oa[4]; for (int d = 0; d < 4; ++d) Oa[d] = (f32x4){0.f, 0.f, 0.f, 0.f};
    int qrow_g = 0, qcol_g = 0, r0 = 0, cs0 = 0;
    if (KIND == 1) { qrow_g = qtok >> 6; qcol_g = qtok & 63; r0 = min(max(qrow_g - 4, 0), 24); cs0 = min(max(qcol_g - 8, 0), 48); }

    const int nt0 = D.seg[0].n >> 6, ntot = nt0 + (D.seg[1].n >> 6);
    u32x4 kreg[(NKC + 511) / 512], vreg;
    auto issue = [&](int t) {
        const AttnSeg& sg = (t < nt0) ? D.seg[0] : D.seg[1]; const int k0 = ((t < nt0) ? t : t - nt0) * 64;
#pragma unroll
        for (int i = 0; i < (NKC + 511) / 512; ++i) { const int c = C.tid + i * 512;
            if (c < NKC) { const int key = c / CPK, part = c % CPK;
                const bf16_t* src = (part < 8) ? sg.K + (size_t)(k0 + key) * sg.ldk + part * 8 : sg.K2 + (size_t)(k0 + key) * sg.ldk2 + (part - 8) * 8;
                kreg[i] = *(const u32x4*)src; } }
        { const int key = C.tid >> 3, part = C.tid & 7; vreg = *(const u32x4*)(sg.V + (size_t)(k0 + key) * sg.ldv + part * 8); }
    };
    auto commit = [&](int buf) {
        LAS unsigned char* kb = C.lds + buf * BUFB; LAS unsigned char* vb = kb + KBYTES;
#pragma unroll
        for (int i = 0; i < (NKC + 511) / 512; ++i) { const int c = C.tid + i * 512; if (c < NKC) { const int key = c / CPK, part = c % CPK; *(LAS u32x4*)(kb + key * KROW + part * 16) = kreg[i]; } }
        { const int key = C.tid >> 3, part = C.tid & 7; *(LAS u32x4*)(vb + key * VROW + part * 16) = vreg; }
    };
    issue(0);
    for (int t = 0; t < ntot; ++t) {
        const int buf = t & 1;
        commit(buf);
        __syncthreads();
        if (t + 1 < ntot) issue(t + 1);
        const LAS unsigned char* kb = C.lds + buf * BUFB; const LAS unsigned char* vb = kb + KBYTES;
        f32x4 s[4];
#pragma unroll
        for (int kg = 0; kg < 4; ++kg) {
            s[kg] = (f32x4){0.f, 0.f, 0.f, 0.f};
#pragma unroll
            for (int ks = 0; ks < DQK / 32; ++ks) { const bf16x8 Kf = *(const LAS bf16x8*)(kb + (kg * 16 + fr) * KROW + ks * 64 + fq * 16); s[kg] = __builtin_amdgcn_mfma_f32_16x16x32_bf16(Kf, Qf[ks], s[kg], 0, 0, 0); }
        }
        const bool seg1 = (t >= nt0);
        const int ktile0 = seg1 ? D.seg[1].tok0 + (t - nt0) * 64 : 0;
        float mx = -1e30f;
#pragma unroll
        for (int kg = 0; kg < 4; ++kg)
#pragma unroll
            for (int j = 0; j < 4; ++j) {
                float v = s[kg][j] * D.c1;
                if (KIND == 1 && seg1) { const int kt = ktile0 + kg * 16 + 4 * fq + j, krow = kt >> 6, kcol = kt & 63;
                    const bool ok = (krow >= r0) && (krow < r0 + 8) && (kcol >= cs0) && (kcol < cs0 + 16);
                    const int dr = min(max(krow - qrow_g + 7, 0), 14), dc = min(max(kcol - qcol_g + 15, 0), 30);
                    v = ok ? v + rpb[dr * 31 + dc] : -1e30f; }
                if (KIND == 2 && seg1) { const int kt = ktile0 + kg * 16 + 4 * fq + j; const int dd = kt - qtok; v = (dd <= 128 && dd >= -128) ? v : -1e30f; }
                s[kg][j] = v; mx = fmaxf(mx, v);
            }
        mx = qmax4(mx);
        const float mn = fmaxf(m, mx), alpha = __builtin_amdgcn_exp2f(m - mn); m = mn;
        float ps = 0.f;
#pragma unroll
        for (int kg = 0; kg < 4; ++kg)
#pragma unroll
            for (int j = 0; j < 4; ++j) { const float e = __builtin_amdgcn_exp2f(s[kg][j] - mn); s[kg][j] = e; ps += e; }
        l = l * alpha + ps;
#pragma unroll
        for (int d = 0; d < 4; ++d) Oa[d] = Oa[d] * alpha;
#pragma unroll
        for (int k2 = 0; k2 < 2; ++k2) {
            u32x4 pw; pw.x = pk2(s[2 * k2][0], s[2 * k2][1]); pw.y = pk2(s[2 * k2][2], s[2 * k2][3]); pw.z = pk2(s[2 * k2 + 1][0], s[2 * k2 + 1][1]); pw.w = pk2(s[2 * k2 + 1][2], s[2 * k2 + 1][3]);
            const bf16x8 Pf = __builtin_bit_cast(bf16x8, pw);
#pragma unroll
            for (int d = 0; d < 4; ++d) {
                const LAS unsigned char* a0 = vb + (32 * k2 + 4 * fq + (fr >> 2)) * VROW + (d * 16 + 4 * (fr & 3)) * 2;
                const s16x4 lo = vtr(a0), hi = vtr(a0 + 16 * VROW);
                const bf16x8 Vf = (bf16x8){lo[0], lo[1], lo[2], lo[3], hi[0], hi[1], hi[2], hi[3]};
                Oa[d] = __builtin_amdgcn_mfma_f32_16x16x32_bf16(Vf, Pf, Oa[d], 0, 0, 0);
            }
        }
    }
    l += __shfl_xor(l, 16); l += __shfl_xor(l, 32);
    const float inv = 1.0f / l;
    __syncthreads();
    { LAS unsigned char* st = C.lds + C.wid * 2048;
#pragma unroll
        for (int d = 0; d < 4; ++d) { const f32x4 v = Oa[d] * inv; *(LAS u32x2*)(st + fr * 128 + (d * 16 + 4 * fq) * 2) = (u32x2){pk2(v.x, v.y), pk2(v.z, v.w)}; }
        asm volatile("s_waitcnt lgkmcnt(0)" ::: "memory");
#pragma unroll
        for (int i = 0; i < 2; ++i) { const int row = i * 8 + (C.lane >> 3), ch = C.lane & 7; const u32x4 v = *(const LAS u32x4*)(st + row * 128 + ch * 16);
            *(u32x4*)(D.O + (size_t)(C.wid * 16 + row) * D.ldo + ch * 8) = v; }
    }
    __syncthreads();
}

__device__ __forceinline__ void pool_unit(const Params& p, Ctx& C, int L, int unit) {
    const bf16_t* P = (const bf16_t*)(p.ws + WS_P); bf16_t* BR = (bf16_t*)(p.ws + WS_BR);
    CTX_FRESH(C);
    const int T0 = unit * 64; int S0, Ls; if (T0 < NCTX) { S0 = T0 & ~255; Ls = 256; } else { S0 = NCTX + ((T0 - NCTX) & ~2047); Ls = 2048; }
    LAS float* dlt = (LAS float*)C.lds;
    LAS bf16_t* raw = (LAS bf16_t*)(C.lds + 66048);
    LAS float* Wl = (LAS float*)(C.lds + 66048);
    f32x4 wreg[8];
    { const f32x4* Wg = (const f32x4*)(p.in[25] + (size_t)L * 4 * 64 * 64);
#pragma unroll
        for (int i = 0; i < 8; ++i) wreg[i] = Wg[C.tid + i * 512]; }
    for (int i = C.tid; i < 80 * 32; i += 512) { const int r = i >> 5, c = i & 31; const int T = T0 - 8 + r;
        u32x4 v = (u32x4){0u, 0u, 0u, 0u}; if (T >= S0 && T < S0 + Ls) v = *(const u32x4*)(P + (size_t)T * LDP + COL_PD + c * 8);
        *(LAS u32x4*)(raw + r * 256 + c * 8) = v; }
    __syncthreads();
    for (int i = C.tid; i < 64 * 256; i += 512) { const int t = i >> 8, ch = i & 255, gi = ch >> 6; const int hw = 1 << gi, w = 2 << gi;
        const int tl = T0 - S0 + t; const int lo = max(tl - hw, 0), hi = min(tl - hw + w, Ls);
        float s = 0.f; for (int j = lo; j < hi; ++j) s += bf2f(raw[(j - (T0 - S0) + 8) * 256 + ch]);
        dlt[t * 257 + ch] = s / (float)(hi - lo) - bf2f(raw[(t + 8) * 256 + ch]); }
    __syncthreads();
#pragma unroll
    for (int i = 0; i < 8; ++i) ((LAS f32x4*)Wl)[C.tid + i * 512] = wreg[i];
    __syncthreads();
    { const int t = C.lane, gi = C.wid & 3, e0 = (C.wid >> 2) * 32;
        const LAS float* W = Wl + gi * 4096 + e0;
        float a[32];
#pragma unroll
        for (int e = 0; e < 32; ++e) a[e] = 0.f;
#pragma unroll 4
        for (int c = 0; c < 64; ++c) { const float d = dlt[t * 257 + gi * 64 + c];
#pragma unroll
            for (int e4 = 0; e4 < 8; ++e4) { const f32x4 w4 = *(const LAS f32x4*)(W + c * 64 + e4 * 4); a[e4 * 4] += d * w4.x; a[e4 * 4 + 1] += d * w4.y; a[e4 * 4 + 2] += d * w4.z; a[e4 * 4 + 3] += d * w4.w; } }
        const float* sc = p.in[26] + L * 256 + gi * 64 + e0;
        bf16_t* orow = BR + (size_t)(T0 + t) * LDH + 768 + gi * 64 + e0;
#pragma unroll
        for (int e = 0; e < 32; e += 8) *(u32x4*)(orow + e) = (u32x4){pk2(a[e] * sc[e], a[e + 1] * sc[e + 1]), pk2(a[e + 2] * sc[e + 2], a[e + 3] * sc[e + 3]), pk2(a[e + 4] * sc[e + 4], a[e + 5] * sc[e + 5]), pk2(a[e + 6] * sc[e + 6], a[e + 7] * sc[e + 7])};
    }
    __syncthreads();
}

__device__ __forceinline__ void phase4(const Params& p, Ctx& C, int L, int rep = 0) {
    const bf16_t* P = (const bf16_t*)(p.ws + WS_P); bf16_t* BR = (bf16_t*)(p.ws + WS_BR);
    const bf16_t* QUP = (const bf16_t*)(p.ws + WS_QUP); const bf16_t* KVUP = (const bf16_t*)(p.ws + WS_KVUP);
    const bf16_t* KVC = (const bf16_t*)(p.ws + WS_KVCUP) + (size_t)L * 512 * LDKV;
    const bf16_t* NAK = (const bf16_t*)(p.ws + WS_NACK) + (size_t)L * 512 * LDNAC; const bf16_t* NAV = (const bf16_t*)(p.ws + WS_NACV) + (size_t)L * 512 * LDNAC;
    const bf16_t* SWK = (const bf16_t*)(p.ws + WS_SWCK) + (size_t)L * 512 * LDSWC; const bf16_t* SWV = (const bf16_t*)(p.ws + WS_SWCV) + (size_t)L * 512 * LDSWC;
    const bf16_t* KRC = (const bf16_t*)(p.ws + WS_KRC) + (size_t)L * 512 * 32;
    unsigned* qhead = (unsigned*)(p.ws + WS_CTL) + CW_QUEUE + 64 * (L * 2 + rep);
    volatile LAS unsigned* bc = (volatile LAS unsigned*)(C.lds + LDS_CTL + 16);
    LAS float* rpb = (LAS float*)(C.lds + LDS_TAB);
    const float ATT_C1 = 0.125f * LOG2E, MLA_C1 = 0.10206207261596575f * LOG2E;
    for (;;) {
        if (C.tid == 0) bc[0] = atomicAdd(qhead, 1u);
        __syncthreads();
        const int u = __builtin_amdgcn_readfirstlane((int)bc[0]);
        __syncthreads();
        if (u >= 1344) break;
        AttnDesc D; D.rope_q = 0; D.m0 = -1e30f; D.l0 = 0.f; D.seg[1].K2 = nullptr; D.seg[0].K2 = nullptr; D.seg[0].ldk2 = 0; D.seg[1].ldk2 = 0; D.seg[0].tok0 = 0; D.seg[1].tok0 = 0;
        if (u < 128) {
            const int b = u >> 6, h = (u >> 4) & 3, qb = u & 15; const int T0 = NCTX + b * 2048;
            D.Q = QUP + (size_t)(T0 + qb * 128) * LDQ + h * 96; D.ldq = LDQ; D.O = BR + (size_t)(T0 + qb * 128) * LDH + 256 + h * 64; D.ldo = LDH;
            D.seg[0] = AttnSeg{KVC + (size_t)b * 256 * LDKV + h * 128, KRC + (size_t)b * 256 * 32, KVC + (size_t)b * 256 * LDKV + h * 128 + 64, LDKV, 32, LDKV, 256, 0};
            D.seg[1] = AttnSeg{KVUP + (size_t)T0 * LDKV + h * 128, P + (size_t)T0 * LDP + COL_KR, KVUP + (size_t)T0 * LDKV + h * 128 + 64, LDKV, LDP, LDKV, 2048, 0};
            D.c1 = MLA_C1; D.qtok0 = qb * 128; D.rope_q = 1;
#ifndef NO_A1
            attn_unit<96, 0>(C, D, rpb);
#endif
        } else if (u < 256) {
            const int v = u - 128, b = v >> 6, h = (v >> 4) & 3, rp = v & 15; const int T0 = NCTX + b * 2048;
            const int ra = 2 * rp, r0a = min(max(ra - 4, 0), 24), r0b = min(max(ra + 1 - 4, 0), 24);
            for (int i = C.tid; i < 15 * 31; i += 512) rpb[i] = p.in[19][(size_t)(L * 4 + h) * 465 + i] * LOG2E;
            D.Q = P + (size_t)(T0 + ra * 64) * LDP + COL_QA + h * 64; D.ldq = LDP; D.O = BR + (size_t)(T0 + ra * 64) * LDH + 0 + h * 64; D.ldo = LDH;
            D.seg[0] = AttnSeg{NAK + (size_t)b * 256 * LDNAC + h * 64, nullptr, NAV + (size_t)b * 256 * LDNAC + h * 64, LDNAC, 0, LDNAC, 256, 0};
            D.seg[1] = AttnSeg{P + (size_t)(T0 + r0a * 64) * LDP + COL_KA + h * 64, nullptr, P + (size_t)(T0 + r0a * 64) * LDP + COL_VA + h * 64, LDP, 0, LDP, (r0b + 8 - r0a) * 64, r0a * 64};
            D.c1 = ATT_C1; D.qtok0 = ra * 64;
            __syncthreads();
#ifndef NO_A2
            attn_unit<64, 1>(C, D, rpb);
#endif
        } else if (u < 384) {
            const int v = u - 256, b = v >> 6, h = (v >> 4) & 3, qb = v & 15; const int T0 = NCTX + b * 2048, kvh = h >> 1;
            const int klo = max(qb * 128 - 128, 0), khi = min(qb * 128 + 256, 2048);
            D.Q = P + (size_t)(T0 + qb * 128) * LDP + COL_QC + h * 64; D.ldq = LDP; D.O = BR + (size_t)(T0 + qb * 128) * LDH + 512 + h * 64; D.ldo = LDH;
            D.seg[0] = AttnSeg{SWK + (size_t)b * 256 * LDSWC + kvh * 64, nullptr, SWV + (size_t)b * 256 * LDSWC + kvh * 64, LDSWC, 0, LDSWC, 256, 0};
            D.seg[1] = AttnSeg{P + (size_t)(T0 + klo) * LDP + COL_KC + kvh * 64, nullptr, P + (size_t)(T0 + klo) * LDP + COL_VC + kvh * 64, LDP, 0, LDP, khi - klo, klo};
            D.c1 = ATT_C1; D.qtok0 = qb * 128; D.m0 = p.in[24][L * 4 + h] * LOG2E; D.l0 = 1.0f;
#ifndef NO_A3
            attn_unit<64, 2>(C, D, rpb);
#endif
        } else if (u >= 576) {
            const int v = u - 576, half = v & 1, kh = (v >> 1) % 12, b = (v >> 1) / 12, kind = kh >> 2, h = kh & 3; const int T0 = b * 256, Tq = T0 + half * 128;
            D.qtok0 = half * 128; D.seg[1].n = 0; D.seg[1].K = nullptr; D.seg[1].V = nullptr; D.seg[1].ldk = 0; D.seg[1].ldv = 0;
            if (kind == 0) {
                D.Q = P + (size_t)Tq * LDP + COL_QA + h * 64; D.ldq = LDP; D.O = BR + (size_t)Tq * LDH + h * 64; D.ldo = LDH;
                D.seg[0] = AttnSeg{P + (size_t)T0 * LDP + COL_KA + h * 64, nullptr, P + (size_t)T0 * LDP + COL_VA + h * 64, LDP, 0, LDP, 256, 0};
#ifndef NO_A4
                D.c1 = ATT_C1; attn_unit<64, 0>(C, D, rpb);
#endif
            } else if (kind == 1) {
                D.Q = QUP + (size_t)Tq * LDQ + h * 96; D.ldq = LDQ; D.O = BR + (size_t)Tq * LDH + 256 + h * 64; D.ldo = LDH;
                D.seg[0] = AttnSeg{KVUP + (size_t)T0 * LDKV + h * 128, P + (size_t)T0 * LDP + COL_KR, KVUP + (size_t)T0 * LDKV + h * 128 + 64, LDKV, LDP, LDKV, 256, 0};
#ifndef NO_A5
                D.c1 = MLA_C1; attn_unit<96, 0>(C, D, rpb);
#endif
            } else {
                const int kvh = h >> 1;
                D.Q = P + (size_t)Tq * LDP + COL_QC + h * 64; D.ldq = LDP; D.O = BR + (size_t)Tq * LDH + 512 + h * 64; D.ldo = LDH;
                D.seg[0] = AttnSeg{P + (size_t)T0 * LDP + COL_KC + kvh * 64, nullptr, P + (size_t)T0 * LDP + COL_VC + kvh * 64, LDP, 0, LDP, 256, 0};
#ifndef NO_A6
                D.c1 = ATT_C1; D.m0 = p.in[24][L * 4 + h] * LOG2E; D.l0 = 1.0f; attn_unit<64, 0>(C, D, rpb);
#endif
            }
        } else {
#ifndef NO_POOL
            pool_unit(p, C, L, u - 384);
#endif
        }
    }
}

struct BrSched {
    const char* BR; const char* Wb; int G, c;
    __device__ __forceinline__ bool next(int i, G8Unit& u) const {
        const int Lu = i * G + c; if (Lu >= 48 * 16) return false;
        int pm, q; unit_map(Lu, 48, 16, pm, q);
        u.A = BR + (size_t)pm * 256 * LDH * 2 + (q >> 2) * 512; u.B = Wb + (size_t)q * 256 * LDWB * 2; u.e0 = pm; u.e1 = q; u.e2 = 0; u.e3 = 0; return true;
    }
};
struct EpiBK {
    static constexpr bool PERM = true, AFTER_DRAIN = false; G8_EPI_PLAIN
    bf16_t* O;
    __device__ __forceinline__ void operator()(const f32x4 (&acc)[2][2][4][2], const G8Unit& u, int wr, int wc, int fr_, int fq_) const {
        const int ln = hw_lane(), fr = ln & 15, fq = ln >> 4;
        const int k = u.e1 >> 2, pn4 = u.e1 & 3;
        char* base = (char*)O + ((size_t)((u.e0 * 16 + wr * 4) * 4 + k) * 256 + pn4 * 64 + wc * 8) * 128;
        const unsigned lo = (unsigned)(2 * fq * 16 + fr) * 8u;
#pragma unroll
        for (int ai = 0; ai < 2; ++ai)
#pragma unroll
            for (int m = 0; m < 4; ++m)
#pragma unroll
                for (int bj = 0; bj < 2; ++bj) { char* q = base + ((size_t)(ai * 8 + m) * 4 * 256 + bj * 32) * 128; asm volatile("" : "+s"(q));
                    const f32x4 v0 = acc[ai][bj][m][0], v1 = acc[ai][bj][m][1];
                    *(GAS u32x2*)(q + lo) = (u32x2){pk2(v0.x, v0.y), pk2(v0.z, v0.w)}; *(GAS u32x2*)(q + lo + 128) = (u32x2){pk2(v1.x, v1.y), pk2(v1.z, v1.w)}; }
    }
};
__device__ __forceinline__ void phase5a(const Params& p, Ctx& C, int L) {
    BrSched S{(const char*)(p.ws + WS_BR), (const char*)(p.ws + WS_W + (size_t)L * W_LAYER + WO_BR), C.G, C.bid};
    EpiBK E{(bf16_t*)(p.ws + WS_BK)};
    gemm8(C, 256, LDH, LDWB, S, E);
}
template <int VAR> struct EpiGateT {
    static constexpr bool PERM = false, AFTER_DRAIN = false, FP8 = true; static constexpr int HROWS_B = 2048;
    static __device__ __forceinline__ int brow(int R) { return ((R >> 4) & 1) * 1024 + (R >> 5) * 16 + (R & 15); }
    const bf16_t* BK; bf16_t* MG; const LAS float* bl;
    __device__ __forceinline__ f32x4 init(const G8Unit& u, int bj, int n, int wc, int fq) const { return *(const LAS f32x4*)(bl + (2 * bj + n) * 1024 + u.e1 * 64 + wc * 16 + 4 * fq); }
    __device__ __forceinline__ void operator()(const f32x4 (&acc)[2][2][4][2], const G8Unit& u, int wr, int wc, int fr_, int fq_) const {
        const int ln = hw_lane(), fr = ln & 15, fq = ln >> 4;
        const int xw = u.e1 * 64 + wc * 16;
#define SPIN_(ptr) asm volatile("" : "+s"(ptr))
        const char* bkb = (const char*)BK + ((size_t)(u.e0 * 16 + wr * 4) * 4 * 256 + u.e1 * 16 + wc * 4) * 128;
        char* mgb = (char*)MG + ((size_t)(u.e0 * 256 + wr * 64) * LDH + xw) * 2;
        const unsigned lob = (unsigned)(fq * 16 + fr) * 8u, lom = (unsigned)(fr * LDH + 4 * fq) * 2u;
        __builtin_amdgcn_sched_barrier(0);
        u32x2 b[8][4];
#pragma unroll
        for (int am = 0; am < 8; ++am) {
#pragma unroll
            for (int k = 0; k < 4; ++k) { const char* r = bkb + ((size_t)((am >> 2) * 8 + (am & 3)) * 4 + k) * 256 * 128; SPIN_(r); b[am][k] = *(const GAS u32x2*)(r + lob); } }
        __builtin_amdgcn_sched_barrier(0);
#pragma unroll
        for (int am = 0; am < 8; ++am) {
            f32x4 sum = (f32x4){0.f, 0.f, 0.f, 0.f};
#pragma unroll
            for (int k = 0; k < 4; ++k) { const f32x4 t = acc[am >> 2][k >> 1][am & 3][k & 1] * (-LOG2E_ * 0.03125f);
                const f32x4 e = (f32x4){__builtin_amdgcn_exp2f(t.x), __builtin_amdgcn_exp2f(t.y), __builtin_amdgcn_exp2f(t.z), __builtin_amdgcn_exp2f(t.w)} + 1.0f;
                const f32x4 g = (f32x4){__builtin_amdgcn_rcpf(e.x), __builtin_amdgcn_rcpf(e.y), __builtin_amdgcn_rcpf(e.z), __builtin_amdgcn_rcpf(e.w)};
                sum += g * (f32x4){lo16(b[am][k].x), hi16(b[am][k].x), lo16(b[am][k].y), hi16(b[am][k].y)}; }
            char* mp = mgb + (size_t)((am >> 2) * 128 + (am & 3) * 16) * LDH * 2; SPIN_(mp);
            *(GAS u32x2*)(mp + lom) = (u32x2){pk2(sum.x, sum.y), pk2(sum.z, sum.w)};
            __builtin_amdgcn_sched_barrier(0);
        }
#undef SPIN_
    }
};
template <int VAR> __device__ __forceinline__ void phase5b(const Params& p, Ctx& C, int L) {
    TileSched S{(const char*)(p.ws + WS_H8), (const char*)(p.ws + WS_W + (size_t)L * W_LAYER + WO_GATE), (size_t)256 * LD8, (size_t)64 * LD8, 48, 16, C.G, C.bid};
    LAS float* bl = (LAS float*)(C.lds + 131072);
    { const float* bg = p.in[18] + (size_t)L * 4096; for (int i = C.tid; i < 1024; i += 512) ((LAS f32x4*)bl)[i] = ((const f32x4*)bg)[i] * 32.0f; }
    __syncthreads();
    EpiGateT<VAR> E{(const bf16_t*)(p.ws + WS_BK), (bf16_t*)(p.ws + (VAR ? WS_BR : WS_MERGED)), bl};
    gemm8(C, 512, LD8 / 2, LD8 / 2, S, E);
}

__device__ __forceinline__ void gemm_bf16_phase(Ctx& C, const bf16_t* A, int lda, const bf16_t* Bt, int ldb, int K, bf16_t* O, int ldo, int nM, int nN) {
    TileSched S{(const char*)A, (const char*)Bt, (size_t)256 * lda * 2, (size_t)256 * ldb * 2, nM, nN, C.G, C.bid};
    EpiBf16 E{O, ldo};
    gemm8(C, K, lda, ldb, S, E);
}


struct RowSumSq {
    float* xbuf;
    unsigned* cnt;
    __device__ __forceinline__ void run(const Ctx& C, const f32x4 (&v)[2][2][4][2], int pm, int pn, int wr, int wc, int fr, int fq, float (&rs)[2][4]) const {
        LAS float* P = (LAS float*)C.lds;
        LAS float* S = (LAS float*)(C.lds + 4096);
#pragma unroll
        for (int ai = 0; ai < 2; ++ai)
#pragma unroll
            for (int m = 0; m < 4; ++m) { float s = 0.f;
#pragma unroll
                for (int bj = 0; bj < 2; ++bj)
#pragma unroll
                    for (int n = 0; n < 2; ++n) { const f32x4 x = v[ai][bj][m][n]; s += (x[0] * x[0] + x[1] * x[1]) + (x[2] * x[2] + x[3] * x[3]); }
                s += __shfl_xor(s, 16); s += __shfl_xor(s, 32);
                if (fq == 0) P[(ai * 128 + wr * 64 + m * 16 + fr) * 4 + wc] = s; }
        asm volatile("s_waitcnt lgkmcnt(0)" ::: "memory"); __builtin_amdgcn_s_barrier(); asm volatile("" ::: "memory");
        const int row = C.wid * 32 + (C.lane & 31);
        if (C.lane < 32) { const float t = (P[row * 4 + 0] + P[row * 4 + 1]) + (P[row * 4 + 2] + P[row * 4 + 3]);
            __hip_atomic_store(xbuf + ((size_t)(pm * 256 + row) * 4 + pn), t, __ATOMIC_RELAXED, __HIP_MEMORY_SCOPE_AGENT); }
        asm volatile("s_waitcnt vmcnt(0)" ::: "memory");
        if (C.lane == 0) __hip_atomic_fetch_add(cnt + 64 * pm, 1u, __ATOMIC_RELAXED, __HIP_MEMORY_SCOPE_AGENT);
        if (C.wid == 0) {
            unsigned spins = 0;
            while ((unsigned)__builtin_amdgcn_readfirstlane(__hip_atomic_load(cnt + 64 * pm, __ATOMIC_RELAXED, __HIP_MEMORY_SCOPE_AGENT)) < 32u) { __builtin_amdgcn_s_sleep(2); if (++spins > (1u << 22)) break; }
            __builtin_amdgcn_fence(__ATOMIC_ACQUIRE, "agent");
        }
        asm volatile("s_waitcnt vmcnt(0) lgkmcnt(0)" ::: "memory"); __builtin_amdgcn_s_barrier(); asm volatile("" ::: "memory");
        if (C.lane < 32) { const float* slot = xbuf + (size_t)(pm * 256 + row) * 4; float t = 0.f;
#pragma unroll
            for (int q = 0; q < 4; ++q) t += __hip_atomic_load(slot + q, __ATOMIC_RELAXED, __HIP_MEMORY_SCOPE_AGENT);
            S[row] = t; }
        asm volatile("s_waitcnt vmcnt(0) lgkmcnt(0)" ::: "memory"); __builtin_amdgcn_s_barrier(); asm volatile("" ::: "memory");
#pragma unroll
        for (int ai = 0; ai < 2; ++ai)
#pragma unroll
            for (int m = 0; m < 4; ++m) rs[ai][m] = S[ai * 128 + wr * 64 + m * 16 + fr];
        asm volatile("s_waitcnt lgkmcnt(0)" ::: "memory"); __builtin_amdgcn_s_barrier(); asm volatile("" ::: "memory");
    }
};
template <int MODE> struct EpiNormFused {
    static constexpr bool PERM = true, AFTER_DRAIN = true; G8_EPI_PLAIN
    const Params& p; int L;
    __device__ __forceinline__ void drained(const Ctx& C, f32x4 (&acc)[2][2][4][2], const G8Unit& u, int wr, int wc, int fr, int fq) const {
        const int pm = u.e0, pn = u.e1, cls = pm < 32 ? 0 : 1 + ((pm - 32) >> 3);
        unsigned* ctl = (unsigned*)(p.ws + WS_CTL);
        const float* modv = (const float*)(p.ws + WS_MODV);
        const float* mv = modv + (size_t)(L * 3 + cls) * 6144;
        float* Y = p.out + OFF_Y; bf16_t* H = (bf16_t*)(p.ws + WS_H);
        const float* gpost = (MODE == 0 ? p.in[13] : p.in[15]) + L * DM;
        const float* gate = mv + (MODE == 0 ? 2048 : 5120);
        const float* xpan = (MODE == 0 && L == 0) ? (pm < 32 ? p.in[0] + (size_t)pm * 256 * DM : p.in[1] + (size_t)(pm - 32) * 256 * DM) : Y + (size_t)pm * 256 * DM;
        float* ypan = Y + (size_t)pm * 256 * DM; bf16_t* hpan = H + (size_t)pm * 256 * LDH; unsigned char* h8pan = p.ws + WS_H8 + (size_t)pm * 256 * LD8;
        float rs[2][4];
        { RowSumSq X{(float*)(ctl + CW_XBUF), ctl + CW_SEAM + ((L * 2 + MODE) * 2 + 0) * 48 * 64}; X.run(C, acc, pm, pn, wr, wc, fr, fq, rs); }
#pragma unroll
        for (int ai = 0; ai < 2; ++ai)
#pragma unroll
            for (int m = 0; m < 4; ++m) rs[ai][m] = __builtin_amdgcn_rsqf(rs[ai][m] * (1.0f / DM) + EPS);
#pragma unroll
        for (int bj = 0; bj < 2; ++bj) { const int col = pn * 256 + bj * 128 + wc * 32 + 8 * fq;
            const f32x4 gp0 = *(const f32x4*)(gpost + col), gp1 = *(const f32x4*)(gpost + col + 4), g0 = *(const f32x4*)(gate + col), g1 = *(const f32x4*)(gate + col + 4);
#pragma unroll
            for (int ai = 0; ai < 2; ++ai)
#pragma unroll
                for (int m = 0; m < 4; ++m) { const int off = (ai * 128 + wr * 64 + m * 16 + fr) * DM + col;
                    const f32x4 x0 = *(const f32x4*)(xpan + off), x1 = *(const f32x4*)(xpan + off + 4);
                    acc[ai][bj][m][0] = x0 + g0 * (acc[ai][bj][m][0] * rs[ai][m] * gp0);
                    acc[ai][bj][m][1] = x1 + g1 * (acc[ai][bj][m][1] * rs[ai][m] * gp1);
                    asm volatile("" : "+v"(acc[ai][bj][m][0]), "+v"(acc[ai][bj][m][1]));
                    if (m & 1) asm volatile("" ::: "memory"); } }
        const bool second = (MODE == 0) || (L == 0);
        if (second) { RowSumSq X{(float*)(ctl + CW_XBUF) + 48 * 256 * 4, ctl + CW_SEAM + ((L * 2 + MODE) * 2 + 1) * 48 * 64}; X.run(C, acc, pm, pn, wr, wc, fr, fq, rs);
#pragma unroll
            for (int ai = 0; ai < 2; ++ai)
#pragma unroll
                for (int m = 0; m < 4; ++m) rs[ai][m] = __builtin_amdgcn_rsqf(rs[ai][m] * (1.0f / DM) + EPS); }
        const float* mvn = (MODE == 0) ? mv : modv + (size_t)(1 * 3 + cls) * 6144;
        const float* gpre = (MODE == 0) ? p.in[14] + L * DM : p.in[12] + DM;
        const float* scv = mvn + (MODE == 0 ? 4096 : 1024); const float* shv = mvn + (MODE == 0 ? 3072 : 0);
#pragma unroll
        for (int bj = 0; bj < 2; ++bj) { const int col = pn * 256 + bj * 128 + wc * 32 + 8 * fq;
            const f32x4 z = (f32x4){0.f, 0.f, 0.f, 0.f};
            f32x4 gg0 = z, gg1 = z, sa0 = z, sa1 = z, sb0 = z, sb1 = z;
            if (second) { gg0 = *(const f32x4*)(gpre + col); gg1 = *(const f32x4*)(gpre + col + 4); sa0 = *(const f32x4*)(scv + col) + 1.0f; sa1 = *(const f32x4*)(scv + col + 4) + 1.0f; sb0 = *(const f32x4*)(shv + col); sb1 = *(const f32x4*)(shv + col + 4); }
#pragma unroll
            for (int ai = 0; ai < 2; ++ai)
#pragma unroll
                for (int m = 0; m < 4; ++m) { const int rl = ai * 128 + wr * 64 + m * 16 + fr; const f32x4 v0 = acc[ai][bj][m][0], v1 = acc[ai][bj][m][1];
                    *(f32x4*)(ypan + rl * DM + col) = v0; *(f32x4*)(ypan + rl * DM + col + 4) = v1;
                    if (second) { const f32x4 h0 = v0 * rs[ai][m] * gg0 * sa0 + sb0, h1 = v1 * rs[ai][m] * gg1 * sa1 + sb1;
                        *(u32x4*)(hpan + rl * LDH + col) = (u32x4){pk2(h0.x, h0.y), pk2(h0.z, h0.w), pk2(h1.x, h1.y), pk2(h1.z, h1.w)};
                        if (MODE == 1) { int w0 = __builtin_amdgcn_cvt_pk_fp8_f32(h0.x, h0.y, 0, false); w0 = __builtin_amdgcn_cvt_pk_fp8_f32(h0.z, h0.w, w0, true);
                            int w1 = __builtin_amdgcn_cvt_pk_fp8_f32(h1.x, h1.y, 0, false); w1 = __builtin_amdgcn_cvt_pk_fp8_f32(h1.z, h1.w, w1, true);
                            *(u32x2*)(h8pan + rl * LD8 + col) = (u32x2){(unsigned)w0, (unsigned)w1}; } }
                    asm volatile("" ::: "memory"); } }
    }
};
template <int MODE> __device__ __forceinline__ void gemm_norm_phase(const Params& p, Ctx& C, int L, const bf16_t* A, int lda, const bf16_t* Bt, int ldb, int K) {
    TileSched S{(const char*)A, (const char*)Bt, (size_t)256 * lda * 2, (size_t)256 * ldb * 2, 48, 4, C.G, C.bid};
    EpiNormFused<MODE> E{p, L};
    gemm8(C, K, lda, ldb, S, E);
}

struct OneUnit { G8Unit u; __device__ __forceinline__ bool next(int i, G8Unit& o) const { if (i > 0) return false; o = u; return true; } };
struct EpiUpConv {
    static constexpr bool PERM = false, AFTER_DRAIN = true; G8_EPI_PLAIN
    bf16_t* ACT; const float* cw;
    __device__ __forceinline__ void drained(const Ctx& C, const f32x4 (&acc)[2][2][4][2], const G8Unit& u, int wr, int wc, int fr, int fq) const {
        constexpr int UROW = 528;
        const int Trow0 = u.e0, pn = u.e1, tpos0 = u.e2, Ls = u.e3;
#pragma unroll
        for (int ai = 0; ai < 2; ++ai)
#pragma unroll
            for (int m = 0; m < 4; ++m) { const int r = ai * 128 + wr * 64 + m * 16 + fr;
#pragma unroll
                for (int bj = 0; bj < 2; ++bj)
#pragma unroll
                    for (int n = 0; n < 2; ++n) { const int c = bj * 128 + wc * 32 + n * 16 + 4 * fq; const f32x4 v = acc[ai][bj][m][n]; *(LAS u32x2*)(C.lds + r * UROW + c * 2) = (u32x2){pk2(v.x, v.y), pk2(v.z, v.w)}; } }
        __syncthreads();
        {
            const int cc = C.tid & 15, rg = C.tid >> 4;
            const int f0 = pn * 128 + cc * 8;
            float wa[3][8], wg[3][8];
#pragma unroll
            for (int j = 0; j < 3; ++j)
#pragma unroll
                for (int e = 0; e < 8; ++e) { const bool ok = (f0 + e) < DFF; wa[j][e] = ok ? cw[j * 5504 + f0 + e] : 0.f; wg[j][e] = ok ? cw[j * 5504 + DFF + f0 + e] : 0.f; }
            for (int ps = 0; ps < 8; ++ps) {
                const int r = ps * 32 + rg, tpos = tpos0 + r;
                const bool valid = (r > 0 || tpos == 0) && (r < 255 || tpos == Ls - 1);
                if (!valid) continue;
                const bool hasl = tpos > 0, hasr = tpos < Ls - 1;
                const LAS unsigned char* base = C.lds + r * UROW + cc * 16;
                const u32x4 z = (u32x4){0u, 0u, 0u, 0u};
                const u32x4 a0 = hasl ? *(const LAS u32x4*)(base - UROW) : z, a1 = *(const LAS u32x4*)base, a2 = hasr ? *(const LAS u32x4*)(base + UROW) : z;
                const u32x4 g0 = hasl ? *(const LAS u32x4*)(base - UROW + 256) : z, g1 = *(const LAS u32x4*)(base + 256), g2 = hasr ? *(const LAS u32x4*)(base + UROW + 256) : z;
                float o[8];
#pragma unroll
                for (int e = 0; e < 8; ++e) {
                    const unsigned ua0 = a0[e >> 1], ua1 = a1[e >> 1], ua2 = a2[e >> 1], ug0 = g0[e >> 1], ug1 = g1[e >> 1], ug2 = g2[e >> 1];
                    const float xa0 = (e & 1) ? hi16(ua0) : lo16(ua0), xa1 = (e & 1) ? hi16(ua1) : lo16(ua1), xa2 = (e & 1) ? hi16(ua2) : lo16(ua2);
                    const float xg0 = (e & 1) ? hi16(ug0) : lo16(ug0), xg1 = (e & 1) ? hi16(ug1) : lo16(ug1), xg2 = (e & 1) ? hi16(ug2) : lo16(ug2);
                    const float av = xa0 * wa[0][e] + xa1 * wa[1][e] + xa2 * wa[2][e];
                    const float gv = xg0 * wg[0][e] + xg1 * wg[1][e] + xg2 * wg[2][e];
                    o[e] = siluf_(gv) * av;
                }
                *(u32x4*)(ACT + (size_t)(Trow0 + r) * LDACT + f0) = (u32x4){pk2(o[0], o[1]), pk2(o[2], o[3]), pk2(o[4], o[5]), pk2(o[6], o[7])};
            }
        }
        __syncthreads();
    }
};
__device__ __forceinline__ float dpp_ror1(float x) { return __int_as_float(__builtin_amdgcn_update_dpp(0, __float_as_int(x), 0x121, 0xf, 0xf, false)); }
__device__ __forceinline__ float dpp_ror15(float x) { return __int_as_float(__builtin_amdgcn_update_dpp(0, __float_as_int(x), 0x12F, 0xf, 0xf, false)); }
struct EpiUpConvReg {
    static constexpr bool PERM = true, AFTER_DRAIN = false; G8_EPI_PLAIN
    bf16_t* ACT; const float* cw; LAS unsigned* halo;
    __device__ __forceinline__ void operator()(const f32x4 (&acc)[2][2][4][2], const G8Unit& u, int wr, int wc, int fr_, int fq_) const {
        int fr = fr_, fq = fq_; asm volatile("" : "+v"(fr), "+v"(fq));
        const int Trow0 = u.e0, pn = u.e1, tpos0 = u.e2, Ls = u.e3;
        const int cl = wc * 32 + 8 * fq;
        unsigned xp[2][4][2][4];
#pragma unroll
        for (int ai = 0; ai < 2; ++ai)
#pragma unroll
            for (int m = 0; m < 4; ++m)
#pragma unroll
                for (int n = 0; n < 2; ++n)
#pragma unroll
                    for (int j = 0; j < 4; ++j) { xp[ai][m][n][j] = pk2(acc[ai][0][m][n][j], acc[ai][1][m][n][j]); asm volatile("" : "+v"(xp[ai][m][n][j])); }
#pragma unroll
        for (int ai = 0; ai < 2; ++ai) { const int b = ai * 2 + wr;
#pragma unroll
            for (int n = 0; n < 2; ++n) {
                if (fr == 0) *(LAS u32x4*)(halo + (b * 2 + 0) * 128 + cl + 4 * n) = (u32x4){xp[ai][0][n][0], xp[ai][0][n][1], xp[ai][0][n][2], xp[ai][0][n][3]};
                if (fr == 15) *(LAS u32x4*)(halo + (b * 2 + 1) * 128 + cl + 4 * n) = (u32x4){xp[ai][3][n][0], xp[ai][3][n][1], xp[ai][3][n][2], xp[ai][3][n][3]};
            } }
        LAS float* cwl = (LAS float*)(halo + 1024);
        const int tx = (wr * 4 + wc) * 64 + fq * 16 + fr;
        if (tx < 192) { const int jp = tx >> 5, ch = tx & 31, f = pn * 128 + ch * 4;
            const f32x4 v = (f < DFF) ? *(const f32x4*)(cw + (jp >> 1) * 5504 + (jp & 1) * DFF + f) : (f32x4){0.f, 0.f, 0.f, 0.f};
            *(LAS f32x4*)(cwl + jp * 128 + ch * 4) = v; }
        asm volatile("s_waitcnt vmcnt(0) lgkmcnt(0)\n\ts_barrier" ::: "memory");
        asm volatile("s_barrier" ::: "memory");
        const int f0 = pn * 128 + cl;
        const int src_up = ((fq << 4) | ((fr + 15) & 15)) << 2, src_dn = ((fq << 4) | ((fr + 1) & 15)) << 2;
        const bool seq_first = (tpos0 == 0), seq_last = (tpos0 + 256 == Ls);
        u32x2 pk0[2][4];
#pragma unroll
        for (int n = 0; n < 2; ++n) {
            f32x2 w0[4], w1[4], w2[4];
            { const f32x4 a0 = *(const LAS f32x4*)(cwl + 0 * 128 + cl + 4 * n), g0 = *(const LAS f32x4*)(cwl + 1 * 128 + cl + 4 * n);
                const f32x4 a1 = *(const LAS f32x4*)(cwl + 2 * 128 + cl + 4 * n), g1 = *(const LAS f32x4*)(cwl + 3 * 128 + cl + 4 * n);
                const f32x4 a2 = *(const LAS f32x4*)(cwl + 4 * 128 + cl + 4 * n), g2 = *(const LAS f32x4*)(cwl + 5 * 128 + cl + 4 * n);
#pragma unroll
                for (int j = 0; j < 4; ++j) { w0[j] = (f32x2){a0[j], g0[j]}; w1[j] = (f32x2){a1[j], g1[j]}; w2[j] = (f32x2){a2[j], g2[j]}; } }
#pragma unroll
            for (int ai = 0; ai < 2; ++ai) { const int b = ai * 2 + wr;
                u32x4 hup = (u32x4){0u, 0u, 0u, 0u}, hdn = hup;
                if (b > 0) hup = *(const LAS u32x4*)(halo + ((b - 1) * 2 + 1) * 128 + cl + 4 * n);
                if (b < 3) hdn = *(const LAS u32x4*)(halo + ((b + 1) * 2 + 0) * 128 + cl + 4 * n);
#pragma unroll
                for (int m = 0; m < 4; ++m) {
                    const int r = ai * 128 + wr * 64 + m * 16 + fr;
                    float o[4];
#pragma unroll
                    for (int j = 0; j < 4; ++j) {
                        const unsigned xc = xp[ai][m][n][j];
                        const unsigned pv = (m > 0) ? xp[ai][m > 0 ? m - 1 : 0][n][j] : hup[j], nv = (m < 3) ? xp[ai][m < 3 ? m + 1 : 3][n][j] : hdn[j];
                        unsigned upk = (unsigned)__builtin_amdgcn_update_dpp(0, (int)(fr == 15 ? pv : xc), 0x121, 0xf, 0xf, false);
                        unsigned dnk = (unsigned)__builtin_amdgcn_update_dpp(0, (int)(fr == 0 ? nv : xc), 0x12F, 0xf, 0xf, false);
                        if (ai == 0 && m == 0) { if (seq_first && r == 0) upk = 0u; }
                        if (ai == 1 && m == 3) { if (seq_last && r == 255) dnk = 0u; }
                        const f32x2 c2 = (f32x2){lo16(upk), hi16(upk)} * w0[j] + (f32x2){lo16(xc), hi16(xc)} * w1[j] + (f32x2){lo16(dnk), hi16(dnk)} * w2[j];
                        o[j] = siluf_(c2.y) * c2.x;
                    }
                    const u32x2 pkn = (u32x2){pk2(o[0], o[1]), pk2(o[2], o[3])};
                    if (n == 0) pk0[ai][m] = pkn;
                    else {
                        bool valid = true;
                        if (ai == 0 && m == 0) valid = (r > 0) || seq_first;
                        if (ai == 1 && m == 3) valid = (r < 255) || seq_last;
                        if (valid) *(u32x4*)(ACT + (size_t)(Trow0 + r) * LDACT + f0) = (u32x4){pk0[ai][m].x, pk0[ai][m].y, pkn.x, pkn.y};
                    }
                }
            }
        }
    }
};
struct UpSched {
    const char* H; const char* Wu; int G, c;
    __device__ __forceinline__ bool next(int i, G8Unit& u) const {
        const int Lu = i * G + c; if (Lu >= 50 * 22) return false;
        int mt, pn; unit_map(Lu, 50, 22, mt, pn);
        int Trow0, tpos0, Ls;
        if (mt < 32) { Trow0 = mt * 256; tpos0 = 0; Ls = 256; }
        else { const int v = mt - 32, b = v / 9, j = v % 9; tpos0 = (j < 8) ? 254 * j : 1792; Trow0 = NCTX + b * 2048 + tpos0; Ls = 2048; }
        u.A = H + (size_t)Trow0 * LDH * 2; u.B = Wu + (size_t)pn * 256 * LDW * 2; u.e0 = Trow0; u.e1 = pn; u.e2 = tpos0; u.e3 = Ls; return true;
    }
};
__device__ __forceinline__ void phase8(const Params& p, Ctx& C, int L) {
    UpSched S{(const char*)(p.ws + WS_H), (const char*)(p.ws + WS_W + (size_t)L * W_LAYER + WO_UP), C.G, C.bid};
    EpiUpConvReg E{(bf16_t*)(p.ws + WS_ACT), p.in[30] + (size_t)L * 3 * 5504, (LAS unsigned*)(C.lds + 131072)};
    gemm8(C, DM, LDH, LDW, S, E);
}

__global__ void __launch_bounds__(512, 2) mega_fwd(Params p) {
    extern __shared__ __attribute__((aligned(16))) unsigned char lds_raw[];
    Ctx C; C.lds = (LAS unsigned char*)lds_raw;
    C.ws = __builtin_amdgcn_readfirstlane((int)(threadIdx.x >> 6)); C.G = gridDim.x; C.bid = blockIdx.x;
#define FRESH() CTX_FRESH(C)
    FRESH();
    if (C.tid < 16) ((LAS unsigned*)(C.lds + LDS_CTL))[C.tid] = 0u;
    __syncthreads();
    XcdBarrier bar = xcd_barrier_post((unsigned*)(p.ws + WS_CTL) + CW_BAR, (volatile LAS unsigned*)(C.lds + LDS_CTL));
#define GRID_BAR() do { xcd_barrier(bar, C.tid); FRESH(); } while (0)
#ifndef PH
#define PH 0xffff
#endif
#ifndef DUP
#define DUP 0
#endif
    if (PH & 1) phase0(p, C); GRID_BAR();
    if (DUP & 1) { phase0(p, C); GRID_BAR(); }
    if (PH & 2) phase1(p, C); GRID_BAR();
    if (DUP & 2) { phase1(p, C); GRID_BAR(); }
#pragma unroll 1
    for (int L = 0; L < 2; ++L) {
        if (PH & 4) phase2(p, C, L); GRID_BAR();
        if (DUP & 4) { phase2(p, C, L); GRID_BAR(); }
        if (PH & 8) phase3(p, C, L); GRID_BAR();
        if (PH & 16) phase4(p, C, L); GRID_BAR();
        if (DUP & 16) { phase4(p, C, L, 1); GRID_BAR(); }
        if (PH & 32) phase5a(p, C, L); GRID_BAR();
        if (DUP & 32) { phase5a(p, C, L); GRID_BAR(); }
        if (PH & 64) phase5b<0>(p, C, L); GRID_BAR();
#ifdef PVAR
        if (DUP & 64) { phase5b<PVAR>(p, C, L); GRID_BAR(); }
#endif
        gemm_norm_phase<0>(p, C, L, (const bf16_t*)(p.ws + WS_MERGED), LDH, (const bf16_t*)(p.ws + WS_W + (size_t)L * W_LAYER + WO_OUT), LDW, DM); GRID_BAR();
        if (PH & 256) phase8(p, C, L); GRID_BAR();
        if (DUP & 256) { phase8(p, C, L); GRID_BAR(); }
        gemm_norm_phase<1>(p, C, L, (const bf16_t*)(p.ws + WS_ACT), LDACT, (const bf16_t*)(p.ws + WS_W + (size_t)L * W_LAYER + WO_DOWN), LDWD, DFFP);
        if (L == 0) GRID_BAR();
    }
}

extern "C" void kernel_launch(void* const* d_in, const int* in_sizes, int n_in, void* d_out, int out_size, void* d_ws, size_t ws_size, hipStream_t stream) {
    static int grid = 0;
    if (grid == 0) {
        if (n_in != 32 || ws_size < WS_END) { fprintf(stderr, "kernel_launch: unexpected n_in %d / ws %zu\n", n_in, ws_size); grid = -1; return; }
        int dev = 0, cus = 0;
        if (hipGetDevice(&dev) != hipSuccess || hipDeviceGetAttribute(&cus, hipDeviceAttributeMultiprocessorCount, dev) != hipSuccess) { grid = -1; return; }
        if (hipFuncSetAttribute((const void*)mega_fwd, hipFuncAttributeMaxDynamicSharedMemorySize, LDS_BYTES) != hipSuccess) { fprintf(stderr, "kernel_launch: hipFuncSetAttribute failed\n"); grid = -1; return; }
        grid = cus;
    }
    if (grid < 0) return;
    (void)hipMemsetAsync((char*)d_ws + WS_CTL, 0, (size_t)(CW_SEAM + 384 * 64) * 4, stream);
    Params a{};
    for (int i = 0; i < 32; ++i) a.in[i] = (const float*)d_in[i];
    a.out = (float*)d_out; a.ws = (unsigned char*)d_ws;
    hipLaunchKernelGGL(mega_fwd, dim3(grid), dim3(512), LDS_BYTES, stream, a);
}
```

```cpp
#include <hip/hip_runtime.h>
#include <cstdio>
#include <cstdint>

#define LAS __attribute__((address_space(3)))
#define GAS __attribute__((address_space(1)))
typedef unsigned short bf16_t;
typedef short bf16x8 __attribute__((ext_vector_type(8)));
typedef short s16x4 __attribute__((ext_vector_type(4)));
typedef float f32x4 __attribute__((ext_vector_type(4)));
typedef float f32x2 __attribute__((ext_vector_type(2)));
typedef unsigned u32x4 __attribute__((ext_vector_type(4)));
typedef unsigned u32x2 __attribute__((ext_vector_type(2)));
typedef __bf16 bf16x2_t __attribute__((ext_vector_type(2)));
#define LOG2E_ 1.4426950408889634f
typedef long lx2 __attribute__((ext_vector_type(2)));
typedef int i32x8 __attribute__((ext_vector_type(8)));
typedef int i32x4 __attribute__((ext_vector_type(4)));

constexpr int DM = 1024, NCTX = 8192, NLAT = 4096, NTOK = 12288;
constexpr int INP = 2048, IN_DIM = 1888, DFF = 2752, DFFP = 2816, NUP = 5632;
constexpr int LD8 = 1152;
constexpr int LDH = 1088, LDP = 1984, LDACT = 2880, LDQ = 448, LDKV = 576, LDW = 1088, LDWB = 320, LDWD = 2880, LDUQ = 192, LDUKV = 192, LDNAC = 320, LDSWC = 192, LDCKVC = 192, LDBK = 4160;
constexpr int COL_QA = 0, COL_KA = 256, COL_VA = 512, COL_CQ = 768, COL_CKV = 960, COL_KR = 1088, COL_QC = 1120, COL_KC = 1376, COL_VC = 1504, COL_PD = 1632;
constexpr float EPS = 1e-6f;
constexpr float LOG2E = 1.4426950408889634f;
constexpr size_t OFF_Y = 0, OFF_NAK = 12582912, OFF_NAV = 16777216, OFF_CKV = 20971520, OFF_KR = 23068672, OFF_SWK = 23592960, OFF_SWV = 25690112;

constexpr size_t MiB = 1u << 20;
constexpr size_t WS_CTL = 0, CTL_BYTES = 1 * MiB;
constexpr size_t WS_MODV = 1 * MiB;
constexpr size_t WS_NACK = 2 * MiB;
constexpr size_t WS_NACV = WS_NACK + 640 * 1024;
constexpr size_t WS_SWCK = WS_NACV + 640 * 1024;
constexpr size_t WS_SWCV = WS_SWCK + 384 * 1024;
constexpr size_t WS_CKVC = WS_SWCV + 384 * 1024;
constexpr size_t WS_KRC = WS_CKVC + 384 * 1024;
constexpr size_t WS_KVCUP = WS_KRC + 64 * 1024;
static_assert(WS_KVCUP + (size_t)2 * 512 * LDKV * 2 <= 6 * MiB, "cache region");
constexpr size_t WS_W = 6 * MiB, W_LAYER = 36 * MiB + 512 * 1024;
constexpr size_t WO_IN = 0, WO_GATE = 4 * MiB + 512 * 1024, WO_BR = 13 * MiB, WO_OUT = 15 * MiB + 512 * 1024, WO_UP = 18 * MiB, WO_DOWN = 30 * MiB, WO_UQ = 35 * MiB + 768 * 1024, WO_UKV = 36 * MiB;
static_assert((size_t)2048 * LDW * 2 <= WO_GATE && WO_GATE + (size_t)4096 * LDW * 2 <= WO_BR && WO_BR + (size_t)4096 * LDWB * 2 <= WO_OUT && WO_OUT + (size_t)1024 * LDW * 2 <= WO_UP && WO_UP + (size_t)NUP * LDW * 2 <= WO_DOWN && WO_DOWN + (size_t)1024 * LDWD * 2 <= WO_UQ && WO_UQ + (size_t)512 * LDUQ * 2 <= WO_UKV && WO_UKV + (size_t)512 * LDUKV * 2 <= W_LAYER, "weight map");
constexpr size_t WS_X1 = 79 * MiB;
constexpr size_t WS_H8 = WS_X1;
constexpr size_t WS_H = 127 * MiB;
constexpr size_t WS_P = 153 * MiB;
constexpr size_t WS_BK = 93 * MiB;
constexpr size_t WS_MERGED = 226 * MiB;
constexpr size_t WS_BR = 200 * MiB;
constexpr size_t WS_O = WS_BR;
constexpr size_t WS_QUP = 226 * MiB;
constexpr size_t WS_KVUP = 237 * MiB;
constexpr size_t WS_ACT = WS_P;
constexpr size_t WS_END = 252 * MiB;
static_assert((size_t)NTOK * LD8 <= (size_t)NTOK * DM * 4 && (size_t)4096 * LD8 <= WO_BR - WO_GATE, "fp8 buffers");
static_assert(WS_W + 2 * W_LAYER <= WS_X1 && WS_X1 + (size_t)NTOK * DM * 4 <= WS_H && WS_H + (size_t)NTOK * LDH * 2 <= WS_P && WS_P + (size_t)NTOK * LDP * 2 <= WS_BR && WS_BR + (size_t)NTOK * LDH * 2 <= WS_QUP
              && WS_QUP + (size_t)NTOK * LDQ * 2 <= WS_KVUP && WS_KVUP + (size_t)NTOK * LDKV * 2 <= WS_END && WS_ACT + (size_t)NTOK * LDACT * 2 <= WS_QUP
              && WS_H8 + (size_t)NTOK * LD8 <= WS_BK && WS_BK + (size_t)NTOK * LDBK * 2 <= WS_BR && WS_MERGED + (size_t)NTOK * LDH * 2 <= WS_END, "workspace map");
constexpr int CW_BAR = 1024;
constexpr int CW_QUEUE = 8192;
constexpr int CW_SEAM = 16384;
constexpr int CW_XBUF = 65536;

constexpr int LDS_CTL = 147456, LDS_TAB = LDS_CTL + 64, LDS_BYTES = LDS_TAB + 4096;

struct Params { const float* in[32]; float* out; unsigned char* ws; };

__device__ __forceinline__ float bf2f(bf16_t b) { return __uint_as_float((unsigned)b << 16); }
__device__ __forceinline__ unsigned pk2(float lo, float hi) { f32x2 v = {lo, hi}; bf16x2_t b = __builtin_convertvector(v, bf16x2_t); return __builtin_bit_cast(unsigned, b); }
__device__ __forceinline__ float lo16(unsigned u) { return __uint_as_float(u << 16); }
__device__ __forceinline__ float hi16(unsigned u) { return __uint_as_float(u & 0xffff0000u); }
__device__ __forceinline__ float wave_sum(float v) {
#pragma unroll
    for (int o = 1; o < 64; o <<= 1) v += __shfl_xor(v, o);
    return v;
}
__device__ __forceinline__ float qmax4(float x) {
    const auto a = __builtin_amdgcn_permlane16_swap(__float_as_uint(x), __float_as_uint(x), false, false); x = fmaxf(__uint_as_float(a[0]), __uint_as_float(a[1]));
    const auto b = __builtin_amdgcn_permlane32_swap(__float_as_uint(x), __float_as_uint(x), false, false); return fmaxf(__uint_as_float(b[0]), __uint_as_float(b[1]));
}
__device__ __forceinline__ float sigmoidf_(float x) { return __builtin_amdgcn_rcpf(1.0f + __builtin_amdgcn_exp2f(x * -LOG2E_)); }
__device__ __forceinline__ float siluf_(float x) { return x * __builtin_amdgcn_rcpf(1.0f + __builtin_amdgcn_exp2f(x * -LOG2E_)); }
#define VM_WAIT_UNUSED_()
#define VM_WAIT() asm volatile("s_waitcnt vmcnt(0)" ::: "memory")

#define XB_TMO      128
#define XB_XCNT(j)  (256  + 64 * (j))
#define XB_XSUB(j)  (1280 + 64 * (j))
#define XB_XGEN(j)  (2304 + 64 * (j))
#define XB_TOP      3328
#define XB_TOPGEN   3392
#define XCD_BAR_WORDS 3456
#define XB_SPIN_CAP (1u << 22)
__device__ __forceinline__ unsigned xb_ld(unsigned* p)              { return __hip_atomic_load(p, __ATOMIC_RELAXED, __HIP_MEMORY_SCOPE_AGENT); }
__device__ __forceinline__ unsigned xb_add(unsigned* p, unsigned v) { return __hip_atomic_fetch_add(p, v, __ATOMIC_RELAXED, __HIP_MEMORY_SCOPE_AGENT); }
__device__ __forceinline__ unsigned xb_xcc_id() { return (unsigned)__builtin_amdgcn_s_getreg((3 << 11) | 20) & 0xFu; }
#define XB_SPIN(cond, bar) do { unsigned _sp = 0; while (cond) { __builtin_amdgcn_s_sleep(1); \
    if ((++_sp & 255u) == 0u) { if (xb_ld(&(bar)[XB_TMO])) break; if (_sp > XB_SPIN_CAP) { atomicAdd(&(bar)[XB_TMO], 1u); break; } } } } while (0)
struct XcdBarrier { unsigned* bar; unsigned x; volatile LAS unsigned* st; };
__device__ __forceinline__ XcdBarrier xcd_barrier_post(unsigned* bar, volatile LAS unsigned* st) {
    XcdBarrier b; b.bar = bar; b.x = xb_xcc_id(); b.st = st;
    if (threadIdx.x == 0) (void)xb_add(&bar[XB_XCNT(b.x)], 1u);
    return b;
}
__device__ __forceinline__ void xcd_barrier_complete(unsigned* bar, unsigned x, unsigned& nloc, unsigned& nx) {
    const unsigned G = gridDim.x * gridDim.y * gridDim.z;
    unsigned sum, cnt, mine, sp = 0u;
    for (;;) {
        sum = 0u; cnt = 0u; mine = 0u;
#pragma unroll
        for (unsigned j = 0; j < 16; ++j) { const unsigned c = xb_ld(&bar[XB_XCNT(j)]); sum += c; cnt += (c > 0u) ? 1u : 0u; mine = (j == x) ? c : mine; }
        if (sum == G) break;
        __builtin_amdgcn_s_sleep(1);
        if ((++sp & 255u) == 0u) { if (xb_ld(&bar[XB_TMO])) break; if (sp > XB_SPIN_CAP) { atomicAdd(&bar[XB_TMO], 1u); break; } }
    }
    nloc = mine > 0u ? mine : 1u; nx = cnt > 0u ? cnt : 1u;
}
__device__ __forceinline__ void xcd_barrier(const XcdBarrier& b, int tid) {
    asm volatile("s_waitcnt vmcnt(0)" ::: "memory");
    __syncthreads();
    if (tid == 0) {
        unsigned* bar = b.bar; unsigned bx = b.x; asm volatile("" : "+s"(bar), "+s"(bx));
        __builtin_amdgcn_s_waitcnt(0);
        unsigned nloc = b.st[0], nx = b.st[1];
        if (nloc == 0u) { xcd_barrier_complete(bar, bx, nloc, nx); b.st[0] = nloc; b.st[1] = nx; }
        const unsigned old = xb_add(&bar[XB_XSUB(bx)], 1u);
        const unsigned gen = old / nloc;
        if (old + 1u == (gen + 1u) * nloc) {
            __builtin_amdgcn_fence(__ATOMIC_RELEASE, "agent");
            asm volatile("s_waitcnt vmcnt(0)" ::: "memory");
            const unsigned og = xb_add(&bar[XB_TOP], 1u);
            const unsigned tg = og / nx;
            if (og + 1u == (tg + 1u) * nx) xb_add(&bar[XB_TOPGEN], 1u);
            else XB_SPIN(xb_ld(&bar[XB_TOPGEN]) == tg, bar);
            __builtin_amdgcn_fence(__ATOMIC_ACQUIRE, "agent");
            xb_add(&bar[XB_XGEN(bx)], 1u);
            asm volatile("s_waitcnt vmcnt(0)" ::: "memory");
        } else {
            XB_SPIN(xb_ld(&bar[XB_XGEN(bx)]) == gen, bar);
            __builtin_amdgcn_fence(__ATOMIC_ACQUIRE, "agent");
            asm volatile("s_waitcnt vmcnt(0)" ::: "memory");
        }
    }
    __syncthreads();
}

struct Ctx {
    LAS unsigned char* lds;
    int tid, lane, wid, fr, fq;
    int G, bid;
    int ws;
};
__device__ __forceinline__ int hw_lane() { int l; asm volatile("v_mbcnt_lo_u32_b32 %0, -1, 0\n\tv_mbcnt_hi_u32_b32 %0, -1, %0" : "=v"(l)); return l; }
#define CTX_FRESH(C) do { int w_ = (C).ws, g_ = (C).G, b_ = (C).bid; asm volatile("" : "+s"(w_), "+s"(g_), "+s"(b_)); (C).G = g_; (C).bid = b_; const int l_ = hw_lane(); (C).lane = l_; (C).wid = __builtin_amdgcn_readfirstlane(w_); (C).tid = (C).wid * 64 + l_; (C).fr = l_ & 15; (C).fq = l_ >> 4; } while (0)

__device__ __forceinline__ int tok_cls(int T) { return T < NCTX ? 0 : 1 + ((T - NCTX) >> 11); }
__device__ __forceinline__ const float* x_in_row(const Params& p, int T) { return T < NCTX ? p.in[0] + (size_t)T * DM : p.in[1] + (size_t)(T - NCTX) * DM; }

__device__ __forceinline__ void p0_item(const float* W, int ldw, int k0, int n0, const float* kscale, bf16_t* WT, int ldt, int dst_row0, LAS float* scr, int lane) {
    float ld[32];
#pragma unroll
    for (int i = 0; i < 32; ++i) { const int kk = 2 * i + (lane >> 5); ld[i] = W[(size_t)(k0 + kk) * ldw + n0 + (lane & 31)]; }
#pragma unroll
    for (int i = 0; i < 32; ++i) { const int kk = 2 * i + (lane >> 5); float v = ld[i]; if (kscale) v *= kscale[k0 + kk]; scr[kk * 33 + (lane & 31)] = v; }
    asm volatile("s_waitcnt lgkmcnt(0)" ::: "memory");
    const int c = lane & 7;
#pragma unroll
    for (int j = 0; j < 4; ++j) { const int n = (lane >> 3) + 8 * j; const LAS float* s = scr + (8 * c) * 33 + n;
        u32x4 o; o.x = pk2(s[0 * 33], s[1 * 33]); o.y = pk2(s[2 * 33], s[3 * 33]); o.z = pk2(s[4 * 33], s[5 * 33]); o.w = pk2(s[6 * 33], s[7 * 33]);
        *(u32x4*)(WT + (size_t)(dst_row0 + n) * ldt + k0 + 8 * c) = o; }
    asm volatile("s_waitcnt lgkmcnt(0)" ::: "memory");
}
__device__ __forceinline__ void p0_item8(const float* W, int ldw, int k0, int n0, float scale, unsigned char* WT, int ldt, int dst_row0, LAS float* scr, int lane) {
    float ld[32];
#pragma unroll
    for (int i = 0; i < 32; ++i) { const int kk = 2 * i + (lane >> 5); ld[i] = W[(size_t)(k0 + kk) * ldw + n0 + (lane & 31)]; }
#pragma unroll
    for (int i = 0; i < 32; ++i) { const int kk = 2 * i + (lane >> 5); scr[kk * 33 + (lane & 31)] = ld[i] * scale; }
    asm volatile("s_waitcnt lgkmcnt(0)" ::: "memory");
    const int c = lane & 7;
#pragma unroll
    for (int j = 0; j < 4; ++j) { const int n = (lane >> 3) + 8 * j; const LAS float* s = scr + (8 * c) * 33 + n;
        int w0 = __builtin_amdgcn_cvt_pk_fp8_f32(s[0 * 33], s[1 * 33], 0, false); w0 = __builtin_amdgcn_cvt_pk_fp8_f32(s[2 * 33], s[3 * 33], w0, true);
        int w1 = __builtin_amdgcn_cvt_pk_fp8_f32(s[4 * 33], s[5 * 33], 0, false); w1 = __builtin_amdgcn_cvt_pk_fp8_f32(s[6 * 33], s[7 * 33], w1, true);
        *(u32x2*)(WT + (size_t)(dst_row0 + n) * ldt + k0 + 8 * c) = (u32x2){(unsigned)w0, (unsigned)w1}; }
    asm volatile("s_waitcnt lgkmcnt(0)" ::: "memory");
}
constexpr int IT_IN = 16 * 59, IT_GATE = 16 * 128, IT_BR = 4 * 4 * 32, IT_OUT = 16 * 32, IT_UP = 16 * 172, IT_DOWN = 43 * 32, IT_UQ = 3 * 12, IT_UKV = 2 * 16;
constexpr int IT_LAYER = IT_IN + IT_GATE + IT_BR + IT_OUT + IT_UP + IT_DOWN + IT_UQ + IT_UKV;

__device__ __forceinline__ void zero_bf16(bf16_t* p, size_t n8, int gtid, int gthreads) {
    for (size_t i = gtid; i < n8; i += gthreads) ((u32x4*)p)[i] = (u32x4){0u, 0u, 0u, 0u};
}

__device__ __forceinline__ void phase0(const Params& p, Ctx& C) {
    LAS float* scr = (LAS float*)(C.lds + C.wid * 16384);
    const int gw = C.bid * 8 + C.wid, NGW = C.G * 8;
    for (int it = gw; it < 2 * IT_LAYER; it += NGW) {
        const int L = it / IT_LAYER; int r = it % IT_LAYER;
        unsigned char* wb = p.ws + WS_W + (size_t)L * W_LAYER;
        if (r < IT_IN) { const int kb = r / 59, nb = r % 59; p0_item(p.in[16] + (size_t)L * 1024 * 1888, 1888, kb * 64, nb * 32, nullptr, (bf16_t*)(wb + WO_IN), LDW, nb * 32, scr, C.lane); continue; } r -= IT_IN;
        if (r < IT_GATE) { const int kb = r / 128, nb = r % 128; p0_item8(p.in[17] + (size_t)L * 1024 * 4096, 4096, kb * 64, nb * 32, 32.0f, (unsigned char*)(wb + WO_GATE), LD8, nb * 32, scr, C.lane); continue; } r -= IT_GATE;
        if (r < IT_BR) { const int k = r / 128, rr = r % 128, kb = rr / 32, nb = rr % 32; p0_item(p.in[27] + (size_t)(L * 4 + k) * 256 * 1024, 1024, kb * 64, nb * 32, nullptr, (bf16_t*)(wb + WO_BR) + (size_t)k * 1024 * LDWB, LDWB, nb * 32, scr, C.lane); continue; } r -= IT_BR;
        if (r < IT_OUT) { const int kb = r / 32, nb = r % 32; p0_item(p.in[28] + (size_t)L * 1024 * 1024, 1024, kb * 64, nb * 32, nullptr, (bf16_t*)(wb + WO_OUT), LDW, nb * 32, scr, C.lane); continue; } r -= IT_OUT;
        if (r < IT_UP) { const int kb = r / 172, nb = r % 172; const int n0 = nb * 32, part = n0 / DFF, j0 = n0 % DFF; const int drow = (j0 >> 7) * 256 + part * 128 + (j0 & 127);
            p0_item(p.in[29] + (size_t)L * 1024 * 5504, 5504, kb * 64, n0, nullptr, (bf16_t*)(wb + WO_UP), LDW, drow, scr, C.lane); continue; } r -= IT_UP;
        if (r < IT_DOWN) { const int kb = r / 32, nb = r % 32; p0_item(p.in[31] + (size_t)L * DFF * 1024, 1024, kb * 64, nb * 32, nullptr, (bf16_t*)(wb + WO_DOWN), LDWD, nb * 32, scr, C.lane); continue; } r -= IT_DOWN;
        if (r < IT_UQ) { const int kb = r / 12, nb = r % 12; p0_item(p.in[21] + (size_t)L * 192 * 384, 384, kb * 64, nb * 32, p.in[20] + L * 192, (bf16_t*)(wb + WO_UQ), LDUQ, nb * 32, scr, C.lane); continue; } r -= IT_UQ;
        { const int kb = r / 16, nb = r % 16; p0_item(p.in[23] + (size_t)L * 128 * 512, 512, kb * 64, nb * 32, p.in[22] + L * 128, (bf16_t*)(wb + WO_UKV), LDUKV, nb * 32, scr, C.lane); }
    }
    const int gtid = C.bid * 512 + C.tid, gth = C.G * 512;
    for (int L = 0; L < 2; ++L) {
        unsigned char* wb = p.ws + WS_W + (size_t)L * W_LAYER;
        zero_bf16((bf16_t*)(wb + WO_IN) + (size_t)IN_DIM * LDW, (size_t)(INP - IN_DIM) * LDW / 8, gtid, gth);
        zero_bf16((bf16_t*)(wb + WO_UP) + (size_t)(21 * 256 + 64) * LDW, (size_t)64 * LDW / 8, gtid, gth);
        zero_bf16((bf16_t*)(wb + WO_UP) + (size_t)(21 * 256 + 128 + 64) * LDW, (size_t)64 * LDW / 8, gtid, gth);
        zero_bf16((bf16_t*)(wb + WO_UQ) + (size_t)384 * LDUQ, (size_t)128 * LDUQ / 8, gtid, gth);
        for (int i = gtid; i < 1024 * 8; i += gth) { const int row = i >> 3, c = i & 7; *(u32x4*)((bf16_t*)(wb + WO_DOWN) + (size_t)row * LDWD + DFF + c * 8) = (u32x4){0u, 0u, 0u, 0u}; }
    }
    __syncthreads();
    LAS float* sv = (LAS float*)(C.lds);
    LAS float* part = (LAS float*)(C.lds + 16384);
    for (int i = C.tid; i < 3 * 1024; i += 512) { const int cls = i >> 10, k = i & 1023; const float v = cls == 0 ? p.in[9][k] : p.in[8][(cls - 1) * 1024 + k]; sv[i] = siluf_(v); }
    __syncthreads();
    float* modv = (float*)(p.ws + WS_MODV);
    for (int it = C.bid; it < 2 * 96; it += C.G) {
        const int L = it / 96, col = (it % 96) * 64 + C.lane;
        const float* w = p.in[10] + (size_t)L * 1024 * 6144 + col;
        float a0 = 0.f, a1 = 0.f, a2 = 0.f;
#pragma unroll 8
        for (int kk = 0; kk < 128; ++kk) { const int k = C.wid * 128 + kk; const float wv = w[(size_t)k * 6144]; a0 += sv[k] * wv; a1 += sv[1024 + k] * wv; a2 += sv[2048 + k] * wv; }
        part[(C.wid * 3 + 0) * 64 + C.lane] = a0; part[(C.wid * 3 + 1) * 64 + C.lane] = a1; part[(C.wid * 3 + 2) * 64 + C.lane] = a2;
        __syncthreads();
        if (C.tid < 192) { const int cls = C.tid >> 6, l = C.tid & 63; float s = 0.f;
#pragma unroll
            for (int w8 = 0; w8 < 8; ++w8) s += part[(w8 * 3 + cls) * 64 + l];
            const int cc = (it % 96) * 64 + l;
            modv[((size_t)L * 3 + cls) * 6144 + cc] = s + p.in[11][(size_t)L * 6144 + cc]; }
        __syncthreads();
    }
}

__device__ __forceinline__ void row_norm_mod(const f32x4 (&v)[4], const float* g, const float* sc, const float* sh, bf16_t* orow, int lane, unsigned char* o8 = nullptr) {
    float ss = 0.f;
#pragma unroll
    for (int j = 0; j < 4; ++j) ss += (v[j].x * v[j].x + v[j].y * v[j].y) + (v[j].z * v[j].z + v[j].w * v[j].w);
    const float rstd = 1.0f / sqrtf(wave_sum(ss) * (1.0f / DM) + EPS);
#pragma unroll
    for (int j = 0; j < 4; ++j) {
        const f32x4 gg = ((const f32x4*)g)[lane + 64 * j], s1 = ((const f32x4*)sc)[lane + 64 * j], s0 = ((const f32x4*)sh)[lane + 64 * j];
        const f32x4 y = v[j] * rstd * gg * (s1 + 1.0f) + s0;
        u32x2 o; o.x = pk2(y.x, y.y); o.y = pk2(y.z, y.w);
        ((u32x2*)orow)[lane + 64 * j] = o;
        if (o8) { int w8 = __builtin_amdgcn_cvt_pk_fp8_f32(y.x, y.y, 0, false); w8 = __builtin_amdgcn_cvt_pk_fp8_f32(y.z, y.w, w8, true); ((int*)o8)[lane + 64 * j] = w8; }
    }
}
__device__ __forceinline__ void load_row_bf16(const bf16_t* r, f32x4 (&v)[4], int lane) {
#pragma unroll
    for (int j = 0; j < 4; ++j) { const u32x2 u = ((const u32x2*)r)[lane + 64 * j]; v[j] = (f32x4){lo16(u.x), hi16(u.x), lo16(u.y), hi16(u.y)}; }
}

__device__ __forceinline__ void phase1(const Params& p, Ctx& C) {
    const int gw = C.bid * 8 + C.wid, NGW = C.G * 8;
    const float* modv = (const float*)(p.ws + WS_MODV);
    bf16_t* H = (bf16_t*)(p.ws + WS_H);
    for (int T = gw; T < NTOK; T += NGW) {
        const float* xr = x_in_row(p, T); f32x4 v[4];
#pragma unroll
        for (int j = 0; j < 4; ++j) v[j] = ((const f32x4*)xr)[C.lane + 64 * j];
        const float* mv = modv + (size_t)(0 * 3 + tok_cls(T)) * 6144;
        row_norm_mod(v, p.in[12], mv + 1024, mv, H + (size_t)T * LDH, C.lane, p.ws + WS_H8 + (size_t)T * LD8);
    }
    const int gtid = C.bid * 512 + C.tid, gth = C.G * 512;
    bf16_t* nak = (bf16_t*)(p.ws + WS_NACK); bf16_t* nav = (bf16_t*)(p.ws + WS_NACV);
    for (int i = gtid; i < 2 * 2 * 256 * 256 / 4; i += gth) {
        const int e = i * 4, w = e & 255, t = (e >> 8) & 255, L = (e >> 16) & 1, b = e >> 17;
        const size_t d = ((size_t)(L * 2 + b) * 256 + t) * LDNAC + w;
        const f32x4 a = *(const f32x4*)(p.in[2] + e), c = *(const f32x4*)(p.in[3] + e);
        *(u32x2*)(nak + d) = (u32x2){pk2(a.x, a.y), pk2(a.z, a.w)}; *(u32x2*)(nav + d) = (u32x2){pk2(c.x, c.y), pk2(c.z, c.w)};
    }
    bf16_t* swk = (bf16_t*)(p.ws + WS_SWCK); bf16_t* swv = (bf16_t*)(p.ws + WS_SWCV); bf16_t* ckv = (bf16_t*)(p.ws + WS_CKVC);
    for (int i = gtid; i < 2 * 2 * 256 * 128 / 4; i += gth) {
        const int e = i * 4, w = e & 127, t = (e >> 7) & 255, L = (e >> 15) & 1, b = e >> 16;
        const size_t d = ((size_t)(L * 2 + b) * 256 + t) * LDSWC + w, d2 = ((size_t)(L * 2 + b) * 256 + t) * LDCKVC + w;
        const f32x4 a = *(const f32x4*)(p.in[6] + e), c = *(const f32x4*)(p.in[7] + e), m = *(const f32x4*)(p.in[4] + e);
        *(u32x2*)(swk + d) = (u32x2){pk2(a.x, a.y), pk2(a.z, a.w)}; *(u32x2*)(swv + d) = (u32x2){pk2(c.x, c.y), pk2(c.z, c.w)};
        *(u32x2*)(ckv + d2) = (u32x2){pk2(m.x, m.y), pk2(m.z, m.w)};
    }
    bf16_t* krc = (bf16_t*)(p.ws + WS_KRC);
    for (int i = gtid; i < 2 * 2 * 256 * 32 / 4; i += gth) {
        const int e = i * 4, w = e & 31, t = (e >> 5) & 255, L = (e >> 13) & 1, b = e >> 14;
        const size_t d = ((size_t)(L * 2 + b) * 256 + t) * 32 + w;
        const f32x4 a = *(const f32x4*)(p.in[5] + e);
        *(u32x2*)(krc + d) = (u32x2){pk2(a.x, a.y), pk2(a.z, a.w)};
    }
}

__device__ __forceinline__ void phase7(const Params& p, Ctx& C, int L) {
    const int gw = C.bid * 8 + C.wid, NGW = C.G * 8;
    const float* modv = (const float*)(p.ws + WS_MODV);
    const bf16_t* O = (const bf16_t*)(p.ws + WS_O); float* X1 = p.out + OFF_Y; bf16_t* H = (bf16_t*)(p.ws + WS_H);
    const float* gpost = p.in[13] + L * DM; const float* gpre = p.in[14] + L * DM;
    for (int T = gw; T < NTOK; T += NGW) {
        const float* xr = (L == 0) ? x_in_row(p, T) : p.out + OFF_Y + (size_t)T * DM;
        const float* mv = modv + (size_t)(L * 3 + tok_cls(T)) * 6144;
        f32x4 o[4]; load_row_bf16(O + (size_t)T * LDH, o, C.lane);
        float ss = 0.f;
#pragma unroll
        for (int j = 0; j < 4; ++j) ss += (o[j].x * o[j].x + o[j].y * o[j].y) + (o[j].z * o[j].z + o[j].w * o[j].w);
        const float rstd = 1.0f / sqrtf(wave_sum(ss) * (1.0f / DM) + EPS);
        f32x4 x1[4];
#pragma unroll
        for (int j = 0; j < 4; ++j) {
            const f32x4 xv = ((const f32x4*)xr)[C.lane + 64 * j], gp = ((const f32x4*)gpost)[C.lane + 64 * j], g1 = ((const f32x4*)(mv + 2048))[C.lane + 64 * j];
            x1[j] = xv + g1 * (o[j] * rstd * gp);
            ((f32x4*)(X1 + (size_t)T * DM))[C.lane + 64 * j] = x1[j];
        }
        row_norm_mod(x1, gpre, mv + 4096, mv + 3072, H + (size_t)T * LDH, C.lane);
    }
}
__device__ __forceinline__ void phase10(const Params& p, Ctx& C, int L) {
    const int gw = C.bid * 8 + C.wid, NGW = C.G * 8;
    const float* modv = (const float*)(p.ws + WS_MODV);
    const float* X1 = p.out + OFF_Y; bf16_t* H = (bf16_t*)(p.ws + WS_H);
    const float* gpost = p.in[15] + L * DM;
    for (int T = gw; T < NTOK; T += NGW) {
        const float* mv = modv + (size_t)(L * 3 + tok_cls(T)) * 6144;
        f32x4 f[4]; load_row_bf16(H + (size_t)T * LDH, f, C.lane);
        float ss = 0.f;
#pragma unroll
        for (int j = 0; j < 4; ++j) ss += (f[j].x * f[j].x + f[j].y * f[j].y) + (f[j].z * f[j].z + f[j].w * f[j].w);
        const float rstd = 1.0f / sqrtf(wave_sum(ss) * (1.0f / DM) + EPS);
        f32x4 y[4];
#pragma unroll
        for (int j = 0; j < 4; ++j) {
            const f32x4 xv = ((const f32x4*)(X1 + (size_t)T * DM))[C.lane + 64 * j], gp = ((const f32x4*)gpost)[C.lane + 64 * j], g2 = ((const f32x4*)(mv + 5120))[C.lane + 64 * j];
            y[j] = xv + g2 * (f[j] * rstd * gp);
            ((f32x4*)(p.out + OFF_Y + (size_t)T * DM))[C.lane + 64 * j] = y[j];
        }
        if (L == 0) { const float* mv1 = modv + (size_t)(1 * 3 + tok_cls(T)) * 6144; row_norm_mod(y, p.in[12] + DM, mv1 + 1024, mv1, H + (size_t)T * LDH, C.lane, p.ws + WS_H8 + (size_t)T * LD8); }
    }
}

__device__ __forceinline__ int lds_byte(int r, int c) { const int st = (r >> 4) * 2 + (c >> 5), ob = (r & 15) * 64 + (c & 31) * 2; return st * 1024 + (ob ^ (((ob >> 9) & 1) << 5)); }
__device__ __forceinline__ void stage_rc(int b, int& R, int& Cc) { const int st = b >> 10, sb = b & 1023, swz = sb ^ (((sb >> 9) & 1) << 5); R = (st >> 1) * 16 + swz / 64; Cc = (st & 1) * 32 + (swz % 64) / 2; }
#define GLDS16(gp, lp) __builtin_amdgcn_global_load_lds((const unsigned*)(gp), (LAS unsigned*)(lp), 16, 0, 0)

template <int TM, int TN> struct GemmStage {
    static constexpr int STAGE = (TM + TN) * 128;
    int offA, offB;
    int lda, ldb;
    __device__ __forceinline__ void init(const Ctx& C, int lda_, int ldb_) { int R, Cc; stage_rc(C.wid * 1024 + C.lane * 16, R, Cc); lda = lda_; ldb = ldb_; offA = R * lda + Cc; offB = R * ldb + Cc; }
    __device__ __forceinline__ void stage(const Ctx& C, int buf, const bf16_t* a, const bf16_t* b) const {
        LAS unsigned char* base = C.lds + buf * STAGE + C.wid * 1024;
#pragma unroll
        for (int i = 0; i < TM / 64; ++i) GLDS16(a + offA + (size_t)i * 64 * lda, base + i * 8192);
#pragma unroll
        for (int i = 0; i < TN / 64; ++i) GLDS16(b + offB + (size_t)i * 64 * ldb, base + TM * 128 + i * 8192);
    }
};
template <int TM, int TN, int MF, int NF>
__device__ __forceinline__ void gemm_compute(const Ctx& C, int buf, int wr, int wc, f32x4 (&acc)[MF][NF]) {
    constexpr int STAGE = (TM + TN) * 128;
    LAS unsigned char* sa = C.lds + buf * STAGE; LAS unsigned char* sb = sa + TM * 128;
#pragma unroll
    for (int ks = 0; ks < 2; ++ks) {
        bf16x8 Af[MF], Bf[NF];
        const int ao = lds_byte(wr * MF * 16 + C.fr, ks * 32 + C.fq * 8), bo = lds_byte(wc * NF * 16 + C.fr, ks * 32 + C.fq * 8);
#pragma unroll
        for (int m = 0; m < MF; ++m) Af[m] = *(const LAS bf16x8*)(sa + ao + m * 2048);
#pragma unroll
        for (int n = 0; n < NF; ++n) Bf[n] = *(const LAS bf16x8*)(sb + bo + n * 2048);
#pragma unroll
        for (int m = 0; m < MF; ++m)
#pragma unroll
            for (int n = 0; n < NF; ++n) acc[m][n] = __builtin_amdgcn_mfma_f32_16x16x32_bf16(Bf[n], Af[m], acc[m][n], 0, 0, 0);
        __builtin_amdgcn_sched_barrier(0);
    }
}
template <int TM, int TN, int MF, int NF>
__device__ __forceinline__ void gemm_kloop(const Ctx& C, const GemmStage<TM, TN>& S, const bf16_t* A, const bf16_t* B, int nt, int wr, int wc, f32x4 (&acc)[MF][NF]) {
    S.stage(C, 0, A, B); VM_WAIT(); __syncthreads();
    for (int t = 0; t < nt; ++t) {
        const int cur = t & 1;
        if (t + 1 < nt) S.stage(C, cur ^ 1, A + (t + 1) * 64, B + (t + 1) * 64);
        gemm_compute<TM, TN, MF, NF>(C, cur, wr, wc, acc);
        VM_WAIT(); __syncthreads();
    }
}
__device__ __forceinline__ void unit_map(int u, int nM, int nN, int& pm, int& pn) {
    const int nwg = nM * nN; int wgid = u;
    { const int q = nwg / 8, r = nwg % 8, xcd = wgid % 8, off = wgid / 8; wgid = (xcd < r ? xcd * (q + 1) : r * (q + 1) + (xcd - r) * q) + off; }
    const int nig = 8 * nN, gid = wgid / nig, fm = gid * 8, gsz = (nM - fm) < 8 ? (nM - fm) : 8;
    pm = fm + ((wgid % nig) % gsz); pn = (wgid % nig) / gsz;
}
#define ZERO_ACC(acc, MF, NF) _Pragma("unroll") for (int m_ = 0; m_ < MF; ++m_) _Pragma("unroll") for (int n_ = 0; n_ < NF; ++n_) acc[m_][n_] = (f32x4){0.f, 0.f, 0.f, 0.f}


struct G8Unit { const char* A; const char* B; int e0, e1, e2, e3; };
__device__ __forceinline__ int perm32(int rho) { const int n = rho >> 4, i = rho & 15; return 8 * (i >> 2) + 4 * n + (i & 3); }
__device__ __forceinline__ i32x8 cat8(bf16x8 a, bf16x8 b) { return __builtin_shufflevector(__builtin_bit_cast(i32x4, a), __builtin_bit_cast(i32x4, b), 0, 1, 2, 3, 4, 5, 6, 7); }
#define G8_EPI_PLAIN static __device__ __forceinline__ f32x4 init(const G8Unit&, int, int, int, int) { return (f32x4){0.f, 0.f, 0.f, 0.f}; } static constexpr bool FP8 = false; static constexpr int HROWS_B = 128; static __device__ __forceinline__ int brow(int R) { return PERM ? ((R & ~31) + perm32(R & 31)) : R; }
template <class Epi, class Sched>
__device__ __forceinline__ void gemm8(const Ctx& C, int K, int lda, int ldb, const Sched& S, const Epi& E) {
    constexpr int HTB = 16384;
    LAS unsigned char* lds = C.lds;
    const int tid = C.tid, wid = C.wid, lane = C.lane, wr = wid >> 2, wc = wid & 3, fr = lane & 15, fq = lane >> 4;
    const int nt = K / 64;
    unsigned voffA, voffB;
    { int R, Cc; stage_rc(tid * 16, R, Cc); voffA = (unsigned)(R * lda + Cc) * 2u; voffB = (unsigned)(Epi::brow(R) * ldb + Cc) * 2u; }
    const size_t kstep = 128;
    const size_t hstepA = (size_t)128 * lda * 2, hstepB = (size_t)Epi::HROWS_B * ldb * 2;
    const size_t r64A = (size_t)64 * lda * 2, r64B = (size_t)(Epi::brow(64) - Epi::brow(0)) * ldb * 2;
    const unsigned ldsw = (unsigned)__builtin_amdgcn_readfirstlane((int)((unsigned)(size_t)lds + (unsigned)wid * 1024u));
    const int aoff = lds_byte(wr * 64 + fr, fq * 8), boff = lds_byte(wc * 32 + fr, fq * 8);
#define G8_SA(b, h) (((b) * 2 + (h)) * HTB)
#define G8_SB(b, h) ((4 + (b) * 2 + (h)) * HTB)
#define G8_GLDS(vo, sb, la) asm volatile("s_mov_b32 m0, %2\n\ts_nop 0\n\tglobal_load_lds_dwordx4 %0, %1" :: "v"(vo), "s"(sb), "s"(la) : "memory", "m0")
#define G8_STAGE(bufoff, gbase, voff, r64) do { const char* _g = (const char*)(gbase); const unsigned _l = ldsw + (unsigned)(bufoff); G8_GLDS(voff, _g, _l); \
        const char* _g2 = _g + (r64); G8_GLDS(voff, _g2, _l + 8192u); } while (0)
#define G8_LDA(dst, b, h) do { _Pragma("unroll") for (int m = 0; m < 4; ++m) _Pragma("unroll") for (int k = 0; k < 2; ++k) dst[m][k] = *(const LAS bf16x8*)(lds + G8_SA(b, h) + aoff + m * 2048 + k * 1024); } while (0)
#define G8_LDB(dst, b, h) do { _Pragma("unroll") for (int n = 0; n < 2; ++n) _Pragma("unroll") for (int k = 0; k < 2; ++k) dst[n][k] = *(const LAS bf16x8*)(lds + G8_SB(b, h) + boff + n * 2048 + k * 1024); } while (0)
#define G8_MMA(ai, bj, At, Bt) do { __builtin_amdgcn_s_setprio(1); _Pragma("unroll") for (int m = 0; m < 4; ++m) _Pragma("unroll") for (int n = 0; n < 2; ++n) { \
        if constexpr (Epi::FP8) acc[ai][bj][m][n] = __builtin_amdgcn_mfma_scale_f32_16x16x128_f8f6f4(cat8(Bt[n][0], Bt[n][1]), cat8(At[m][0], At[m][1]), acc[ai][bj][m][n], 0, 0, 0, 0, 0, 0); \
        else { _Pragma("unroll") for (int k = 0; k < 2; ++k) acc[ai][bj][m][n] = __builtin_amdgcn_mfma_f32_16x16x32_bf16(Bt[n][k], At[m][k], acc[ai][bj][m][n], 0, 0, 0); } } \
        __builtin_amdgcn_s_setprio(0); } while (0)
#define G8_WAIT_V(n) asm volatile("s_waitcnt vmcnt(" #n ")" ::: "memory")
#define G8_WAIT_L(n) asm volatile("s_waitcnt lgkmcnt(" #n ")" ::: "memory")
#define G8_BAR __builtin_amdgcn_s_barrier()
#define G8_SCHED __builtin_amdgcn_sched_barrier(0)
    G8Unit cur, nxt; int ui = 0;
    if (!S.next(0, cur)) return;
    f32x4 acc[2][2][4][2];
#pragma unroll
    for (int a = 0; a < 2; ++a)
#pragma unroll
        for (int b = 0; b < 2; ++b)
#pragma unroll
            for (int m = 0; m < 4; ++m)
#pragma unroll
                for (int n = 0; n < 2; ++n) acc[a][b][m][n] = E.init(cur, b, n, wc, fq);
    bf16x8 At[4][2], B0[2][2], B1[2][2];
    const char* cA = cur.A; const char* cB = cur.B;
    G8_STAGE(G8_SB(0, 0), cB, voffB, r64B); G8_STAGE(G8_SA(0, 0), cA, voffA, r64A); G8_STAGE(G8_SB(0, 1), cB + hstepB, voffB, r64B); G8_STAGE(G8_SA(0, 1), cA + hstepA, voffA, r64A);
    if (wr == 1) G8_BAR;
    G8_WAIT_V(4); G8_BAR;
    G8_STAGE(G8_SB(1, 0), cB + kstep, voffB, r64B); G8_STAGE(G8_SA(1, 0), cA + kstep, voffA, r64A); G8_STAGE(G8_SB(1, 1), cB + hstepB + kstep, voffB, r64B);
    G8_WAIT_V(6); G8_BAR;
    for (;;) {
        const bool has_next = S.next(ui + 1, nxt);
        const char* nA = has_next ? nxt.A : cA; const char* nB = has_next ? nxt.B : cB;
#pragma unroll 1
        for (int t = 0; t < nt; t += 2) {
            const bool last = (t == nt - 2);
            const char* a1 = cA + (size_t)(t + 1) * kstep;
            const char* a2 = last ? nA : cA + (size_t)(t + 2) * kstep; const char* b2 = last ? nB : cB + (size_t)(t + 2) * kstep;
            const char* a3 = a2 + kstep; const char* b3 = b2 + kstep;
            G8_LDB(B0, 0, 0); G8_SCHED; G8_LDA(At, 0, 0); G8_STAGE(G8_SA(1, 1), a1 + hstepA, voffA, r64A);
            G8_WAIT_L(8); G8_BAR; G8_WAIT_L(0); G8_MMA(0, 0, At, B0); G8_BAR; G8_SCHED;
            G8_LDB(B1, 0, 1); G8_STAGE(G8_SB(0, 0), b2, voffB, r64B);
            G8_BAR; G8_WAIT_L(0); G8_MMA(0, 1, At, B1); G8_BAR;
            G8_LDA(At, 0, 1); G8_STAGE(G8_SA(0, 0), a2, voffA, r64A);
            G8_BAR; G8_WAIT_L(0); G8_MMA(1, 0, At, B0); G8_BAR; G8_SCHED;
            G8_STAGE(G8_SB(0, 1), b2 + hstepB, voffB, r64B);
            G8_WAIT_V(6); G8_BAR; G8_MMA(1, 1, At, B1); G8_BAR;
            G8_LDB(B0, 1, 0); G8_SCHED; G8_LDA(At, 1, 0); G8_STAGE(G8_SA(0, 1), a2 + hstepA, voffA, r64A);
            G8_WAIT_L(8); G8_BAR; G8_WAIT_L(0); G8_MMA(0, 0, At, B0); G8_BAR; G8_SCHED;
            G8_LDB(B1, 1, 1); G8_STAGE(G8_SB(1, 0), b3, voffB, r64B);
            G8_BAR; G8_WAIT_L(0); G8_MMA(0, 1, At, B1); G8_BAR;
            G8_LDA(At, 1, 1); G8_STAGE(G8_SA(1, 0), a3, voffA, r64A);
            G8_BAR; G8_WAIT_L(0); G8_MMA(1, 0, At, B0); G8_BAR; G8_SCHED;
            G8_STAGE(G8_SB(1, 1), b3 + hstepB, voffB, r64B);
            G8_WAIT_V(6); G8_BAR; G8_MMA(1, 1, At, B1); G8_BAR;
        }
        if constexpr (!Epi::AFTER_DRAIN) E(acc, cur, wr, wc, fr, fq);
        if (!has_next) break;
#pragma unroll
        for (int a = 0; a < 2; ++a)
#pragma unroll
            for (int b = 0; b < 2; ++b)
#pragma unroll
                for (int m = 0; m < 4; ++m)
#pragma unroll
                    for (int n = 0; n < 2; ++n) acc[a][b][m][n] = E.init(nxt, b, n, wc, fq);
        cur = nxt; cA = nA; cB = nB; ++ui;
    }
    G8_WAIT_V(0);
    if (wr == 0) G8_BAR;
    G8_BAR;
    if constexpr (Epi::AFTER_DRAIN) E.drained(C, acc, cur, wr, wc, fr, fq);
#undef G8_SA
#undef G8_SB
#undef G8_STAGE
#undef G8_GLDS
#undef G8_LDA
#undef G8_LDB
#undef G8_MMA
#undef G8_WAIT_V
#undef G8_WAIT_L
#undef G8_BAR
#undef G8_SCHED
}
struct TileSched {
    const char* A; const char* B; size_t tstepA, tstepB; int nM, nN, G, c;
    __device__ __forceinline__ bool next(int i, G8Unit& u) const {
        const int L = i * G + c; if (L >= nM * nN) return false;
        int pm, pn; unit_map(L, nM, nN, pm, pn);
        u.A = A + (size_t)pm * tstepA; u.B = B + (size_t)pn * tstepB; u.e0 = pm; u.e1 = pn; u.e2 = 0; u.e3 = 0; return true;
    }
};
struct EpiBf16 {
    static constexpr bool PERM = true, AFTER_DRAIN = false; G8_EPI_PLAIN
    bf16_t* O; int ldo;
    __device__ __forceinline__ void operator()(const f32x4 (&acc)[2][2][4][2], const G8Unit& u, int wr, int wc, int fr, int fq) const {
        const int row0 = u.e0 * 256 + wr * 64 + fr, col0 = u.e1 * 256 + wc * 32 + 8 * fq;
#pragma unroll
        for (int ai = 0; ai < 2; ++ai)
#pragma unroll
            for (int m = 0; m < 4; ++m) { bf16_t* rowp = O + (size_t)(row0 + ai * 128 + m * 16) * ldo + col0;
#pragma unroll
                for (int bj = 0; bj < 2; ++bj) { const f32x4 v0 = acc[ai][bj][m][0], v1 = acc[ai][bj][m][1];
                    *(u32x4*)(rowp + bj * 128) = (u32x4){pk2(v0.x, v0.y), pk2(v0.z, v0.w), pk2(v1.x, v1.y), pk2(v1.z, v1.w)}; } }
    }
};
struct EpiInProj {
    static constexpr bool PERM = true, AFTER_DRAIN = false; G8_EPI_PLAIN
    bf16_t* P; float* out; int L;
    __device__ __forceinline__ void operator()(const f32x4 (&acc)[2][2][4][2], const G8Unit& u, int wr, int wc, int fr, int fq) const {
        const int row0 = u.e0 * 256 + wr * 64 + fr, col0 = u.e1 * 256 + wc * 32 + 8 * fq;
        const bool ctx = u.e0 < 32;
#pragma unroll
        for (int bj = 0; bj < 2; ++bj) { const int col = col0 + bj * 128;
            int W = 0, cc = 0; size_t off = 0;
            if (ctx) {
                if (col >= COL_KA && col < COL_VA) { off = OFF_NAK; W = 256; cc = col - COL_KA; }
                else if (col >= COL_VA && col < COL_CQ) { off = OFF_NAV; W = 256; cc = col - COL_VA; }
                else if (col >= COL_CKV && col < COL_KR) { off = OFF_CKV; W = 128; cc = col - COL_CKV; }
                else if (col >= COL_KR && col < COL_QC) { off = OFF_KR; W = 32; cc = col - COL_KR; }
                else if (col >= COL_KC && col < COL_VC) { off = OFF_SWK; W = 128; cc = col - COL_KC; }
                else if (col >= COL_VC && col < COL_PD) { off = OFF_SWV; W = 128; cc = col - COL_VC; }
            }
            float* dbase = out + off + cc;
#pragma unroll
            for (int ai = 0; ai < 2; ++ai)
#pragma unroll
                for (int m = 0; m < 4; ++m) { const int row = row0 + ai * 128 + m * 16; const f32x4 v0 = acc[ai][bj][m][0], v1 = acc[ai][bj][m][1];
                    if (col < IN_DIM) *(u32x4*)(P + (size_t)row * LDP + col) = (u32x4){pk2(v0.x, v0.y), pk2(v0.z, v0.w), pk2(v1.x, v1.y), pk2(v1.z, v1.w)};
                    if (W) { float* dst = dbase + (size_t)(((row >> 8) * 2 + L) * 256 + (row & 255)) * W; *(f32x4*)dst = v0; *(f32x4*)(dst + 4) = v1; } }
        }
    }
};
__device__ __forceinline__ void phase2(const Params& p, Ctx& C, int L) {
    TileSched S{(const char*)(p.ws + WS_H), (const char*)(p.ws + WS_W + (size_t)L * W_LAYER + WO_IN), (size_t)256 * LDH * 2, (size_t)256 * LDW * 2, 48, 8, C.G, C.bid};
    EpiInProj E{(bf16_t*)(p.ws + WS_P), p.out, L};
    gemm8(C, DM, LDH, LDW, S, E);
}

__device__ __forceinline__ void rope_pair(bf16_t* p1, bf16_t* p2, float pos, float inv) {
    const float ang = pos * inv; float rev = ang * 0.15915494309189535f; rev -= floorf(rev);
    const float s = __builtin_amdgcn_sinf(rev), c = __builtin_amdgcn_cosf(rev);
    const float x1 = bf2f(*p1), x2 = bf2f(*p2);
    const unsigned o = pk2(x1 * c - x2 * s, x1 * s + x2 * c);
    *p1 = (bf16_t)(o & 0xffffu); *p2 = (bf16_t)(o >> 16);
}
__device__ __forceinline__ void phase3(const Params& p, Ctx& C, int L) {
    bf16_t* P = (bf16_t*)(p.ws + WS_P);
    {
        const int gw = C.bid * 8 + C.wid, NGW = C.G * 8;
        for (int t = gw; t < NLAT; t += NGW) {
            bf16_t* row = P + (size_t)(NCTX + t) * LDP; const int pos = t & 2047; const float prow = (float)(pos >> 6), pcol = (float)(pos & 63);
            for (int i = C.lane; i < 208; i += 64) {
                if (i < 16) { const int blk = i >> 3, f = i & 7; bf16_t* b = row + COL_KR + blk * 16 + f; rope_pair(b, b + 8, blk ? pcol : prow, exp2f(-(float)f * (13.287712379549449f / 8.0f))); }
                else { const int j = i - 16, head = j >> 5, blk = (j >> 4) & 1, f = j & 15;
                    bf16_t* b = row + COL_QC + head * 64 + blk * 32 + f; rope_pair(b, b + 16, blk ? pcol : prow, exp2f(-(float)f * (13.287712379549449f / 16.0f))); }
            }
        }
    }
    const int wr = C.wid >> 2, wc = C.wid & 3;
    LAS float* rs = (LAS float*)(C.lds + LDS_TAB);
    const unsigned char* wb = p.ws + WS_W + (size_t)L * W_LAYER;
    int R, Cc; stage_rc(C.wid * 1024 + C.lane * 16, R, Cc);
    const int Rb = (R & ~31) + perm32(R & 31);
    for (int u = C.bid; u < 96 * 7 + 4 * 4; u += C.G) {
        int pm, tn;
        if (u < 672) { pm = u / 7; tn = u % 7; } else { const int r = u - 672; pm = 96 + (r >> 2); tn = 3 + (r & 3); }
        const int which = tn >= 3, K = which ? 128 : 192, nkt = K / 64, ldb = which ? LDUKV : LDUQ, n0 = (which ? tn - 3 : tn) * 128;
        const bf16_t* A; int lda;
        if (pm < 96) { A = P + (size_t)pm * 128 * LDP + (which ? COL_CKV : COL_CQ); lda = LDP; }
        else { A = (const bf16_t*)(p.ws + WS_CKVC) + (size_t)(L * 512 + (pm - 96) * 128) * LDCKVC; lda = LDCKVC; }
        const bf16_t* B = (const bf16_t*)(wb + (which ? WO_UKV : WO_UQ)) + (size_t)n0 * ldb;
        for (int t = 0; t < nkt; ++t) { LAS unsigned char* base = C.lds + t * 32768 + C.wid * 1024;
            const bf16_t* a = A + (size_t)R * lda + Cc + t * 64; const bf16_t* bq = B + (size_t)Rb * ldb + Cc + t * 64;
            GLDS16(a, base); GLDS16(a + (size_t)64 * lda, base + 8192); GLDS16(bq, base + 16384); GLDS16(bq + (size_t)64 * ldb, base + 16384 + 8192); }
        VM_WAIT(); __syncthreads();
        { const int row = C.tid >> 2, part = C.tid & 3; float ss = 0.f;
            for (int c = part; c < K / 8; c += 4) { const int t = c >> 3, cc = (c & 7) * 8; const u32x4 q = *(const LAS u32x4*)(C.lds + t * 32768 + lds_byte(row, cc));
                ss += lo16(q.x) * lo16(q.x) + hi16(q.x) * hi16(q.x) + lo16(q.y) * lo16(q.y) + hi16(q.y) * hi16(q.y) + lo16(q.z) * lo16(q.z) + hi16(q.z) * hi16(q.z) + lo16(q.w) * lo16(q.w) + hi16(q.w) * hi16(q.w); }
            ss += __shfl_xor(ss, 1); ss += __shfl_xor(ss, 2);
            if (part == 0) rs[row] = __builtin_amdgcn_rsqf(ss / (float)K + EPS); }
        f32x4 acc[4][2]; ZERO_ACC(acc, 4, 2);
        for (int t = 0; t < nkt; ++t) gemm_compute<128, 128, 4, 2>(C, t, wr, wc, acc);
        __syncthreads();
        bf16_t* O; int ldo;
        if (pm < 96) { if (which) { O = (bf16_t*)(p.ws + WS_KVUP) + (size_t)pm * 128 * LDKV; ldo = LDKV; } else { O = (bf16_t*)(p.ws + WS_QUP) + (size_t)pm * 128 * LDQ; ldo = LDQ; } }
        else { O = (bf16_t*)(p.ws + WS_KVCUP) + (size_t)(L * 512 + (pm - 96) * 128) * LDKV; ldo = LDKV; }
#pragma unroll
        for (int m = 0; m < 4; ++m) { const int r = wr * 64 + m * 16 + C.fr; const float sc = rs[r]; const f32x4 v0 = acc[m][0] * sc, v1 = acc[m][1] * sc;
            *(u32x4*)(O + (size_t)r * ldo + n0 + wc * 32 + 8 * C.fq) = (u32x4){pk2(v0.x, v0.y), pk2(v0.z, v0.w), pk2(v1.x, v1.y), pk2(v1.z, v1.w)}; }
        __syncthreads();
    }
}

struct AttnSeg { const bf16_t* K; const bf16_t* K2; const bf16_t* V; int ldk, ldk2, ldv, n, tok0; };
struct AttnDesc { const bf16_t* Q; bf16_t* O; AttnSeg seg[2]; int ldq, ldo; float c1, m0, l0; int qtok0; int rope_q; };
typedef short v4i16_t __attribute__((ext_vector_type(4)));
__device__ __forceinline__ s16x4 vtr(const LAS unsigned char* p) { return __builtin_bit_cast(s16x4, __builtin_amdgcn_ds_read_tr16_b64_v4i16((LAS v4i16_t*)p)); }

template <int DQK, int KIND>
__device__ __forceinline__ void attn_unit(const Ctx& C, const AttnDesc& D, const LAS float* rpb) {
    constexpr int KROW = DQK * 2 + 16, VROW = 160, KBYTES = 64 * KROW, BUFB = KBYTES + 64 * VROW, CPK = DQK / 8, NKC = 64 * CPK;
    const int fr = C.fr, fq = C.fq, q = C.wid * 16 + fr;
    bf16x8 Qf[DQK / 32];
    const bf16_t* qrow = D.Q + (size_t)q * D.ldq;
#pragma unroll
    for (int s = 0; s < DQK / 32; ++s) Qf[s] = *(const bf16x8*)(qrow + s * 32 + fq * 8);
    const int qtok = D.qtok0 + q;
    if (DQK == 96 && D.rope_q) {
        bf16x8 mine = Qf[2], oth;
#pragma unroll
        for (int j = 0; j < 8; ++j) oth[j] = (short)__shfl_xor((int)mine[j], 16);
        const float pos = (fq < 2) ? (float)(qtok >> 6) : (float)(qtok & 63);
#pragma unroll
        for (int j = 0; j < 8; j += 2) {
            float o2[2];
#pragma unroll
            for (int e = 0; e < 2; ++e) {
                const float ang = pos * exp2f(-(float)(j + e) * (13.287712379549449f / 8.0f)); float rev = ang * 0.15915494309189535f; rev -= floorf(rev);
                const float sn = __builtin_amdgcn_sinf(rev), cs = __builtin_amdgcn_cosf(rev);
                const float a = bf2f((bf16_t)mine[j + e]), b = bf2f((bf16_t)oth[j + e]);
                o2[e] = (fq & 1) ? (b * sn + a * cs) : (a * cs - b * sn);
            }
            const unsigned pk = pk2(o2[0], o2[1]); Qf[2][j] = (short)(pk & 0xffffu); Qf[2][j + 1] = (short)(pk >> 16);
        }
    }
    float m = D.m0, l = D.l0 * (fq == 0 ? 1.0f : 0.0f);
    f32x4 Oa[4]; for (int d = 0; d < 4; ++d) Oa[d] = (f32x4){0.f, 0.f, 0.f, 0.f};
    int qrow_g = 0, qcol_g = 0, r0 = 0, cs0 = 0;
    if (KIND == 1) { qrow_g = qtok >> 6; qcol_g = qtok & 63; r0 = min(max(qrow_g - 4, 0), 24); cs0 = min(max(qcol_g - 8, 0), 48); }

    const int nt0 = D.seg[0].n >> 6, ntot = nt0 + (D.seg[1].n >> 6);
    u32x4 kreg[(NKC + 511) / 512], vreg;
    auto issue = [&](int t) {
        const AttnSeg& sg = (t < nt0) ? D.seg[0] : D.seg[1]; const int k0 = ((t < nt0) ? t : t - nt0) * 64;
#pragma unroll
        for (int i = 0; i < (NKC + 511) / 512; ++i) { const int c = C.tid + i * 512;
            if (c < NKC) { const int key = c / CPK, part = c % CPK;
                const bf16_t* src = (part < 8) ? sg.K + (size_t)(k0 + key) * sg.ldk + part * 8 : sg.K2 + (size_t)(k0 + key) * sg.ldk2 + (part - 8) * 8;
                kreg[i] = *(const u32x4*)src; } }
        { const int key = C.tid >> 3, part = C.tid & 7; vreg = *(const u32x4*)(sg.V + (size_t)(k0 + key) * sg.ldv + part * 8); }
    };
    auto commit = [&](int buf) {
        LAS unsigned char* kb = C.lds + buf * BUFB; LAS unsigned char* vb = kb + KBYTES;
#pragma unroll
        for (int i = 0; i < (NKC + 511) / 512; ++i) { const int c = C.tid + i * 512; if (c < NKC) { const int key = c / CPK, part = c % CPK; *(LAS u32x4*)(kb + key * KROW + part * 16) = kreg[i]; } }
        { const int key = C.tid >> 3, part = C.tid & 7; *(LAS u32x4*)(vb + key * VROW + part * 16) = vreg; }
    };
    issue(0);
    for (int t = 0; t < ntot; ++t) {
        const int buf = t & 1;
        commit(buf);
        __syncthreads();
        if (t + 1 < ntot) issue(t + 1);
        const LAS unsigned char* kb = C.lds + buf * BUFB; const LAS unsigned char* vb = kb + KBYTES;
        f32x4 s[4];
#pragma unroll
        for (int kg = 0; kg < 4; ++kg) {
            s[kg] = (f32x4){0.f, 0.f, 0.f, 0.f};
#pragma unroll
            for (int ks = 0; ks < DQK / 32; ++ks) { const bf16x8 Kf = *(const LAS bf16x8*)(kb + (kg * 16 + fr) * KROW + ks * 64 + fq * 16); s[kg] = __builtin_amdgcn_mfma_f32_16x16x32_bf16(Kf, Qf[ks], s[kg], 0, 0, 0); }
        }
        const bool seg1 = (t >= nt0);
        const int ktile0 = seg1 ? D.seg[1].tok0 + (t - nt0) * 64 : 0;
        float mx = -1e30f;
#pragma unroll
        for (int kg = 0; kg < 4; ++kg)
#pragma unroll
            for (int j = 0; j < 4; ++j) {
                float v = s[kg][j] * D.c1;
                if (KIND == 1 && seg1) { const int kt = ktile0 + kg * 16 + 4 * fq + j, krow = kt >> 6, kcol = kt & 63;
                    const bool ok = (krow >= r0) && (krow < r0 + 8) && (kcol >= cs0) && (kcol < cs0 + 16);
                    const int dr = min(max(krow - qrow_g + 7, 0), 14), dc = min(max(kcol - qcol_g + 15, 0), 30);
                    v = ok ? v + rpb[dr * 31 + dc] : -1e30f; }
                if (KIND == 2 && seg1) { const int kt = ktile0 + kg * 16 + 4 * fq + j; const int dd = kt - qtok; v = (dd <= 128 && dd >= -128) ? v : -1e30f; }
                s[kg][j] = v; mx = fmaxf(mx, v);
            }
        mx = qmax4(mx);
        const float mn = fmaxf(m, mx), alpha = __builtin_amdgcn_exp2f(m - mn); m = mn;
        float ps = 0.f;
#pragma unroll
        for (int kg = 0; kg < 4; ++kg)
#pragma unroll
            for (int j = 0; j < 4; ++j) { const float e = __builtin_amdgcn_exp2f(s[kg][j] - mn); s[kg][j] = e; ps += e; }
        l = l * alpha + ps;
#pragma unroll
        for (int d = 0; d < 4; ++d) Oa[d] = Oa[d] * alpha;
#pragma unroll
        for (int k2 = 0; k2 < 2; ++k2) {
            u32x4 pw; pw.x = pk2(s[2 * k2][0], s[2 * k2][1]); pw.y = pk2(s[2 * k2][2], s[2 * k2][3]); pw.z = pk2(s[2 * k2 + 1][0], s[2 * k2 + 1][1]); pw.w = pk2(s[2 * k2 + 1][2], s[2 * k2 + 1][3]);
            const bf16x8 Pf = __builtin_bit_cast(bf16x8, pw);
#pragma unroll
            for (int d = 0; d < 4; ++d) {
                const LAS unsigned char* a0 = vb + (32 * k2 + 4 * fq + (fr >> 2)) * VROW + (d * 16 + 4 * (fr & 3)) * 2;
                const s16x4 lo = vtr(a0), hi = vtr(a0 + 16 * VROW);
                const bf16x8 Vf = (bf16x8){lo[0], lo[1], lo[2], lo[3], hi[0], hi[1], hi[2], hi[3]};
                Oa[d] = __builtin_amdgcn_mfma_f32_16x16x32_bf16(Vf, Pf, Oa[d], 0, 0, 0);
            }
        }
    }
    l += __shfl_xor(l, 16); l += __shfl_xor(l, 32);
    const float inv = 1.0f / l;
    __syncthreads();
    { LAS unsigned char* st = C.lds + C.wid * 2048;
#pragma unroll
        for (int d = 0; d < 4; ++d) { const f32x4 v = Oa[d] * inv; *(LAS u32x2*)(st + fr * 128 + (d * 16 + 4 * fq) * 2) = (u32x2){pk2(v.x, v.y), pk2(v.z, v.w)}; }
        asm volatile("s_waitcnt lgkmcnt(0)" ::: "memory");
#pragma unroll
        for (int i = 0; i < 2; ++i) { const int row = i * 8 + (C.lane >> 3), ch = C.lane & 7; const u32x4 v = *(const LAS u32x4*)(st + row * 128 + ch * 16);
            *(u32x4*)(D.O + (size_t)(C.wid * 16 + row) * D.ldo + ch * 8) = v; }
    }
    __syncthreads();
}

__device__ __forceinline__ void pool_unit(const Params& p, Ctx& C, int L, int unit) {
    const bf16_t* P = (const bf16_t*)(p.ws + WS_P); bf16_t* BR = (bf16_t*)(p.ws + WS_BR);
    CTX_FRESH(C);
    constexpr int WROW = 160, DROW = 544;
    const int T0 = unit * 64; int S0, Ls; if (T0 < NCTX) { S0 = T0 & ~255; Ls = 256; } else { S0 = NCTX + ((T0 - NCTX) & ~2047); Ls = 2048; }
    LAS bf16_t* raw = (LAS bf16_t*)C.lds;
    LAS unsigned char* wl = C.lds + 40960;
    LAS unsigned char* dl = C.lds + 81920;
    f32x4 wreg[8];
    { const f32x4* Wg = (const f32x4*)(p.in[25] + (size_t)L * 4 * 64 * 64);
#pragma unroll
        for (int i = 0; i < 8; ++i) wreg[i] = Wg[C.tid + i * 512]; }
    for (int i = C.tid; i < 80 * 32; i += 512) { const int r = i >> 5, c = i & 31; const int T = T0 - 8 + r;
        u32x4 v = (u32x4){0u, 0u, 0u, 0u}; if (T >= S0 && T < S0 + Ls) v = *(const u32x4*)(P + (size_t)T * LDP + COL_PD + c * 8);
        *(LAS u32x4*)(raw + r * 256 + c * 8) = v; }
#pragma unroll
    for (int i = 0; i < 8; ++i) { const int e4 = (C.tid + i * 512) * 4, gi = e4 >> 12, c = (e4 >> 6) & 63, e = e4 & 63;
        *(LAS u32x2*)(wl + (gi * 64 + c) * WROW + e * 2) = (u32x2){pk2(wreg[i].x, wreg[i].y), pk2(wreg[i].z, wreg[i].w)}; }
    __syncthreads();
    { const int ch = C.tid & 255, t0 = (C.tid >> 8) * 32, gi = __builtin_amdgcn_readfirstlane(ch >> 6), hw = 1 << gi;
        const LAS bf16_t* col = raw + ch;
        float sum = 0.f;
        for (int r = t0 + 8 - hw; r < t0 + 8 + hw; ++r) sum += bf2f(col[r * 256]);
        const int tl0 = T0 - S0 + t0;
#pragma unroll 4
        for (int i = 0; i < 32; ++i) { const int t = t0 + i, tl = tl0 + i; const int lo = max(tl - hw, 0), hi = min(tl + hw, Ls);
            const float d = sum * __builtin_amdgcn_rcpf((float)(hi - lo)) - bf2f(col[(t + 8) * 256]);
            *(LAS bf16_t*)(dl + t * DROW + ch * 2) = (bf16_t)(pk2(d, 0.f) & 0xffffu);
            sum += bf2f(col[(t + 8 + hw) * 256]) - bf2f(col[(t + 8 - hw) * 256]); }
    }
    __syncthreads();
    { const int gi = C.wid & 3, mh = C.wid >> 2, fr = C.fr, fq = C.fq;
        f32x4 acc[2][4];
#pragma unroll
        for (int mb = 0; mb < 2; ++mb)
#pragma unroll
            for (int d = 0; d < 4; ++d) acc[mb][d] = (f32x4){0.f, 0.f, 0.f, 0.f};
#pragma unroll
        for (int ks = 0; ks < 2; ++ks) {
            bf16x8 Af[2];
#pragma unroll
            for (int mb = 0; mb < 2; ++mb) { const LAS unsigned char* ap = dl + (mh * 32 + mb * 16 + fr) * DROW + (gi * 64 + ks * 32 + 4 * fq) * 2;
                const s16x4 lo = *(const LAS s16x4*)ap, hi = *(const LAS s16x4*)(ap + 32); Af[mb] = (bf16x8){lo[0], lo[1], lo[2], lo[3], hi[0], hi[1], hi[2], hi[3]}; }
#pragma unroll
            for (int d = 0; d < 4; ++d) { const LAS unsigned char* a0 = wl + (gi * 64 + 32 * ks + 4 * fq + (fr >> 2)) * WROW + (d * 16 + 4 * (fr & 3)) * 2;
                const s16x4 lo = vtr(a0), hi = vtr(a0 + 16 * WROW);
                const bf16x8 Wf = (bf16x8){lo[0], lo[1], lo[2], lo[3], hi[0], hi[1], hi[2], hi[3]};
#pragma unroll
                for (int mb = 0; mb < 2; ++mb) acc[mb][d] = __builtin_amdgcn_mfma_f32_16x16x32_bf16(Wf, Af[mb], acc[mb][d], 0, 0, 0); }
        }
        const float* sc = p.in[26] + L * 256 + gi * 64 + 4 * fq;
#pragma unroll
        for (int d = 0; d < 4; ++d) { const f32x4 s4 = *(const f32x4*)(sc + d * 16);
#pragma unroll
            for (int mb = 0; mb < 2; ++mb) { const f32x4 v = acc[mb][d] * s4;
                *(u32x2*)(BR + (size_t)(T0 + mh * 32 + mb * 16 + fr) * LDH + 768 + gi * 64 + d * 16 + 4 * fq) = (u32x2){pk2(v.x, v.y), pk2(v.z, v.w)}; } }
    }
    __syncthreads();
}

__device__ __forceinline__ void phase4(const Params& p, Ctx& C, int L, int rep = 0) {
    const bf16_t* P = (const bf16_t*)(p.ws + WS_P); bf16_t* BR = (bf16_t*)(p.ws + WS_BR);
    const bf16_t* QUP = (const bf16_t*)(p.ws + WS_QUP); const bf16_t* KVUP = (const bf16_t*)(p.ws + WS_KVUP);
    const bf16_t* KVC = (const bf16_t*)(p.ws + WS_KVCUP) + (size_t)L * 512 * LDKV;
    const bf16_t* NAK = (const bf16_t*)(p.ws + WS_NACK) + (size_t)L * 512 * LDNAC; const bf16_t* NAV = (const bf16_t*)(p.ws + WS_NACV) + (size_t)L * 512 * LDNAC;
    const bf16_t* SWK = (const bf16_t*)(p.ws + WS_SWCK) + (size_t)L * 512 * LDSWC; const bf16_t* SWV = (const bf16_t*)(p.ws + WS_SWCV) + (size_t)L * 512 * LDSWC;
    const bf16_t* KRC = (const bf16_t*)(p.ws + WS_KRC) + (size_t)L * 512 * 32;
    unsigned* qhead = (unsigned*)(p.ws + WS_CTL) + CW_QUEUE + 64 * (L * 2 + rep);
    volatile LAS unsigned* bc = (volatile LAS unsigned*)(C.lds + LDS_CTL + 16);
    LAS float* rpb = (LAS float*)(C.lds + LDS_TAB);
    const float ATT_C1 = 0.125f * LOG2E, MLA_C1 = 0.10206207261596575f * LOG2E;
    for (;;) {
        if (C.tid == 0) bc[0] = atomicAdd(qhead, 1u);
        __syncthreads();
        const int u = __builtin_amdgcn_readfirstlane((int)bc[0]);
        __syncthreads();
        if (u >= 1344) break;
        AttnDesc D; D.rope_q = 0; D.m0 = -1e30f; D.l0 = 0.f; D.seg[1].K2 = nullptr; D.seg[0].K2 = nullptr; D.seg[0].ldk2 = 0; D.seg[1].ldk2 = 0; D.seg[0].tok0 = 0; D.seg[1].tok0 = 0;
        if (u < 128) {
            const int b = u >> 6, h = (u >> 4) & 3, qb = u & 15; const int T0 = NCTX + b * 2048;
            D.Q = QUP + (size_t)(T0 + qb * 128) * LDQ + h * 96; D.ldq = LDQ; D.O = BR + (size_t)(T0 + qb * 128) * LDH + 256 + h * 64; D.ldo = LDH;
            D.seg[0] = AttnSeg{KVC + (size_t)b * 256 * LDKV + h * 128, KRC + (size_t)b * 256 * 32, KVC + (size_t)b * 256 * LDKV + h * 128 + 64, LDKV, 32, LDKV, 256, 0};
            D.seg[1] = AttnSeg{KVUP + (size_t)T0 * LDKV + h * 128, P + (size_t)T0 * LDP + COL_KR, KVUP + (size_t)T0 * LDKV + h * 128 + 64, LDKV, LDP, LDKV, 2048, 0};
            D.c1 = MLA_C1; D.qtok0 = qb * 128; D.rope_q = 1;
#ifndef NO_A1
            attn_unit<96, 0>(C, D, rpb);
#endif
        } else if (u < 256) {
            const int v = u - 128, b = v >> 6, h = (v >> 4) & 3, rp = v & 15; const int T0 = NCTX + b * 2048;
            const int ra = 2 * rp, r0a = min(max(ra - 4, 0), 24), r0b = min(max(ra + 1 - 4, 0), 24);
            for (int i = C.tid; i < 15 * 31; i += 512) rpb[i] = p.in[19][(size_t)(L * 4 + h) * 465 + i] * LOG2E;
            D.Q = P + (size_t)(T0 + ra * 64) * LDP + COL_QA + h * 64; D.ldq = LDP; D.O = BR + (size_t)(T0 + ra * 64) * LDH + 0 + h * 64; D.ldo = LDH;
            D.seg[0] = AttnSeg{NAK + (size_t)b * 256 * LDNAC + h * 64, nullptr, NAV + (size_t)b * 256 * LDNAC + h * 64, LDNAC, 0, LDNAC, 256, 0};
            D.seg[1] = AttnSeg{P + (size_t)(T0 + r0a * 64) * LDP + COL_KA + h * 64, nullptr, P + (size_t)(T0 + r0a * 64) * LDP + COL_VA + h * 64, LDP, 0, LDP, (r0b + 8 - r0a) * 64, r0a * 64};
            D.c1 = ATT_C1; D.qtok0 = ra * 64;
            __syncthreads();
#ifndef NO_A2
            attn_unit<64, 1>(C, D, rpb);
#endif
        } else if (u < 384) {
            const int v = u - 256, b = v >> 6, h = (v >> 4) & 3, qb = v & 15; const int T0 = NCTX + b * 2048, kvh = h >> 1;
            const int klo = max(qb * 128 - 128, 0), khi = min(qb * 128 + 256, 2048);
            D.Q = P + (size_t)(T0 + qb * 128) * LDP + COL_QC + h * 64; D.ldq = LDP; D.O = BR + (size_t)(T0 + qb * 128) * LDH + 512 + h * 64; D.ldo = LDH;
            D.seg[0] = AttnSeg{SWK + (size_t)b * 256 * LDSWC + kvh * 64, nullptr, SWV + (size_t)b * 256 * LDSWC + kvh * 64, LDSWC, 0, LDSWC, 256, 0};
            D.seg[1] = AttnSeg{P + (size_t)(T0 + klo) * LDP + COL_KC + kvh * 64, nullptr, P + (size_t)(T0 + klo) * LDP + COL_VC + kvh * 64, LDP, 0, LDP, khi - klo, klo};
            D.c1 = ATT_C1; D.qtok0 = qb * 128; D.m0 = p.in[24][L * 4 + h] * LOG2E; D.l0 = 1.0f;
#ifndef NO_A3
            attn_unit<64, 2>(C, D, rpb);
#endif
        } else if (u >= 576) {
            const int v = u - 576, half = v & 1, kh = (v >> 1) % 12, b = (v >> 1) / 12, kind = kh >> 2, h = kh & 3; const int T0 = b * 256, Tq = T0 + half * 128;
            D.qtok0 = half * 128; D.seg[1].n = 0; D.seg[1].K = nullptr; D.seg[1].V = nullptr; D.seg[1].ldk = 0; D.seg[1].ldv = 0;
            if (kind == 0) {
                D.Q = P + (size_t)Tq * LDP + COL_QA + h * 64; D.ldq = LDP; D.O = BR + (size_t)Tq * LDH + h * 64; D.ldo = LDH;
                D.seg[0] = AttnSeg{P + (size_t)T0 * LDP + COL_KA + h * 64, nullptr, P + (size_t)T0 * LDP + COL_VA + h * 64, LDP, 0, LDP, 256, 0};
#ifndef NO_A4
                D.c1 = ATT_C1; attn_unit<64, 0>(C, D, rpb);
#endif
            } else if (kind == 1) {
                D.Q = QUP + (size_t)Tq * LDQ + h * 96; D.ldq = LDQ; D.O = BR + (size_t)Tq * LDH + 256 + h * 64; D.ldo = LDH;
                D.seg[0] = AttnSeg{KVUP + (size_t)T0 * LDKV + h * 128, P + (size_t)T0 * LDP + COL_KR, KVUP + (size_t)T0 * LDKV + h * 128 + 64, LDKV, LDP, LDKV, 256, 0};
#ifndef NO_A5
                D.c1 = MLA_C1; attn_unit<96, 0>(C, D, rpb);
#endif
            } else {
                const int kvh = h >> 1;
                D.Q = P + (size_t)Tq * LDP + COL_QC + h * 64; D.ldq = LDP; D.O = BR + (size_t)Tq * LDH + 512 + h * 64; D.ldo = LDH;
                D.seg[0] = AttnSeg{P + (size_t)T0 * LDP + COL_KC + kvh * 64, nullptr, P + (size_t)T0 * LDP + COL_VC + kvh * 64, LDP, 0, LDP, 256, 0};
#ifndef NO_A6
                D.c1 = ATT_C1; D.m0 = p.in[24][L * 4 + h] * LOG2E; D.l0 = 1.0f; attn_unit<64, 0>(C, D, rpb);
#endif
            }
        } else {
#ifndef NO_POOL
            pool_unit(p, C, L, u - 384);
#endif
        }
    }
}

struct BrSched {
    const char* BR; const char* Wb; int G, c;
    __device__ __forceinline__ bool next(int i, G8Unit& u) const {
        const int Lu = i * G + c; if (Lu >= 48 * 16) return false;
        int pm, q; unit_map(Lu, 48, 16, pm, q);
        u.A = BR + (size_t)pm * 256 * LDH * 2 + (q >> 2) * 512; u.B = Wb + (size_t)q * 256 * LDWB * 2; u.e0 = pm; u.e1 = q; u.e2 = 0; u.e3 = 0; return true;
    }
};
struct EpiBK {
    static constexpr bool PERM = true, AFTER_DRAIN = false; G8_EPI_PLAIN
    bf16_t* O;
    __device__ __forceinline__ void operator()(const f32x4 (&acc)[2][2][4][2], const G8Unit& u, int wr, int wc, int fr_, int fq_) const {
        const int ln = hw_lane(), fr = ln & 15, fq = ln >> 4;
        const int k = u.e1 >> 2, pn4 = u.e1 & 3;
        char* base = (char*)O + ((size_t)((u.e0 * 16 + wr * 4) * 4 + k) * 256 + pn4 * 64 + wc * 8) * 128;
        const unsigned lo = (unsigned)(2 * fq * 16 + fr) * 8u;
#pragma unroll
        for (int ai = 0; ai < 2; ++ai)
#pragma unroll
            for (int m = 0; m < 4; ++m)
#pragma unroll
                for (int bj = 0; bj < 2; ++bj) { char* q = base + ((size_t)(ai * 8 + m) * 4 * 256 + bj * 32) * 128; asm volatile("" : "+s"(q));
                    const f32x4 v0 = acc[ai][bj][m][0], v1 = acc[ai][bj][m][1];
                    *(GAS u32x2*)(q + lo) = (u32x2){pk2(v0.x, v0.y), pk2(v0.z, v0.w)}; *(GAS u32x2*)(q + lo + 128) = (u32x2){pk2(v1.x, v1.y), pk2(v1.z, v1.w)}; }
    }
};
__device__ __forceinline__ void phase5a(const Params& p, Ctx& C, int L) {
    BrSched S{(const char*)(p.ws + WS_BR), (const char*)(p.ws + WS_W + (size_t)L * W_LAYER + WO_BR), C.G, C.bid};
    EpiBK E{(bf16_t*)(p.ws + WS_BK)};
    gemm8(C, 256, LDH, LDWB, S, E);
}
template <int VAR> struct EpiGateT {
    static constexpr bool PERM = false, AFTER_DRAIN = false, FP8 = true; static constexpr int HROWS_B = 2048;
    static __device__ __forceinline__ int brow(int R) { return ((R >> 4) & 1) * 1024 + (R >> 5) * 16 + (R & 15); }
    const bf16_t* BK; bf16_t* MG; const LAS float* bl;
    __device__ __forceinline__ f32x4 init(const G8Unit& u, int bj, int n, int wc, int fq) const { return *(const LAS f32x4*)(bl + (2 * bj + n) * 1024 + u.e1 * 64 + wc * 16 + 4 * fq); }
    __device__ __forceinline__ void operator()(const f32x4 (&acc)[2][2][4][2], const G8Unit& u, int wr, int wc, int fr_, int fq_) const {
        const int ln = hw_lane(), fr = ln & 15, fq = ln >> 4;
        const int xw = u.e1 * 64 + wc * 16;
#define SPIN_(ptr) asm volatile("" : "+s"(ptr))
        const char* bkb = (const char*)BK + ((size_t)(u.e0 * 16 + wr * 4) * 4 * 256 + u.e1 * 16 + wc * 4) * 128;
        char* mgb = (char*)MG + ((size_t)(u.e0 * 256 + wr * 64) * LDH + xw) * 2;
        const unsigned lob = (unsigned)(fq * 16 + fr) * 8u, lom = (unsigned)(fr * LDH + 4 * fq) * 2u;
        __builtin_amdgcn_sched_barrier(0);
        u32x2 b[8][4];
#pragma unroll
        for (int am = 0; am < 8; ++am) {
#pragma unroll
            for (int k = 0; k < 4; ++k) { const char* r = bkb + ((size_t)((am >> 2) * 8 + (am & 3)) * 4 + k) * 256 * 128; SPIN_(r); b[am][k] = *(const GAS u32x2*)(r + lob); } }
        __builtin_amdgcn_sched_barrier(0);
#pragma unroll
        for (int am = 0; am < 8; ++am) {
            f32x4 sum = (f32x4){0.f, 0.f, 0.f, 0.f};
#pragma unroll
            for (int k = 0; k < 4; ++k) { const f32x4 t = acc[am >> 2][k >> 1][am & 3][k & 1] * (-LOG2E_ * 0.03125f);
                const f32x4 e = (f32x4){__builtin_amdgcn_exp2f(t.x), __builtin_amdgcn_exp2f(t.y), __builtin_amdgcn_exp2f(t.z), __builtin_amdgcn_exp2f(t.w)} + 1.0f;
                const f32x4 g = (f32x4){__builtin_amdgcn_rcpf(e.x), __builtin_amdgcn_rcpf(e.y), __builtin_amdgcn_rcpf(e.z), __builtin_amdgcn_rcpf(e.w)};
                sum += g * (f32x4){lo16(b[am][k].x), hi16(b[am][k].x), lo16(b[am][k].y), hi16(b[am][k].y)}; }
            char* mp = mgb + (size_t)((am >> 2) * 128 + (am & 3) * 16) * LDH * 2; SPIN_(mp);
            *(GAS u32x2*)(mp + lom) = (u32x2){pk2(sum.x, sum.y), pk2(sum.z, sum.w)};
            __builtin_amdgcn_sched_barrier(0);
        }
#undef SPIN_
    }
};
template <int VAR> __device__ __forceinline__ void phase5b(const Params& p, Ctx& C, int L) {
    TileSched S{(const char*)(p.ws + WS_H8), (const char*)(p.ws + WS_W + (size_t)L * W_LAYER + WO_GATE), (size_t)256 * LD8, (size_t)64 * LD8, 48, 16, C.G, C.bid};
    LAS float* bl = (LAS float*)(C.lds + 131072);
    { const float* bg = p.in[18] + (size_t)L * 4096; for (int i = C.tid; i < 1024; i += 512) ((LAS f32x4*)bl)[i] = ((const f32x4*)bg)[i] * 32.0f; }
    __syncthreads();
    EpiGateT<VAR> E{(const bf16_t*)(p.ws + WS_BK), (bf16_t*)(p.ws + (VAR ? WS_BR : WS_MERGED)), bl};
    gemm8(C, 512, LD8 / 2, LD8 / 2, S, E);
}

__device__ __forceinline__ void gemm_bf16_phase(Ctx& C, const bf16_t* A, int lda, const bf16_t* Bt, int ldb, int K, bf16_t* O, int ldo, int nM, int nN) {
    TileSched S{(const char*)A, (const char*)Bt, (size_t)256 * lda * 2, (size_t)256 * ldb * 2, nM, nN, C.G, C.bid};
    EpiBf16 E{O, ldo};
    gemm8(C, K, lda, ldb, S, E);
}


struct RowSumSq {
    float* xbuf;
    unsigned* cnt;
    __device__ __forceinline__ void run(const Ctx& C, const f32x4 (&v)[2][2][4][2], int pm, int pn, int wr, int wc, int fr, int fq, float (&rs)[2][4]) const {
        LAS float* P = (LAS float*)C.lds;
        LAS float* S = (LAS float*)(C.lds + 4096);
#pragma unroll
        for (int ai = 0; ai < 2; ++ai)
#pragma unroll
            for (int m = 0; m < 4; ++m) { float s = 0.f;
#pragma unroll
                for (int bj = 0; bj < 2; ++bj)
#pragma unroll
                    for (int n = 0; n < 2; ++n) { const f32x4 x = v[ai][bj][m][n]; s += (x[0] * x[0] + x[1] * x[1]) + (x[2] * x[2] + x[3] * x[3]); }
                s += __shfl_xor(s, 16); s += __shfl_xor(s, 32);
                if (fq == 0) P[(ai * 128 + wr * 64 + m * 16 + fr) * 4 + wc] = s; }
        asm volatile("s_waitcnt lgkmcnt(0)" ::: "memory"); __builtin_amdgcn_s_barrier(); asm volatile("" ::: "memory");
        const int row = C.wid * 32 + (C.lane & 31);
        if (C.lane < 32) { const float t = (P[row * 4 + 0] + P[row * 4 + 1]) + (P[row * 4 + 2] + P[row * 4 + 3]);
            __hip_atomic_store(xbuf + ((size_t)(pm * 256 + row) * 4 + pn), t, __ATOMIC_RELAXED, __HIP_MEMORY_SCOPE_AGENT); }
        asm volatile("s_waitcnt vmcnt(0)" ::: "memory");
        if (C.lane == 0) __hip_atomic_fetch_add(cnt + 64 * pm, 1u, __ATOMIC_RELAXED, __HIP_MEMORY_SCOPE_AGENT);
        if (C.wid == 0) {
            unsigned spins = 0;
            while ((unsigned)__builtin_amdgcn_readfirstlane(__hip_atomic_load(cnt + 64 * pm, __ATOMIC_RELAXED, __HIP_MEMORY_SCOPE_AGENT)) < 32u) { __builtin_amdgcn_s_sleep(2); if (++spins > (1u << 22)) break; }
            __builtin_amdgcn_fence(__ATOMIC_ACQUIRE, "agent");
        }
        asm volatile("s_waitcnt vmcnt(0) lgkmcnt(0)" ::: "memory"); __builtin_amdgcn_s_barrier(); asm volatile("" ::: "memory");
        if (C.lane < 32) { const float* slot = xbuf + (size_t)(pm * 256 + row) * 4; float t = 0.f;
#pragma unroll
            for (int q = 0; q < 4; ++q) t += __hip_atomic_load(slot + q, __ATOMIC_RELAXED, __HIP_MEMORY_SCOPE_AGENT);
            S[row] = t; }
        asm volatile("s_waitcnt vmcnt(0) lgkmcnt(0)" ::: "memory"); __builtin_amdgcn_s_barrier(); asm volatile("" ::: "memory");
#pragma unroll
        for (int ai = 0; ai < 2; ++ai)
#pragma unroll
            for (int m = 0; m < 4; ++m) rs[ai][m] = S[ai * 128 + wr * 64 + m * 16 + fr];
        asm volatile("s_waitcnt lgkmcnt(0)" ::: "memory"); __builtin_amdgcn_s_barrier(); asm volatile("" ::: "memory");
    }
};
template <int MODE> struct EpiNormFused {
    static constexpr bool PERM = true, AFTER_DRAIN = true; G8_EPI_PLAIN
    const Params& p; int L;
    __device__ __forceinline__ void drained(const Ctx& C, f32x4 (&acc)[2][2][4][2], const G8Unit& u, int wr, int wc, int fr, int fq) const {
        const int pm = u.e0, pn = u.e1, cls = pm < 32 ? 0 : 1 + ((pm - 32) >> 3);
        unsigned* ctl = (unsigned*)(p.ws + WS_CTL);
        const float* modv = (const float*)(p.ws + WS_MODV);
        const float* mv = modv + (size_t)(L * 3 + cls) * 6144;
        float* Y = p.out + OFF_Y; bf16_t* H = (bf16_t*)(p.ws + WS_H);
        const float* gpost = (MODE == 0 ? p.in[13] : p.in[15]) + L * DM;
        const float* gate = mv + (MODE == 0 ? 2048 : 5120);
        const float* xpan = (MODE == 0 && L == 0) ? (pm < 32 ? p.in[0] + (size_t)pm * 256 * DM : p.in[1] + (size_t)(pm - 32) * 256 * DM) : Y + (size_t)pm * 256 * DM;
        float* ypan = Y + (size_t)pm * 256 * DM; bf16_t* hpan = H + (size_t)pm * 256 * LDH; unsigned char* h8pan = p.ws + WS_H8 + (size_t)pm * 256 * LD8;
        float rs[2][4];
        { RowSumSq X{(float*)(ctl + CW_XBUF), ctl + CW_SEAM + ((L * 2 + MODE) * 2 + 0) * 48 * 64}; X.run(C, acc, pm, pn, wr, wc, fr, fq, rs); }
#pragma unroll
        for (int ai = 0; ai < 2; ++ai)
#pragma unroll
            for (int m = 0; m < 4; ++m) rs[ai][m] = __builtin_amdgcn_rsqf(rs[ai][m] * (1.0f / DM) + EPS);
#pragma unroll
        for (int bj = 0; bj < 2; ++bj) { const int col = pn * 256 + bj * 128 + wc * 32 + 8 * fq;
            const f32x4 gp0 = *(const f32x4*)(gpost + col), gp1 = *(const f32x4*)(gpost + col + 4), g0 = *(const f32x4*)(gate + col), g1 = *(const f32x4*)(gate + col + 4);
#pragma unroll
            for (int ai = 0; ai < 2; ++ai)
#pragma unroll
                for (int m = 0; m < 4; ++m) { const int off = (ai * 128 + wr * 64 + m * 16 + fr) * DM + col;
                    const f32x4 x0 = *(const f32x4*)(xpan + off), x1 = *(const f32x4*)(xpan + off + 4);
                    acc[ai][bj][m][0] = x0 + g0 * (acc[ai][bj][m][0] * rs[ai][m] * gp0);
                    acc[ai][bj][m][1] = x1 + g1 * (acc[ai][bj][m][1] * rs[ai][m] * gp1);
                    asm volatile("" : "+v"(acc[ai][bj][m][0]), "+v"(acc[ai][bj][m][1]));
                    if (m & 1) asm volatile("" ::: "memory"); } }
        const bool second = (MODE == 0) || (L == 0);
        if (second) { RowSumSq X{(float*)(ctl + CW_XBUF) + 48 * 256 * 4, ctl + CW_SEAM + ((L * 2 + MODE) * 2 + 1) * 48 * 64}; X.run(C, acc, pm, pn, wr, wc, fr, fq, rs);
#pragma unroll
            for (int ai = 0; ai < 2; ++ai)
#pragma unroll
                for (int m = 0; m < 4; ++m) rs[ai][m] = __builtin_amdgcn_rsqf(rs[ai][m] * (1.0f / DM) + EPS); }
        const float* mvn = (MODE == 0) ? mv : modv + (size_t)(1 * 3 + cls) * 6144;
        const float* gpre = (MODE == 0) ? p.in[14] + L * DM : p.in[12] + DM;
        const float* scv = mvn + (MODE == 0 ? 4096 : 1024); const float* shv = mvn + (MODE == 0 ? 3072 : 0);
#pragma unroll
        for (int bj = 0; bj < 2; ++bj) { const int col = pn * 256 + bj * 128 + wc * 32 + 8 * fq;
            const f32x4 z = (f32x4){0.f, 0.f, 0.f, 0.f};
            f32x4 gg0 = z, gg1 = z, sa0 = z, sa1 = z, sb0 = z, sb1 = z;
            if (second) { gg0 = *(const f32x4*)(gpre + col); gg1 = *(const f32x4*)(gpre + col + 4); sa0 = *(const f32x4*)(scv + col) + 1.0f; sa1 = *(const f32x4*)(scv + col + 4) + 1.0f; sb0 = *(const f32x4*)(shv + col); sb1 = *(const f32x4*)(shv + col + 4); }
#pragma unroll
            for (int ai = 0; ai < 2; ++ai)
#pragma unroll
                for (int m = 0; m < 4; ++m) { const int rl = ai * 128 + wr * 64 + m * 16 + fr; const f32x4 v0 = acc[ai][bj][m][0], v1 = acc[ai][bj][m][1];
                    *(f32x4*)(ypan + rl * DM + col) = v0; *(f32x4*)(ypan + rl * DM + col + 4) = v1;
                    if (second) { const f32x4 h0 = v0 * rs[ai][m] * gg0 * sa0 + sb0, h1 = v1 * rs[ai][m] * gg1 * sa1 + sb1;
                        *(u32x4*)(hpan + rl * LDH + col) = (u32x4){pk2(h0.x, h0.y), pk2(h0.z, h0.w), pk2(h1.x, h1.y), pk2(h1.z, h1.w)};
                        if (MODE == 1) { int w0 = __builtin_amdgcn_cvt_pk_fp8_f32(h0.x, h0.y, 0, false); w0 = __builtin_amdgcn_cvt_pk_fp8_f32(h0.z, h0.w, w0, true);
                            int w1 = __builtin_amdgcn_cvt_pk_fp8_f32(h1.x, h1.y, 0, false); w1 = __builtin_amdgcn_cvt_pk_fp8_f32(h1.z, h1.w, w1, true);
                            *(u32x2*)(h8pan + rl * LD8 + col) = (u32x2){(unsigned)w0, (unsigned)w1}; } }
                    asm volatile("" ::: "memory"); } }
    }
};
template <int MODE> __device__ __forceinline__ void gemm_norm_phase(const Params& p, Ctx& C, int L, const bf16_t* A, int lda, const bf16_t* Bt, int ldb, int K) {
    TileSched S{(const char*)A, (const char*)Bt, (size_t)256 * lda * 2, (size_t)256 * ldb * 2, 48, 4, C.G, C.bid};
    EpiNormFused<MODE> E{p, L};
    gemm8(C, K, lda, ldb, S, E);
}

struct OneUnit { G8Unit u; __device__ __forceinline__ bool next(int i, G8Unit& o) const { if (i > 0) return false; o = u; return true; } };
struct EpiUpConv {
    static constexpr bool PERM = false, AFTER_DRAIN = true; G8_EPI_PLAIN
    bf16_t* ACT; const float* cw;
    __device__ __forceinline__ void drained(const Ctx& C, const f32x4 (&acc)[2][2][4][2], const G8Unit& u, int wr, int wc, int fr, int fq) const {
        constexpr int UROW = 528;
        const int Trow0 = u.e0, pn = u.e1, tpos0 = u.e2, Ls = u.e3;
#pragma unroll
        for (int ai = 0; ai < 2; ++ai)
#pragma unroll
            for (int m = 0; m < 4; ++m) { const int r = ai * 128 + wr * 64 + m * 16 + fr;
#pragma unroll
                for (int bj = 0; bj < 2; ++bj)
#pragma unroll
                    for (int n = 0; n < 2; ++n) { const int c = bj * 128 + wc * 32 + n * 16 + 4 * fq; const f32x4 v = acc[ai][bj][m][n]; *(LAS u32x2*)(C.lds + r * UROW + c * 2) = (u32x2){pk2(v.x, v.y), pk2(v.z, v.w)}; } }
        __syncthreads();
        {
            const int cc = C.tid & 15, rg = C.tid >> 4;
            const int f0 = pn * 128 + cc * 8;
            float wa[3][8], wg[3][8];
#pragma unroll
            for (int j = 0; j < 3; ++j)
#pragma unroll
                for (int e = 0; e < 8; ++e) { const bool ok = (f0 + e) < DFF; wa[j][e] = ok ? cw[j * 5504 + f0 + e] : 0.f; wg[j][e] = ok ? cw[j * 5504 + DFF + f0 + e] : 0.f; }
            for (int ps = 0; ps < 8; ++ps) {
                const int r = ps * 32 + rg, tpos = tpos0 + r;
                const bool valid = (r > 0 || tpos == 0) && (r < 255 || tpos == Ls - 1);
                if (!valid) continue;
                const bool hasl = tpos > 0, hasr = tpos < Ls - 1;
                const LAS unsigned char* base = C.lds + r * UROW + cc * 16;
                const u32x4 z = (u32x4){0u, 0u, 0u, 0u};
                const u32x4 a0 = hasl ? *(const LAS u32x4*)(base - UROW) : z, a1 = *(const LAS u32x4*)base, a2 = hasr ? *(const LAS u32x4*)(base + UROW) : z;
                const u32x4 g0 = hasl ? *(const LAS u32x4*)(base - UROW + 256) : z, g1 = *(const LAS u32x4*)(base + 256), g2 = hasr ? *(const LAS u32x4*)(base + UROW + 256) : z;
                float o[8];
#pragma unroll
                for (int e = 0; e < 8; ++e) {
                    const unsigned ua0 = a0[e >> 1], ua1 = a1[e >> 1], ua2 = a2[e >> 1], ug0 = g0[e >> 1], ug1 = g1[e >> 1], ug2 = g2[e >> 1];
                    const float xa0 = (e & 1) ? hi16(ua0) : lo16(ua0), xa1 = (e & 1) ? hi16(ua1) : lo16(ua1), xa2 = (e & 1) ? hi16(ua2) : lo16(ua2);
                    const float xg0 = (e & 1) ? hi16(ug0) : lo16(ug0), xg1 = (e & 1) ? hi16(ug1) : lo16(ug1), xg2 = (e & 1) ? hi16(ug2) : lo16(ug2);
                    const float av = xa0 * wa[0][e] + xa1 * wa[1][e] + xa2 * wa[2][e];
                    const float gv = xg0 * wg[0][e] + xg1 * wg[1][e] + xg2 * wg[2][e];
                    o[e] = siluf_(gv) * av;
                }
                *(u32x4*)(ACT + (size_t)(Trow0 + r) * LDACT + f0) = (u32x4){pk2(o[0], o[1]), pk2(o[2], o[3]), pk2(o[4], o[5]), pk2(o[6], o[7])};
            }
        }
        __syncthreads();
    }
};
__device__ __forceinline__ float dpp_ror1(float x) { return __int_as_float(__builtin_amdgcn_update_dpp(0, __float_as_int(x), 0x121, 0xf, 0xf, false)); }
__device__ __forceinline__ float dpp_ror15(float x) { return __int_as_float(__builtin_amdgcn_update_dpp(0, __float_as_int(x), 0x12F, 0xf, 0xf, false)); }
struct EpiUpConvReg {
    static constexpr bool PERM = true, AFTER_DRAIN = false; G8_EPI_PLAIN
    bf16_t* ACT; const float* cw; LAS unsigned* halo;
    __device__ __forceinline__ void operator()(const f32x4 (&acc)[2][2][4][2], const G8Unit& u, int wr, int wc, int fr_, int fq_) const {
        int fr = fr_, fq = fq_; asm volatile("" : "+v"(fr), "+v"(fq));
        const int Trow0 = u.e0, pn = u.e1, tpos0 = u.e2, Ls = u.e3;
        const int cl = wc * 32 + 8 * fq;
        unsigned xp[2][4][2][4];
#pragma unroll
        for (int ai = 0; ai < 2; ++ai)
#pragma unroll
            for (int m = 0; m < 4; ++m)
#pragma unroll
                for (int n = 0; n < 2; ++n)
#pragma unroll
                    for (int j = 0; j < 4; ++j) { xp[ai][m][n][j] = pk2(acc[ai][0][m][n][j], acc[ai][1][m][n][j]); asm volatile("" : "+v"(xp[ai][m][n][j])); }
#pragma unroll
        for (int ai = 0; ai < 2; ++ai) { const int b = ai * 2 + wr;
#pragma unroll
            for (int n = 0; n < 2; ++n) {
                if (fr == 0) *(LAS u32x4*)(halo + (b * 2 + 0) * 128 + cl + 4 * n) = (u32x4){xp[ai][0][n][0], xp[ai][0][n][1], xp[ai][0][n][2], xp[ai][0][n][3]};
                if (fr == 15) *(LAS u32x4*)(halo + (b * 2 + 1) * 128 + cl + 4 * n) = (u32x4){xp[ai][3][n][0], xp[ai][3][n][1], xp[ai][3][n][2], xp[ai][3][n][3]};
            } }
        LAS float* cwl = (LAS float*)(halo + 1024);
        const int tx = (wr * 4 + wc) * 64 + fq * 16 + fr;
        if (tx < 192) { const int jp = tx >> 5, ch = tx & 31, f = pn * 128 + ch * 4;
            const f32x4 v = (f < DFF) ? *(const f32x4*)(cw + (jp >> 1) * 5504 + (jp & 1) * DFF + f) : (f32x4){0.f, 0.f, 0.f, 0.f};
            *(LAS f32x4*)(cwl + jp * 128 + ch * 4) = v; }
        asm volatile("s_waitcnt vmcnt(0) lgkmcnt(0)\n\ts_barrier" ::: "memory");
        asm volatile("s_barrier" ::: "memory");
        const int f0 = pn * 128 + cl;
        const int src_up = ((fq << 4) | ((fr + 15) & 15)) << 2, src_dn = ((fq << 4) | ((fr + 1) & 15)) << 2;
        const bool seq_first = (tpos0 == 0), seq_last = (tpos0 + 256 == Ls);
        u32x2 pk0[2][4];
#pragma unroll
        for (int n = 0; n < 2; ++n) {
            f32x2 w0[4], w1[4], w2[4];
            { const f32x4 a0 = *(const LAS f32x4*)(cwl + 0 * 128 + cl + 4 * n), g0 = *(const LAS f32x4*)(cwl + 1 * 128 + cl + 4 * n);
                const f32x4 a1 = *(const LAS f32x4*)(cwl + 2 * 128 + cl + 4 * n), g1 = *(const LAS f32x4*)(cwl + 3 * 128 + cl + 4 * n);
                const f32x4 a2 = *(const LAS f32x4*)(cwl + 4 * 128 + cl + 4 * n), g2 = *(const LAS f32x4*)(cwl + 5 * 128 + cl + 4 * n);
#pragma unroll
                for (int j = 0; j < 4; ++j) { w0[j] = (f32x2){a0[j], g0[j]}; w1[j] = (f32x2){a1[j], g1[j]}; w2[j] = (f32x2){a2[j], g2[j]}; } }
#pragma unroll
            for (int ai = 0; ai < 2; ++ai) { const int b = ai * 2 + wr;
                u32x4 hup = (u32x4){0u, 0u, 0u, 0u}, hdn = hup;
                if (b > 0) hup = *(const LAS u32x4*)(halo + ((b - 1) * 2 + 1) * 128 + cl + 4 * n);
                if (b < 3) hdn = *(const LAS u32x4*)(halo + ((b + 1) * 2 + 0) * 128 + cl + 4 * n);
#pragma unroll
                for (int m = 0; m < 4; ++m) {
                    const int r = ai * 128 + wr * 64 + m * 16 + fr;
                    float o[4];
#pragma unroll
                    for (int j = 0; j < 4; ++j) {
                        const unsigned xc = xp[ai][m][n][j];
                        const unsigned pv = (m > 0) ? xp[ai][m > 0 ? m - 1 : 0][n][j] : hup[j], nv = (m < 3) ? xp[ai][m < 3 ? m + 1 : 3][n][j] : hdn[j];
                        unsigned upk = (unsigned)__builtin_amdgcn_update_dpp(0, (int)(fr == 15 ? pv : xc), 0x121, 0xf, 0xf, false);
                        unsigned dnk = (unsigned)__builtin_amdgcn_update_dpp(0, (int)(fr == 0 ? nv : xc), 0x12F, 0xf, 0xf, false);
                        if (ai == 0 && m == 0) { if (seq_first && r == 0) upk = 0u; }
                        if (ai == 1 && m == 3) { if (seq_last && r == 255) dnk = 0u; }
                        const f32x2 c2 = (f32x2){lo16(upk), hi16(upk)} * w0[j] + (f32x2){lo16(xc), hi16(xc)} * w1[j] + (f32x2){lo16(dnk), hi16(dnk)} * w2[j];
                        o[j] = siluf_(c2.y) * c2.x;
                    }
                    const u32x2 pkn = (u32x2){pk2(o[0], o[1]), pk2(o[2], o[3])};
                    if (n == 0) pk0[ai][m] = pkn;
                    else {
                        bool valid = true;
                        if (ai == 0 && m == 0) valid = (r > 0) || seq_first;
                        if (ai == 1 && m == 3) valid = (r < 255) || seq_last;
                        if (valid) *(u32x4*)(ACT + (size_t)(Trow0 + r) * LDACT + f0) = (u32x4){pk0[ai][m].x, pk0[ai][m].y, pkn.x, pkn.y};
                    }
                }
            }
        }
    }
};
struct UpSched {
    const char* H; const char* Wu; int G, c;
    __device__ __forceinline__ bool next(int i, G8Unit& u) const {
        const int Lu = i * G + c; if (Lu >= 50 * 22) return false;
        int mt, pn; unit_map(Lu, 50, 22, mt, pn);
        int Trow0, tpos0, Ls;
        if (mt < 32) { Trow0 = mt * 256; tpos0 = 0; Ls = 256; }
        else { const int v = mt - 32, b = v / 9, j = v % 9; tpos0 = (j < 8) ? 254 * j : 1792; Trow0 = NCTX + b * 2048 + tpos0; Ls = 2048; }
        u.A = H + (size_t)Trow0 * LDH * 2; u.B = Wu + (size_t)pn * 256 * LDW * 2; u.e0 = Trow0; u.e1 = pn; u.e2 = tpos0; u.e3 = Ls; return true;
    }
};
__device__ __forceinline__ void phase8(const Params& p, Ctx& C, int L) {
    UpSched S{(const char*)(p.ws + WS_H), (const char*)(p.ws + WS_W + (size_t)L * W_LAYER + WO_UP), C.G, C.bid};
    EpiUpConvReg E{(bf16_t*)(p.ws + WS_ACT), p.in[30] + (size_t)L * 3 * 5504, (LAS unsigned*)(C.lds + 131072)};
    gemm8(C, DM, LDH, LDW, S, E);
}

__global__ void __launch_bounds__(512, 2) mega_fwd(Params p) {
    extern __shared__ __attribute__((aligned(16))) unsigned char lds_raw[];
    Ctx C; C.lds = (LAS unsigned char*)lds_raw;
    C.ws = __builtin_amdgcn_readfirstlane((int)(threadIdx.x >> 6)); C.G = gridDim.x; C.bid = blockIdx.x;
#define FRESH() CTX_FRESH(C)
    FRESH();
    if (C.tid < 16) ((LAS unsigned*)(C.lds + LDS_CTL))[C.tid] = 0u;
    __syncthreads();
    XcdBarrier bar = xcd_barrier_post((unsigned*)(p.ws + WS_CTL) + CW_BAR, (volatile LAS unsigned*)(C.lds + LDS_CTL));
#define GRID_BAR() do { xcd_barrier(bar, C.tid); FRESH(); } while (0)
#ifndef PH
#define PH 0xffff
#endif
#ifndef DUP
#define DUP 0
#endif
    if (PH & 1) phase0(p, C); GRID_BAR();
    if (DUP & 1) { phase0(p, C); GRID_BAR(); }
    if (PH & 2) phase1(p, C); GRID_BAR();
    if (DUP & 2) { phase1(p, C); GRID_BAR(); }
#pragma unroll 1
    for (int L = 0; L < 2; ++L) {
        if (PH & 4) phase2(p, C, L); GRID_BAR();
        if (DUP & 4) { phase2(p, C, L); GRID_BAR(); }
        if (PH & 8) phase3(p, C, L); GRID_BAR();
        if (PH & 16) phase4(p, C, L); GRID_BAR();
        if (DUP & 16) { phase4(p, C, L, 1); GRID_BAR(); }
        if (PH & 32) phase5a(p, C, L); GRID_BAR();
        if (DUP & 32) { phase5a(p, C, L); GRID_BAR(); }
        if (PH & 64) phase5b<0>(p, C, L); GRID_BAR();
#ifdef PVAR
        if (DUP & 64) { phase5b<PVAR>(p, C, L); GRID_BAR(); }
#endif
        gemm_norm_phase<0>(p, C, L, (const bf16_t*)(p.ws + WS_MERGED), LDH, (const bf16_t*)(p.ws + WS_W + (size_t)L * W_LAYER + WO_OUT), LDW, DM); GRID_BAR();
        if (PH & 256) phase8(p, C, L); GRID_BAR();
        if (DUP & 256) { phase8(p, C, L); GRID_BAR(); }
        gemm_norm_phase<1>(p, C, L, (const bf16_t*)(p.ws + WS_ACT), LDACT, (const bf16_t*)(p.ws + WS_W + (size_t)L * W_LAYER + WO_DOWN), LDWD, DFFP);
        if (L == 0) GRID_BAR();
    }
}

extern "C" void kernel_launch(void* const* d_in, const int* in_sizes, int n_in, void* d_out, int out_size, void* d_ws, size_t ws_size, hipStream_t stream) {
    static int grid = 0;
    if (grid == 0) {
        if (n_in != 32 || ws_size < WS_END) { fprintf(stderr, "kernel_launch: unexpected n_in %d / ws %zu\n", n_in, ws_size); grid = -1; return; }
        int dev = 0, cus = 0;
        if (hipGetDevice(&dev) != hipSuccess || hipDeviceGetAttribute(&cus, hipDeviceAttributeMultiprocessorCount, dev) != hipSuccess) { grid = -1; return; }
        if (hipFuncSetAttribute((const void*)mega_fwd, hipFuncAttributeMaxDynamicSharedMemorySize, LDS_BYTES) != hipSuccess) { fprintf(stderr, "kernel_launch: hipFuncSetAttribute failed\n"); grid = -1; return; }
        grid = cus;
    }
    if (grid < 0) return;
    (void)hipMemsetAsync((char*)d_ws + WS_CTL, 0, (size_t)(CW_SEAM + 384 * 64) * 4, stream);
    Params a{};
    for (int i = 0; i < 32; ++i) a.in[i] = (const float*)d_in[i];
    a.out = (float*)d_out; a.ws = (unsigned char*)d_ws;
    hipLaunchKernelGGL(mega_fwd, dim3(grid), dim3(512), LDS_BYTES, stream, a);
}
```

```cpp
#include <hip/hip_runtime.h>
#include <cstdio>
#include <cstdint>

#define LAS __attribute__((address_space(3)))
#define GAS __attribute__((address_space(1)))
typedef unsigned short bf16_t;
typedef short bf16x8 __attribute__((ext_vector_type(8)));
typedef short s16x4 __attribute__((ext_vector_type(4)));
typedef float f32x4 __attribute__((ext_vector_type(4)));
typedef float f32x2 __attribute__((ext_vector_type(2)));
typedef unsigned u32x4 __attribute__((ext_vector_type(4)));
typedef unsigned u32x2 __attribute__((ext_vector_type(2)));
typedef __bf16 bf16x2_t __attribute__((ext_vector_type(2)));
#define LOG2E_ 1.4426950408889634f
typedef long lx2 __attribute__((ext_vector_type(2)));
typedef int i32x8 __attribute__((ext_vector_type(8)));
typedef int i32x4 __attribute__((ext_vector_type(4)));

constexpr int DM = 1024, NCTX = 8192, NLAT = 4096, NTOK = 12288;
constexpr int INP = 2048, IN_DIM = 1888, DFF = 2752, DFFP = 2816, NUP = 5632;
constexpr int LD8 = 1152;
constexpr int LDH = 1088, LDP = 1984, LDACT = 2880, LDQ = 448, LDKV = 576, LDW = 1088, LDWB = 320, LDWD = 2880, LDUQ = 192, LDUKV = 192, LDNAC = 320, LDSWC = 192, LDCKVC = 192, LDBK = 4160;
constexpr int COL_QA = 0, COL_KA = 256, COL_VA = 512, COL_CQ = 768, COL_CKV = 960, COL_KR = 1088, COL_QC = 1120, COL_KC = 1376, COL_VC = 1504, COL_PD = 1632;
constexpr float EPS = 1e-6f;
constexpr float LOG2E = 1.4426950408889634f;
constexpr size_t OFF_Y = 0, OFF_NAK = 12582912, OFF_NAV = 16777216, OFF_CKV = 20971520, OFF_KR = 23068672, OFF_SWK = 23592960, OFF_SWV = 25690112;

constexpr size_t MiB = 1u << 20;
constexpr size_t WS_CTL = 0, CTL_BYTES = 1 * MiB;
constexpr size_t WS_MODV = 1 * MiB;
constexpr size_t WS_NACK = 2 * MiB;
constexpr size_t WS_NACV = WS_NACK + 640 * 1024;
constexpr size_t WS_SWCK = WS_NACV + 640 * 1024;
constexpr size_t WS_SWCV = WS_SWCK + 384 * 1024;
constexpr size_t WS_CKVC = WS_SWCV + 384 * 1024;
constexpr size_t WS_KRC = WS_CKVC + 384 * 1024;
constexpr size_t WS_KVCUP = WS_KRC + 64 * 1024;
static_assert(WS_KVCUP + (size_t)2 * 512 * LDKV * 2 <= 6 * MiB, "cache region");
constexpr size_t WS_W = 6 * MiB, W_LAYER = 36 * MiB + 512 * 1024;
constexpr size_t WO_IN = 0, WO_GATE = 4 * MiB + 512 * 1024, WO_BR = 13 * MiB, WO_OUT = 15 * MiB + 512 * 1024, WO_UP = 18 * MiB, WO_DOWN = 30 * MiB, WO_UQ = 35 * MiB + 768 * 1024, WO_UKV = 36 * MiB;
static_assert((size_t)2048 * LDW * 2 <= WO_GATE && WO_GATE + (size_t)4096 * LDW * 2 <= WO_BR && WO_BR + (size_t)4096 * LDWB * 2 <= WO_OUT && WO_OUT + (size_t)1024 * LDW * 2 <= WO_UP && WO_UP + (size_t)NUP * LDW * 2 <= WO_DOWN && WO_DOWN + (size_t)1024 * LDWD * 2 <= WO_UQ && WO_UQ + (size_t)512 * LDUQ * 2 <= WO_UKV && WO_UKV + (size_t)512 * LDUKV * 2 <= W_LAYER, "weight map");
constexpr size_t WS_X1 = 79 * MiB;
constexpr size_t WS_H8 = WS_X1;
constexpr size_t WS_H = 127 * MiB;
constexpr size_t WS_P = 153 * MiB;
constexpr size_t WS_BK = 93 * MiB;
constexpr size_t WS_MERGED = 226 * MiB;
constexpr size_t WS_BR = 200 * MiB;
constexpr size_t WS_O = WS_BR;
constexpr size_t WS_QUP = 226 * MiB;
constexpr size_t WS_KVUP = 237 * MiB;
constexpr size_t WS_ACT = WS_P;
constexpr size_t WS_END = 252 * MiB;
static_assert((size_t)NTOK * LD8 <= (size_t)NTOK * DM * 4 && (size_t)4096 * LD8 <= WO_BR - WO_GATE, "fp8 buffers");
static_assert(WS_W + 2 * W_LAYER <= WS_X1 && WS_X1 + (size_t)NTOK * DM * 4 <= WS_H && WS_H + (size_t)NTOK * LDH * 2 <= WS_P && WS_P + (size_t)NTOK * LDP * 2 <= WS_BR && WS_BR + (size_t)NTOK * LDH * 2 <= WS_QUP
              && WS_QUP + (size_t)NTOK * LDQ * 2 <= WS_KVUP && WS_KVUP + (size_t)NTOK * LDKV * 2 <= WS_END && WS_ACT + (size_t)NTOK * LDACT * 2 <= WS_QUP
              && WS_H8 + (size_t)NTOK * LD8 <= WS_BK && WS_BK + (size_t)NTOK * LDBK * 2 <= WS_BR && WS_MERGED + (size_t)NTOK * LDH * 2 <= WS_END, "workspace map");
constexpr int CW_BAR = 1024;
constexpr int CW_QUEUE = 8192;
constexpr int CW_SEAM = 16384;
constexpr int CW_XBUF = 65536;

constexpr int LDS_CTL = 147456, LDS_TAB = LDS_CTL + 64, LDS_BYTES = LDS_TAB + 4096;

struct Params { const float* in[32]; float* out; unsigned char* ws; };

__device__ __forceinline__ float bf2f(bf16_t b) { return __uint_as_float((unsigned)b << 16); }
__device__ __forceinline__ unsigned pk2(float lo, float hi) { f32x2 v = {lo, hi}; bf16x2_t b = __builtin_convertvector(v, bf16x2_t); return __builtin_bit_cast(unsigned, b); }
__device__ __forceinline__ float lo16(unsigned u) { return __uint_as_float(u << 16); }
__device__ __forceinline__ float hi16(unsigned u) { return __uint_as_float(u & 0xffff0000u); }
__device__ __forceinline__ float wave_sum(float v) {
#pragma unroll
    for (int o = 1; o < 64; o <<= 1) v += __shfl_xor(v, o);
    return v;
}
__device__ __forceinline__ float qmax4(float x) {
    const auto a = __builtin_amdgcn_permlane16_swap(__float_as_uint(x), __float_as_uint(x), false, false); x = fmaxf(__uint_as_float(a[0]), __uint_as_float(a[1]));
    const auto b = __builtin_amdgcn_permlane32_swap(__float_as_uint(x), __float_as_uint(x), false, false); return fmaxf(__uint_as_float(b[0]), __uint_as_float(b[1]));
}
__device__ __forceinline__ float sigmoidf_(float x) { return __builtin_amdgcn_rcpf(1.0f + __builtin_amdgcn_exp2f(x * -LOG2E_)); }
__device__ __forceinline__ float siluf_(float x) { return x * __builtin_amdgcn_rcpf(1.0f + __builtin_amdgcn_exp2f(x * -LOG2E_)); }
#define VM_WAIT_UNUSED_()
#define VM_WAIT() asm volatile("s_waitcnt vmcnt(0)" ::: "memory")

#define XB_TMO      128
#define XB_XCNT(j)  (256  + 64 * (j))
#define XB_XSUB(j)  (1280 + 64 * (j))
#define XB_XGEN(j)  (2304 + 64 * (j))
#define XB_TOP      3328
#define XB_TOPGEN   3392
#define XCD_BAR_WORDS 3456
#define XB_SPIN_CAP (1u << 22)
__device__ __forceinline__ unsigned xb_ld(unsigned* p)              { return __hip_atomic_load(p, __ATOMIC_RELAXED, __HIP_MEMORY_SCOPE_AGENT); }
__device__ __forceinline__ unsigned xb_add(unsigned* p, unsigned v) { return __hip_atomic_fetch_add(p, v, __ATOMIC_RELAXED, __HIP_MEMORY_SCOPE_AGENT); }
__device__ __forceinline__ unsigned xb_xcc_id() { return (unsigned)__builtin_amdgcn_s_getreg((3 << 11) | 20) & 0xFu; }
#define XB_SPIN(cond, bar) do { unsigned _sp = 0; while (cond) { __builtin_amdgcn_s_sleep(1); \
    if ((++_sp & 255u) == 0u) { if (xb_ld(&(bar)[XB_TMO])) break; if (_sp > XB_SPIN_CAP) { atomicAdd(&(bar)[XB_TMO], 1u); break; } } } } while (0)
struct XcdBarrier { unsigned* bar; unsigned x; volatile LAS unsigned* st; };
__device__ __forceinline__ XcdBarrier xcd_barrier_post(unsigned* bar, volatile LAS unsigned* st) {
    XcdBarrier b; b.bar = bar; b.x = xb_xcc_id(); b.st = st;
    if (threadIdx.x == 0) (void)xb_add(&bar[XB_XCNT(b.x)], 1u);
    return b;
}
__device__ __forceinline__ void xcd_barrier_complete(unsigned* bar, unsigned x, unsigned& nloc, unsigned& nx) {
    const unsigned G = gridDim.x * gridDim.y * gridDim.z;
    unsigned sum, cnt, mine, sp = 0u;
    for (;;) {
        sum = 0u; cnt = 0u; mine = 0u;
#pragma unroll
        for (unsigned j = 0; j < 16; ++j) { const unsigned c = xb_ld(&bar[XB_XCNT(j)]); sum += c; cnt += (c > 0u) ? 1u : 0u; mine = (j == x) ? c : mine; }
        if (sum == G) break;
        __builtin_amdgcn_s_sleep(1);
        if ((++sp & 255u) == 0u) { if (xb_ld(&bar[XB_TMO])) break; if (sp > XB_SPIN_CAP) { atomicAdd(&bar[XB_TMO], 1u); break; } }
    }
    nloc = mine > 0u ? mine : 1u; nx = cnt > 0u ? cnt : 1u;
}
__device__ __forceinline__ void xcd_barrier(const XcdBarrier& b, int tid) {
    asm volatile("s_waitcnt vmcnt(0)" ::: "memory");
    __syncthreads();
    if (tid == 0) {
        unsigned* bar = b.bar; unsigned bx = b.x; asm volatile("" : "+s"(bar), "+s"(bx));
        __builtin_amdgcn_s_waitcnt(0);
        unsigned nloc = b.st[0], nx = b.st[1];
        if (nloc == 0u) { xcd_barrier_complete(bar, bx, nloc, nx); b.st[0] = nloc; b.st[1] = nx; }
        const unsigned old = xb_add(&bar[XB_XSUB(bx)], 1u);
        const unsigned gen = old / nloc;
        if (old + 1u == (gen + 1u) * nloc) {
            __builtin_amdgcn_fence(__ATOMIC_RELEASE, "agent");
            asm volatile("s_waitcnt vmcnt(0)" ::: "memory");
            const unsigned og = xb_add(&bar[XB_TOP], 1u);
            const unsigned tg = og / nx;
            if (og + 1u == (tg + 1u) * nx) xb_add(&bar[XB_TOPGEN], 1u);
            else XB_SPIN(xb_ld(&bar[XB_TOPGEN]) == tg, bar);
            __builtin_amdgcn_fence(__ATOMIC_ACQUIRE, "agent");
            xb_add(&bar[XB_XGEN(bx)], 1u);
            asm volatile("s_waitcnt vmcnt(0)" ::: "memory");
        } else {
            XB_SPIN(xb_ld(&bar[XB_XGEN(bx)]) == gen, bar);
            __builtin_amdgcn_fence(__ATOMIC_ACQUIRE, "agent");
            asm volatile("s_waitcnt vmcnt(0)" ::: "memory");
        }
    }
    __syncthreads();
}

struct Ctx {
    LAS unsigned char* lds;
    int tid, lane, wid, fr, fq;
    int G, bid;
    int ws;
};
__device__ __forceinline__ int hw_lane() { int l; asm volatile("v_mbcnt_lo_u32_b32 %0, -1, 0\n\tv_mbcnt_hi_u32_b32 %0, -1, %0" : "=v"(l)); return l; }
#define CTX_FRESH(C) do { int w_ = (C).ws, g_ = (C).G, b_ = (C).bid; asm volatile("" : "+s"(w_), "+s"(g_), "+s"(b_)); (C).G = g_; (C).bid = b_; const int l_ = hw_lane(); (C).lane = l_; (C).wid = __builtin_amdgcn_readfirstlane(w_); (C).tid = (C).wid * 64 + l_; (C).fr = l_ & 15; (C).fq = l_ >> 4; } while (0)

__device__ __forceinline__ int tok_cls(int T) { return T < NCTX ? 0 : 1 + ((T - NCTX) >> 11); }
__device__ __forceinline__ const float* x_in_row(const Params& p, int T) { return T < NCTX ? p.in[0] + (size_t)T * DM : p.in[1] + (size_t)(T - NCTX) * DM; }

__device__ __forceinline__ void p0_item(const float* W, int ldw, int k0, int n0, const float* kscale, bf16_t* WT, int ldt, int dst_row0, LAS float* scr, int lane) {
    float ld[32];
#pragma unroll
    for (int i = 0; i < 32; ++i) { const int kk = 2 * i + (lane >> 5); ld[i] = W[(size_t)(k0 + kk) * ldw + n0 + (lane & 31)]; }
#pragma unroll
    for (int i = 0; i < 32; ++i) { const int kk = 2 * i + (lane >> 5); float v = ld[i]; if (kscale) v *= kscale[k0 + kk]; scr[kk * 33 + (lane & 31)] = v; }
    asm volatile("s_waitcnt lgkmcnt(0)" ::: "memory");
    const int c = lane & 7;
#pragma unroll
    for (int j = 0; j < 4; ++j) { const int n = (lane >> 3) + 8 * j; const LAS float* s = scr + (8 * c) * 33 + n;
        u32x4 o; o.x = pk2(s[0 * 33], s[1 * 33]); o.y = pk2(s[2 * 33], s[3 * 33]); o.z = pk2(s[4 * 33], s[5 * 33]); o.w = pk2(s[6 * 33], s[7 * 33]);
        *(u32x4*)(WT + (size_t)(dst_row0 + n) * ldt + k0 + 8 * c) = o; }
    asm volatile("s_waitcnt lgkmcnt(0)" ::: "memory");
}
__device__ __forceinline__ void p0_item8(const float* W, int ldw, int k0, int n0, float scale, unsigned char* WT, int ldt, int dst_row0, LAS float* scr, int lane) {
    float ld[32];
#pragma unroll
    for (int i = 0; i < 32; ++i) { const int kk = 2 * i + (lane >> 5); ld[i] = W[(size_t)(k0 + kk) * ldw + n0 + (lane & 31)]; }
#pragma unroll
    for (int i = 0; i < 32; ++i) { const int kk = 2 * i + (lane >> 5); scr[kk * 33 + (lane & 31)] = ld[i] * scale; }
    asm volatile("s_waitcnt lgkmcnt(0)" ::: "memory");
    const int c = lane & 7;
#pragma unroll
    for (int j = 0; j < 4; ++j) { const int n = (lane >> 3) + 8 * j; const LAS float* s = scr + (8 * c) * 33 + n;
        int w0 = __builtin_amdgcn_cvt_pk_fp8_f32(s[0 * 33], s[1 * 33], 0, false); w0 = __builtin_amdgcn_cvt_pk_fp8_f32(s[2 * 33], s[3 * 33], w0, true);
        int w1 = __builtin_amdgcn_cvt_pk_fp8_f32(s[4 * 33], s[5 * 33], 0, false); w1 = __builtin_amdgcn_cvt_pk_fp8_f32(s[6 * 33], s[7 * 33], w1, true);
        *(u32x2*)(WT + (size_t)(dst_row0 + n) * ldt + k0 + 8 * c) = (u32x2){(unsigned)w0, (unsigned)w1}; }
    asm volatile("s_waitcnt lgkmcnt(0)" ::: "memory");
}
constexpr int IT_IN = 16 * 59, IT_GATE = 16 * 128, IT_BR = 4 * 4 * 32, IT_OUT = 16 * 32, IT_UP = 16 * 172, IT_DOWN = 43 * 32, IT_UQ = 3 * 12, IT_UKV = 2 * 16;
constexpr int IT_LAYER = IT_IN + IT_GATE + IT_BR + IT_OUT + IT_UP + IT_DOWN + IT_UQ + IT_UKV;

__device__ __forceinline__ void zero_bf16(bf16_t* p, size_t n8, int gtid, int gthreads) {
    for (size_t i = gtid; i < n8; i += gthreads) ((u32x4*)p)[i] = (u32x4){0u, 0u, 0u, 0u};
}

__device__ __forceinline__ void phase0(const Params& p, Ctx& C) {
    LAS float* scr = (LAS float*)(C.lds + C.wid * 16384);
    const int gw = C.bid * 8 + C.wid, NGW = C.G * 8;
    for (int it = gw; it < 2 * IT_LAYER; it += NGW) {
        const int L = it / IT_LAYER; int r = it % IT_LAYER;
        unsigned char* wb = p.ws + WS_W + (size_t)L * W_LAYER;
        if (r < IT_IN) { const int kb = r / 59, nb = r % 59; p0_item(p.in[16] + (size_t)L * 1024 * 1888, 1888, kb * 64, nb * 32, nullptr, (bf16_t*)(wb + WO_IN), LDW, nb * 32, scr, C.lane); continue; } r -= IT_IN;
        if (r < IT_GATE) { const int kb = r / 128, nb = r % 128; p0_item8(p.in[17] + (size_t)L * 1024 * 4096, 4096, kb * 64, nb * 32, 32.0f, (unsigned char*)(wb + WO_GATE), LD8, nb * 32, scr, C.lane); continue; } r -= IT_GATE;
        if (r < IT_BR) { const int k = r / 128, rr = r % 128, kb = rr / 32, nb = rr % 32; p0_item(p.in[27] + (size_t)(L * 4 + k) * 256 * 1024, 1024, kb * 64, nb * 32, nullptr, (bf16_t*)(wb + WO_BR) + (size_t)k * 1024 * LDWB, LDWB, nb * 32, scr, C.lane); continue; } r -= IT_BR;
        if (r < IT_OUT) { const int kb = r / 32, nb = r % 32; p0_item(p.in[28] + (size_t)L * 1024 * 1024, 1024, kb * 64, nb * 32, nullptr, (bf16_t*)(wb + WO_OUT), LDW, nb * 32, scr, C.lane); continue; } r -= IT_OUT;
        if (r < IT_UP) { const int kb = r / 172, nb = r % 172; const int n0 = nb * 32, part = n0 / DFF, j0 = n0 % DFF; const int drow = (j0 >> 7) * 256 + part * 128 + (j0 & 127);
            p0_item(p.in[29] + (size_t)L * 1024 * 5504, 5504, kb * 64, n0, nullptr, (bf16_t*)(wb + WO_UP), LDW, drow, scr, C.lane); continue; } r -= IT_UP;
        if (r < IT_DOWN) { const int kb = r / 32, nb = r % 32; p0_item(p.in[31] + (size_t)L * DFF * 1024, 1024, kb * 64, nb * 32, nullptr, (bf16_t*)(wb + WO_DOWN), LDWD, nb * 32, scr, C.lane); continue; } r -= IT_DOWN;
        if (r < IT_UQ) { const int kb = r / 12, nb = r % 12; p0_item(p.in[21] + (size_t)L * 192 * 384, 384, kb * 64, nb * 32, p.in[20] + L * 192, (bf16_t*)(wb + WO_UQ), LDUQ, nb * 32, scr, C.lane); continue; } r -= IT_UQ;
        { const int kb = r / 16, nb = r % 16; p0_item(p.in[23] + (size_t)L * 128 * 512, 512, kb * 64, nb * 32, p.in[22] + L * 128, (bf16_t*)(wb + WO_UKV), LDUKV, nb * 32, scr, C.lane); }
    }
    const int gtid = C.bid * 512 + C.tid, gth = C.G * 512;
    for (int L = 0; L < 2; ++L) {
        unsigned char* wb = p.ws + WS_W + (size_t)L * W_LAYER;
        zero_bf16((bf16_t*)(wb + WO_IN) + (size_t)IN_DIM * LDW, (size_t)(INP - IN_DIM) * LDW / 8, gtid, gth);
        zero_bf16((bf16_t*)(wb + WO_UP) + (size_t)(21 * 256 + 64) * LDW, (size_t)64 * LDW / 8, gtid, gth);
        zero_bf16((bf16_t*)(wb + WO_UP) + (size_t)(21 * 256 + 128 + 64) * LDW, (size_t)64 * LDW / 8, gtid, gth);
        zero_bf16((bf16_t*)(wb + WO_UQ) + (size_t)384 * LDUQ, (size_t)128 * LDUQ / 8, gtid, gth);
        for (int i = gtid; i < 1024 * 8; i += gth) { const int row = i >> 3, c = i & 7; *(u32x4*)((bf16_t*)(wb + WO_DOWN) + (size_t)row * LDWD + DFF + c * 8) = (u32x4){0u, 0u, 0u, 0u}; }
    }
    __syncthreads();
    LAS float* sv = (LAS float*)(C.lds);
    LAS float* part = (LAS float*)(C.lds + 16384);
    for (int i = C.tid; i < 3 * 1024; i += 512) { const int cls = i >> 10, k = i & 1023; const float v = cls == 0 ? p.in[9][k] : p.in[8][(cls - 1) * 1024 + k]; sv[i] = siluf_(v); }
    __syncthreads();
    float* modv = (float*)(p.ws + WS_MODV);
    for (int it = C.bid; it < 2 * 96; it += C.G) {
        const int L = it / 96, col = (it % 96) * 64 + C.lane;
        const float* w = p.in[10] + (size_t)L * 1024 * 6144 + col;
        float a0 = 0.f, a1 = 0.f, a2 = 0.f;
#pragma unroll 8
        for (int kk = 0; kk < 128; ++kk) { const int k = C.wid * 128 + kk; const float wv = w[(size_t)k * 6144]; a0 += sv[k] * wv; a1 += sv[1024 + k] * wv; a2 += sv[2048 + k] * wv; }
        part[(C.wid * 3 + 0) * 64 + C.lane] = a0; part[(C.wid * 3 + 1) * 64 + C.lane] = a1; part[(C.wid * 3 + 2) * 64 + C.lane] = a2;
        __syncthreads();
        if (C.tid < 192) { const int cls = C.tid >> 6, l = C.tid & 63; float s = 0.f;
#pragma unroll
            for (int w8 = 0; w8 < 8; ++w8) s += part[(w8 * 3 + cls) * 64 + l];
            const int cc = (it % 96) * 64 + l;
            modv[((size_t)L * 3 + cls) * 6144 + cc] = s + p.in[11][(size_t)L * 6144 + cc]; }
        __syncthreads();
    }
}

__device__ __forceinline__ void row_norm_mod(const f32x4 (&v)[4], const float* g, const float* sc, const float* sh, bf16_t* orow, int lane, unsigned char* o8 = nullptr) {
    float ss = 0.f;
#pragma unroll
    for (int j = 0; j < 4; ++j) ss += (v[j].x * v[j].x + v[j].y * v[j].y) + (v[j].z * v[j].z + v[j].w * v[j].w);
    const float rstd = 1.0f / sqrtf(wave_sum(ss) * (1.0f / DM) + EPS);
#pragma unroll
    for (int j = 0; j < 4; ++j) {
        const f32x4 gg = ((const f32x4*)g)[lane + 64 * j], s1 = ((const f32x4*)sc)[lane + 64 * j], s0 = ((const f32x4*)sh)[lane + 64 * j];
        const f32x4 y = v[j] * rstd * gg * (s1 + 1.0f) + s0;
        u32x2 o; o.x = pk2(y.x, y.y); o.y = pk2(y.z, y.w);
        ((u32x2*)orow)[lane + 64 * j] = o;
        if (o8) { int w8 = __builtin_amdgcn_cvt_pk_fp8_f32(y.x, y.y, 0, false); w8 = __builtin_amdgcn_cvt_pk_fp8_f32(y.z, y.w, w8, true); ((int*)o8)[lane + 64 * j] = w8; }
    }
}
__device__ __forceinline__ void load_row_bf16(const bf16_t* r, f32x4 (&v)[4], int lane) {
#pragma unroll
    for (int j = 0; j < 4; ++j) { const u32x2 u = ((const u32x2*)r)[lane + 64 * j]; v[j] = (f32x4){lo16(u.x), hi16(u.x), lo16(u.y), hi16(u.y)}; }
}

__device__ __forceinline__ void phase1(const Params& p, Ctx& C) {
    const int gw = C.bid * 8 + C.wid, NGW = C.G * 8;
    const float* modv = (const float*)(p.ws + WS_MODV);
    bf16_t* H = (bf16_t*)(p.ws + WS_H);
    for (int T = gw; T < NTOK; T += NGW) {
        const float* xr = x_in_row(p, T); f32x4 v[4];
#pragma unroll
        for (int j = 0; j < 4; ++j) v[j] = ((const f32x4*)xr)[C.lane + 64 * j];
        const float* mv = modv + (size_t)(0 * 3 + tok_cls(T)) * 6144;
        row_norm_mod(v, p.in[12], mv + 1024, mv, H + (size_t)T * LDH, C.lane, p.ws + WS_H8 + (size_t)T * LD8);
    }
    const int gtid = C.bid * 512 + C.tid, gth = C.G * 512;
    bf16_t* nak = (bf16_t*)(p.ws + WS_NACK); bf16_t* nav = (bf16_t*)(p.ws + WS_NACV);
    for (int i = gtid; i < 2 * 2 * 256 * 256 / 4; i += gth) {
        const int e = i * 4, w = e & 255, t = (e >> 8) & 255, L = (e >> 16) & 1, b = e >> 17;
        const size_t d = ((size_t)(L * 2 + b) * 256 + t) * LDNAC + w;
        const f32x4 a = *(const f32x4*)(p.in[2] + e), c = *(const f32x4*)(p.in[3] + e);
        *(u32x2*)(nak + d) = (u32x2){pk2(a.x, a.y), pk2(a.z, a.w)}; *(u32x2*)(nav + d) = (u32x2){pk2(c.x, c.y), pk2(c.z, c.w)};
    }
    bf16_t* swk = (bf16_t*)(p.ws + WS_SWCK); bf16_t* swv = (bf16_t*)(p.ws + WS_SWCV); bf16_t* ckv = (bf16_t*)(p.ws + WS_CKVC);
    for (int i = gtid; i < 2 * 2 * 256 * 128 / 4; i += gth) {
        const int e = i * 4, w = e & 127, t = (e >> 7) & 255, L = (e >> 15) & 1, b = e >> 16;
        const size_t d = ((size_t)(L * 2 + b) * 256 + t) * LDSWC + w, d2 = ((size_t)(L * 2 + b) * 256 + t) * LDCKVC + w;
        const f32x4 a = *(const f32x4*)(p.in[6] + e), c = *(const f32x4*)(p.in[7] + e), m = *(const f32x4*)(p.in[4] + e);
        *(u32x2*)(swk + d) = (u32x2){pk2(a.x, a.y), pk2(a.z, a.w)}; *(u32x2*)(swv + d) = (u32x2){pk2(c.x, c.y), pk2(c.z, c.w)};
        *(u32x2*)(ckv + d2) = (u32x2){pk2(m.x, m.y), pk2(m.z, m.w)};
    }
    bf16_t* krc = (bf16_t*)(p.ws + WS_KRC);
    for (int i = gtid; i < 2 * 2 * 256 * 32 / 4; i += gth) {
        const int e = i * 4, w = e & 31, t = (e >> 5) & 255, L = (e >> 13) & 1, b = e >> 14;
        const size_t d = ((size_t)(L * 2 + b) * 256 + t) * 32 + w;
        const f32x4 a = *(const f32x4*)(p.in[5] + e);
        *(u32x2*)(krc + d) = (u32x2){pk2(a.x, a.y), pk2(a.z, a.w)};
    }
}

__device__ __forceinline__ void phase7(const Params& p, Ctx& C, int L) {
    const int gw = C.bid * 8 + C.wid, NGW = C.G * 8;
    const float* modv = (const float*)(p.ws + WS_MODV);
    const bf16_t* O = (const bf16_t*)(p.ws + WS_O); float* X1 = p.out + OFF_Y; bf16_t* H = (bf16_t*)(p.ws + WS_H);
    const float* gpost = p.in[13] + L * DM; const float* gpre = p.in[14] + L * DM;
    for (int T = gw; T < NTOK; T += NGW) {
        const float* xr = (L == 0) ? x_in_row(p, T) : p.out + OFF_Y + (size_t)T * DM;
        const float* mv = modv + (size_t)(L * 3 + tok_cls(T)) * 6144;
        f32x4 o[4]; load_row_bf16(O + (size_t)T * LDH, o, C.lane);
        float ss = 0.f;
#pragma unroll
        for (int j = 0; j < 4; ++j) ss += (o[j].x * o[j].x + o[j].y * o[j].y) + (o[j].z * o[j].z + o[j].w * o[j].w);
        const float rstd = 1.0f / sqrtf(wave_sum(ss) * (1.0f / DM) + EPS);
        f32x4 x1[4];
#pragma unroll
        for (int j = 0; j < 4; ++j) {
            const f32x4 xv = ((const f32x4*)xr)[C.lane + 64 * j], gp = ((const f32x4*)gpost)[C.lane + 64 * j], g1 = ((const f32x4*)(mv + 2048))[C.lane + 64 * j];
            x1[j] = xv + g1 * (o[j] * rstd * gp);
            ((f32x4*)(X1 + (size_t)T * DM))[C.lane + 64 * j] = x1[j];
        }
        row_norm_mod(x1, gpre, mv + 4096, mv + 3072, H + (size_t)T * LDH, C.lane);
    }
}
__device__ __forceinline__ void phase10(const Params& p, Ctx& C, int L) {
    const int gw = C.bid * 8 + C.wid, NGW = C.G * 8;
    const float* modv = (const float*)(p.ws + WS_MODV);
    const float* X1 = p.out + OFF_Y; bf16_t* H = (bf16_t*)(p.ws + WS_H);
    const float* gpost = p.in[15] + L * DM;
    for (int T = gw; T < NTOK; T += NGW) {
        const float* mv = modv + (size_t)(L * 3 + tok_cls(T)) * 6144;
        f32x4 f[4]; load_row_bf16(H + (size_t)T * LDH, f, C.lane);
        float ss = 0.f;
#pragma unroll
        for (int j = 0; j < 4; ++j) ss += (f[j].x * f[j].x + f[j].y * f[j].y) + (f[j].z * f[j].z + f[j].w * f[j].w);
        const float rstd = 1.0f / sqrtf(wave_sum(ss) * (1.0f / DM) + EPS);
        f32x4 y[4];
#pragma unroll
        for (int j = 0; j < 4; ++j) {
            const f32x4 xv = ((const f32x4*)(X1 + (size_t)T * DM))[C.lane + 64 * j], gp = ((const f32x4*)gpost)[C.lane + 64 * j], g2 = ((const f32x4*)(mv + 5120))[C.lane + 64 * j];
            y[j] = xv + g2 * (f[j] * rstd * gp);
            ((f32x4*)(p.out + OFF_Y + (size_t)T * DM))[C.lane + 64 * j] = y[j];
        }
        if (L == 0) { const float* mv1 = modv + (size_t)(1 * 3 + tok_cls(T)) * 6144; row_norm_mod(y, p.in[12] + DM, mv1 + 1024, mv1, H + (size_t)T * LDH, C.lane, p.ws + WS_H8 + (size_t)T * LD8); }
    }
}

__device__ __forceinline__ int lds_byte(int r, int c) { const int st = (r >> 4) * 2 + (c >> 5), ob = (r & 15) * 64 + (c & 31) * 2; return st * 1024 + (ob ^ (((ob >> 9) & 1) << 5)); }
__device__ __forceinline__ void stage_rc(int b, int& R, int& Cc) { const int st = b >> 10, sb = b & 1023, swz = sb ^ (((sb >> 9) & 1) << 5); R = (st >> 1) * 16 + swz / 64; Cc = (st & 1) * 32 + (swz % 64) / 2; }
#define GLDS16(gp, lp) __builtin_amdgcn_global_load_lds((const unsigned*)(gp), (LAS unsigned*)(lp), 16, 0, 0)

template <int TM, int TN> struct GemmStage {
    static constexpr int STAGE = (TM + TN) * 128;
    int offA, offB;
    int lda, ldb;
    __device__ __forceinline__ void init(const Ctx& C, int lda_, int ldb_) { int R, Cc; stage_rc(C.wid * 1024 + C.lane * 16, R, Cc); lda = lda_; ldb = ldb_; offA = R * lda + Cc; offB = R * ldb + Cc; }
    __device__ __forceinline__ void stage(const Ctx& C, int buf, const bf16_t* a, const bf16_t* b) const {
        LAS unsigned char* base = C.lds + buf * STAGE + C.wid * 1024;
#pragma unroll
        for (int i = 0; i < TM / 64; ++i) GLDS16(a + offA + (size_t)i * 64 * lda, base + i * 8192);
#pragma unroll
        for (int i = 0; i < TN / 64; ++i) GLDS16(b + offB + (size_t)i * 64 * ldb, base + TM * 128 + i * 8192);
    }
};
template <int TM, int TN, int MF, int NF>
__device__ __forceinline__ void gemm_compute(const Ctx& C, int buf, int wr, int wc, f32x4 (&acc)[MF][NF]) {
    constexpr int STAGE = (TM + TN) * 128;
    LAS unsigned char* sa = C.lds + buf * STAGE; LAS unsigned char* sb = sa + TM * 128;
#pragma unroll
    for (int ks = 0; ks < 2; ++ks) {
        bf16x8 Af[MF], Bf[NF];
        const int ao = lds_byte(wr * MF * 16 + C.fr, ks * 32 + C.fq * 8), bo = lds_byte(wc * NF * 16 + C.fr, ks * 32 + C.fq * 8);
#pragma unroll
        for (int m = 0; m < MF; ++m) Af[m] = *(const LAS bf16x8*)(sa + ao + m * 2048);
#pragma unroll
        for (int n = 0; n < NF; ++n) Bf[n] = *(const LAS bf16x8*)(sb + bo + n * 2048);
#pragma unroll
        for (int m = 0; m < MF; ++m)
#pragma unroll
            for (int n = 0; n < NF; ++n) acc[m][n] = __builtin_amdgcn_mfma_f32_16x16x32_bf16(Bf[n], Af[m], acc[m][n], 0, 0, 0);
        __builtin_amdgcn_sched_barrier(0);
    }
}
template <int TM, int TN, int MF, int NF>
__device__ __forceinline__ void gemm_kloop(const Ctx& C, const GemmStage<TM, TN>& S, const bf16_t* A, const bf16_t* B, int nt, int wr, int wc, f32x4 (&acc)[MF][NF]) {
    S.stage(C, 0, A, B); VM_WAIT(); __syncthreads();
    for (int t = 0; t < nt; ++t) {
        const int cur = t & 1;
        if (t + 1 < nt) S.stage(C, cur ^ 1, A + (t + 1) * 64, B + (t + 1) * 64);
        gemm_compute<TM, TN, MF, NF>(C, cur, wr, wc, acc);
        VM_WAIT(); __syncthreads();
    }
}
__device__ __forceinline__ void unit_map(int u, int nM, int nN, int& pm, int& pn) {
    const int nwg = nM * nN; int wgid = u;
    { const int q = nwg / 8, r = nwg % 8, xcd = wgid % 8, off = wgid / 8; wgid = (xcd < r ? xcd * (q + 1) : r * (q + 1) + (xcd - r) * q) + off; }
    const int nig = 8 * nN, gid = wgid / nig, fm = gid * 8, gsz = (nM - fm) < 8 ? (nM - fm) : 8;
    pm = fm + ((wgid % nig) % gsz); pn = (wgid % nig) / gsz;
}
#define ZERO_ACC(acc, MF, NF) _Pragma("unroll") for (int m_ = 0; m_ < MF; ++m_) _Pragma("unroll") for (int n_ = 0; n_ < NF; ++n_) acc[m_][n_] = (f32x4){0.f, 0.f, 0.f, 0.f}


struct G8Unit { const char* A; const char* B; int e0, e1, e2, e3; };
__device__ __forceinline__ int perm32(int rho) { const int n = rho >> 4, i = rho & 15; return 8 * (i >> 2) + 4 * n + (i & 3); }
__device__ __forceinline__ i32x8 cat8(bf16x8 a, bf16x8 b) { return __builtin_shufflevector(__builtin_bit_cast(i32x4, a), __builtin_bit_cast(i32x4, b), 0, 1, 2, 3, 4, 5, 6, 7); }
#define G8_EPI_PLAIN static __device__ __forceinline__ f32x4 init(const G8Unit&, int, int, int, int) { return (f32x4){0.f, 0.f, 0.f, 0.f}; } static constexpr bool FP8 = false; static constexpr int HROWS_B = 128; static __device__ __forceinline__ int brow(int R) { return PERM ? ((R & ~31) + perm32(R & 31)) : R; }
template <class Epi, class Sched>
__device__ __forceinline__ void gemm8(const Ctx& C, int K, int lda, int ldb, const Sched& S, const Epi& E) {
    constexpr int HTB = 16384;
    LAS unsigned char* lds = C.lds;
    const int tid = C.tid, wid = C.wid, lane = C.lane, wr = wid >> 2, wc = wid & 3, fr = lane & 15, fq = lane >> 4;
    const int nt = K / 64;
    unsigned voffA, voffB;
    { int R, Cc; stage_rc(tid * 16, R, Cc); voffA = (unsigned)(R * lda + Cc) * 2u; voffB = (unsigned)(Epi::brow(R) * ldb + Cc) * 2u; }
    const size_t kstep = 128;
    const size_t hstepA = (size_t)128 * lda * 2, hstepB = (size_t)Epi::HROWS_B * ldb * 2;
    const size_t r64A = (size_t)64 * lda * 2, r64B = (size_t)(Epi::brow(64) - Epi::brow(0)) * ldb * 2;
    const unsigned ldsw = (unsigned)__builtin_amdgcn_readfirstlane((int)((unsigned)(size_t)lds + (unsigned)wid * 1024u));
    const int aoff = lds_byte(wr * 64 + fr, fq * 8), boff = lds_byte(wc * 32 + fr, fq * 8);
#define G8_SA(b, h) (((b) * 2 + (h)) * HTB)
#define G8_SB(b, h) ((4 + (b) * 2 + (h)) * HTB)
#define G8_GLDS(vo, sb, la) asm volatile("s_mov_b32 m0, %2\n\ts_nop 0\n\tglobal_load_lds_dwordx4 %0, %1" :: "v"(vo), "s"(sb), "s"(la) : "memory", "m0")
#define G8_STAGE(bufoff, gbase, voff, r64) do { const char* _g = (const char*)(gbase); const unsigned _l = ldsw + (unsigned)(bufoff); G8_GLDS(voff, _g, _l); \
        const char* _g2 = _g + (r64); G8_GLDS(voff, _g2, _l + 8192u); } while (0)
#define G8_LDA(dst, b, h) do { _Pragma("unroll") for (int m = 0; m < 4; ++m) _Pragma("unroll") for (int k = 0; k < 2; ++k) dst[m][k] = *(const LAS bf16x8*)(lds + G8_SA(b, h) + aoff + m * 2048 + k * 1024); } while (0)
#define G8_LDB(dst, b, h) do { _Pragma("unroll") for (int n = 0; n < 2; ++n) _Pragma("unroll") for (int k = 0; k < 2; ++k) dst[n][k] = *(const LAS bf16x8*)(lds + G8_SB(b, h) + boff + n * 2048 + k * 1024); } while (0)
#define G8_MMA(ai, bj, At, Bt) do { __builtin_amdgcn_s_setprio(1); _Pragma("unroll") for (int m = 0; m < 4; ++m) _Pragma("unroll") for (int n = 0; n < 2; ++n) { \
        if constexpr (Epi::FP8) acc[ai][bj][m][n] = __builtin_amdgcn_mfma_scale_f32_16x16x128_f8f6f4(cat8(Bt[n][0], Bt[n][1]), cat8(At[m][0], At[m][1]), acc[ai][bj][m][n], 0, 0, 0, 0, 0, 0); \
        else { _Pragma("unroll") for (int k = 0; k < 2; ++k) acc[ai][bj][m][n] = __builtin_amdgcn_mfma_f32_16x16x32_bf16(Bt[n][k], At[m][k], acc[ai][bj][m][n], 0, 0, 0); } } \
        __builtin_amdgcn_s_setprio(0); } while (0)
#define G8_WAIT_V(n) asm volatile("s_waitcnt vmcnt(" #n ")" ::: "memory")
#define G8_WAIT_L(n) asm volatile("s_waitcnt lgkmcnt(" #n ")" ::: "memory")
#define G8_BAR __builtin_amdgcn_s_barrier()
#define G8_SCHED __builtin_amdgcn_sched_barrier(0)
    G8Unit cur, nxt; int ui = 0;
    if (!S.next(0, cur)) return;
    f32x4 acc[2][2][4][2];
#pragma unroll
    for (int a = 0; a < 2; ++a)
#pragma unroll
        for (int b = 0; b < 2; ++b)
#pragma unroll
            for (int m = 0; m < 4; ++m)
#pragma unroll
                for (int n = 0; n < 2; ++n) acc[a][b][m][n] = E.init(cur, b, n, wc, fq);
    bf16x8 At[4][2], B0[2][2], B1[2][2];
    const char* cA = cur.A; const char* cB = cur.B;
    G8_STAGE(G8_SB(0, 0), cB, voffB, r64B); G8_STAGE(G8_SA(0, 0), cA, voffA, r64A); G8_STAGE(G8_SB(0, 1), cB + hstepB, voffB, r64B); G8_STAGE(G8_SA(0, 1), cA + hstepA, voffA, r64A);
    if (wr == 1) G8_BAR;
    G8_WAIT_V(4); G8_BAR;
    G8_STAGE(G8_SB(1, 0), cB + kstep, voffB, r64B); G8_STAGE(G8_SA(1, 0), cA + kstep, voffA, r64A); G8_STAGE(G8_SB(1, 1), cB + hstepB + kstep, voffB, r64B);
    G8_WAIT_V(6); G8_BAR;
    for (;;) {
        const bool has_next = S.next(ui + 1, nxt);
        const char* nA = has_next ? nxt.A : cA; const char* nB = has_next ? nxt.B : cB;
#pragma unroll 1
        for (int t = 0; t < nt; t += 2) {
            const bool last = (t == nt - 2);
            const char* a1 = cA + (size_t)(t + 1) * kstep;
            const char* a2 = last ? nA : cA + (size_t)(t + 2) * kstep; const char* b2 = last ? nB : cB + (size_t)(t + 2) * kstep;
            const char* a3 = a2 + kstep; const char* b3 = b2 + kstep;
            G8_LDB(B0, 0, 0); G8_SCHED; G8_LDA(At, 0, 0); G8_STAGE(G8_SA(1, 1), a1 + hstepA, voffA, r64A);
            G8_WAIT_L(8); G8_BAR; G8_WAIT_L(0); G8_MMA(0, 0, At, B0); G8_BAR; G8_SCHED;
            G8_LDB(B1, 0, 1); G8_STAGE(G8_SB(0, 0), b2, voffB, r64B);
            G8_BAR; G8_WAIT_L(0); G8_MMA(0, 1, At, B1); G8_BAR;
            G8_LDA(At, 0, 1); G8_STAGE(G8_SA(0, 0), a2, voffA, r64A);
            G8_BAR; G8_WAIT_L(0); G8_MMA(1, 0, At, B0); G8_BAR; G8_SCHED;
            G8_STAGE(G8_SB(0, 1), b2 + hstepB, voffB, r64B);
            G8_WAIT_V(6); G8_BAR; G8_MMA(1, 1, At, B1); G8_BAR;
            G8_LDB(B0, 1, 0); G8_SCHED; G8_LDA(At, 1, 0); G8_STAGE(G8_SA(0, 1), a2 + hstepA, voffA, r64A);
            G8_WAIT_L(8); G8_BAR; G8_WAIT_L(0); G8_MMA(0, 0, At, B0); G8_BAR; G8_SCHED;
            G8_LDB(B1, 1, 1); G8_STAGE(G8_SB(1, 0), b3, voffB, r64B);
            G8_BAR; G8_WAIT_L(0); G8_MMA(0, 1, At, B1); G8_BAR;
            G8_LDA(At, 1, 1); G8_STAGE(G8_SA(1, 0), a3, voffA, r64A);
            G8_BAR; G8_WAIT_L(0); G8_MMA(1, 0, At, B0); G8_BAR; G8_SCHED;
            G8_STAGE(G8_SB(1, 1), b3 + hstepB, voffB, r64B);
            G8_WAIT_V(6); G8_BAR; G8_MMA(1, 1, At, B1); G8_BAR;
        }
        if constexpr (!Epi::AFTER_DRAIN) E(acc, cur, wr, wc, fr, fq);
        if (!has_next) break;
#pragma unroll
        for (int a = 0; a < 2; ++a)
#pragma unroll
            for (int b = 0; b < 2; ++b)
#pragma unroll
                for (int m = 0; m < 4; ++m)
#pragma unroll
                    for (int n = 0; n < 2; ++n) acc[a][b][m][n] = E.init(nxt, b, n, wc, fq);
        cur = nxt; cA = nA; cB = nB; ++ui;
    }
    G8_WAIT_V(0);
    if (wr == 0) G8_BAR;
    G8_BAR;
    if constexpr (Epi::AFTER_DRAIN) E.drained(C, acc, cur, wr, wc, fr, fq);
#undef G8_SA
#undef G8_SB
#undef G8_STAGE
#undef G8_GLDS
#undef G8_LDA
#undef G8_LDB
#undef G8_MMA
#undef G8_WAIT_V
#undef G8_WAIT_L
#undef G8_BAR
#undef G8_SCHED
}
struct TileSched {
    const char* A; const char* B; size_t tstepA, tstepB; int nM, nN, G, c;
    __device__ __forceinline__ bool next(int i, G8Unit& u) const {
        const int L = i * G + c; if (L >= nM * nN) return false;
        int pm, pn; unit_map(L, nM, nN, pm, pn);
        u.A = A + (size_t)pm * tstepA; u.B = B + (size_t)pn * tstepB; u.e0 = pm; u.e1 = pn; u.e2 = 0; u.e3 = 0; return true;
    }
};
struct EpiBf16 {
    static constexpr bool PERM = true, AFTER_DRAIN = false; G8_EPI_PLAIN
    bf16_t* O; int ldo;
    __device__ __forceinline__ void operator()(const f32x4 (&acc)[2][2][4][2], const G8Unit& u, int wr, int wc, int fr, int fq) const {
        const int row0 = u.e0 * 256 + wr * 64 + fr, col0 = u.e1 * 256 + wc * 32 + 8 * fq;
#pragma unroll
        for (int ai = 0; ai < 2; ++ai)
#pragma unroll
            for (int m = 0; m < 4; ++m) { bf16_t* rowp = O + (size_t)(row0 + ai * 128 + m * 16) * ldo + col0;
#pragma unroll
                for (int bj = 0; bj < 2; ++bj) { const f32x4 v0 = acc[ai][bj][m][0], v1 = acc[ai][bj][m][1];
                    *(u32x4*)(rowp + bj * 128) = (u32x4){pk2(v0.x, v0.y), pk2(v0.z, v0.w), pk2(v1.x, v1.y), pk2(v1.z, v1.w)}; } }
    }
};
struct EpiInProj {
    static constexpr bool PERM = true, AFTER_DRAIN = false; G8_EPI_PLAIN
    bf16_t* P; float* out; int L;
    __device__ __forceinline__ void operator()(const f32x4 (&acc)[2][2][4][2], const G8Unit& u, int wr, int wc, int fr, int fq) const {
        const int row0 = u.e0 * 256 + wr * 64 + fr, col0 = u.e1 * 256 + wc * 32 + 8 * fq;
        const bool ctx = u.e0 < 32;
#pragma unroll
        for (int bj = 0; bj < 2; ++bj) { const int col = col0 + bj * 128;
            int W = 0, cc = 0; size_t off = 0;
            if (ctx) {
                if (col >= COL_KA && col < COL_VA) { off = OFF_NAK; W = 256; cc = col - COL_KA; }
                else if (col >= COL_VA && col < COL_CQ) { off = OFF_NAV; W = 256; cc = col - COL_VA; }
                else if (col >= COL_CKV && col < COL_KR) { off = OFF_CKV; W = 128; cc = col - COL_CKV; }
                else if (col >= COL_KR && col < COL_QC) { off = OFF_KR; W = 32; cc = col - COL_KR; }
                else if (col >= COL_KC && col < COL_VC) { off = OFF_SWK; W = 128; cc = col - COL_KC; }
                else if (col >= COL_VC && col < COL_PD) { off = OFF_SWV; W = 128; cc = col - COL_VC; }
            }
            float* dbase = out + off + cc;
#pragma unroll
            for (int ai = 0; ai < 2; ++ai)
#pragma unroll
                for (int m = 0; m < 4; ++m) { const int row = row0 + ai * 128 + m * 16; const f32x4 v0 = acc[ai][bj][m][0], v1 = acc[ai][bj][m][1];
                    if (col < IN_DIM) *(u32x4*)(P + (size_t)row * LDP + col) = (u32x4){pk2(v0.x, v0.y), pk2(v0.z, v0.w), pk2(v1.x, v1.y), pk2(v1.z, v1.w)};
                    if (W) { float* dst = dbase + (size_t)(((row >> 8) * 2 + L) * 256 + (row & 255)) * W; *(f32x4*)dst = v0; *(f32x4*)(dst + 4) = v1; } }
        }
    }
};
__device__ __forceinline__ void phase2(const Params& p, Ctx& C, int L) {
    TileSched S{(const char*)(p.ws + WS_H), (const char*)(p.ws + WS_W + (size_t)L * W_LAYER + WO_IN), (size_t)256 * LDH * 2, (size_t)256 * LDW * 2, 48, 8, C.G, C.bid};
    EpiInProj E{(bf16_t*)(p.ws + WS_P), p.out, L};
    gemm8(C, DM, LDH, LDW, S, E);
}

__device__ __forceinline__ void rope_pair(bf16_t* p1, bf16_t* p2, float pos, float inv) {
    const float ang = pos * inv; float rev = ang * 0.15915494309189535f; rev -= floorf(rev);
    const float s = __builtin_amdgcn_sinf(rev), c = __builtin_amdgcn_cosf(rev);
    const float x1 = bf2f(*p1), x2 = bf2f(*p2);
    const unsigned o = pk2(x1 * c - x2 * s, x1 * s + x2 * c);
    *p1 = (bf16_t)(o & 0xffffu); *p2 = (bf16_t)(o >> 16);
}
__device__ __forceinline__ void phase3(const Params& p, Ctx& C, int L) {
    bf16_t* P = (bf16_t*)(p.ws + WS_P);
    {
        const int gw = C.bid * 8 + C.wid, NGW = C.G * 8;
        for (int t = gw; t < NLAT; t += NGW) {
            bf16_t* row = P + (size_t)(NCTX + t) * LDP; const int pos = t & 2047; const float prow = (float)(pos >> 6), pcol = (float)(pos & 63);
            for (int i = C.lane; i < 208; i += 64) {
                if (i < 16) { const int blk = i >> 3, f = i & 7; bf16_t* b = row + COL_KR + blk * 16 + f; rope_pair(b, b + 8, blk ? pcol : prow, exp2f(-(float)f * (13.287712379549449f / 8.0f))); }
                else { const int j = i - 16, head = j >> 5, blk = (j >> 4) & 1, f = j & 15;
                    bf16_t* b = row + COL_QC + head * 64 + blk * 32 + f; rope_pair(b, b + 16, blk ? pcol : prow, exp2f(-(float)f * (13.287712379549449f / 16.0f))); }
            }
        }
    }
    const int wr = C.wid >> 2, wc = C.wid & 3;
    LAS float* rs = (LAS float*)(C.lds + LDS_TAB);
    const unsigned char* wb = p.ws + WS_W + (size_t)L * W_LAYER;
    int R, Cc; stage_rc(C.wid * 1024 + C.lane * 16, R, Cc);
    const int Rb = (R & ~31) + perm32(R & 31);
    for (int u = C.bid; u < 96 * 7 + 4 * 4; u += C.G) {
        int pm, tn;
        if (u < 672) { pm = u / 7; tn = u % 7; } else { const int r = u - 672; pm = 96 + (r >> 2); tn = 3 + (r & 3); }
        const int which = tn >= 3, K = which ? 128 : 192, nkt = K / 64, ldb = which ? LDUKV : LDUQ, n0 = (which ? tn - 3 : tn) * 128;
        const bf16_t* A; int lda;
        if (pm < 96) { A = P + (size_t)pm * 128 * LDP + (which ? COL_CKV : COL_CQ); lda = LDP; }
        else { A = (const bf16_t*)(p.ws + WS_CKVC) + (size_t)(L * 512 + (pm - 96) * 128) * LDCKVC; lda = LDCKVC; }
        const bf16_t* B = (const bf16_t*)(wb + (which ? WO_UKV : WO_UQ)) + (size_t)n0 * ldb;
        for (int t = 0; t < nkt; ++t) { LAS unsigned char* base = C.lds + t * 32768 + C.wid * 1024;
            const bf16_t* a = A + (size_t)R * lda + Cc + t * 64; const bf16_t* bq = B + (size_t)Rb * ldb + Cc + t * 64;
            GLDS16(a, base); GLDS16(a + (size_t)64 * lda, base + 8192); GLDS16(bq, base + 16384); GLDS16(bq + (size_t)64 * ldb, base + 16384 + 8192); }
        VM_WAIT(); __syncthreads();
        { const int row = C.tid >> 2, part = C.tid & 3; float ss = 0.f;
            for (int c = part; c < K / 8; c += 4) { const int t = c >> 3, cc = (c & 7) * 8; const u32x4 q = *(const LAS u32x4*)(C.lds + t * 32768 + lds_byte(row, cc));
                ss += lo16(q.x) * lo16(q.x) + hi16(q.x) * hi16(q.x) + lo16(q.y) * lo16(q.y) + hi16(q.y) * hi16(q.y) + lo16(q.z) * lo16(q.z) + hi16(q.z) * hi16(q.z) + lo16(q.w) * lo16(q.w) + hi16(q.w) * hi16(q.w); }
            ss += __shfl_xor(ss, 1); ss += __shfl_xor(ss, 2);
            if (part == 0) rs[row] = __builtin_amdgcn_rsqf(ss / (float)K + EPS); }
        f32x4 acc[4][2]; ZERO_ACC(acc, 4, 2);
        for (int t = 0; t < nkt; ++t) gemm_compute<128, 128, 4, 2>(C, t, wr, wc, acc);
        __syncthreads();
        bf16_t* O; int ldo;
        if (pm < 96) { if (which) { O = (bf16_t*)(p.ws + WS_KVUP) + (size_t)pm * 128 * LDKV; ldo = LDKV; } else { O = (bf16_t*)(p.ws + WS_QUP) + (size_t)pm * 128 * LDQ; ldo = LDQ; } }
        else { O = (bf16_t*)(p.ws + WS_KVCUP) + (size_t)(L * 512 + (pm - 96) * 128) * LDKV; ldo = LDKV; }
#pragma unroll
        for (int m = 0; m < 4; ++m) { const int r = wr * 64 + m * 16 + C.fr; const float sc = rs[r]; const f32x4 v0 = acc[m][0] * sc, v1 = acc[m][1] * sc;
            *(u32x4*)(O + (size_t)r * ldo + n0 + wc * 32 + 8 * C.fq) = (u32x4){pk2(v0.x, v0.y), pk2(v0.z, v0.w), pk2(v1.x, v1.y), pk2(v1.z, v1.w)}; }
        __syncthreads();
    }
}

struct AttnSeg { const bf16_t* K; const bf16_t* K2; const bf16_t* V; int ldk, ldk2, ldv, n, tok0; };
struct AttnDesc { const bf16_t* Q; bf16_t* O; AttnSeg seg[2]; int ldq, ldo; float c1, m0, l0; int qtok0; int rope_q; };
typedef short v4i16_t __attribute__((ext_vector_type(4)));
__device__ __forceinline__ s16x4 vtr(const LAS unsigned char* p) { return __builtin_bit_cast(s16x4, __builtin_amdgcn_ds_read_tr16_b64_v4i16((LAS v4i16_t*)p)); }

template <int DQK, int KIND, int QB>
__device__ __forceinline__ void attn_unit(const Ctx& C, const AttnDesc& D, const LAS float* rpb) {
    constexpr int KROW = DQK * 2 + 16, VROW = 160, KBYTES = 64 * KROW, BUFB = KBYTES + 64 * VROW, CPK = DQK / 8, NKC = 64 * CPK;
    const int fr = C.fr, fq = C.fq;
    bf16x8 Qf[QB][DQK / 32];
#pragma unroll
    for (int qb = 0; qb < QB; ++qb) { const bf16_t* qrow = D.Q + (size_t)(qb * 128 + C.wid * 16 + fr) * D.ldq;
#pragma unroll
        for (int s = 0; s < DQK / 32; ++s) Qf[qb][s] = *(const bf16x8*)(qrow + s * 32 + fq * 8); }
    const int qtok = D.qtok0 + C.wid * 16 + fr;
    if (QB == 1 && DQK == 96 && D.rope_q) {
        bf16x8 mine = Qf[0][2], oth;
#pragma unroll
        for (int j = 0; j < 8; ++j) oth[j] = (short)__shfl_xor((int)mine[j], 16);
        const float pos = (fq < 2) ? (float)(qtok >> 6) : (float)(qtok & 63);
#pragma unroll
        for (int j = 0; j < 8; j += 2) {
            float o2[2];
#pragma unroll
            for (int e = 0; e < 2; ++e) {
                const float ang = pos * exp2f(-(float)(j + e) * (13.287712379549449f / 8.0f)); float rev = ang * 0.15915494309189535f; rev -= floorf(rev);
                const float sn = __builtin_amdgcn_sinf(rev), cs = __builtin_amdgcn_cosf(rev);
                const float a = bf2f((bf16_t)mine[j + e]), b = bf2f((bf16_t)oth[j + e]);
                o2[e] = (fq & 1) ? (b * sn + a * cs) : (a * cs - b * sn);
            }
            const unsigned pk = pk2(o2[0], o2[1]); Qf[0][2][j] = (short)(pk & 0xffffu); Qf[0][2][j + 1] = (short)(pk >> 16);
        }
    }
    float m[QB], l[QB]; f32x4 Oa[QB][4];
#pragma unroll
    for (int qb = 0; qb < QB; ++qb) { m[qb] = D.m0; l[qb] = D.l0 * (fq == 0 ? 1.0f : 0.0f);
#pragma unroll
        for (int d = 0; d < 4; ++d) Oa[qb][d] = (f32x4){0.f, 0.f, 0.f, 0.f}; }
    int qrow_g = 0, qcol_g = 0, r0 = 0, cs0 = 0;
    if (KIND == 1) { qrow_g = qtok >> 6; qcol_g = qtok & 63; r0 = min(max(qrow_g - 4, 0), 24); cs0 = min(max(qcol_g - 8, 0), 48); }

    const int nt0 = D.seg[0].n >> 6, ntot = nt0 + (D.seg[1].n >> 6);
    u32x4 kreg[(NKC + 511) / 512], vreg;
    auto issue = [&](int t) {
        const AttnSeg& sg = (t < nt0) ? D.seg[0] : D.seg[1]; const int k0 = ((t < nt0) ? t : t - nt0) * 64;
#pragma unroll
        for (int i = 0; i < (NKC + 511) / 512; ++i) { const int c = C.tid + i * 512;
            if (c < NKC) { const int key = c / CPK, part = c % CPK;
                const bf16_t* src = (part < 8) ? sg.K + (size_t)(k0 + key) * sg.ldk + part * 8 : sg.K2 + (size_t)(k0 + key) * sg.ldk2 + (part - 8) * 8;
                kreg[i] = *(const u32x4*)src; } }
        { const int key = C.tid >> 3, part = C.tid & 7; vreg = *(const u32x4*)(sg.V + (size_t)(k0 + key) * sg.ldv + part * 8); }
    };
    auto commit = [&](int buf) {
        LAS unsigned char* kb = C.lds + buf * BUFB; LAS unsigned char* vb = kb + KBYTES;
#pragma unroll
        for (int i = 0; i < (NKC + 511) / 512; ++i) { const int c = C.tid + i * 512; if (c < NKC) { const int key = c / CPK, part = c % CPK; *(LAS u32x4*)(kb + key * KROW + part * 16) = kreg[i]; } }
        { const int key = C.tid >> 3, part = C.tid & 7; *(LAS u32x4*)(vb + key * VROW + part * 16) = vreg; }
    };
    issue(0);
    for (int t = 0; t < ntot; ++t) {
        const int buf = t & 1;
        commit(buf);
        __syncthreads();
        if (t + 1 < ntot) issue(t + 1);
        const LAS unsigned char* kb = C.lds + buf * BUFB; const LAS unsigned char* vb = kb + KBYTES;
        f32x4 s[QB][4];
#pragma unroll
        for (int kg = 0; kg < 4; ++kg) {
#pragma unroll
            for (int qb = 0; qb < QB; ++qb) s[qb][kg] = (f32x4){0.f, 0.f, 0.f, 0.f};
#pragma unroll
            for (int ks = 0; ks < DQK / 32; ++ks) { const bf16x8 Kf = *(const LAS bf16x8*)(kb + (kg * 16 + fr) * KROW + ks * 64 + fq * 16);
#pragma unroll
                for (int qb = 0; qb < QB; ++qb) s[qb][kg] = __builtin_amdgcn_mfma_f32_16x16x32_bf16(Kf, Qf[qb][ks], s[qb][kg], 0, 0, 0); }
        }
        const bool seg1 = (t >= nt0);
        const int ktile0 = seg1 ? D.seg[1].tok0 + (t - nt0) * 64 : 0;
        bf16x8 Pf[QB][2];
#pragma unroll
        for (int qb = 0; qb < QB; ++qb) {
            float mx = -1e30f;
#pragma unroll
            for (int kg = 0; kg < 4; ++kg)
#pragma unroll
                for (int j = 0; j < 4; ++j) {
                    float v = s[qb][kg][j] * D.c1;
                    if (KIND == 1 && seg1) { const int kt = ktile0 + kg * 16 + 4 * fq + j, krow = kt >> 6, kcol = kt & 63;
                        const bool ok = (krow >= r0) && (krow < r0 + 8) && (kcol >= cs0) && (kcol < cs0 + 16);
                        const int dr = min(max(krow - qrow_g + 7, 0), 14), dc = min(max(kcol - qcol_g + 15, 0), 30);
                        v = ok ? v + rpb[dr * 31 + dc] : -1e30f; }
                    if (KIND == 2 && seg1) { const int kt = ktile0 + kg * 16 + 4 * fq + j; const int dd = kt - qtok; v = (dd <= 128 && dd >= -128) ? v : -1e30f; }
                    s[qb][kg][j] = v; mx = fmaxf(mx, v);
                }
            mx = qmax4(mx);
            const float mn = fmaxf(m[qb], mx), alpha = __builtin_amdgcn_exp2f(m[qb] - mn); m[qb] = mn;
            float ps = 0.f;
#pragma unroll
            for (int kg = 0; kg < 4; ++kg)
#pragma unroll
                for (int j = 0; j < 4; ++j) { const float e = __builtin_amdgcn_exp2f(s[qb][kg][j] - mn); s[qb][kg][j] = e; ps += e; }
            l[qb] = l[qb] * alpha + ps;
#pragma unroll
            for (int d = 0; d < 4; ++d) Oa[qb][d] = Oa[qb][d] * alpha;
#pragma unroll
            for (int k2 = 0; k2 < 2; ++k2) {
                u32x4 pw; pw.x = pk2(s[qb][2 * k2][0], s[qb][2 * k2][1]); pw.y = pk2(s[qb][2 * k2][2], s[qb][2 * k2][3]); pw.z = pk2(s[qb][2 * k2 + 1][0], s[qb][2 * k2 + 1][1]); pw.w = pk2(s[qb][2 * k2 + 1][2], s[qb][2 * k2 + 1][3]);
                Pf[qb][k2] = __builtin_bit_cast(bf16x8, pw); }
        }
#pragma unroll
        for (int k2 = 0; k2 < 2; ++k2)
#pragma unroll
            for (int d = 0; d < 4; ++d) {
                const LAS unsigned char* a0 = vb + (32 * k2 + 4 * fq + (fr >> 2)) * VROW + (d * 16 + 4 * (fr & 3)) * 2;
                const s16x4 lo = vtr(a0), hi = vtr(a0 + 16 * VROW);
                const bf16x8 Vf = (bf16x8){lo[0], lo[1], lo[2], lo[3], hi[0], hi[1], hi[2], hi[3]};
#pragma unroll
                for (int qb = 0; qb < QB; ++qb) Oa[qb][d] = __builtin_amdgcn_mfma_f32_16x16x32_bf16(Vf, Pf[qb][k2], Oa[qb][d], 0, 0, 0);
            }
    }
    __syncthreads();
#pragma unroll
    for (int qb = 0; qb < QB; ++qb) {
        float lq = l[qb]; lq += __shfl_xor(lq, 16); lq += __shfl_xor(lq, 32);
        const float inv = 1.0f / lq;
        LAS unsigned char* st = C.lds + (qb * 8 + C.wid) * 2048;
#pragma unroll
        for (int d = 0; d < 4; ++d) { const f32x4 v = Oa[qb][d] * inv; *(LAS u32x2*)(st + fr * 128 + (d * 16 + 4 * fq) * 2) = (u32x2){pk2(v.x, v.y), pk2(v.z, v.w)}; }
        asm volatile("s_waitcnt lgkmcnt(0)" ::: "memory");
#pragma unroll
        for (int i = 0; i < 2; ++i) { const int row = i * 8 + (C.lane >> 3), ch = C.lane & 7; const u32x4 v = *(const LAS u32x4*)(st + row * 128 + ch * 16);
            *(u32x4*)(D.O + (size_t)(qb * 128 + C.wid * 16 + row) * D.ldo + ch * 8) = v; }
    }
    __syncthreads();
}

__device__ __forceinline__ void pool_unit(const Params& p, Ctx& C, int L, int unit) {
    const bf16_t* P = (const bf16_t*)(p.ws + WS_P); bf16_t* BR = (bf16_t*)(p.ws + WS_BR);
    CTX_FRESH(C);
    constexpr int WROW = 160, DROW = 544;
    const int T0 = unit * 64; int S0, Ls; if (T0 < NCTX) { S0 = T0 & ~255; Ls = 256; } else { S0 = NCTX + ((T0 - NCTX) & ~2047); Ls = 2048; }
    LAS bf16_t* raw = (LAS bf16_t*)C.lds;
    LAS unsigned char* wl = C.lds + 40960;
    LAS unsigned char* dl = C.lds + 81920;
    f32x4 wreg[8];
    { const f32x4* Wg = (const f32x4*)(p.in[25] + (size_t)L * 4 * 64 * 64);
#pragma unroll
        for (int i = 0; i < 8; ++i) wreg[i] = Wg[C.tid + i * 512]; }
    for (int i = C.tid; i < 80 * 32; i += 512) { const int r = i >> 5, c = i & 31; const int T = T0 - 8 + r;
        u32x4 v = (u32x4){0u, 0u, 0u, 0u}; if (T >= S0 && T < S0 + Ls) v = *(const u32x4*)(P + (size_t)T * LDP + COL_PD + c * 8);
        *(LAS u32x4*)(raw + r * 256 + c * 8) = v; }
#pragma unroll
    for (int i = 0; i < 8; ++i) { const int e4 = (C.tid + i * 512) * 4, gi = e4 >> 12, c = (e4 >> 6) & 63, e = e4 & 63;
        *(LAS u32x2*)(wl + (gi * 64 + c) * WROW + e * 2) = (u32x2){pk2(wreg[i].x, wreg[i].y), pk2(wreg[i].z, wreg[i].w)}; }
    __syncthreads();
    { const int ch = C.tid & 255, t0 = (C.tid >> 8) * 32, gi = __builtin_amdgcn_readfirstlane(ch >> 6), hw = 1 << gi;
        const LAS bf16_t* col = raw + ch;
        float sum = 0.f;
        for (int r = t0 + 8 - hw; r < t0 + 8 + hw; ++r) sum += bf2f(col[r * 256]);
        const int tl0 = T0 - S0 + t0;
#pragma unroll 4
        for (int i = 0; i < 32; ++i) { const int t = t0 + i, tl = tl0 + i; const int lo = max(tl - hw, 0), hi = min(tl + hw, Ls);
            const float d = sum * __builtin_amdgcn_rcpf((float)(hi - lo)) - bf2f(col[(t + 8) * 256]);
            *(LAS bf16_t*)(dl + t * DROW + ch * 2) = (bf16_t)(pk2(d, 0.f) & 0xffffu);
            sum += bf2f(col[(t + 8 + hw) * 256]) - bf2f(col[(t + 8 - hw) * 256]); }
    }
    __syncthreads();
    { const int gi = C.wid & 3, mh = C.wid >> 2, fr = C.fr, fq = C.fq;
        f32x4 acc[2][4];
#pragma unroll
        for (int mb = 0; mb < 2; ++mb)
#pragma unroll
            for (int d = 0; d < 4; ++d) acc[mb][d] = (f32x4){0.f, 0.f, 0.f, 0.f};
#pragma unroll
        for (int ks = 0; ks < 2; ++ks) {
            bf16x8 Af[2];
#pragma unroll
            for (int mb = 0; mb < 2; ++mb) { const LAS unsigned char* ap = dl + (mh * 32 + mb * 16 + fr) * DROW + (gi * 64 + ks * 32 + 4 * fq) * 2;
                const s16x4 lo = *(const LAS s16x4*)ap, hi = *(const LAS s16x4*)(ap + 32); Af[mb] = (bf16x8){lo[0], lo[1], lo[2], lo[3], hi[0], hi[1], hi[2], hi[3]}; }
#pragma unroll
            for (int d = 0; d < 4; ++d) { const LAS unsigned char* a0 = wl + (gi * 64 + 32 * ks + 4 * fq + (fr >> 2)) * WROW + (d * 16 + 4 * (fr & 3)) * 2;
                const s16x4 lo = vtr(a0), hi = vtr(a0 + 16 * WROW);
                const bf16x8 Wf = (bf16x8){lo[0], lo[1], lo[2], lo[3], hi[0], hi[1], hi[2], hi[3]};
#pragma unroll
                for (int mb = 0; mb < 2; ++mb) acc[mb][d] = __builtin_amdgcn_mfma_f32_16x16x32_bf16(Wf, Af[mb], acc[mb][d], 0, 0, 0); }
        }
        const float* sc = p.in[26] + L * 256 + gi * 64 + 4 * fq;
#pragma unroll
        for (int d = 0; d < 4; ++d) { const f32x4 s4 = *(const f32x4*)(sc + d * 16);
#pragma unroll
            for (int mb = 0; mb < 2; ++mb) { const f32x4 v = acc[mb][d] * s4;
                *(u32x2*)(BR + (size_t)(T0 + mh * 32 + mb * 16 + fr) * LDH + 768 + gi * 64 + d * 16 + 4 * fq) = (u32x2){pk2(v.x, v.y), pk2(v.z, v.w)}; } }
    }
    __syncthreads();
}

__device__ __forceinline__ void phase4(const Params& p, Ctx& C, int L, int rep = 0) {
    const bf16_t* P = (const bf16_t*)(p.ws + WS_P); bf16_t* BR = (bf16_t*)(p.ws + WS_BR);
    const bf16_t* QUP = (const bf16_t*)(p.ws + WS_QUP); const bf16_t* KVUP = (const bf16_t*)(p.ws + WS_KVUP);
    const bf16_t* KVC = (const bf16_t*)(p.ws + WS_KVCUP) + (size_t)L * 512 * LDKV;
    const bf16_t* NAK = (const bf16_t*)(p.ws + WS_NACK) + (size_t)L * 512 * LDNAC; const bf16_t* NAV = (const bf16_t*)(p.ws + WS_NACV) + (size_t)L * 512 * LDNAC;
    const bf16_t* SWK = (const bf16_t*)(p.ws + WS_SWCK) + (size_t)L * 512 * LDSWC; const bf16_t* SWV = (const bf16_t*)(p.ws + WS_SWCV) + (size_t)L * 512 * LDSWC;
    const bf16_t* KRC = (const bf16_t*)(p.ws + WS_KRC) + (size_t)L * 512 * 32;
    unsigned* qhead = (unsigned*)(p.ws + WS_CTL) + CW_QUEUE + 64 * (L * 2 + rep);
    volatile LAS unsigned* bc = (volatile LAS unsigned*)(C.lds + LDS_CTL + 16);
    LAS float* rpb = (LAS float*)(C.lds + LDS_TAB);
    const float ATT_C1 = 0.125f * LOG2E, MLA_C1 = 0.10206207261596575f * LOG2E;
    for (;;) {
        if (C.tid == 0) bc[0] = atomicAdd(qhead, 1u);
        __syncthreads();
        const int u = __builtin_amdgcn_readfirstlane((int)bc[0]);
        __syncthreads();
        if (u >= 960) break;
        AttnDesc D; D.rope_q = 0; D.m0 = -1e30f; D.l0 = 0.f; D.seg[1].K2 = nullptr; D.seg[0].K2 = nullptr; D.seg[0].ldk2 = 0; D.seg[1].ldk2 = 0; D.seg[0].tok0 = 0; D.seg[1].tok0 = 0;
        if (u < 128) {
            const int b = u >> 6, h = (u >> 4) & 3, qb = u & 15; const int T0 = NCTX + b * 2048;
            D.Q = QUP + (size_t)(T0 + qb * 128) * LDQ + h * 96; D.ldq = LDQ; D.O = BR + (size_t)(T0 + qb * 128) * LDH + 256 + h * 64; D.ldo = LDH;
            D.seg[0] = AttnSeg{KVC + (size_t)b * 256 * LDKV + h * 128, KRC + (size_t)b * 256 * 32, KVC + (size_t)b * 256 * LDKV + h * 128 + 64, LDKV, 32, LDKV, 256, 0};
            D.seg[1] = AttnSeg{KVUP + (size_t)T0 * LDKV + h * 128, P + (size_t)T0 * LDP + COL_KR, KVUP + (size_t)T0 * LDKV + h * 128 + 64, LDKV, LDP, LDKV, 2048, 0};
            D.c1 = MLA_C1; D.qtok0 = qb * 128; D.rope_q = 1;
#ifndef NO_A1
            attn_unit<96, 0, 1>(C, D, rpb);
#endif
        } else if (u < 256) {
            const int v = u - 128, b = v >> 6, h = (v >> 4) & 3, rp = v & 15; const int T0 = NCTX + b * 2048;
            const int ra = 2 * rp, r0a = min(max(ra - 4, 0), 24), r0b = min(max(ra + 1 - 4, 0), 24);
            for (int i = C.tid; i < 15 * 31; i += 512) rpb[i] = p.in[19][(size_t)(L * 4 + h) * 465 + i] * LOG2E;
            D.Q = P + (size_t)(T0 + ra * 64) * LDP + COL_QA + h * 64; D.ldq = LDP; D.O = BR + (size_t)(T0 + ra * 64) * LDH + 0 + h * 64; D.ldo = LDH;
            D.seg[0] = AttnSeg{NAK + (size_t)b * 256 * LDNAC + h * 64, nullptr, NAV + (size_t)b * 256 * LDNAC + h * 64, LDNAC, 0, LDNAC, 256, 0};
            D.seg[1] = AttnSeg{P + (size_t)(T0 + r0a * 64) * LDP + COL_KA + h * 64, nullptr, P + (size_t)(T0 + r0a * 64) * LDP + COL_VA + h * 64, LDP, 0, LDP, (r0b + 8 - r0a) * 64, r0a * 64};
            D.c1 = ATT_C1; D.qtok0 = ra * 64;
            __syncthreads();
#ifndef NO_A2
            attn_unit<64, 1, 1>(C, D, rpb);
#endif
        } else if (u < 384) {
            const int v = u - 256, b = v >> 6, h = (v >> 4) & 3, qb = v & 15; const int T0 = NCTX + b * 2048, kvh = h >> 1;
            const int klo = max(qb * 128 - 128, 0), khi = min(qb * 128 + 256, 2048);
            D.Q = P + (size_t)(T0 + qb * 128) * LDP + COL_QC + h * 64; D.ldq = LDP; D.O = BR + (size_t)(T0 + qb * 128) * LDH + 512 + h * 64; D.ldo = LDH;
            D.seg[0] = AttnSeg{SWK + (size_t)b * 256 * LDSWC + kvh * 64, nullptr, SWV + (size_t)b * 256 * LDSWC + kvh * 64, LDSWC, 0, LDSWC, 256, 0};
            D.seg[1] = AttnSeg{P + (size_t)(T0 + klo) * LDP + COL_KC + kvh * 64, nullptr, P + (size_t)(T0 + klo) * LDP + COL_VC + kvh * 64, LDP, 0, LDP, khi - klo, klo};
            D.c1 = ATT_C1; D.qtok0 = qb * 128; D.m0 = p.in[24][L * 4 + h] * LOG2E; D.l0 = 1.0f;
#ifndef NO_A3
            attn_unit<64, 2, 1>(C, D, rpb);
#endif
        } else if (u >= 576) {
            const int v = u - 576, kh = v % 12, b = v / 12, kind = kh >> 2, h = kh & 3; const int T0 = b * 256, Tq = T0;
            D.qtok0 = 0; D.seg[1].n = 0; D.seg[1].K = nullptr; D.seg[1].V = nullptr; D.seg[1].ldk = 0; D.seg[1].ldv = 0;
            if (kind == 0) {
                D.Q = P + (size_t)Tq * LDP + COL_QA + h * 64; D.ldq = LDP; D.O = BR + (size_t)Tq * LDH + h * 64; D.ldo = LDH;
                D.seg[0] = AttnSeg{P + (size_t)T0 * LDP + COL_KA + h * 64, nullptr, P + (size_t)T0 * LDP + COL_VA + h * 64, LDP, 0, LDP, 256, 0};
#ifndef NO_A4
                D.c1 = ATT_C1; attn_unit<64, 0, 2>(C, D, rpb);
#endif
            } else if (kind == 1) {
                D.Q = QUP + (size_t)Tq * LDQ + h * 96; D.ldq = LDQ; D.O = BR + (size_t)Tq * LDH + 256 + h * 64; D.ldo = LDH;
                D.seg[0] = AttnSeg{KVUP + (size_t)T0 * LDKV + h * 128, P + (size_t)T0 * LDP + COL_KR, KVUP + (size_t)T0 * LDKV + h * 128 + 64, LDKV, LDP, LDKV, 256, 0};
#ifndef NO_A5
                D.c1 = MLA_C1; attn_unit<96, 0, 2>(C, D, rpb);
#endif
            } else {
                const int kvh = h >> 1;
                D.Q = P + (size_t)Tq * LDP + COL_QC + h * 64; D.ldq = LDP; D.O = BR + (size_t)Tq * LDH + 512 + h * 64; D.ldo = LDH;
                D.seg[0] = AttnSeg{P + (size_t)T0 * LDP + COL_KC + kvh * 64, nullptr, P + (size_t)T0 * LDP + COL_VC + kvh * 64, LDP, 0, LDP, 256, 0};
#ifndef NO_A6
                D.c1 = ATT_C1; D.m0 = p.in[24][L * 4 + h] * LOG2E; D.l0 = 1.0f; attn_unit<64, 0, 2>(C, D, rpb);
#endif
            }
        } else {
#ifndef NO_POOL
            pool_unit(p, C, L, u - 384);
#endif
        }
    }
}

struct BrSched {
    const char* BR; const char* Wb; int G, c;
    __device__ __forceinline__ bool next(int i, G8Unit& u) const {
        const int Lu = i * G + c; if (Lu >= 48 * 16) return false;
        int pm, q; unit_map(Lu, 48, 16, pm, q);
        u.A = BR + (size_t)pm * 256 * LDH * 2 + (q >> 2) * 512; u.B = Wb + (size_t)q * 256 * LDWB * 2; u.e0 = pm; u.e1 = q; u.e2 = 0; u.e3 = 0; return true;
    }
};
struct EpiBK {
    static constexpr bool PERM = true, AFTER_DRAIN = false; G8_EPI_PLAIN
    bf16_t* O;
    __device__ __forceinline__ void operator()(const f32x4 (&acc)[2][2][4][2], const G8Unit& u, int wr, int wc, int fr_, int fq_) const {
        const int ln = hw_lane(), fr = ln & 15, fq = ln >> 4;
        const int k = u.e1 >> 2, pn4 = u.e1 & 3;
        char* base = (char*)O + ((size_t)((u.e0 * 16 + wr * 4) * 4 + k) * 256 + pn4 * 64 + wc * 8) * 128;
        const unsigned lo = (unsigned)(2 * fq * 16 + fr) * 8u;
#pragma unroll
        for (int ai = 0; ai < 2; ++ai)
#pragma unroll
            for (int m = 0; m < 4; ++m)
#pragma unroll
                for (int bj = 0; bj < 2; ++bj) { char* q = base + ((size_t)(ai * 8 + m) * 4 * 256 + bj * 32) * 128; asm volatile("" : "+s"(q));
                    const f32x4 v0 = acc[ai][bj][m][0], v1 = acc[ai][bj][m][1];
                    *(GAS u32x2*)(q + lo) = (u32x2){pk2(v0.x, v0.y), pk2(v0.z, v0.w)}; *(GAS u32x2*)(q + lo + 128) = (u32x2){pk2(v1.x, v1.y), pk2(v1.z, v1.w)}; }
    }
};
__device__ __forceinline__ void phase5a(const Params& p, Ctx& C, int L) {
    BrSched S{(const char*)(p.ws + WS_BR), (const char*)(p.ws + WS_W + (size_t)L * W_LAYER + WO_BR), C.G, C.bid};
    EpiBK E{(bf16_t*)(p.ws + WS_BK)};
    gemm8(C, 256, LDH, LDWB, S, E);
}
template <int VAR> struct EpiGateT {
    static constexpr bool PERM = false, AFTER_DRAIN = false, FP8 = true; static constexpr int HROWS_B = 2048;
    static __device__ __forceinline__ int brow(int R) { return ((R >> 4) & 1) * 1024 + (R >> 5) * 16 + (R & 15); }
    const bf16_t* BK; bf16_t* MG; const LAS float* bl;
    __device__ __forceinline__ f32x4 init(const G8Unit& u, int bj, int n, int wc, int fq) const { return *(const LAS f32x4*)(bl + (2 * bj + n) * 1024 + u.e1 * 64 + wc * 16 + 4 * fq); }
    __device__ __forceinline__ void operator()(const f32x4 (&acc)[2][2][4][2], const G8Unit& u, int wr, int wc, int fr_, int fq_) const {
        const int ln = hw_lane(), fr = ln & 15, fq = ln >> 4;
        const int xw = u.e1 * 64 + wc * 16;
#define SPIN_(ptr) asm volatile("" : "+s"(ptr))
        const char* bkb = (const char*)BK + ((size_t)(u.e0 * 16 + wr * 4) * 4 * 256 + u.e1 * 16 + wc * 4) * 128;
        char* mgb = (char*)MG + ((size_t)(u.e0 * 256 + wr * 64) * LDH + xw) * 2;
        const unsigned lob = (unsigned)(fq * 16 + fr) * 8u, lom = (unsigned)(fr * LDH + 4 * fq) * 2u;
        __builtin_amdgcn_sched_barrier(0);
        u32x2 b[8][4];
#pragma unroll
        for (int am = 0; am < 8; ++am) {
#pragma unroll
            for (int k = 0; k < 4; ++k) { const char* r = bkb + ((size_t)((am >> 2) * 8 + (am & 3)) * 4 + k) * 256 * 128; SPIN_(r); b[am][k] = *(const GAS u32x2*)(r + lob); } }
        __builtin_amdgcn_sched_barrier(0);
#pragma unroll
        for (int am = 0; am < 8; ++am) {
            f32x4 sum = (f32x4){0.f, 0.f, 0.f, 0.f};
#pragma unroll
            for (int k = 0; k < 4; ++k) { const f32x4 t = acc[am >> 2][k >> 1][am & 3][k & 1] * (-LOG2E_ * 0.03125f);
                const f32x4 e = (f32x4){__builtin_amdgcn_exp2f(t.x), __builtin_amdgcn_exp2f(t.y), __builtin_amdgcn_exp2f(t.z), __builtin_amdgcn_exp2f(t.w)} + 1.0f;
                const f32x4 g = (f32x4){__builtin_amdgcn_rcpf(e.x), __builtin_amdgcn_rcpf(e.y), __builtin_amdgcn_rcpf(e.z), __builtin_amdgcn_rcpf(e.w)};
                sum += g * (f32x4){lo16(b[am][k].x), hi16(b[am][k].x), lo16(b[am][k].y), hi16(b[am][k].y)}; }
            char* mp = mgb + (size_t)((am >> 2) * 128 + (am & 3) * 16) * LDH * 2; SPIN_(mp);
            *(GAS u32x2*)(mp + lom) = (u32x2){pk2(sum.x, sum.y), pk2(sum.z, sum.w)};
            __builtin_amdgcn_sched_barrier(0);
        }
#undef SPIN_
    }
};
template <int VAR> __device__ __forceinline__ void phase5b(const Params& p, Ctx& C, int L) {
    TileSched S{(const char*)(p.ws + WS_H8), (const char*)(p.ws + WS_W + (size_t)L * W_LAYER + WO_GATE), (size_t)256 * LD8, (size_t)64 * LD8, 48, 16, C.G, C.bid};
    LAS float* bl = (LAS float*)(C.lds + 131072);
    { const float* bg = p.in[18] + (size_t)L * 4096; for (int i = C.tid; i < 1024; i += 512) ((LAS f32x4*)bl)[i] = ((const f32x4*)bg)[i] * 32.0f; }
    __syncthreads();
    EpiGateT<VAR> E{(const bf16_t*)(p.ws + WS_BK), (bf16_t*)(p.ws + (VAR ? WS_BR : WS_MERGED)), bl};
    gemm8(C, 512, LD8 / 2, LD8 / 2, S, E);
}

__device__ __forceinline__ void gemm_bf16_phase(Ctx& C, const bf16_t* A, int lda, const bf16_t* Bt, int ldb, int K, bf16_t* O, int ldo, int nM, int nN) {
    TileSched S{(const char*)A, (const char*)Bt, (size_t)256 * lda * 2, (size_t)256 * ldb * 2, nM, nN, C.G, C.bid};
    EpiBf16 E{O, ldo};
    gemm8(C, K, lda, ldb, S, E);
}


struct RowSumSq {
    float* xbuf;
    unsigned* cnt;
    __device__ __forceinline__ void run(const Ctx& C, const f32x4 (&v)[2][2][4][2], int pm, int pn, int wr, int wc, int fr, int fq, float (&rs)[2][4]) const {
        LAS float* P = (LAS float*)C.lds;
        LAS float* S = (LAS float*)(C.lds + 4096);
#pragma unroll
        for (int ai = 0; ai < 2; ++ai)
#pragma unroll
            for (int m = 0; m < 4; ++m) { float s = 0.f;
#pragma unroll
                for (int bj = 0; bj < 2; ++bj)
#pragma unroll
                    for (int n = 0; n < 2; ++n) { const f32x4 x = v[ai][bj][m][n]; s += (x[0] * x[0] + x[1] * x[1]) + (x[2] * x[2] + x[3] * x[3]); }
                s += __shfl_xor(s, 16); s += __shfl_xor(s, 32);
                if (fq == 0) P[(ai * 128 + wr * 64 + m * 16 + fr) * 4 + wc] = s; }
        asm volatile("s_waitcnt lgkmcnt(0)" ::: "memory"); __builtin_amdgcn_s_barrier(); asm volatile("" ::: "memory");
        const int row = C.wid * 32 + (C.lane & 31);
        if (C.lane < 32) { const float t = (P[row * 4 + 0] + P[row * 4 + 1]) + (P[row * 4 + 2] + P[row * 4 + 3]);
            __hip_atomic_store(xbuf + ((size_t)(pm * 256 + row) * 4 + pn), t, __ATOMIC_RELAXED, __HIP_MEMORY_SCOPE_AGENT); }
        asm volatile("s_waitcnt vmcnt(0)" ::: "memory");
        if (C.lane == 0) __hip_atomic_fetch_add(cnt + 64 * pm, 1u, __ATOMIC_RELAXED, __HIP_MEMORY_SCOPE_AGENT);
        if (C.wid == 0) {
            unsigned spins = 0;
            while ((unsigned)__builtin_amdgcn_readfirstlane(__hip_atomic_load(cnt + 64 * pm, __ATOMIC_RELAXED, __HIP_MEMORY_SCOPE_AGENT)) < 32u) { __builtin_amdgcn_s_sleep(2); if (++spins > (1u << 22)) break; }
            __builtin_amdgcn_fence(__ATOMIC_ACQUIRE, "agent");
        }
        asm volatile("s_waitcnt vmcnt(0) lgkmcnt(0)" ::: "memory"); __builtin_amdgcn_s_barrier(); asm volatile("" ::: "memory");
        if (C.lane < 32) { const float* slot = xbuf + (size_t)(pm * 256 + row) * 4; float t = 0.f;
#pragma unroll
            for (int q = 0; q < 4; ++q) t += __hip_atomic_load(slot + q, __ATOMIC_RELAXED, __HIP_MEMORY_SCOPE_AGENT);
            S[row] = t; }
        asm volatile("s_waitcnt vmcnt(0) lgkmcnt(0)" ::: "memory"); __builtin_amdgcn_s_barrier(); asm volatile("" ::: "memory");
#pragma unroll
        for (int ai = 0; ai < 2; ++ai)
#pragma unroll
            for (int m = 0; m < 4; ++m) rs[ai][m] = S[ai * 128 + wr * 64 + m * 16 + fr];
        asm volatile("s_waitcnt lgkmcnt(0)" ::: "memory"); __builtin_amdgcn_s_barrier(); asm volatile("" ::: "memory");
    }
};
template <int MODE> struct EpiNormFused {
    static constexpr bool PERM = true, AFTER_DRAIN = true; G8_EPI_PLAIN
    const Params& p; int L;
    __device__ __forceinline__ void drained(const Ctx& C, f32x4 (&acc)[2][2][4][2], const G8Unit& u, int wr, int wc, int fr, int fq) const {
        const int pm = u.e0, pn = u.e1, cls = pm < 32 ? 0 : 1 + ((pm - 32) >> 3);
        unsigned* ctl = (unsigned*)(p.ws + WS_CTL);
        const float* modv = (const float*)(p.ws + WS_MODV);
        const float* mv = modv + (size_t)(L * 3 + cls) * 6144;
        float* Y = p.out + OFF_Y; bf16_t* H = (bf16_t*)(p.ws + WS_H);
        const float* gpost = (MODE == 0 ? p.in[13] : p.in[15]) + L * DM;
        const float* gate = mv + (MODE == 0 ? 2048 : 5120);
        const float* xpan = (MODE == 0 && L == 0) ? (pm < 32 ? p.in[0] + (size_t)pm * 256 * DM : p.in[1] + (size_t)(pm - 32) * 256 * DM) : Y + (size_t)pm * 256 * DM;
        float* ypan = Y + (size_t)pm * 256 * DM; bf16_t* hpan = H + (size_t)pm * 256 * LDH; unsigned char* h8pan = p.ws + WS_H8 + (size_t)pm * 256 * LD8;
        float rs[2][4];
        { RowSumSq X{(float*)(ctl + CW_XBUF), ctl + CW_SEAM + ((L * 2 + MODE) * 2 + 0) * 48 * 64}; X.run(C, acc, pm, pn, wr, wc, fr, fq, rs); }
#pragma unroll
        for (int ai = 0; ai < 2; ++ai)
#pragma unroll
            for (int m = 0; m < 4; ++m) rs[ai][m] = __builtin_amdgcn_rsqf(rs[ai][m] * (1.0f / DM) + EPS);
#pragma unroll
        for (int bj = 0; bj < 2; ++bj) { const int col = pn * 256 + bj * 128 + wc * 32 + 8 * fq;
            const f32x4 gp0 = *(const f32x4*)(gpost + col), gp1 = *(const f32x4*)(gpost + col + 4), g0 = *(const f32x4*)(gate + col), g1 = *(const f32x4*)(gate + col + 4);
#pragma unroll
            for (int ai = 0; ai < 2; ++ai)
#pragma unroll
                for (int m = 0; m < 4; ++m) { const int off = (ai * 128 + wr * 64 + m * 16 + fr) * DM + col;
                    const f32x4 x0 = *(const f32x4*)(xpan + off), x1 = *(const f32x4*)(xpan + off + 4);
                    acc[ai][bj][m][0] = x0 + g0 * (acc[ai][bj][m][0] * rs[ai][m] * gp0);
                    acc[ai][bj][m][1] = x1 + g1 * (acc[ai][bj][m][1] * rs[ai][m] * gp1);
                    asm volatile("" : "+v"(acc[ai][bj][m][0]), "+v"(acc[ai][bj][m][1]));
                    if (m & 1) asm volatile("" ::: "memory"); } }
        const bool second = (MODE == 0) || (L == 0);
        if (second) { RowSumSq X{(float*)(ctl + CW_XBUF) + 48 * 256 * 4, ctl + CW_SEAM + ((L * 2 + MODE) * 2 + 1) * 48 * 64}; X.run(C, acc, pm, pn, wr, wc, fr, fq, rs);
#pragma unroll
            for (int ai = 0; ai < 2; ++ai)
#pragma unroll
                for (int m = 0; m < 4; ++m) rs[ai][m] = __builtin_amdgcn_rsqf(rs[ai][m] * (1.0f / DM) + EPS); }
        const float* mvn = (MODE == 0) ? mv : modv + (size_t)(1 * 3 + cls) * 6144;
        const float* gpre = (MODE == 0) ? p.in[14] + L * DM : p.in[12] + DM;
        const float* scv = mvn + (MODE == 0 ? 4096 : 1024); const float* shv = mvn + (MODE == 0 ? 3072 : 0);
#pragma unroll
        for (int bj = 0; bj < 2; ++bj) { const int col = pn * 256 + bj * 128 + wc * 32 + 8 * fq;
            const f32x4 z = (f32x4){0.f, 0.f, 0.f, 0.f};
            f32x4 gg0 = z, gg1 = z, sa0 = z, sa1 = z, sb0 = z, sb1 = z;
            if (second) { gg0 = *(const f32x4*)(gpre + col); gg1 = *(const f32x4*)(gpre + col + 4); sa0 = *(const f32x4*)(scv + col) + 1.0f; sa1 = *(const f32x4*)(scv + col + 4) + 1.0f; sb0 = *(const f32x4*)(shv + col); sb1 = *(const f32x4*)(shv + col + 4); }
#pragma unroll
            for (int ai = 0; ai < 2; ++ai)
#pragma unroll
                for (int m = 0; m < 4; ++m) { const int rl = ai * 128 + wr * 64 + m * 16 + fr; const f32x4 v0 = acc[ai][bj][m][0], v1 = acc[ai][bj][m][1];
                    *(f32x4*)(ypan + rl * DM + col) = v0; *(f32x4*)(ypan + rl * DM + col + 4) = v1;
                    if (second) { const f32x4 h0 = v0 * rs[ai][m] * gg0 * sa0 + sb0, h1 = v1 * rs[ai][m] * gg1 * sa1 + sb1;
                        *(u32x4*)(hpan + rl * LDH + col) = (u32x4){pk2(h0.x, h0.y), pk2(h0.z, h0.w), pk2(h1.x, h1.y), pk2(h1.z, h1.w)};
                        if (MODE == 1) { int w0 = __builtin_amdgcn_cvt_pk_fp8_f32(h0.x, h0.y, 0, false); w0 = __builtin_amdgcn_cvt_pk_fp8_f32(h0.z, h0.w, w0, true);
                            int w1 = __builtin_amdgcn_cvt_pk_fp8_f32(h1.x, h1.y, 0, false); w1 = __builtin_amdgcn_cvt_pk_fp8_f32(h1.z, h1.w, w1, true);
                            *(u32x2*)(h8pan + rl * LD8 + col) = (u32x2){(unsigned)w0, (unsigned)w1}; } }
                    asm volatile("" ::: "memory"); } }
    }
};
template <int MODE> __device__ __forceinline__ void gemm_norm_phase(const Params& p, Ctx& C, int L, const bf16_t* A, int lda, const bf16_t* Bt, int ldb, int K) {
    TileSched S{(const char*)A, (const char*)Bt, (size_t)256 * lda * 2, (size_t)256 * ldb * 2, 48, 4, C.G, C.bid};
    EpiNormFused<MODE> E{p, L};
    gemm8(C, K, lda, ldb, S, E);
}

struct OneUnit { G8Unit u; __device__ __forceinline__ bool next(int i, G8Unit& o) const { if (i > 0) return false; o = u; return true; } };
struct EpiUpConv {
    static constexpr bool PERM = false, AFTER_DRAIN = true; G8_EPI_PLAIN
    bf16_t* ACT; const float* cw;
    __device__ __forceinline__ void drained(const Ctx& C, const f32x4 (&acc)[2][2][4][2], const G8Unit& u, int wr, int wc, int fr, int fq) const {
        constexpr int UROW = 528;
        const int Trow0 = u.e0, pn = u.e1, tpos0 = u.e2, Ls = u.e3;
#pragma unroll
        for (int ai = 0; ai < 2; ++ai)
#pragma unroll
            for (int m = 0; m < 4; ++m) { const int r = ai * 128 + wr * 64 + m * 16 + fr;
#pragma unroll
                for (int bj = 0; bj < 2; ++bj)
#pragma unroll
                    for (int n = 0; n < 2; ++n) { const int c = bj * 128 + wc * 32 + n * 16 + 4 * fq; const f32x4 v = acc[ai][bj][m][n]; *(LAS u32x2*)(C.lds + r * UROW + c * 2) = (u32x2){pk2(v.x, v.y), pk2(v.z, v.w)}; } }
        __syncthreads();
        {
            const int cc = C.tid & 15, rg = C.tid >> 4;
            const int f0 = pn * 128 + cc * 8;
            float wa[3][8], wg[3][8];
#pragma unroll
            for (int j = 0; j < 3; ++j)
#pragma unroll
                for (int e = 0; e < 8; ++e) { const bool ok = (f0 + e) < DFF; wa[j][e] = ok ? cw[j * 5504 + f0 + e] : 0.f; wg[j][e] = ok ? cw[j * 5504 + DFF + f0 + e] : 0.f; }
            for (int ps = 0; ps < 8; ++ps) {
                const int r = ps * 32 + rg, tpos = tpos0 + r;
                const bool valid = (r > 0 || tpos == 0) && (r < 255 || tpos == Ls - 1);
                if (!valid) continue;
                const bool hasl = tpos > 0, hasr = tpos < Ls - 1;
                const LAS unsigned char* base = C.lds + r * UROW + cc * 16;
                const u32x4 z = (u32x4){0u, 0u, 0u, 0u};
                const u32x4 a0 = hasl ? *(const LAS u32x4*)(base - UROW) : z, a1 = *(const LAS u32x4*)base, a2 = hasr ? *(const LAS u32x4*)(base + UROW) : z;
                const u32x4 g0 = hasl ? *(const LAS u32x4*)(base - UROW + 256) : z, g1 = *(const LAS u32x4*)(base + 256), g2 = hasr ? *(const LAS u32x4*)(base + UROW + 256) : z;
                float o[8];
#pragma unroll
                for (int e = 0; e < 8; ++e) {
                    const unsigned ua0 = a0[e >> 1], ua1 = a1[e >> 1], ua2 = a2[e >> 1], ug0 = g0[e >> 1], ug1 = g1[e >> 1], ug2 = g2[e >> 1];
                    const float xa0 = (e & 1) ? hi16(ua0) : lo16(ua0), xa1 = (e & 1) ? hi16(ua1) : lo16(ua1), xa2 = (e & 1) ? hi16(ua2) : lo16(ua2);
                    const float xg0 = (e & 1) ? hi16(ug0) : lo16(ug0), xg1 = (e & 1) ? hi16(ug1) : lo16(ug1), xg2 = (e & 1) ? hi16(ug2) : lo16(ug2);
                    const float av = xa0 * wa[0][e] + xa1 * wa[1][e] + xa2 * wa[2][e];
                    const float gv = xg0 * wg[0][e] + xg1 * wg[1][e] + xg2 * wg[2][e];
                    o[e] = siluf_(gv) * av;
                }
                *(u32x4*)(ACT + (size_t)(Trow0 + r) * LDACT + f0) = (u32x4){pk2(o[0], o[1]), pk2(o[2], o[3]), pk2(o[4], o[5]), pk2(o[6], o[7])};
            }
        }
        __syncthreads();
    }
};
__device__ __forceinline__ float dpp_ror1(float x) { return __int_as_float(__builtin_amdgcn_update_dpp(0, __float_as_int(x), 0x121, 0xf, 0xf, false)); }
__device__ __forceinline__ float dpp_ror15(float x) { return __int_as_float(__builtin_amdgcn_update_dpp(0, __float_as_int(x), 0x12F, 0xf, 0xf, false)); }
struct EpiUpConvReg {
    static constexpr bool PERM = true, AFTER_DRAIN = false; G8_EPI_PLAIN
    bf16_t* ACT; const float* cw; LAS unsigned* halo;
    __device__ __forceinline__ void operator()(const f32x4 (&acc)[2][2][4][2], const G8Unit& u, int wr, int wc, int fr_, int fq_) const {
        int fr = fr_, fq = fq_; asm volatile("" : "+v"(fr), "+v"(fq));
        const int Trow0 = u.e0, pn = u.e1, tpos0 = u.e2, Ls = u.e3;
        const int cl = wc * 32 + 8 * fq;
        unsigned xp[2][4][2][4];
#pragma unroll
        for (int ai = 0; ai < 2; ++ai)
#pragma unroll
            for (int m = 0; m < 4; ++m)
#pragma unroll
                for (int n = 0; n < 2; ++n)
#pragma unroll
                    for (int j = 0; j < 4; ++j) { xp[ai][m][n][j] = pk2(acc[ai][0][m][n][j], acc[ai][1][m][n][j]); asm volatile("" : "+v"(xp[ai][m][n][j])); }
#pragma unroll
        for (int ai = 0; ai < 2; ++ai) { const int b = ai * 2 + wr;
#pragma unroll
            for (int n = 0; n < 2; ++n) {
                if (fr == 0) *(LAS u32x4*)(halo + (b * 2 + 0) * 128 + cl + 4 * n) = (u32x4){xp[ai][0][n][0], xp[ai][0][n][1], xp[ai][0][n][2], xp[ai][0][n][3]};
                if (fr == 15) *(LAS u32x4*)(halo + (b * 2 + 1) * 128 + cl + 4 * n) = (u32x4){xp[ai][3][n][0], xp[ai][3][n][1], xp[ai][3][n][2], xp[ai][3][n][3]};
            } }
        LAS float* cwl = (LAS float*)(halo + 1024);
        const int tx = (wr * 4 + wc) * 64 + fq * 16 + fr;
        if (tx < 192) { const int jp = tx >> 5, ch = tx & 31, f = pn * 128 + ch * 4;
            const f32x4 v = (f < DFF) ? *(const f32x4*)(cw + (jp >> 1) * 5504 + (jp & 1) * DFF + f) : (f32x4){0.f, 0.f, 0.f, 0.f};
            *(LAS f32x4*)(cwl + jp * 128 + ch * 4) = v; }
        asm volatile("s_waitcnt vmcnt(0) lgkmcnt(0)\n\ts_barrier" ::: "memory");
        asm volatile("s_barrier" ::: "memory");
        const int f0 = pn * 128 + cl;
        const int src_up = ((fq << 4) | ((fr + 15) & 15)) << 2, src_dn = ((fq << 4) | ((fr + 1) & 15)) << 2;
        const bool seq_first = (tpos0 == 0), seq_last = (tpos0 + 256 == Ls);
        u32x2 pk0[2][4];
#pragma unroll
        for (int n = 0; n < 2; ++n) {
            f32x2 w0[4], w1[4], w2[4];
            { const f32x4 a0 = *(const LAS f32x4*)(cwl + 0 * 128 + cl + 4 * n), g0 = *(const LAS f32x4*)(cwl + 1 * 128 + cl + 4 * n);
                const f32x4 a1 = *(const LAS f32x4*)(cwl + 2 * 128 + cl + 4 * n), g1 = *(const LAS f32x4*)(cwl + 3 * 128 + cl + 4 * n);
                const f32x4 a2 = *(const LAS f32x4*)(cwl + 4 * 128 + cl + 4 * n), g2 = *(const LAS f32x4*)(cwl + 5 * 128 + cl + 4 * n);
#pragma unroll
                for (int j = 0; j < 4; ++j) { w0[j] = (f32x2){a0[j], g0[j]}; w1[j] = (f32x2){a1[j], g1[j]}; w2[j] = (f32x2){a2[j], g2[j]}; } }
#pragma unroll
            for (int ai = 0; ai < 2; ++ai) { const int b = ai * 2 + wr;
                u32x4 hup = (u32x4){0u, 0u, 0u, 0u}, hdn = hup;
                if (b > 0) hup = *(const LAS u32x4*)(halo + ((b - 1) * 2 + 1) * 128 + cl + 4 * n);
                if (b < 3) hdn = *(const LAS u32x4*)(halo + ((b + 1) * 2 + 0) * 128 + cl + 4 * n);
#pragma unroll
                for (int m = 0; m < 4; ++m) {
                    const int r = ai * 128 + wr * 64 + m * 16 + fr;
                    float o[4];
#pragma unroll
                    for (int j = 0; j < 4; ++j) {
                        const unsigned xc = xp[ai][m][n][j];
                        const unsigned pv = (m > 0) ? xp[ai][m > 0 ? m - 1 : 0][n][j] : hup[j], nv = (m < 3) ? xp[ai][m < 3 ? m + 1 : 3][n][j] : hdn[j];
                        unsigned upk = (unsigned)__builtin_amdgcn_update_dpp(0, (int)(fr == 15 ? pv : xc), 0x121, 0xf, 0xf, false);
                        unsigned dnk = (unsigned)__builtin_amdgcn_update_dpp(0, (int)(fr == 0 ? nv : xc), 0x12F, 0xf, 0xf, false);
                        if (ai == 0 && m == 0) { if (seq_first && r == 0) upk = 0u; }
                        if (ai == 1 && m == 3) { if (seq_last && r == 255) dnk = 0u; }
                        const f32x2 c2 = (f32x2){lo16(upk), hi16(upk)} * w0[j] + (f32x2){lo16(xc), hi16(xc)} * w1[j] + (f32x2){lo16(dnk), hi16(dnk)} * w2[j];
                        o[j] = siluf_(c2.y) * c2.x;
                    }
                    const u32x2 pkn = (u32x2){pk2(o[0], o[1]), pk2(o[2], o[3])};
                    if (n == 0) pk0[ai][m] = pkn;
                    else {
                        bool valid = true;
                        if (ai == 0 && m == 0) valid = (r > 0) || seq_first;
                        if (ai == 1 && m == 3) valid = (r < 255) || seq_last;
                        if (valid) *(u32x4*)(ACT + (size_t)(Trow0 + r) * LDACT + f0) = (u32x4){pk0[ai][m].x, pk0[ai][m].y, pkn.x, pkn.y};
                    }
                }
            }
        }
    }
};
struct UpSched {
    const char* H; const char* Wu; int G, c;
    __device__ __forceinline__ bool next(int i, G8Unit& u) const {
        const int Lu = i * G + c; if (Lu >= 50 * 22) return false;
        int mt, pn; unit_map(Lu, 50, 22, mt, pn);
        int Trow0, tpos0, Ls;
        if (mt < 32) { Trow0 = mt * 256; tpos0 = 0; Ls = 256; }
        else { const int v = mt - 32, b = v / 9, j = v % 9; tpos0 = (j < 8) ? 254 * j : 1792; Trow0 = NCTX + b * 2048 + tpos0; Ls = 2048; }
        u.A = H + (size_t)Trow0 * LDH * 2; u.B = Wu + (size_t)pn * 256 * LDW * 2; u.e0 = Trow0; u.e1 = pn; u.e2 = tpos0; u.e3 = Ls; return true;
    }
};
__device__ __forceinline__ void phase8(const Params& p, Ctx& C, int L) {
    UpSched S{(const char*)(p.ws + WS_H), (const char*)(p.ws + WS_W + (size_t)L * W_LAYER + WO_UP), C.G, C.bid};
    EpiUpConvReg E{(bf16_t*)(p.ws + WS_ACT), p.in[30] + (size_t)L * 3 * 5504, (LAS unsigned*)(C.lds + 131072)};
    gemm8(C, DM, LDH, LDW, S, E);
}

__global__ void __launch_bounds__(512, 2) mega_fwd(Params p) {
    extern __shared__ __attribute__((aligned(16))) unsigned char lds_raw[];
    Ctx C; C.lds = (LAS unsigned char*)lds_raw;
    C.ws = __builtin_amdgcn_readfirstlane((int)(threadIdx.x >> 6)); C.G = gridDim.x; C.bid = blockIdx.x;
#define FRESH() CTX_FRESH(C)
    FRESH();
    if (C.tid < 16) ((LAS unsigned*)(C.lds + LDS_CTL))[C.tid] = 0u;
    __syncthreads();
    XcdBarrier bar = xcd_barrier_post((unsigned*)(p.ws + WS_CTL) + CW_BAR, (volatile LAS unsigned*)(C.lds + LDS_CTL));
#define GRID_BAR() do { xcd_barrier(bar, C.tid); FRESH(); } while (0)
#ifndef PH
#define PH 0xffff
#endif
#ifndef DUP
#define DUP 0
#endif
    if (PH & 1) phase0(p, C); GRID_BAR();
    if (DUP & 1) { phase0(p, C); GRID_BAR(); }
    if (PH & 2) phase1(p, C); GRID_BAR();
    if (DUP & 2) { phase1(p, C); GRID_BAR(); }
#pragma unroll 1
    for (int L = 0; L < 2; ++L) {
        if (PH & 4) phase2(p, C, L); GRID_BAR();
        if (DUP & 4) { phase2(p, C, L); GRID_BAR(); }
        if (PH & 8) phase3(p, C, L); GRID_BAR();
        if (PH & 16) phase4(p, C, L); GRID_BAR();
        if (DUP & 16) { phase4(p, C, L, 1); GRID_BAR(); }
        if (PH & 32) phase5a(p, C, L); GRID_BAR();
        if (DUP & 32) { phase5a(p, C, L); GRID_BAR(); }
        if (PH & 64) phase5b<0>(p, C, L); GRID_BAR();
#ifdef PVAR
        if (DUP & 64) { phase5b<PVAR>(p, C, L); GRID_BAR(); }
#endif
        gemm_norm_phase<0>(p, C, L, (const bf16_t*)(p.ws + WS_MERGED), LDH, (const bf16_t*)(p.ws + WS_W + (size_t)L * W_LAYER + WO_OUT), LDW, DM); GRID_BAR();
        if (PH & 256) phase8(p, C, L); GRID_BAR();
        if (DUP & 256) { phase8(p, C, L); GRID_BAR(); }
        gemm_norm_phase<1>(p, C, L, (const bf16_t*)(p.ws + WS_ACT), LDACT, (const bf16_t*)(p.ws + WS_W + (size_t)L * W_LAYER + WO_DOWN), LDWD, DFFP);
        if (L == 0) GRID_BAR();
    }
}

extern "C" void kernel_launch(void* const* d_in, const int* in_sizes, int n_in, void* d_out, int out_size, void* d_ws, size_t ws_size, hipStream_t stream) {
    static int grid = 0;
    if (grid == 0) {
        if (n_in != 32 || ws_size < WS_END) { fprintf(stderr, "kernel_launch: unexpected n_in %d / ws %zu\n", n_in, ws_size); grid = -1; return; }
        int dev = 0, cus = 0;
        if (hipGetDevice(&dev) != hipSuccess || hipDeviceGetAttribute(&cus, hipDeviceAttributeMultiprocessorCount, dev) != hipSuccess) { grid = -1; return; }
        if (hipFuncSetAttribute((const void*)mega_fwd, hipFuncAttributeMaxDynamicSharedMemorySize, LDS_BYTES) != hipSuccess) { fprintf(stderr, "kernel_launch: hipFuncSetAttribute failed\n"); grid = -1; return; }
        grid = cus;
    }
    if (grid < 0) return;
    (void)hipMemsetAsync((char*)d_ws + WS_CTL, 0, (size_t)(CW_SEAM + 384 * 64) * 4, stream);
    Params a{};
    for (int i = 0; i < 32; ++i) a.in[i] = (const float*)d_in[i];
    a.out = (float*)d_out; a.ws = (unsigned char*)d_ws;
    hipLaunchKernelGGL(mega_fwd, dim3(grid), dim3(512), LDS_BYTES, stream, a);
}
```

```cpp
#include <hip/hip_runtime.h>
#include <cstdio>
#include <cstdint>

#define LAS __attribute__((address_space(3)))
#define GAS __attribute__((address_space(1)))
typedef unsigned short bf16_t;
typedef short bf16x8 __attribute__((ext_vector_type(8)));
typedef short s16x4 __attribute__((ext_vector_type(4)));
typedef float f32x4 __attribute__((ext_vector_type(4)));
typedef float f32x2 __attribute__((ext_vector_type(2)));
typedef unsigned u32x4 __attribute__((ext_vector_type(4)));
typedef unsigned u32x2 __attribute__((ext_vector_type(2)));
typedef __bf16 bf16x2_t __attribute__((ext_vector_type(2)));
#define LOG2E_ 1.4426950408889634f
typedef long lx2 __attribute__((ext_vector_type(2)));
typedef int i32x8 __attribute__((ext_vector_type(8)));
typedef int i32x4 __attribute__((ext_vector_type(4)));

constexpr int DM = 1024, NCTX = 8192, NLAT = 4096, NTOK = 12288;
constexpr int INP = 2048, IN_DIM = 1888, DFF = 2752, DFFP = 2816, NUP = 5632;
constexpr int LD8 = 1152;
constexpr int LDH = 1088, LDP = 1984, LDACT = 2880, LDQ = 448, LDKV = 576, LDW = 1088, LDWB = 320, LDWD = 2880, LDUQ = 192, LDUKV = 192, LDNAC = 320, LDSWC = 192, LDCKVC = 192, LDBK = 4160;
constexpr int COL_QA = 0, COL_KA = 256, COL_VA = 512, COL_CQ = 768, COL_CKV = 960, COL_KR = 1088, COL_QC = 1120, COL_KC = 1376, COL_VC = 1504, COL_PD = 1632;
constexpr float EPS = 1e-6f;
constexpr float LOG2E = 1.4426950408889634f;
constexpr size_t OFF_Y = 0, OFF_NAK = 12582912, OFF_NAV = 16777216, OFF_CKV = 20971520, OFF_KR = 23068672, OFF_SWK = 23592960, OFF_SWV = 25690112;

constexpr size_t MiB = 1u << 20;
constexpr size_t WS_CTL = 0, CTL_BYTES = 1 * MiB;
constexpr size_t WS_MODV = 1 * MiB;
constexpr size_t WS_NACK = 2 * MiB;
constexpr size_t WS_NACV = WS_NACK + 640 * 1024;
constexpr size_t WS_SWCK = WS_NACV + 640 * 1024;
constexpr size_t WS_SWCV = WS_SWCK + 384 * 1024;
constexpr size_t WS_CKVC = WS_SWCV + 384 * 1024;
constexpr size_t WS_KRC = WS_CKVC + 384 * 1024;
constexpr size_t WS_KVCUP = WS_KRC + 64 * 1024;
static_assert(WS_KVCUP + (size_t)2 * 512 * LDKV * 2 <= 6 * MiB, "cache region");
constexpr size_t WS_W = 6 * MiB, W_LAYER = 36 * MiB + 512 * 1024;
constexpr size_t WO_IN = 0, WO_GATE = 4 * MiB + 512 * 1024, WO_BR = 13 * MiB, WO_OUT = 15 * MiB + 512 * 1024, WO_UP = 18 * MiB, WO_DOWN = 30 * MiB, WO_UQ = 35 * MiB + 768 * 1024, WO_UKV = 36 * MiB;
static_assert((size_t)2048 * LDW * 2 <= WO_GATE && WO_GATE + (size_t)4096 * LDW * 2 <= WO_BR && WO_BR + (size_t)4096 * LDWB * 2 <= WO_OUT && WO_OUT + (size_t)1024 * LDW * 2 <= WO_UP && WO_UP + (size_t)NUP * LDW * 2 <= WO_DOWN && WO_DOWN + (size_t)1024 * LDWD * 2 <= WO_UQ && WO_UQ + (size_t)512 * LDUQ * 2 <= WO_UKV && WO_UKV + (size_t)512 * LDUKV * 2 <= W_LAYER, "weight map");
constexpr size_t WS_X1 = 79 * MiB;
constexpr size_t WS_H8 = WS_X1;
constexpr size_t WS_H = 127 * MiB;
constexpr size_t WS_P = 153 * MiB;
constexpr size_t WS_BK = 93 * MiB;
constexpr size_t WS_MERGED = 226 * MiB;
constexpr size_t WS_BR = 200 * MiB;
constexpr size_t WS_O = WS_BR;
constexpr size_t WS_QUP = 226 * MiB;
constexpr size_t WS_KVUP = 237 * MiB;
constexpr size_t WS_ACT = WS_P;
constexpr size_t WS_END = 252 * MiB;
static_assert((size_t)NTOK * LD8 <= (size_t)NTOK * DM * 4 && (size_t)4096 * LD8 <= WO_BR - WO_GATE, "fp8 buffers");
static_assert(WS_W + 2 * W_LAYER <= WS_X1 && WS_X1 + (size_t)NTOK * DM * 4 <= WS_H && WS_H + (size_t)NTOK * LDH * 2 <= WS_P && WS_P + (size_t)NTOK * LDP * 2 <= WS_BR && WS_BR + (size_t)NTOK * LDH * 2 <= WS_QUP
              && WS_QUP + (size_t)NTOK * LDQ * 2 <= WS_KVUP && WS_KVUP + (size_t)NTOK * LDKV * 2 <= WS_END && WS_ACT + (size_t)NTOK * LDACT * 2 <= WS_QUP
              && WS_H8 + (size_t)NTOK * LD8 <= WS_BK && WS_BK + (size_t)NTOK * LDBK * 2 <= WS_BR && WS_MERGED + (size_t)NTOK * LDH * 2 <= WS_END, "workspace map");
constexpr int CW_BAR = 1024;
constexpr int CW_QUEUE = 8192;
constexpr int CW_SEAM = 16384;
constexpr int CW_XBUF = 65536;

constexpr int LDS_CTL = 147456, LDS_TAB = LDS_CTL + 64, LDS_BYTES = LDS_TAB + 4096;

struct Params { const float* in[32]; float* out; unsigned char* ws; };

__device__ __forceinline__ float bf2f(bf16_t b) { return __uint_as_float((unsigned)b << 16); }
__device__ __forceinline__ unsigned pk2(float lo, float hi) { f32x2 v = {lo, hi}; bf16x2_t b = __builtin_convertvector(v, bf16x2_t); return __builtin_bit_cast(unsigned, b); }
__device__ __forceinline__ float lo16(unsigned u) { return __uint_as_float(u << 16); }
__device__ __forceinline__ float hi16(unsigned u) { return __uint_as_float(u & 0xffff0000u); }
__device__ __forceinline__ float wave_sum(float v) {
#pragma unroll
    for (int o = 1; o < 64; o <<= 1) v += __shfl_xor(v, o);
    return v;
}
__device__ __forceinline__ float qmax4(float x) {
    const auto a = __builtin_amdgcn_permlane16_swap(__float_as_uint(x), __float_as_uint(x), false, false); x = fmaxf(__uint_as_float(a[0]), __uint_as_float(a[1]));
    const auto b = __builtin_amdgcn_permlane32_swap(__float_as_uint(x), __float_as_uint(x), false, false); return fmaxf(__uint_as_float(b[0]), __uint_as_float(b[1]));
}
__device__ __forceinline__ float sigmoidf_(float x) { return __builtin_amdgcn_rcpf(1.0f + __builtin_amdgcn_exp2f(x * -LOG2E_)); }
__device__ __forceinline__ float siluf_(float x) { return x * __builtin_amdgcn_rcpf(1.0f + __builtin_amdgcn_exp2f(x * -LOG2E_)); }
#define VM_WAIT_UNUSED_()
#define VM_WAIT() asm volatile("s_waitcnt vmcnt(0)" ::: "memory")

#define XB_TMO      128
#define XB_XCNT(j)  (256  + 64 * (j))
#define XB_XSUB(j)  (1280 + 64 * (j))
#define XB_XGEN(j)  (2304 + 64 * (j))
#define XB_TOP      3328
#define XB_TOPGEN   3392
#define XCD_BAR_WORDS 3456
#define XB_SPIN_CAP (1u << 22)
__device__ __forceinline__ unsigned xb_ld(unsigned* p)              { return __hip_atomic_load(p, __ATOMIC_RELAXED, __HIP_MEMORY_SCOPE_AGENT); }
__device__ __forceinline__ unsigned xb_add(unsigned* p, unsigned v) { return __hip_atomic_fetch_add(p, v, __ATOMIC_RELAXED, __HIP_MEMORY_SCOPE_AGENT); }
__device__ __forceinline__ unsigned xb_xcc_id() { return (unsigned)__builtin_amdgcn_s_getreg((3 << 11) | 20) & 0xFu; }
#define XB_SPIN(cond, bar) do { unsigned _sp = 0; while (cond) { __builtin_amdgcn_s_sleep(1); \
    if ((++_sp & 255u) == 0u) { if (xb_ld(&(bar)[XB_TMO])) break; if (_sp > XB_SPIN_CAP) { atomicAdd(&(bar)[XB_TMO], 1u); break; } } } } while (0)
struct XcdBarrier { unsigned* bar; unsigned x; volatile LAS unsigned* st; };
__device__ __forceinline__ XcdBarrier xcd_barrier_post(unsigned* bar, volatile LAS unsigned* st) {
    XcdBarrier b; b.bar = bar; b.x = xb_xcc_id(); b.st = st;
    if (threadIdx.x == 0) (void)xb_add(&bar[XB_XCNT(b.x)], 1u);
    return b;
}
__device__ __forceinline__ void xcd_barrier_complete(unsigned* bar, unsigned x, unsigned& nloc, unsigned& nx) {
    const unsigned G = gridDim.x * gridDim.y * gridDim.z;
    unsigned sum, cnt, mine, sp = 0u;
    for (;;) {
        sum = 0u; cnt = 0u; mine = 0u;
#pragma unroll
        for (unsigned j = 0; j < 16; ++j) { const unsigned c = xb_ld(&bar[XB_XCNT(j)]); sum += c; cnt += (c > 0u) ? 1u : 0u; mine = (j == x) ? c : mine; }
        if (sum == G) break;
        __builtin_amdgcn_s_sleep(1);
        if ((++sp & 255u) == 0u) { if (xb_ld(&bar[XB_TMO])) break; if (sp > XB_SPIN_CAP) { atomicAdd(&bar[XB_TMO], 1u); break; } }
    }
    nloc = mine > 0u ? mine : 1u; nx = cnt > 0u ? cnt : 1u;
}
__device__ __forceinline__ void xcd_barrier(const XcdBarrier& b, int tid) {
    asm volatile("s_waitcnt vmcnt(0)" ::: "memory");
    __syncthreads();
    if (tid == 0) {
        unsigned* bar = b.bar; unsigned bx = b.x; asm volatile("" : "+s"(bar), "+s"(bx));
        __builtin_amdgcn_s_waitcnt(0);
        unsigned nloc = b.st[0], nx = b.st[1];
        if (nloc == 0u) { xcd_barrier_complete(bar, bx, nloc, nx); b.st[0] = nloc; b.st[1] = nx; }
        const unsigned old = xb_add(&bar[XB_XSUB(bx)], 1u);
        const unsigned gen = old / nloc;
        if (old + 1u == (gen + 1u) * nloc) {
            __builtin_amdgcn_fence(__ATOMIC_RELEASE, "agent");
            asm volatile("s_waitcnt vmcnt(0)" ::: "memory");
            const unsigned og = xb_add(&bar[XB_TOP], 1u);
            const unsigned tg = og / nx;
            if (og + 1u == (tg + 1u) * nx) xb_add(&bar[XB_TOPGEN], 1u);
            else XB_SPIN(xb_ld(&bar[XB_TOPGEN]) == tg, bar);
            __builtin_amdgcn_fence(__ATOMIC_ACQUIRE, "agent");
            xb_add(&bar[XB_XGEN(bx)], 1u);
            asm volatile("s_waitcnt vmcnt(0)" ::: "memory");
        } else {
            XB_SPIN(xb_ld(&bar[XB_XGEN(bx)]) == gen, bar);
            __builtin_amdgcn_fence(__ATOMIC_ACQUIRE, "agent");
            asm volatile("s_waitcnt vmcnt(0)" ::: "memory");
        }
    }
    __syncthreads();
}

struct Ctx {
    LAS unsigned char* lds;
    int tid, lane, wid, fr, fq;
    int G, bid;
    int ws;
};
__device__ __forceinline__ int hw_lane() { int l; asm volatile("v_mbcnt_lo_u32_b32 %0, -1, 0\n\tv_mbcnt_hi_u32_b32 %0, -1, %0" : "=v"(l)); return l; }
#define CTX_FRESH(C) do { int w_ = (C).ws, g_ = (C).G, b_ = (C).bid; asm volatile("" : "+s"(w_), "+s"(g_), "+s"(b_)); (C).G = g_; (C).bid = b_; const int l_ = hw_lane(); (C).lane = l_; (C).wid = __builtin_amdgcn_readfirstlane(w_); (C).tid = (C).wid * 64 + l_; (C).fr = l_ & 15; (C).fq = l_ >> 4; } while (0)

__device__ __forceinline__ int tok_cls(int T) { return T < NCTX ? 0 : 1 + ((T - NCTX) >> 11); }
__device__ __forceinline__ const float* x_in_row(const Params& p, int T) { return T < NCTX ? p.in[0] + (size_t)T * DM : p.in[1] + (size_t)(T - NCTX) * DM; }

__device__ __forceinline__ void p0_item(const float* W, int ldw, int k0, int n0, const float* kscale, bf16_t* WT, int ldt, int dst_row0, LAS float* scr, int lane) {
    float ld[32];
#pragma unroll
    for (int i = 0; i < 32; ++i) { const int kk = 2 * i + (lane >> 5); ld[i] = W[(size_t)(k0 + kk) * ldw + n0 + (lane & 31)]; }
#pragma unroll
    for (int i = 0; i < 32; ++i) { const int kk = 2 * i + (lane >> 5); float v = ld[i]; if (kscale) v *= kscale[k0 + kk]; scr[kk * 33 + (lane & 31)] = v; }
    asm volatile("s_waitcnt lgkmcnt(0)" ::: "memory");
    const int c = lane & 7;
#pragma unroll
    for (int j = 0; j < 4; ++j) { const int n = (lane >> 3) + 8 * j; const LAS float* s = scr + (8 * c) * 33 + n;
        u32x4 o; o.x = pk2(s[0 * 33], s[1 * 33]); o.y = pk2(s[2 * 33], s[3 * 33]); o.z = pk2(s[4 * 33], s[5 * 33]); o.w = pk2(s[6 * 33], s[7 * 33]);
        *(u32x4*)(WT + (size_t)(dst_row0 + n) * ldt + k0 + 8 * c) = o; }
    asm volatile("s_waitcnt lgkmcnt(0)" ::: "memory");
}
__device__ __forceinline__ void p0_item8(const float* W, int ldw, int k0, int n0, float scale, unsigned char* WT, int ldt, int dst_row0, LAS float* scr, int lane) {
    float ld[32];
#pragma unroll
    for (int i = 0; i < 32; ++i) { const int kk = 2 * i + (lane >> 5); ld[i] = W[(size_t)(k0 + kk) * ldw + n0 + (lane & 31)]; }
#pragma unroll
    for (int i = 0; i < 32; ++i) { const int kk = 2 * i + (lane >> 5); scr[kk * 33 + (lane & 31)] = ld[i] * scale; }
    asm volatile("s_waitcnt lgkmcnt(0)" ::: "memory");
    const int c = lane & 7;
#pragma unroll
    for (int j = 0; j < 4; ++j) { const int n = (lane >> 3) + 8 * j; const LAS float* s = scr + (8 * c) * 33 + n;
        int w0 = __builtin_amdgcn_cvt_pk_fp8_f32(s[0 * 33], s[1 * 33], 0, false); w0 = __builtin_amdgcn_cvt_pk_fp8_f32(s[2 * 33], s[3 * 33], w0, true);
        int w1 = __builtin_amdgcn_cvt_pk_fp8_f32(s[4 * 33], s[5 * 33], 0, false); w1 = __builtin_amdgcn_cvt_pk_fp8_f32(s[6 * 33], s[7 * 33], w1, true);
        *(u32x2*)(WT + (size_t)(dst_row0 + n) * ldt + k0 + 8 * c) = (u32x2){(unsigned)w0, (unsigned)w1}; }
    asm volatile("s_waitcnt lgkmcnt(0)" ::: "memory");
}
constexpr int IT_IN = 16 * 59, IT_GATE = 16 * 128, IT_BR = 4 * 4 * 32, IT_OUT = 16 * 32, IT_UP = 16 * 172, IT_DOWN = 43 * 32, IT_UQ = 3 * 12, IT_UKV = 2 * 16;
constexpr int IT_LAYER = IT_IN + IT_GATE + IT_BR + IT_OUT + IT_UP + IT_DOWN + IT_UQ + IT_UKV;

__device__ __forceinline__ void zero_bf16(bf16_t* p, size_t n8, int gtid, int gthreads) {
    for (size_t i = gtid; i < n8; i += gthreads) ((u32x4*)p)[i] = (u32x4){0u, 0u, 0u, 0u};
}

__device__ __forceinline__ void phase0(const Params& p, Ctx& C) {
    LAS float* scr = (LAS float*)(C.lds + C.wid * 16384);
    const int gw = C.bid * 8 + C.wid, NGW = C.G * 8;
    for (int it = gw; it < 2 * IT_LAYER; it += NGW) {
        const int L = it / IT_LAYER; int r = it % IT_LAYER;
        unsigned char* wb = p.ws + WS_W + (size_t)L * W_LAYER;
        if (r < IT_IN) { const int kb = r / 59, nb = r % 59; p0_item(p.in[16] + (size_t)L * 1024 * 1888, 1888, kb * 64, nb * 32, nullptr, (bf16_t*)(wb + WO_IN), LDW, nb * 32, scr, C.lane); continue; } r -= IT_IN;
        if (r < IT_GATE) { const int kb = r / 128, nb = r % 128; p0_item8(p.in[17] + (size_t)L * 1024 * 4096, 4096, kb * 64, nb * 32, 32.0f, (unsigned char*)(wb + WO_GATE), LD8, nb * 32, scr, C.lane); continue; } r -= IT_GATE;
        if (r < IT_BR) { const int k = r / 128, rr = r % 128, kb = rr / 32, nb = rr % 32; p0_item(p.in[27] + (size_t)(L * 4 + k) * 256 * 1024, 1024, kb * 64, nb * 32, nullptr, (bf16_t*)(wb + WO_BR) + (size_t)k * 1024 * LDWB, LDWB, nb * 32, scr, C.lane); continue; } r -= IT_BR;
        if (r < IT_OUT) { const int kb = r / 32, nb = r % 32; p0_item(p.in[28] + (size_t)L * 1024 * 1024, 1024, kb * 64, nb * 32, nullptr, (bf16_t*)(wb + WO_OUT), LDW, nb * 32, scr, C.lane); continue; } r -= IT_OUT;
        if (r < IT_UP) { const int kb = r / 172, nb = r % 172; const int n0 = nb * 32, part = n0 / DFF, j0 = n0 % DFF; const int drow = (j0 >> 7) * 256 + part * 128 + (j0 & 127);
            p0_item(p.in[29] + (size_t)L * 1024 * 5504, 5504, kb * 64, n0, nullptr, (bf16_t*)(wb + WO_UP), LDW, drow, scr, C.lane); continue; } r -= IT_UP;
        if (r < IT_DOWN) { const int kb = r / 32, nb = r % 32; p0_item(p.in[31] + (size_t)L * DFF * 1024, 1024, kb * 64, nb * 32, nullptr, (bf16_t*)(wb + WO_DOWN), LDWD, nb * 32, scr, C.lane); continue; } r -= IT_DOWN;
        if (r < IT_UQ) { const int kb = r / 12, nb = r % 12; p0_item(p.in[21] + (size_t)L * 192 * 384, 384, kb * 64, nb * 32, p.in[20] + L * 192, (bf16_t*)(wb + WO_UQ), LDUQ, nb * 32, scr, C.lane); continue; } r -= IT_UQ;
        { const int kb = r / 16, nb = r % 16; p0_item(p.in[23] + (size_t)L * 128 * 512, 512, kb * 64, nb * 32, p.in[22] + L * 128, (bf16_t*)(wb + WO_UKV), LDUKV, nb * 32, scr, C.lane); }
    }
    const int gtid = C.bid * 512 + C.tid, gth = C.G * 512;
    for (int L = 0; L < 2; ++L) {
        unsigned char* wb = p.ws + WS_W + (size_t)L * W_LAYER;
        zero_bf16((bf16_t*)(wb + WO_IN) + (size_t)IN_DIM * LDW, (size_t)(INP - IN_DIM) * LDW / 8, gtid, gth);
        zero_bf16((bf16_t*)(wb + WO_UP) + (size_t)(21 * 256 + 64) * LDW, (size_t)64 * LDW / 8, gtid, gth);
        zero_bf16((bf16_t*)(wb + WO_UP) + (size_t)(21 * 256 + 128 + 64) * LDW, (size_t)64 * LDW / 8, gtid, gth);
        zero_bf16((bf16_t*)(wb + WO_UQ) + (size_t)384 * LDUQ, (size_t)128 * LDUQ / 8, gtid, gth);
        for (int i = gtid; i < 1024 * 8; i += gth) { const int row = i >> 3, c = i & 7; *(u32x4*)((bf16_t*)(wb + WO_DOWN) + (size_t)row * LDWD + DFF + c * 8) = (u32x4){0u, 0u, 0u, 0u}; }
    }
    __syncthreads();
    LAS float* sv = (LAS float*)(C.lds);
    LAS float* part = (LAS float*)(C.lds + 16384);
    for (int i = C.tid; i < 3 * 1024; i += 512) { const int cls = i >> 10, k = i & 1023; const float v = cls == 0 ? p.in[9][k] : p.in[8][(cls - 1) * 1024 + k]; sv[i] = siluf_(v); }
    __syncthreads();
    float* modv = (float*)(p.ws + WS_MODV);
    for (int it = C.bid; it < 2 * 96; it += C.G) {
        const int L = it / 96, col = (it % 96) * 64 + C.lane;
        const float* w = p.in[10] + (size_t)L * 1024 * 6144 + col;
        float a0 = 0.f, a1 = 0.f, a2 = 0.f;
#pragma unroll 8
        for (int kk = 0; kk < 128; ++kk) { const int k = C.wid * 128 + kk; const float wv = w[(size_t)k * 6144]; a0 += sv[k] * wv; a1 += sv[1024 + k] * wv; a2 += sv[2048 + k] * wv; }
        part[(C.wid * 3 + 0) * 64 + C.lane] = a0; part[(C.wid * 3 + 1) * 64 + C.lane] = a1; part[(C.wid * 3 + 2) * 64 + C.lane] = a2;
        __syncthreads();
        if (C.tid < 192) { const int cls = C.tid >> 6, l = C.tid & 63; float s = 0.f;
#pragma unroll
            for (int w8 = 0; w8 < 8; ++w8) s += part[(w8 * 3 + cls) * 64 + l];
            const int cc = (it % 96) * 64 + l;
            modv[((size_t)L * 3 + cls) * 6144 + cc] = s + p.in[11][(size_t)L * 6144 + cc]; }
        __syncthreads();
    }
}

__device__ __forceinline__ void row_norm_mod(const f32x4 (&v)[4], const float* g, const float* sc, const float* sh, bf16_t* orow, int lane, unsigned char* o8 = nullptr) {
    float ss = 0.f;
#pragma unroll
    for (int j = 0; j < 4; ++j) ss += (v[j].x * v[j].x + v[j].y * v[j].y) + (v[j].z * v[j].z + v[j].w * v[j].w);
    const float rstd = 1.0f / sqrtf(wave_sum(ss) * (1.0f / DM) + EPS);
#pragma unroll
    for (int j = 0; j < 4; ++j) {
        const f32x4 gg = ((const f32x4*)g)[lane + 64 * j], s1 = ((const f32x4*)sc)[lane + 64 * j], s0 = ((const f32x4*)sh)[lane + 64 * j];
        const f32x4 y = v[j] * rstd * gg * (s1 + 1.0f) + s0;
        u32x2 o; o.x = pk2(y.x, y.y); o.y = pk2(y.z, y.w);
        ((u32x2*)orow)[lane + 64 * j] = o;
        if (o8) { int w8 = __builtin_amdgcn_cvt_pk_fp8_f32(y.x, y.y, 0, false); w8 = __builtin_amdgcn_cvt_pk_fp8_f32(y.z, y.w, w8, true); ((int*)o8)[lane + 64 * j] = w8; }
    }
}
__device__ __forceinline__ void load_row_bf16(const bf16_t* r, f32x4 (&v)[4], int lane) {
#pragma unroll
    for (int j = 0; j < 4; ++j) { const u32x2 u = ((const u32x2*)r)[lane + 64 * j]; v[j] = (f32x4){lo16(u.x), hi16(u.x), lo16(u.y), hi16(u.y)}; }
}

__device__ __forceinline__ void phase1(const Params& p, Ctx& C) {
    const int gw = C.bid * 8 + C.wid, NGW = C.G * 8;
    const float* modv = (const float*)(p.ws + WS_MODV);
    bf16_t* H = (bf16_t*)(p.ws + WS_H);
    for (int T = gw; T < NTOK; T += NGW) {
        const float* xr = x_in_row(p, T); f32x4 v[4];
#pragma unroll
        for (int j = 0; j < 4; ++j) v[j] = ((const f32x4*)xr)[C.lane + 64 * j];
        const float* mv = modv + (size_t)(0 * 3 + tok_cls(T)) * 6144;
        row_norm_mod(v, p.in[12], mv + 1024, mv, H + (size_t)T * LDH, C.lane, p.ws + WS_H8 + (size_t)T * LD8);
    }
    const int gtid = C.bid * 512 + C.tid, gth = C.G * 512;
    bf16_t* nak = (bf16_t*)(p.ws + WS_NACK); bf16_t* nav = (bf16_t*)(p.ws + WS_NACV);
    for (int i = gtid; i < 2 * 2 * 256 * 256 / 4; i += gth) {
        const int e = i * 4, w = e & 255, t = (e >> 8) & 255, L = (e >> 16) & 1, b = e >> 17;
        const size_t d = ((size_t)(L * 2 + b) * 256 + t) * LDNAC + w;
        const f32x4 a = *(const f32x4*)(p.in[2] + e), c = *(const f32x4*)(p.in[3] + e);
        *(u32x2*)(nak + d) = (u32x2){pk2(a.x, a.y), pk2(a.z, a.w)}; *(u32x2*)(nav + d) = (u32x2){pk2(c.x, c.y), pk2(c.z, c.w)};
    }
    bf16_t* swk = (bf16_t*)(p.ws + WS_SWCK); bf16_t* swv = (bf16_t*)(p.ws + WS_SWCV); bf16_t* ckv = (bf16_t*)(p.ws + WS_CKVC);
    for (int i = gtid; i < 2 * 2 * 256 * 128 / 4; i += gth) {
        const int e = i * 4, w = e & 127, t = (e >> 7) & 255, L = (e >> 15) & 1, b = e >> 16;
        const size_t d = ((size_t)(L * 2 + b) * 256 + t) * LDSWC + w, d2 = ((size_t)(L * 2 + b) * 256 + t) * LDCKVC + w;
        const f32x4 a = *(const f32x4*)(p.in[6] + e), c = *(const f32x4*)(p.in[7] + e), m = *(const f32x4*)(p.in[4] + e);
        *(u32x2*)(swk + d) = (u32x2){pk2(a.x, a.y), pk2(a.z, a.w)}; *(u32x2*)(swv + d) = (u32x2){pk2(c.x, c.y), pk2(c.z, c.w)};
        *(u32x2*)(ckv + d2) = (u32x2){pk2(m.x, m.y), pk2(m.z, m.w)};
    }
    bf16_t* krc = (bf16_t*)(p.ws + WS_KRC);
    for (int i = gtid; i < 2 * 2 * 256 * 32 / 4; i += gth) {
        const int e = i * 4, w = e & 31, t = (e >> 5) & 255, L = (e >> 13) & 1, b = e >> 14;
        const size_t d = ((size_t)(L * 2 + b) * 256 + t) * 32 + w;
        const f32x4 a = *(const f32x4*)(p.in[5] + e);
        *(u32x2*)(krc + d) = (u32x2){pk2(a.x, a.y), pk2(a.z, a.w)};
    }
}

__device__ __forceinline__ void phase7(const Params& p, Ctx& C, int L) {
    const int gw = C.bid * 8 + C.wid, NGW = C.G * 8;
    const float* modv = (const float*)(p.ws + WS_MODV);
    const bf16_t* O = (const bf16_t*)(p.ws + WS_O); float* X1 = p.out + OFF_Y; bf16_t* H = (bf16_t*)(p.ws + WS_H);
    const float* gpost = p.in[13] + L * DM; const float* gpre = p.in[14] + L * DM;
    for (int T = gw; T < NTOK; T += NGW) {
        const float* xr = (L == 0) ? x_in_row(p, T) : p.out + OFF_Y + (size_t)T * DM;
        const float* mv = modv + (size_t)(L * 3 + tok_cls(T)) * 6144;
        f32x4 o[4]; load_row_bf16(O + (size_t)T * LDH, o, C.lane);
        float ss = 0.f;
#pragma unroll
        for (int j = 0; j < 4; ++j) ss += (o[j].x * o[j].x + o[j].y * o[j].y) + (o[j].z * o[j].z + o[j].w * o[j].w);
        const float rstd = 1.0f / sqrtf(wave_sum(ss) * (1.0f / DM) + EPS);
        f32x4 x1[4];
#pragma unroll
        for (int j = 0; j < 4; ++j) {
            const f32x4 xv = ((const f32x4*)xr)[C.lane + 64 * j], gp = ((const f32x4*)gpost)[C.lane + 64 * j], g1 = ((const f32x4*)(mv + 2048))[C.lane + 64 * j];
            x1[j] = xv + g1 * (o[j] * rstd * gp);
            ((f32x4*)(X1 + (size_t)T * DM))[C.lane + 64 * j] = x1[j];
        }
        row_norm_mod(x1, gpre, mv + 4096, mv + 3072, H + (size_t)T * LDH, C.lane);
    }
}
__device__ __forceinline__ void phase10(const Params& p, Ctx& C, int L) {
    const int gw = C.bid * 8 + C.wid, NGW = C.G * 8;
    const float* modv = (const float*)(p.ws + WS_MODV);
    const float* X1 = p.out + OFF_Y; bf16_t* H = (bf16_t*)(p.ws + WS_H);
    const float* gpost = p.in[15] + L * DM;
    for (int T = gw; T < NTOK; T += NGW) {
        const float* mv = modv + (size_t)(L * 3 + tok_cls(T)) * 6144;
        f32x4 f[4]; load_row_bf16(H + (size_t)T * LDH, f, C.lane);
        float ss = 0.f;
#pragma unroll
        for (int j = 0; j < 4; ++j) ss += (f[j].x * f[j].x + f[j].y * f[j].y) + (f[j].z * f[j].z + f[j].w * f[j].w);
        const float rstd = 1.0f / sqrtf(wave_sum(ss) * (1.0f / DM) + EPS);
        f32x4 y[4];
#pragma unroll
        for (int j = 0; j < 4; ++j) {
            const f32x4 xv = ((const f32x4*)(X1 + (size_t)T * DM))[C.lane + 64 * j], gp = ((const f32x4*)gpost)[C.lane + 64 * j], g2 = ((const f32x4*)(mv + 5120))[C.lane + 64 * j];
            y[j] = xv + g2 * (f[j] * rstd * gp);
            ((f32x4*)(p.out + OFF_Y + (size_t)T * DM))[C.lane + 64 * j] = y[j];
        }
        if (L == 0) { const float* mv1 = modv + (size_t)(1 * 3 + tok_cls(T)) * 6144; row_norm_mod(y, p.in[12] + DM, mv1 + 1024, mv1, H + (size_t)T * LDH, C.lane, p.ws + WS_H8 + (size_t)T * LD8); }
    }
}

__device__ __forceinline__ int lds_byte(int r, int c) { const int st = (r >> 4) * 2 + (c >> 5), ob = (r & 15) * 64 + (c & 31) * 2; return st * 1024 + (ob ^ (((ob >> 9) & 1) << 5)); }
__device__ __forceinline__ void stage_rc(int b, int& R, int& Cc) { const int st = b >> 10, sb = b & 1023, swz = sb ^ (((sb >> 9) & 1) << 5); R = (st >> 1) * 16 + swz / 64; Cc = (st & 1) * 32 + (swz % 64) / 2; }
#define GLDS16(gp, lp) __builtin_amdgcn_global_load_lds((const unsigned*)(gp), (LAS unsigned*)(lp), 16, 0, 0)

template <int TM, int TN> struct GemmStage {
    static constexpr int STAGE = (TM + TN) * 128;
    int offA, offB;
    int lda, ldb;
    __device__ __forceinline__ void init(const Ctx& C, int lda_, int ldb_) { int R, Cc; stage_rc(C.wid * 1024 + C.lane * 16, R, Cc); lda = lda_; ldb = ldb_; offA = R * lda + Cc; offB = R * ldb + Cc; }
    __device__ __forceinline__ void stage(const Ctx& C, int buf, const bf16_t* a, const bf16_t* b) const {
        LAS unsigned char* base = C.lds + buf * STAGE + C.wid * 1024;
#pragma unroll
        for (int i = 0; i < TM / 64; ++i) GLDS16(a + offA + (size_t)i * 64 * lda, base + i * 8192);
#pragma unroll
        for (int i = 0; i < TN / 64; ++i) GLDS16(b + offB + (size_t)i * 64 * ldb, base + TM * 128 + i * 8192);
    }
};
template <int TM, int TN, int MF, int NF>
__device__ __forceinline__ void gemm_compute(const Ctx& C, int buf, int wr, int wc, f32x4 (&acc)[MF][NF]) {
    constexpr int STAGE = (TM + TN) * 128;
    LAS unsigned char* sa = C.lds + buf * STAGE; LAS unsigned char* sb = sa + TM * 128;
#pragma unroll
    for (int ks = 0; ks < 2; ++ks) {
        bf16x8 Af[MF], Bf[NF];
        const int ao = lds_byte(wr * MF * 16 + C.fr, ks * 32 + C.fq * 8), bo = lds_byte(wc * NF * 16 + C.fr, ks * 32 + C.fq * 8);
#pragma unroll
        for (int m = 0; m < MF; ++m) Af[m] = *(const LAS bf16x8*)(sa + ao + m * 2048);
#pragma unroll
        for (int n = 0; n < NF; ++n) Bf[n] = *(const LAS bf16x8*)(sb + bo + n * 2048);
#pragma unroll
        for (int m = 0; m < MF; ++m)
#pragma unroll
            for (int n = 0; n < NF; ++n) acc[m][n] = __builtin_amdgcn_mfma_f32_16x16x32_bf16(Bf[n], Af[m], acc[m][n], 0, 0, 0);
        __builtin_amdgcn_sched_barrier(0);
    }
}
template <int TM, int TN, int MF, int NF>
__device__ __forceinline__ void gemm_kloop(const Ctx& C, const GemmStage<TM, TN>& S, const bf16_t* A, const bf16_t* B, int nt, int wr, int wc, f32x4 (&acc)[MF][NF]) {
    S.stage(C, 0, A, B); VM_WAIT(); __syncthreads();
    for (int t = 0; t < nt; ++t) {
        const int cur = t & 1;
        if (t + 1 < nt) S.stage(C, cur ^ 1, A + (t + 1) * 64, B + (t + 1) * 64);
        gemm_compute<TM, TN, MF, NF>(C, cur, wr, wc, acc);
        VM_WAIT(); __syncthreads();
    }
}
__device__ __forceinline__ void unit_map(int u, int nM, int nN, int& pm, int& pn) {
    const int nwg = nM * nN; int wgid = u;
    { const int q = nwg / 8, r = nwg % 8, xcd = wgid % 8, off = wgid / 8; wgid = (xcd < r ? xcd * (q + 1) : r * (q + 1) + (xcd - r) * q) + off; }
    const int nig = 8 * nN, gid = wgid / nig, fm = gid * 8, gsz = (nM - fm) < 8 ? (nM - fm) : 8;
    pm = fm + ((wgid % nig) % gsz); pn = (wgid % nig) / gsz;
}
#define ZERO_ACC(acc, MF, NF) _Pragma("unroll") for (int m_ = 0; m_ < MF; ++m_) _Pragma("unroll") for (int n_ = 0; n_ < NF; ++n_) acc[m_][n_] = (f32x4){0.f, 0.f, 0.f, 0.f}


struct G8Unit { const char* A; const char* B; int e0, e1, e2, e3; };
__device__ __forceinline__ int perm32(int rho) { const int n = rho >> 4, i = rho & 15; return 8 * (i >> 2) + 4 * n + (i & 3); }
__device__ __forceinline__ i32x8 cat8(bf16x8 a, bf16x8 b) { return __builtin_shufflevector(__builtin_bit_cast(i32x4, a), __builtin_bit_cast(i32x4, b), 0, 1, 2, 3, 4, 5, 6, 7); }
#define G8_EPI_PLAIN static __device__ __forceinline__ f32x4 init(const G8Unit&, int, int, int, int) { return (f32x4){0.f, 0.f, 0.f, 0.f}; } static constexpr bool FP8 = false; static constexpr int HROWS_B = 128; static __device__ __forceinline__ int brow(int R) { return PERM ? ((R & ~31) + perm32(R & 31)) : R; }
template <class Epi, class Sched>
__device__ __forceinline__ void gemm8(const Ctx& C, int K, int lda, int ldb, const Sched& S, const Epi& E) {
    constexpr int HTB = 16384;
    LAS unsigned char* lds = C.lds;
    const int tid = C.tid, wid = C.wid, lane = C.lane, wr = wid >> 2, wc = wid & 3, fr = lane & 15, fq = lane >> 4;
    const int nt = K / 64;
    unsigned voffA, voffB;
    { int R, Cc; stage_rc(tid * 16, R, Cc); voffA = (unsigned)(R * lda + Cc) * 2u; voffB = (unsigned)(Epi::brow(R) * ldb + Cc) * 2u; }
    const size_t kstep = 128;
    const size_t hstepA = (size_t)128 * lda * 2, hstepB = (size_t)Epi::HROWS_B * ldb * 2;
    const size_t r64A = (size_t)64 * lda * 2, r64B = (size_t)(Epi::brow(64) - Epi::brow(0)) * ldb * 2;
    const unsigned ldsw = (unsigned)__builtin_amdgcn_readfirstlane((int)((unsigned)(size_t)lds + (unsigned)wid * 1024u));
    const int aoff = lds_byte(wr * 64 + fr, fq * 8), boff = lds_byte(wc * 32 + fr, fq * 8);
#define G8_SA(b, h) (((b) * 2 + (h)) * HTB)
#define G8_SB(b, h) ((4 + (b) * 2 + (h)) * HTB)
#define G8_GLDS(vo, sb, la) asm volatile("s_mov_b32 m0, %2\n\ts_nop 0\n\tglobal_load_lds_dwordx4 %0, %1" :: "v"(vo), "s"(sb), "s"(la) : "memory", "m0")
#define G8_STAGE(bufoff, gbase, voff, r64) do { const char* _g = (const char*)(gbase); const unsigned _l = ldsw + (unsigned)(bufoff); G8_GLDS(voff, _g, _l); \
        const char* _g2 = _g + (r64); G8_GLDS(voff, _g2, _l + 8192u); } while (0)
#define G8_LDA(dst, b, h) do { _Pragma("unroll") for (int m = 0; m < 4; ++m) _Pragma("unroll") for (int k = 0; k < 2; ++k) dst[m][k] = *(const LAS bf16x8*)(lds + G8_SA(b, h) + aoff + m * 2048 + k * 1024); } while (0)
#define G8_LDB(dst, b, h) do { _Pragma("unroll") for (int n = 0; n < 2; ++n) _Pragma("unroll") for (int k = 0; k < 2; ++k) dst[n][k] = *(const LAS bf16x8*)(lds + G8_SB(b, h) + boff + n * 2048 + k * 1024); } while (0)
#define G8_MMA(ai, bj, At, Bt) do { __builtin_amdgcn_s_setprio(1); _Pragma("unroll") for (int m = 0; m < 4; ++m) _Pragma("unroll") for (int n = 0; n < 2; ++n) { \
        if constexpr (Epi::FP8) acc[ai][bj][m][n] = __builtin_amdgcn_mfma_scale_f32_16x16x128_f8f6f4(cat8(Bt[n][0], Bt[n][1]), cat8(At[m][0], At[m][1]), acc[ai][bj][m][n], 0, 0, 0, 0, 0, 0); \
        else { _Pragma("unroll") for (int k = 0; k < 2; ++k) acc[ai][bj][m][n] = __builtin_amdgcn_mfma_f32_16x16x32_bf16(Bt[n][k], At[m][k], acc[ai][bj][m][n], 0, 0, 0); } } \
        __builtin_amdgcn_s_setprio(0); } while (0)
#define G8_WAIT_V(n) asm volatile("s_waitcnt vmcnt(" #n ")" ::: "memory")
#define G8_WAIT_L(n) asm volatile("s_waitcnt lgkmcnt(" #n ")" ::: "memory")
#define G8_BAR __builtin_amdgcn_s_barrier()
#define G8_SCHED __builtin_amdgcn_sched_barrier(0)
    G8Unit cur, nxt; int ui = 0;
    if (!S.next(0, cur)) return;
    f32x4 acc[2][2][4][2];
#pragma unroll
    for (int a = 0; a < 2; ++a)
#pragma unroll
        for (int b = 0; b < 2; ++b)
#pragma unroll
            for (int m = 0; m < 4; ++m)
#pragma unroll
                for (int n = 0; n < 2; ++n) acc[a][b][m][n] = E.init(cur, b, n, wc, fq);
    bf16x8 At[4][2], B0[2][2], B1[2][2];
    const char* cA = cur.A; const char* cB = cur.B;
    G8_STAGE(G8_SB(0, 0), cB, voffB, r64B); G8_STAGE(G8_SA(0, 0), cA, voffA, r64A); G8_STAGE(G8_SB(0, 1), cB + hstepB, voffB, r64B); G8_STAGE(G8_SA(0, 1), cA + hstepA, voffA, r64A);
    if (wr == 1) G8_BAR;
    G8_WAIT_V(4); G8_BAR;
    G8_STAGE(G8_SB(1, 0), cB + kstep, voffB, r64B); G8_STAGE(G8_SA(1, 0), cA + kstep, voffA, r64A); G8_STAGE(G8_SB(1, 1), cB + hstepB + kstep, voffB, r64B);
    G8_WAIT_V(6); G8_BAR;
    for (;;) {
        const bool has_next = S.next(ui + 1, nxt);
        const char* nA = has_next ? nxt.A : cA; const char* nB = has_next ? nxt.B : cB;
#pragma unroll 1
        for (int t = 0; t < nt; t += 2) {
            const bool last = (t == nt - 2);
            const char* a1 = cA + (size_t)(t + 1) * kstep;
            const char* a2 = last ? nA : cA + (size_t)(t + 2) * kstep; const char* b2 = last ? nB : cB + (size_t)(t + 2) * kstep;
            const char* a3 = a2 + kstep; const char* b3 = b2 + kstep;
            G8_LDB(B0, 0, 0); G8_SCHED; G8_LDA(At, 0, 0); G8_STAGE(G8_SA(1, 1), a1 + hstepA, voffA, r64A);
            G8_WAIT_L(8); G8_BAR; G8_WAIT_L(0); G8_MMA(0, 0, At, B0); G8_BAR; G8_SCHED;
            G8_LDB(B1, 0, 1); G8_STAGE(G8_SB(0, 0), b2, voffB, r64B);
            G8_BAR; G8_WAIT_L(0); G8_MMA(0, 1, At, B1); G8_BAR;
            G8_LDA(At, 0, 1); G8_STAGE(G8_SA(0, 0), a2, voffA, r64A);
            G8_BAR; G8_WAIT_L(0); G8_MMA(1, 0, At, B0); G8_BAR; G8_SCHED;
            G8_STAGE(G8_SB(0, 1), b2 + hstepB, voffB, r64B);
            G8_WAIT_V(6); G8_BAR; G8_MMA(1, 1, At, B1); G8_BAR;
            G8_LDB(B0, 1, 0); G8_SCHED; G8_LDA(At, 1, 0); G8_STAGE(G8_SA(0, 1), a2 + hstepA, voffA, r64A);
            G8_WAIT_L(8); G8_BAR; G8_WAIT_L(0); G8_MMA(0, 0, At, B0); G8_BAR; G8_SCHED;
            G8_LDB(B1, 1, 1); G8_STAGE(G8_SB(1, 0), b3, voffB, r64B);
            G8_BAR; G8_WAIT_L(0); G8_MMA(0, 1, At, B1); G8_BAR;
            G8_LDA(At, 1, 1); G8_STAGE(G8_SA(1, 0), a3, voffA, r64A);
            G8_BAR; G8_WAIT_L(0); G8_MMA(1, 0, At, B0); G8_BAR; G8_SCHED;
            G8_STAGE(G8_SB(1, 1), b3 + hstepB, voffB, r64B);
            G8_WAIT_V(6); G8_BAR; G8_MMA(1, 1, At, B1); G8_BAR;
        }
        if constexpr (!Epi::AFTER_DRAIN) E(acc, cur, wr, wc, fr, fq);
        if (!has_next) break;
#pragma unroll
        for (int a = 0; a < 2; ++a)
#pragma unroll
            for (int b = 0; b < 2; ++b)
#pragma unroll
                for (int m = 0; m < 4; ++m)
#pragma unroll
                    for (int n = 0; n < 2; ++n) acc[a][b][m][n] = E.init(nxt, b, n, wc, fq);
        cur = nxt; cA = nA; cB = nB; ++ui;
    }
    G8_WAIT_V(0);
    if (wr == 0) G8_BAR;
    G8_BAR;
    if constexpr (Epi::AFTER_DRAIN) E.drained(C, acc, cur, wr, wc, fr, fq);
#undef G8_SA
#undef G8_SB
#undef G8_STAGE
#undef G8_GLDS
#undef G8_LDA
#undef G8_LDB
#undef G8_MMA
#undef G8_WAIT_V
#undef G8_WAIT_L
#undef G8_BAR
#undef G8_SCHED
}
struct TileSched {
    const char* A; const char* B; size_t tstepA, tstepB; int nM, nN, G, c;
    __device__ __forceinline__ bool next(int i, G8Unit& u) const {
        const int L = i * G + c; if (L >= nM * nN) return false;
        int pm, pn; unit_map(L, nM, nN, pm, pn);
        u.A = A + (size_t)pm * tstepA; u.B = B + (size_t)pn * tstepB; u.e0 = pm; u.e1 = pn; u.e2 = 0; u.e3 = 0; return true;
    }
};
struct EpiBf16 {
    static constexpr bool PERM = true, AFTER_DRAIN = false; G8_EPI_PLAIN
    bf16_t* O; int ldo;
    __device__ __forceinline__ void operator()(const f32x4 (&acc)[2][2][4][2], const G8Unit& u, int wr, int wc, int fr, int fq) const {
        const int row0 = u.e0 * 256 + wr * 64 + fr, col0 = u.e1 * 256 + wc * 32 + 8 * fq;
#pragma unroll
        for (int ai = 0; ai < 2; ++ai)
#pragma unroll
            for (int m = 0; m < 4; ++m) { bf16_t* rowp = O + (size_t)(row0 + ai * 128 + m * 16) * ldo + col0;
#pragma unroll
                for (int bj = 0; bj < 2; ++bj) { const f32x4 v0 = acc[ai][bj][m][0], v1 = acc[ai][bj][m][1];
                    *(u32x4*)(rowp + bj * 128) = (u32x4){pk2(v0.x, v0.y), pk2(v0.z, v0.w), pk2(v1.x, v1.y), pk2(v1.z, v1.w)}; } }
    }
};
struct EpiInProj {
    static constexpr bool PERM = true, AFTER_DRAIN = false; G8_EPI_PLAIN
    bf16_t* P; float* out; int L;
    __device__ __forceinline__ void operator()(const f32x4 (&acc)[2][2][4][2], const G8Unit& u, int wr, int wc, int fr, int fq) const {
        const int row0 = u.e0 * 256 + wr * 64 + fr, col0 = u.e1 * 256 + wc * 32 + 8 * fq;
        const bool ctx = u.e0 < 32;
#pragma unroll
        for (int bj = 0; bj < 2; ++bj) { const int col = col0 + bj * 128;
            int W = 0, cc = 0; size_t off = 0;
            if (ctx) {
                if (col >= COL_KA && col < COL_VA) { off = OFF_NAK; W = 256; cc = col - COL_KA; }
                else if (col >= COL_VA && col < COL_CQ) { off = OFF_NAV; W = 256; cc = col - COL_VA; }
                else if (col >= COL_CKV && col < COL_KR) { off = OFF_CKV; W = 128; cc = col - COL_CKV; }
                else if (col >= COL_KR && col < COL_QC) { off = OFF_KR; W = 32; cc = col - COL_KR; }
                else if (col >= COL_KC && col < COL_VC) { off = OFF_SWK; W = 128; cc = col - COL_KC; }
                else if (col >= COL_VC && col < COL_PD) { off = OFF_SWV; W = 128; cc = col - COL_VC; }
            }
            float* dbase = out + off + cc;
#pragma unroll
            for (int ai = 0; ai < 2; ++ai)
#pragma unroll
                for (int m = 0; m < 4; ++m) { const int row = row0 + ai * 128 + m * 16; const f32x4 v0 = acc[ai][bj][m][0], v1 = acc[ai][bj][m][1];
                    if (col < IN_DIM) *(u32x4*)(P + (size_t)row * LDP + col) = (u32x4){pk2(v0.x, v0.y), pk2(v0.z, v0.w), pk2(v1.x, v1.y), pk2(v1.z, v1.w)};
                    if (W) { float* dst = dbase + (size_t)(((row >> 8) * 2 + L) * 256 + (row & 255)) * W; *(f32x4*)dst = v0; *(f32x4*)(dst + 4) = v1; } }
        }
    }
};
__device__ __forceinline__ void phase2(const Params& p, Ctx& C, int L) {
    TileSched S{(const char*)(p.ws + WS_H), (const char*)(p.ws + WS_W + (size_t)L * W_LAYER + WO_IN), (size_t)256 * LDH * 2, (size_t)256 * LDW * 2, 48, 8, C.G, C.bid};
    EpiInProj E{(bf16_t*)(p.ws + WS_P), p.out, L};
    gemm8(C, DM, LDH, LDW, S, E);
}

__device__ __forceinline__ void rope_pair(bf16_t* p1, bf16_t* p2, float pos, float inv) {
    const float ang = pos * inv; float rev = ang * 0.15915494309189535f; rev -= floorf(rev);
    const float s = __builtin_amdgcn_sinf(rev), c = __builtin_amdgcn_cosf(rev);
    const float x1 = bf2f(*p1), x2 = bf2f(*p2);
    const unsigned o = pk2(x1 * c - x2 * s, x1 * s + x2 * c);
    *p1 = (bf16_t)(o & 0xffffu); *p2 = (bf16_t)(o >> 16);
}
__device__ __forceinline__ void phase3(const Params& p, Ctx& C, int L) {
    bf16_t* P = (bf16_t*)(p.ws + WS_P);
    {
        const int gw = C.bid * 8 + C.wid, NGW = C.G * 8;
        for (int t = gw; t < NLAT; t += NGW) {
            bf16_t* row = P + (size_t)(NCTX + t) * LDP; const int pos = t & 2047; const float prow = (float)(pos >> 6), pcol = (float)(pos & 63);
            for (int i = C.lane; i < 208; i += 64) {
                if (i < 16) { const int blk = i >> 3, f = i & 7; bf16_t* b = row + COL_KR + blk * 16 + f; rope_pair(b, b + 8, blk ? pcol : prow, exp2f(-(float)f * (13.287712379549449f / 8.0f))); }
                else { const int j = i - 16, head = j >> 5, blk = (j >> 4) & 1, f = j & 15;
                    bf16_t* b = row + COL_QC + head * 64 + blk * 32 + f; rope_pair(b, b + 16, blk ? pcol : prow, exp2f(-(float)f * (13.287712379549449f / 16.0f))); }
            }
        }
    }
    const int wr = C.wid >> 2, wc = C.wid & 3;
    LAS float* rs = (LAS float*)(C.lds + LDS_TAB);
    const unsigned char* wb = p.ws + WS_W + (size_t)L * W_LAYER;
    int R, Cc; stage_rc(C.wid * 1024 + C.lane * 16, R, Cc);
    const int Rb = (R & ~31) + perm32(R & 31);
    for (int u = C.bid; u < 96 * 7 + 4 * 4; u += C.G) {
        int pm, tn;
        if (u < 672) { pm = u / 7; tn = u % 7; } else { const int r = u - 672; pm = 96 + (r >> 2); tn = 3 + (r & 3); }
        const int which = tn >= 3, K = which ? 128 : 192, nkt = K / 64, ldb = which ? LDUKV : LDUQ, n0 = (which ? tn - 3 : tn) * 128;
        const bf16_t* A; int lda;
        if (pm < 96) { A = P + (size_t)pm * 128 * LDP + (which ? COL_CKV : COL_CQ); lda = LDP; }
        else { A = (const bf16_t*)(p.ws + WS_CKVC) + (size_t)(L * 512 + (pm - 96) * 128) * LDCKVC; lda = LDCKVC; }
        const bf16_t* B = (const bf16_t*)(wb + (which ? WO_UKV : WO_UQ)) + (size_t)n0 * ldb;
        for (int t = 0; t < nkt; ++t) { LAS unsigned char* base = C.lds + t * 32768 + C.wid * 1024;
            const bf16_t* a = A + (size_t)R * lda + Cc + t * 64; const bf16_t* bq = B + (size_t)Rb * ldb + Cc + t * 64;
            GLDS16(a, base); GLDS16(a + (size_t)64 * lda, base + 8192); GLDS16(bq, base + 16384); GLDS16(bq + (size_t)64 * ldb, base + 16384 + 8192); }
        VM_WAIT(); __syncthreads();
        { const int row = C.tid >> 2, part = C.tid & 3; float ss = 0.f;
            for (int c = part; c < K / 8; c += 4) { const int t = c >> 3, cc = (c & 7) * 8; const u32x4 q = *(const LAS u32x4*)(C.lds + t * 32768 + lds_byte(row, cc));
                ss += lo16(q.x) * lo16(q.x) + hi16(q.x) * hi16(q.x) + lo16(q.y) * lo16(q.y) + hi16(q.y) * hi16(q.y) + lo16(q.z) * lo16(q.z) + hi16(q.z) * hi16(q.z) + lo16(q.w) * lo16(q.w) + hi16(q.w) * hi16(q.w); }
            ss += __shfl_xor(ss, 1); ss += __shfl_xor(ss, 2);
            if (part == 0) rs[row] = __builtin_amdgcn_rsqf(ss / (float)K + EPS); }
        f32x4 acc[4][2]; ZERO_ACC(acc, 4, 2);
        for (int t = 0; t < nkt; ++t) gemm_compute<128, 128, 4, 2>(C, t, wr, wc, acc);
        __syncthreads();
        bf16_t* O; int ldo;
        if (pm < 96) { if (which) { O = (bf16_t*)(p.ws + WS_KVUP) + (size_t)pm * 128 * LDKV; ldo = LDKV; } else { O = (bf16_t*)(p.ws + WS_QUP) + (size_t)pm * 128 * LDQ; ldo = LDQ; } }
        else { O = (bf16_t*)(p.ws + WS_KVCUP) + (size_t)(L * 512 + (pm - 96) * 128) * LDKV; ldo = LDKV; }
#pragma unroll
        for (int m = 0; m < 4; ++m) { const int r = wr * 64 + m * 16 + C.fr; const float sc = rs[r]; const f32x4 v0 = acc[m][0] * sc, v1 = acc[m][1] * sc;
            *(u32x4*)(O + (size_t)r * ldo + n0 + wc * 32 + 8 * C.fq) = (u32x4){pk2(v0.x, v0.y), pk2(v0.z, v0.w), pk2(v1.x, v1.y), pk2(v1.z, v1.w)}; }
        __syncthreads();
    }
}

struct AttnSeg { const bf16_t* K; const bf16_t* K2; const bf16_t* V; int ldk, ldk2, ldv, n, tok0; };
struct AttnDesc { const bf16_t* Q; bf16_t* O; AttnSeg seg[2]; int ldq, ldo; float c1, m0, l0; int qtok0; int rope_q; };
typedef short v4i16_t __attribute__((ext_vector_type(4)));
__device__ __forceinline__ s16x4 vtr(const LAS unsigned char* p) { return __builtin_bit_cast(s16x4, __builtin_amdgcn_ds_read_tr16_b64_v4i16((LAS v4i16_t*)p)); }

template <int DQK, int KIND, int QB>
__device__ __forceinline__ void attn_unit(const Ctx& C, const AttnDesc& D, const LAS float* rpb) {
    constexpr int KROW = DQK * 2 + 16, VROW = 160, KBYTES = 64 * KROW, BUFB = KBYTES + 64 * VROW, CPK = DQK / 8, NKC = 64 * CPK;
    const int fr = C.fr, fq = C.fq;
    bf16x8 Qf[QB][DQK / 32];
#pragma unroll
    for (int qb = 0; qb < QB; ++qb) { const bf16_t* qrow = D.Q + (size_t)(qb * 128 + C.wid * 16 + fr) * D.ldq;
#pragma unroll
        for (int s = 0; s < DQK / 32; ++s) Qf[qb][s] = *(const bf16x8*)(qrow + s * 32 + fq * 8); }
    const int qtok = D.qtok0 + C.wid * 16 + fr;
    if (QB == 1 && DQK == 96 && D.rope_q) {
        bf16x8 mine = Qf[0][2], oth;
#pragma unroll
        for (int j = 0; j < 8; ++j) oth[j] = (short)__shfl_xor((int)mine[j], 16);
        const float pos = (fq < 2) ? (float)(qtok >> 6) : (float)(qtok & 63);
#pragma unroll
        for (int j = 0; j < 8; j += 2) {
            float o2[2];
#pragma unroll
            for (int e = 0; e < 2; ++e) {
                const float ang = pos * exp2f(-(float)(j + e) * (13.287712379549449f / 8.0f)); float rev = ang * 0.15915494309189535f; rev -= floorf(rev);
                const float sn = __builtin_amdgcn_sinf(rev), cs = __builtin_amdgcn_cosf(rev);
                const float a = bf2f((bf16_t)mine[j + e]), b = bf2f((bf16_t)oth[j + e]);
                o2[e] = (fq & 1) ? (b * sn + a * cs) : (a * cs - b * sn);
            }
            const unsigned pk = pk2(o2[0], o2[1]); Qf[0][2][j] = (short)(pk & 0xffffu); Qf[0][2][j + 1] = (short)(pk >> 16);
        }
    }
    float m[QB], l[QB]; f32x4 Oa[QB][4];
#pragma unroll
    for (int qb = 0; qb < QB; ++qb) { m[qb] = D.m0; l[qb] = D.l0 * (fq == 0 ? 1.0f : 0.0f);
#pragma unroll
        for (int d = 0; d < 4; ++d) Oa[qb][d] = (f32x4){0.f, 0.f, 0.f, 0.f}; }
    int qrow_g = 0, qcol_g = 0, r0 = 0, cs0 = 0;
    if (KIND == 1) { qrow_g = qtok >> 6; qcol_g = qtok & 63; r0 = min(max(qrow_g - 4, 0), 24); cs0 = min(max(qcol_g - 8, 0), 48); }

    const int nt0 = D.seg[0].n >> 6, ntot = nt0 + (D.seg[1].n >> 6);
    u32x4 kreg[(NKC + 511) / 512], vreg;
    auto issue = [&](int t) {
        const AttnSeg& sg = (t < nt0) ? D.seg[0] : D.seg[1]; const int k0 = ((t < nt0) ? t : t - nt0) * 64;
#pragma unroll
        for (int i = 0; i < (NKC + 511) / 512; ++i) { const int c = C.tid + i * 512;
            if (c < NKC) { const int key = c / CPK, part = c % CPK;
                const bf16_t* src = (part < 8) ? sg.K + (size_t)(k0 + key) * sg.ldk + part * 8 : sg.K2 + (size_t)(k0 + key) * sg.ldk2 + (part - 8) * 8;
                kreg[i] = *(const u32x4*)src; } }
        { const int key = C.tid >> 3, part = C.tid & 7; vreg = *(const u32x4*)(sg.V + (size_t)(k0 + key) * sg.ldv + part * 8); }
    };
    auto commit = [&](int buf) {
        LAS unsigned char* kb = C.lds + buf * BUFB; LAS unsigned char* vb = kb + KBYTES;
#pragma unroll
        for (int i = 0; i < (NKC + 511) / 512; ++i) { const int c = C.tid + i * 512; if (c < NKC) { const int key = c / CPK, part = c % CPK; *(LAS u32x4*)(kb + key * KROW + part * 16) = kreg[i]; } }
        { const int key = C.tid >> 3, part = C.tid & 7; *(LAS u32x4*)(vb + key * VROW + part * 16) = vreg; }
    };
    issue(0);
    for (int t = 0; t < ntot; ++t) {
        const int buf = t & 1;
        commit(buf);
        __syncthreads();
        if (t + 1 < ntot) issue(t + 1);
        const LAS unsigned char* kb = C.lds + buf * BUFB; const LAS unsigned char* vb = kb + KBYTES;
        f32x4 s[QB][4];
#pragma unroll
        for (int kg = 0; kg < 4; ++kg) {
#pragma unroll
            for (int qb = 0; qb < QB; ++qb) s[qb][kg] = (f32x4){0.f, 0.f, 0.f, 0.f};
#pragma unroll
            for (int ks = 0; ks < DQK / 32; ++ks) { const bf16x8 Kf = *(const LAS bf16x8*)(kb + (kg * 16 + fr) * KROW + ks * 64 + fq * 16);
#pragma unroll
                for (int qb = 0; qb < QB; ++qb) s[qb][kg] = __builtin_amdgcn_mfma_f32_16x16x32_bf16(Kf, Qf[qb][ks], s[qb][kg], 0, 0, 0); }
        }
        const bool seg1 = (t >= nt0);
        const int ktile0 = seg1 ? D.seg[1].tok0 + (t - nt0) * 64 : 0;
        bf16x8 Pf[QB][2];
#pragma unroll
        for (int qb = 0; qb < QB; ++qb) {
            float mx = -1e30f;
#pragma unroll
            for (int kg = 0; kg < 4; ++kg)
#pragma unroll
                for (int j = 0; j < 4; ++j) {
                    float v = s[qb][kg][j] * D.c1;
                    if (KIND == 1 && seg1) { const int kt = ktile0 + kg * 16 + 4 * fq + j, krow = kt >> 6, kcol = kt & 63;
                        const bool ok = (krow >= r0) && (krow < r0 + 8) && (kcol >= cs0) && (kcol < cs0 + 16);
                        const int dr = min(max(krow - qrow_g + 7, 0), 14), dc = min(max(kcol - qcol_g + 15, 0), 30);
                        v = ok ? v + rpb[dr * 31 + dc] : -1e30f; }
                    if (KIND == 2 && seg1) { const int kt = ktile0 + kg * 16 + 4 * fq + j; const int dd = kt - qtok; v = (dd <= 128 && dd >= -128) ? v : -1e30f; }
                    s[qb][kg][j] = v; mx = fmaxf(mx, v);
                }
            mx = qmax4(mx);
            const float mn = fmaxf(m[qb], mx), alpha = __builtin_amdgcn_exp2f(m[qb] - mn); m[qb] = mn;
            float ps = 0.f;
#pragma unroll
            for (int kg = 0; kg < 4; ++kg)
#pragma unroll
                for (int j = 0; j < 4; ++j) { const float e = __builtin_amdgcn_exp2f(s[qb][kg][j] - mn); s[qb][kg][j] = e; ps += e; }
            l[qb] = l[qb] * alpha + ps;
#pragma unroll
            for (int d = 0; d < 4; ++d) Oa[qb][d] = Oa[qb][d] * alpha;
#pragma unroll
            for (int k2 = 0; k2 < 2; ++k2) {
                u32x4 pw; pw.x = pk2(s[qb][2 * k2][0], s[qb][2 * k2][1]); pw.y = pk2(s[qb][2 * k2][2], s[qb][2 * k2][3]); pw.z = pk2(s[qb][2 * k2 + 1][0], s[qb][2 * k2 + 1][1]); pw.w = pk2(s[qb][2 * k2 + 1][2], s[qb][2 * k2 + 1][3]);
                Pf[qb][k2] = __builtin_bit_cast(bf16x8, pw); }
        }
#pragma unroll
        for (int k2 = 0; k2 < 2; ++k2)
#pragma unroll
            for (int d = 0; d < 4; ++d) {
                const LAS unsigned char* a0 = vb + (32 * k2 + 4 * fq + (fr >> 2)) * VROW + (d * 16 + 4 * (fr & 3)) * 2;
                const s16x4 lo = vtr(a0), hi = vtr(a0 + 16 * VROW);
                const bf16x8 Vf = (bf16x8){lo[0], lo[1], lo[2], lo[3], hi[0], hi[1], hi[2], hi[3]};
#pragma unroll
                for (int qb = 0; qb < QB; ++qb) Oa[qb][d] = __builtin_amdgcn_mfma_f32_16x16x32_bf16(Vf, Pf[qb][k2], Oa[qb][d], 0, 0, 0);
            }
    }
    __syncthreads();
#pragma unroll
    for (int qb = 0; qb < QB; ++qb) {
        float lq = l[qb]; lq += __shfl_xor(lq, 16); lq += __shfl_xor(lq, 32);
        const float inv = 1.0f / lq;
        LAS unsigned char* st = C.lds + (qb * 8 + C.wid) * 2048;
#pragma unroll
        for (int d = 0; d < 4; ++d) { const f32x4 v = Oa[qb][d] * inv; *(LAS u32x2*)(st + fr * 128 + (d * 16 + 4 * fq) * 2) = (u32x2){pk2(v.x, v.y), pk2(v.z, v.w)}; }
        asm volatile("s_waitcnt lgkmcnt(0)" ::: "memory");
#pragma unroll
        for (int i = 0; i < 2; ++i) { const int row = i * 8 + (C.lane >> 3), ch = C.lane & 7; const u32x4 v = *(const LAS u32x4*)(st + row * 128 + ch * 16);
            *(u32x4*)(D.O + (size_t)(qb * 128 + C.wid * 16 + row) * D.ldo + ch * 8) = v; }
    }
    __syncthreads();
}

__device__ __forceinline__ void pool_unit(const Params& p, Ctx& C, int L, int unit) {
    const bf16_t* P = (const bf16_t*)(p.ws + WS_P); bf16_t* BR = (bf16_t*)(p.ws + WS_BR);
    CTX_FRESH(C);
    constexpr int WROW = 160, DROW = 544;
    const int T0 = unit * 64; int S0, Ls; if (T0 < NCTX) { S0 = T0 & ~255; Ls = 256; } else { S0 = NCTX + ((T0 - NCTX) & ~2047); Ls = 2048; }
    LAS bf16_t* raw = (LAS bf16_t*)C.lds;
    LAS unsigned char* wl = C.lds + 40960;
    LAS unsigned char* dl = C.lds + 81920;
    f32x4 wreg[8];
    { const f32x4* Wg = (const f32x4*)(p.in[25] + (size_t)L * 4 * 64 * 64);
#pragma unroll
        for (int i = 0; i < 8; ++i) wreg[i] = Wg[C.tid + i * 512]; }
    for (int i = C.tid; i < 80 * 32; i += 512) { const int r = i >> 5, c = i & 31; const int T = T0 - 8 + r;
        u32x4 v = (u32x4){0u, 0u, 0u, 0u}; if (T >= S0 && T < S0 + Ls) v = *(const u32x4*)(P + (size_t)T * LDP + COL_PD + c * 8);
        *(LAS u32x4*)(raw + r * 256 + c * 8) = v; }
#pragma unroll
    for (int i = 0; i < 8; ++i) { const int e4 = (C.tid + i * 512) * 4, gi = e4 >> 12, c = (e4 >> 6) & 63, e = e4 & 63;
        *(LAS u32x2*)(wl + (gi * 64 + c) * WROW + e * 2) = (u32x2){pk2(wreg[i].x, wreg[i].y), pk2(wreg[i].z, wreg[i].w)}; }
    __syncthreads();
    { const int ch = C.tid & 255, t0 = (C.tid >> 8) * 32, gi = __builtin_amdgcn_readfirstlane(ch >> 6), hw = 1 << gi;
        const LAS bf16_t* col = raw + ch;
        float sum = 0.f;
        for (int r = t0 + 8 - hw; r < t0 + 8 + hw; ++r) sum += bf2f(col[r * 256]);
        const int tl0 = T0 - S0 + t0;
#pragma unroll 4
        for (int i = 0; i < 32; ++i) { const int t = t0 + i, tl = tl0 + i; const int lo = max(tl - hw, 0), hi = min(tl + hw, Ls);
            const float d = sum * __builtin_amdgcn_rcpf((float)(hi - lo)) - bf2f(col[(t + 8) * 256]);
            *(LAS bf16_t*)(dl + t * DROW + ch * 2) = (bf16_t)(pk2(d, 0.f) & 0xffffu);
            sum += bf2f(col[(t + 8 + hw) * 256]) - bf2f(col[(t + 8 - hw) * 256]); }
    }
    __syncthreads();
    { const int gi = C.wid & 3, mh = C.wid >> 2, fr = C.fr, fq = C.fq;
        f32x4 acc[2][4];
#pragma unroll
        for (int mb = 0; mb < 2; ++mb)
#pragma unroll
            for (int d = 0; d < 4; ++d) acc[mb][d] = (f32x4){0.f, 0.f, 0.f, 0.f};
#pragma unroll
        for (int ks = 0; ks < 2; ++ks) {
            bf16x8 Af[2];
#pragma unroll
            for (int mb = 0; mb < 2; ++mb) { const LAS unsigned char* ap = dl + (mh * 32 + mb * 16 + fr) * DROW + (gi * 64 + ks * 32 + 4 * fq) * 2;
                const s16x4 lo = *(const LAS s16x4*)ap, hi = *(const LAS s16x4*)(ap + 32); Af[mb] = (bf16x8){lo[0], lo[1], lo[2], lo[3], hi[0], hi[1], hi[2], hi[3]}; }
#pragma unroll
            for (int d = 0; d < 4; ++d) { const LAS unsigned char* a0 = wl + (gi * 64 + 32 * ks + 4 * fq + (fr >> 2)) * WROW + (d * 16 + 4 * (fr & 3)) * 2;
                const s16x4 lo = vtr(a0), hi = vtr(a0 + 16 * WROW);
                const bf16x8 Wf = (bf16x8){lo[0], lo[1], lo[2], lo[3], hi[0], hi[1], hi[2], hi[3]};
#pragma unroll
                for (int mb = 0; mb < 2; ++mb) acc[mb][d] = __builtin_amdgcn_mfma_f32_16x16x32_bf16(Wf, Af[mb], acc[mb][d], 0, 0, 0); }
        }
        const float* sc = p.in[26] + L * 256 + gi * 64 + 4 * fq;
#pragma unroll
        for (int d = 0; d < 4; ++d) { const f32x4 s4 = *(const f32x4*)(sc + d * 16);
#pragma unroll
            for (int mb = 0; mb < 2; ++mb) { const f32x4 v = acc[mb][d] * s4;
                *(u32x2*)(BR + (size_t)(T0 + mh * 32 + mb * 16 + fr) * LDH + 768 + gi * 64 + d * 16 + 4 * fq) = (u32x2){pk2(v.x, v.y), pk2(v.z, v.w)}; } }
    }
    __syncthreads();
}

__device__ __forceinline__ void phase4(const Params& p, Ctx& C, int L, int rep = 0) {
    const bf16_t* P = (const bf16_t*)(p.ws + WS_P); bf16_t* BR = (bf16_t*)(p.ws + WS_BR);
    const bf16_t* QUP = (const bf16_t*)(p.ws + WS_QUP); const bf16_t* KVUP = (const bf16_t*)(p.ws + WS_KVUP);
    const bf16_t* KVC = (const bf16_t*)(p.ws + WS_KVCUP) + (size_t)L * 512 * LDKV;
    const bf16_t* NAK = (const bf16_t*)(p.ws + WS_NACK) + (size_t)L * 512 * LDNAC; const bf16_t* NAV = (const bf16_t*)(p.ws + WS_NACV) + (size_t)L * 512 * LDNAC;
    const bf16_t* SWK = (const bf16_t*)(p.ws + WS_SWCK) + (size_t)L * 512 * LDSWC; const bf16_t* SWV = (const bf16_t*)(p.ws + WS_SWCV) + (size_t)L * 512 * LDSWC;
    const bf16_t* KRC = (const bf16_t*)(p.ws + WS_KRC) + (size_t)L * 512 * 32;
    unsigned* qhead = (unsigned*)(p.ws + WS_CTL) + CW_QUEUE + 64 * (L * 2 + rep);
    volatile LAS unsigned* bc = (volatile LAS unsigned*)(C.lds + LDS_CTL + 16);
    LAS float* rpb = (LAS float*)(C.lds + LDS_TAB);
    const float ATT_C1 = 0.125f * LOG2E, MLA_C1 = 0.10206207261596575f * LOG2E;
    for (;;) {
        if (C.tid == 0) bc[0] = atomicAdd(qhead, 1u);
        __syncthreads();
        const int u = __builtin_amdgcn_readfirstlane((int)bc[0]);
        __syncthreads();
        if (u >= 960) break;
        AttnDesc D; D.rope_q = 0; D.m0 = -1e30f; D.l0 = 0.f; D.seg[1].K2 = nullptr; D.seg[0].K2 = nullptr; D.seg[0].ldk2 = 0; D.seg[1].ldk2 = 0; D.seg[0].tok0 = 0; D.seg[1].tok0 = 0;
        if (u < 128) {
            const int b = u >> 6, h = (u >> 4) & 3, qb = u & 15; const int T0 = NCTX + b * 2048;
            D.Q = QUP + (size_t)(T0 + qb * 128) * LDQ + h * 96; D.ldq = LDQ; D.O = BR + (size_t)(T0 + qb * 128) * LDH + 256 + h * 64; D.ldo = LDH;
            D.seg[0] = AttnSeg{KVC + (size_t)b * 256 * LDKV + h * 128, KRC + (size_t)b * 256 * 32, KVC + (size_t)b * 256 * LDKV + h * 128 + 64, LDKV, 32, LDKV, 256, 0};
            D.seg[1] = AttnSeg{KVUP + (size_t)T0 * LDKV + h * 128, P + (size_t)T0 * LDP + COL_KR, KVUP + (size_t)T0 * LDKV + h * 128 + 64, LDKV, LDP, LDKV, 2048, 0};
            D.c1 = MLA_C1; D.qtok0 = qb * 128; D.rope_q = 1;
#ifndef NO_A1
            attn_unit<96, 0, 1>(C, D, rpb);
#endif
        } else if (u < 256) {
            const int v = u - 128, b = v >> 6, h = (v >> 4) & 3, rp = v & 15; const int T0 = NCTX + b * 2048;
            const int ra = 2 * rp, r0a = min(max(ra - 4, 0), 24), r0b = min(max(ra + 1 - 4, 0), 24);
            for (int i = C.tid; i < 15 * 31; i += 512) rpb[i] = p.in[19][(size_t)(L * 4 + h) * 465 + i] * LOG2E;
            D.Q = P + (size_t)(T0 + ra * 64) * LDP + COL_QA + h * 64; D.ldq = LDP; D.O = BR + (size_t)(T0 + ra * 64) * LDH + 0 + h * 64; D.ldo = LDH;
            D.seg[0] = AttnSeg{NAK + (size_t)b * 256 * LDNAC + h * 64, nullptr, NAV + (size_t)b * 256 * LDNAC + h * 64, LDNAC, 0, LDNAC, 256, 0};
            D.seg[1] = AttnSeg{P + (size_t)(T0 + r0a * 64) * LDP + COL_KA + h * 64, nullptr, P + (size_t)(T0 + r0a * 64) * LDP + COL_VA + h * 64, LDP, 0, LDP, (r0b + 8 - r0a) * 64, r0a * 64};
            D.c1 = ATT_C1; D.qtok0 = ra * 64;
            __syncthreads();
#ifndef NO_A2
            attn_unit<64, 1, 1>(C, D, rpb);
#endif
        } else if (u < 384) {
            const int v = u - 256, b = v >> 6, h = (v >> 4) & 3, qb = v & 15; const int T0 = NCTX + b * 2048, kvh = h >> 1;
            const int klo = max(qb * 128 - 128, 0), khi = min(qb * 128 + 256, 2048);
            D.Q = P + (size_t)(T0 + qb * 128) * LDP + COL_QC + h * 64; D.ldq = LDP; D.O = BR + (size_t)(T0 + qb * 128) * LDH + 512 + h * 64; D.ldo = LDH;
            D.seg[0] = AttnSeg{SWK + (size_t)b * 256 * LDSWC + kvh * 64, nullptr, SWV + (size_t)b * 256 * LDSWC + kvh * 64, LDSWC, 0, LDSWC, 256, 0};
            D.seg[1] = AttnSeg{P + (size_t)(T0 + klo) * LDP + COL_KC + kvh * 64, nullptr, P + (size_t)(T0 + klo) * LDP + COL_VC + kvh * 64, LDP, 0, LDP, khi - klo, klo};
            D.c1 = ATT_C1; D.qtok0 = qb * 128; D.m0 = p.in[24][L * 4 + h] * LOG2E; D.l0 = 1.0f;
#ifndef NO_A3
            attn_unit<64, 2, 1>(C, D, rpb);
#endif
        } else if (u >= 576) {
            const int v = u - 576, kh = v % 12, b = v / 12, kind = kh >> 2, h = kh & 3; const int T0 = b * 256, Tq = T0;
            D.qtok0 = 0; D.seg[1].n = 0; D.seg[1].K = nullptr; D.seg[1].V = nullptr; D.seg[1].ldk = 0; D.seg[1].ldv = 0;
            if (kind == 0) {
                D.Q = P + (size_t)Tq * LDP + COL_QA + h * 64; D.ldq = LDP; D.O = BR + (size_t)Tq * LDH + h * 64; D.ldo = LDH;
                D.seg[0] = AttnSeg{P + (size_t)T0 * LDP + COL_KA + h * 64, nullptr, P + (size_t)T0 * LDP + COL_VA + h * 64, LDP, 0, LDP, 256, 0};
#ifndef NO_A4
                D.c1 = ATT_C1; attn_unit<64, 0, 2>(C, D, rpb);
#endif
            } else if (kind == 1) {
                D.Q = QUP + (size_t)Tq * LDQ + h * 96; D.ldq = LDQ; D.O = BR + (size_t)Tq * LDH + 256 + h * 64; D.ldo = LDH;
                D.seg[0] = AttnSeg{KVUP + (size_t)T0 * LDKV + h * 128, P + (size_t)T0 * LDP + COL_KR, KVUP + (size_t)T0 * LDKV + h * 128 + 64, LDKV, LDP, LDKV, 256, 0};
#ifndef NO_A5
                D.c1 = MLA_C1; attn_unit<96, 0, 2>(C, D, rpb);
#endif
            } else {
                const int kvh = h >> 1;
                D.Q = P + (size_t)Tq * LDP + COL_QC + h * 64; D.ldq = LDP; D.O = BR + (size_t)Tq * LDH + 512 + h * 64; D.ldo = LDH;
                D.seg[0] = AttnSeg{P + (size_t)T0 * LDP + COL_KC + kvh * 64, nullptr, P + (size_t)T0 * LDP + COL_VC + kvh * 64, LDP, 0, LDP, 256, 0};
#ifndef NO_A6
                D.c1 = ATT_C1; D.m0 = p.in[24][L * 4 + h] * LOG2E; D.l0 = 1.0f; attn_unit<64, 0, 2>(C, D, rpb);
#endif
            }
        } else {
#ifndef NO_POOL
            pool_unit(p, C, L, u - 384);
#endif
        }
    }
}

struct BrSched {
    const char* BR; const char* Wb; int G, c;
    __device__ __forceinline__ bool next(int i, G8Unit& u) const {
        const int Lu = i * G + c; if (Lu >= 48 * 16) return false;
        int pm, q; unit_map(Lu, 48, 16, pm, q);
        u.A = BR + (size_t)pm * 256 * LDH * 2 + (q >> 2) * 512; u.B = Wb + (size_t)q * 256 * LDWB * 2; u.e0 = pm; u.e1 = q; u.e2 = 0; u.e3 = 0; return true;
    }
};
struct EpiBK {
    static constexpr bool PERM = true, AFTER_DRAIN = false; G8_EPI_PLAIN
    bf16_t* O;
    __device__ __forceinline__ void operator()(const f32x4 (&acc)[2][2][4][2], const G8Unit& u, int wr, int wc, int fr_, int fq_) const {
        const int ln = hw_lane(), fr = ln & 15, fq = ln >> 4;
        const int k = u.e1 >> 2, pn4 = u.e1 & 3;
        char* base = (char*)O + ((size_t)((u.e0 * 16 + wr * 4) * 4 + k) * 256 + pn4 * 64 + wc * 8) * 128;
        const unsigned lo = (unsigned)(2 * fq * 16 + fr) * 8u;
#pragma unroll
        for (int ai = 0; ai < 2; ++ai)
#pragma unroll
            for (int m = 0; m < 4; ++m)
#pragma unroll
                for (int bj = 0; bj < 2; ++bj) { char* q = base + ((size_t)(ai * 8 + m) * 4 * 256 + bj * 32) * 128; asm volatile("" : "+s"(q));
                    const f32x4 v0 = acc[ai][bj][m][0], v1 = acc[ai][bj][m][1];
                    *(GAS u32x2*)(q + lo) = (u32x2){pk2(v0.x, v0.y), pk2(v0.z, v0.w)}; *(GAS u32x2*)(q + lo + 128) = (u32x2){pk2(v1.x, v1.y), pk2(v1.z, v1.w)}; }
    }
};
__device__ __forceinline__ void phase5a(const Params& p, Ctx& C, int L) {
    BrSched S{(const char*)(p.ws + WS_BR), (const char*)(p.ws + WS_W + (size_t)L * W_LAYER + WO_BR), C.G, C.bid};
    EpiBK E{(bf16_t*)(p.ws + WS_BK)};
    gemm8(C, 256, LDH, LDWB, S, E);
}
template <int VAR> struct EpiGateT {
    static constexpr bool PERM = false, AFTER_DRAIN = false, FP8 = true; static constexpr int HROWS_B = 2048;
    static __device__ __forceinline__ int brow(int R) { return ((R >> 4) & 1) * 1024 + (R >> 5) * 16 + (R & 15); }
    const bf16_t* BK; bf16_t* MG; const LAS float* bl;
    __device__ __forceinline__ f32x4 init(const G8Unit& u, int bj, int n, int wc, int fq) const { return *(const LAS f32x4*)(bl + (2 * bj + n) * 1024 + u.e1 * 64 + wc * 16 + 4 * fq); }
    __device__ __forceinline__ void operator()(const f32x4 (&acc)[2][2][4][2], const G8Unit& u, int wr, int wc, int fr_, int fq_) const {
        const int ln = hw_lane(), fr = ln & 15, fq = ln >> 4;
        const int xw = u.e1 * 64 + wc * 16;
#define SPIN_(ptr) asm volatile("" : "+s"(ptr))
        const char* bkb = (const char*)BK + ((size_t)(u.e0 * 16 + wr * 4) * 4 * 256 + u.e1 * 16 + wc * 4) * 128;
        char* mgb = (char*)MG + ((size_t)(u.e0 * 256 + wr * 64) * LDH + xw) * 2;
        const unsigned lob = (unsigned)(fq * 16 + fr) * 8u, lom = (unsigned)(fr * LDH + 4 * fq) * 2u;
        __builtin_amdgcn_sched_barrier(0);
        u32x2 b[8][4];
#pragma unroll
        for (int am = 0; am < 8; ++am) {
#pragma unroll
            for (int k = 0; k < 4; ++k) { const char* r = bkb + ((size_t)((am >> 2) * 8 + (am & 3)) * 4 + k) * 256 * 128; SPIN_(r); b[am][k] = *(const GAS u32x2*)(r + lob); } }
        __builtin_amdgcn_sched_barrier(0);
#pragma unroll
        for (int am = 0; am < 8; ++am) {
            f32x4 sum = (f32x4){0.f, 0.f, 0.f, 0.f};
#pragma unroll
            for (int k = 0; k < 4; ++k) { const f32x4 t = acc[am >> 2][k >> 1][am & 3][k & 1] * (-LOG2E_ * 0.03125f);
                const f32x4 e = (f32x4){__builtin_amdgcn_exp2f(t.x), __builtin_amdgcn_exp2f(t.y), __builtin_amdgcn_exp2f(t.z), __builtin_amdgcn_exp2f(t.w)} + 1.0f;
                const f32x4 g = (f32x4){__builtin_amdgcn_rcpf(e.x), __builtin_amdgcn_rcpf(e.y), __builtin_amdgcn_rcpf(e.z), __builtin_amdgcn_rcpf(e.w)};
                sum += g * (f32x4){lo16(b[am][k].x), hi16(b[am][k].x), lo16(b[am][k].y), hi16(b[am][k].y)}; }
            char* mp = mgb + (size_t)((am >> 2) * 128 + (am & 3) * 16) * LDH * 2; SPIN_(mp);
            *(GAS u32x2*)(mp + lom) = (u32x2){pk2(sum.x, sum.y), pk2(sum.z, sum.w)};
            __builtin_amdgcn_sched_barrier(0);
        }
#undef SPIN_
    }
};
template <int VAR> __device__ __forceinline__ void phase5b(const Params& p, Ctx& C, int L) {
    TileSched S{(const char*)(p.ws + WS_H8), (const char*)(p.ws + WS_W + (size_t)L * W_LAYER + WO_GATE), (size_t)256 * LD8, (size_t)64 * LD8, 48, 16, C.G, C.bid};
    LAS float* bl = (LAS float*)(C.lds + 131072);
    { const float* bg = p.in[18] + (size_t)L * 4096; for (int i = C.tid; i < 1024; i += 512) ((LAS f32x4*)bl)[i] = ((const f32x4*)bg)[i] * 32.0f; }
    __syncthreads();
    EpiGateT<VAR> E{(const bf16_t*)(p.ws + WS_BK), (bf16_t*)(p.ws + (VAR ? WS_BR : WS_MERGED)), bl};
    gemm8(C, 512, LD8 / 2, LD8 / 2, S, E);
}

__device__ __forceinline__ void gemm_bf16_phase(Ctx& C, const bf16_t* A, int lda, const bf16_t* Bt, int ldb, int K, bf16_t* O, int ldo, int nM, int nN) {
    TileSched S{(const char*)A, (const char*)Bt, (size_t)256 * lda * 2, (size_t)256 * ldb * 2, nM, nN, C.G, C.bid};
    EpiBf16 E{O, ldo};
    gemm8(C, K, lda, ldb, S, E);
}


struct RowSumSq {
    float* xbuf;
    unsigned* cnt;
    __device__ __forceinline__ void run(const Ctx& C, const f32x4 (&v)[2][2][4][2], int pm, int pn, int wr, int wc, int fr, int fq, float (&rs)[2][4]) const {
        LAS float* P = (LAS float*)C.lds;
        LAS float* S = (LAS float*)(C.lds + 4096);
#pragma unroll
        for (int ai = 0; ai < 2; ++ai)
#pragma unroll
            for (int m = 0; m < 4; ++m) { float s = 0.f;
#pragma unroll
                for (int bj = 0; bj < 2; ++bj)
#pragma unroll
                    for (int n = 0; n < 2; ++n) { const f32x4 x = v[ai][bj][m][n]; s += (x[0] * x[0] + x[1] * x[1]) + (x[2] * x[2] + x[3] * x[3]); }
                s += __shfl_xor(s, 16); s += __shfl_xor(s, 32);
                if (fq == 0) P[(ai * 128 + wr * 64 + m * 16 + fr) * 4 + wc] = s; }
        asm volatile("s_waitcnt lgkmcnt(0)" ::: "memory"); __builtin_amdgcn_s_barrier(); asm volatile("" ::: "memory");
        const int row = C.wid * 32 + (C.lane & 31);
        if (C.lane < 32) { const float t = (P[row * 4 + 0] + P[row * 4 + 1]) + (P[row * 4 + 2] + P[row * 4 + 3]);
            __hip_atomic_store(xbuf + ((size_t)(pm * 256 + row) * 4 + pn), t, __ATOMIC_RELAXED, __HIP_MEMORY_SCOPE_AGENT); }
        asm volatile("s_waitcnt vmcnt(0)" ::: "memory");
        if (C.lane == 0) __hip_atomic_fetch_add(cnt + 64 * pm, 1u, __ATOMIC_RELAXED, __HIP_MEMORY_SCOPE_AGENT);
        if (C.wid == 0) {
            unsigned spins = 0;
            while ((unsigned)__builtin_amdgcn_readfirstlane(__hip_atomic_load(cnt + 64 * pm, __ATOMIC_RELAXED, __HIP_MEMORY_SCOPE_AGENT)) < 32u) { __builtin_amdgcn_s_sleep(2); if (++spins > (1u << 22)) break; }
            __builtin_amdgcn_fence(__ATOMIC_ACQUIRE, "agent");
        }
        asm volatile("s_waitcnt vmcnt(0) lgkmcnt(0)" ::: "memory"); __builtin_amdgcn_s_barrier(); asm volatile("" ::: "memory");
        if (C.lane < 32) { const float* slot = xbuf + (size_t)(pm * 256 + row) * 4; float t = 0.f;
#pragma unroll
            for (int q = 0; q < 4; ++q) t += __hip_atomic_load(slot + q, __ATOMIC_RELAXED, __HIP_MEMORY_SCOPE_AGENT);
            S[row] = t; }
        asm volatile("s_waitcnt vmcnt(0) lgkmcnt(0)" ::: "memory"); __builtin_amdgcn_s_barrier(); asm volatile("" ::: "memory");
#pragma unroll
        for (int ai = 0; ai < 2; ++ai)
#pragma unroll
            for (int m = 0; m < 4; ++m) rs[ai][m] = S[ai * 128 + wr * 64 + m * 16 + fr];
        asm volatile("s_waitcnt lgkmcnt(0)" ::: "memory"); __builtin_amdgcn_s_barrier(); asm volatile("" ::: "memory");
    }
};
template <int MODE> struct EpiNormFused {
    static constexpr bool PERM = true, AFTER_DRAIN = true; G8_EPI_PLAIN
    const Params& p; int L;
    __device__ __forceinline__ void drained(const Ctx& C, f32x4 (&acc)[2][2][4][2], const G8Unit& u, int wr, int wc, int fr, int fq) const {
        const int pm = u.e0, pn = u.e1, cls = pm < 32 ? 0 : 1 + ((pm - 32) >> 3);
        unsigned* ctl = (unsigned*)(p.ws + WS_CTL);
        const float* modv = (const float*)(p.ws + WS_MODV);
        const float* mv = modv + (size_t)(L * 3 + cls) * 6144;
        float* Y = p.out + OFF_Y; bf16_t* H = (bf16_t*)(p.ws + WS_H);
        const float* gpost = (MODE == 0 ? p.in[13] : p.in[15]) + L * DM;
        const float* gate = mv + (MODE == 0 ? 2048 : 5120);
        const float* xpan = (MODE == 0 && L == 0) ? (pm < 32 ? p.in[0] + (size_t)pm * 256 * DM : p.in[1] + (size_t)(pm - 32) * 256 * DM) : Y + (size_t)pm * 256 * DM;
        float* ypan = Y + (size_t)pm * 256 * DM;
        const bool src_ao = !(MODE == 0 && L == 0), dst_ao = !(MODE == 1 && L == 1);
        float* xw1 = (float*)(p.ws + WS_X1);
        const float* aos = ((MODE == 1 && L == 1) ? xw1 : Y) + (size_t)(pm * 4 + pn) * 65536 + C.wid * 256 + C.lane * 4;
        float* aod = ((MODE == 0 && L == 1) ? xw1 : Y) + (size_t)(pm * 4 + pn) * 65536 + C.wid * 256 + C.lane * 4; bf16_t* hpan = H + (size_t)pm * 256 * LDH; unsigned char* h8pan = p.ws + WS_H8 + (size_t)pm * 256 * LD8;
        float rs[2][4];
        { RowSumSq X{(float*)(ctl + CW_XBUF), ctl + CW_SEAM + ((L * 2 + MODE) * 2 + 0) * 48 * 64}; X.run(C, acc, pm, pn, wr, wc, fr, fq, rs); }
#pragma unroll
        for (int ai = 0; ai < 2; ++ai)
#pragma unroll
            for (int m = 0; m < 4; ++m) rs[ai][m] = __builtin_amdgcn_rsqf(rs[ai][m] * (1.0f / DM) + EPS);
#pragma unroll
        for (int bj = 0; bj < 2; ++bj) { const int col = pn * 256 + bj * 128 + wc * 32 + 8 * fq;
            const f32x4 gp0 = *(const f32x4*)(gpost + col), gp1 = *(const f32x4*)(gpost + col + 4), g0 = *(const f32x4*)(gate + col), g1 = *(const f32x4*)(gate + col + 4);
#pragma unroll
            for (int ai = 0; ai < 2; ++ai)
#pragma unroll
                for (int m = 0; m < 4; ++m) { const int off = (ai * 128 + wr * 64 + m * 16 + fr) * DM + col;
                    const int fi = ((ai * 4 + m) * 2 + bj) * 2;
                    const f32x4 x0 = src_ao ? *(const f32x4*)(aos + fi * 2048) : *(const f32x4*)(xpan + off), x1 = src_ao ? *(const f32x4*)(aos + (fi + 1) * 2048) : *(const f32x4*)(xpan + off + 4);
                    acc[ai][bj][m][0] = x0 + g0 * (acc[ai][bj][m][0] * rs[ai][m] * gp0);
                    acc[ai][bj][m][1] = x1 + g1 * (acc[ai][bj][m][1] * rs[ai][m] * gp1);
                    asm volatile("" : "+v"(acc[ai][bj][m][0]), "+v"(acc[ai][bj][m][1]));
                    if (m & 1) asm volatile("" ::: "memory"); } }
        const bool second = (MODE == 0) || (L == 0);
        if (second) { RowSumSq X{(float*)(ctl + CW_XBUF) + 48 * 256 * 4, ctl + CW_SEAM + ((L * 2 + MODE) * 2 + 1) * 48 * 64}; X.run(C, acc, pm, pn, wr, wc, fr, fq, rs);
#pragma unroll
            for (int ai = 0; ai < 2; ++ai)
#pragma unroll
                for (int m = 0; m < 4; ++m) rs[ai][m] = __builtin_amdgcn_rsqf(rs[ai][m] * (1.0f / DM) + EPS); }
        const float* mvn = (MODE == 0) ? mv : modv + (size_t)(1 * 3 + cls) * 6144;
        const float* gpre = (MODE == 0) ? p.in[14] + L * DM : p.in[12] + DM;
        const float* scv = mvn + (MODE == 0 ? 4096 : 1024); const float* shv = mvn + (MODE == 0 ? 3072 : 0);
#pragma unroll
        for (int bj = 0; bj < 2; ++bj) { const int col = pn * 256 + bj * 128 + wc * 32 + 8 * fq;
            const f32x4 z = (f32x4){0.f, 0.f, 0.f, 0.f};
            f32x4 gg0 = z, gg1 = z, sa0 = z, sa1 = z, sb0 = z, sb1 = z;
            if (second) { gg0 = *(const f32x4*)(gpre + col); gg1 = *(const f32x4*)(gpre + col + 4); sa0 = *(const f32x4*)(scv + col) + 1.0f; sa1 = *(const f32x4*)(scv + col + 4) + 1.0f; sb0 = *(const f32x4*)(shv + col); sb1 = *(const f32x4*)(shv + col + 4); }
#pragma unroll
            for (int ai = 0; ai < 2; ++ai)
#pragma unroll
                for (int m = 0; m < 4; ++m) { const int rl = ai * 128 + wr * 64 + m * 16 + fr; const f32x4 v0 = acc[ai][bj][m][0], v1 = acc[ai][bj][m][1];
                    const int fi = ((ai * 4 + m) * 2 + bj) * 2;
                    if (dst_ao) { *(f32x4*)(aod + fi * 2048) = v0; *(f32x4*)(aod + (fi + 1) * 2048) = v1; } else { *(f32x4*)(ypan + rl * DM + col) = v0; *(f32x4*)(ypan + rl * DM + col + 4) = v1; }
                    if (second) { const f32x4 h0 = v0 * rs[ai][m] * gg0 * sa0 + sb0, h1 = v1 * rs[ai][m] * gg1 * sa1 + sb1;
                        *(u32x4*)(hpan + rl * LDH + col) = (u32x4){pk2(h0.x, h0.y), pk2(h0.z, h0.w), pk2(h1.x, h1.y), pk2(h1.z, h1.w)};
                        if (MODE == 1) { int w0 = __builtin_amdgcn_cvt_pk_fp8_f32(h0.x, h0.y, 0, false); w0 = __builtin_amdgcn_cvt_pk_fp8_f32(h0.z, h0.w, w0, true);
                            int w1 = __builtin_amdgcn_cvt_pk_fp8_f32(h1.x, h1.y, 0, false); w1 = __builtin_amdgcn_cvt_pk_fp8_f32(h1.z, h1.w, w1, true);
                            *(u32x2*)(h8pan + rl * LD8 + col) = (u32x2){(unsigned)w0, (unsigned)w1}; } }
                    asm volatile("" ::: "memory"); } }
    }
};
template <int MODE> __device__ __forceinline__ void gemm_norm_phase(const Params& p, Ctx& C, int L, const bf16_t* A, int lda, const bf16_t* Bt, int ldb, int K) {
    TileSched S{(const char*)A, (const char*)Bt, (size_t)256 * lda * 2, (size_t)256 * ldb * 2, 48, 4, C.G, C.bid};
    EpiNormFused<MODE> E{p, L};
    gemm8(C, K, lda, ldb, S, E);
}

struct OneUnit { G8Unit u; __device__ __forceinline__ bool next(int i, G8Unit& o) const { if (i > 0) return false; o = u; return true; } };
struct EpiUpConv {
    static constexpr bool PERM = false, AFTER_DRAIN = true; G8_EPI_PLAIN
    bf16_t* ACT; const float* cw;
    __device__ __forceinline__ void drained(const Ctx& C, const f32x4 (&acc)[2][2][4][2], const G8Unit& u, int wr, int wc, int fr, int fq) const {
        constexpr int UROW = 528;
        const int Trow0 = u.e0, pn = u.e1, tpos0 = u.e2, Ls = u.e3;
#pragma unroll
        for (int ai = 0; ai < 2; ++ai)
#pragma unroll
            for (int m = 0; m < 4; ++m) { const int r = ai * 128 + wr * 64 + m * 16 + fr;
#pragma unroll
                for (int bj = 0; bj < 2; ++bj)
#pragma unroll
                    for (int n = 0; n < 2; ++n) { const int c = bj * 128 + wc * 32 + n * 16 + 4 * fq; const f32x4 v = acc[ai][bj][m][n]; *(LAS u32x2*)(C.lds + r * UROW + c * 2) = (u32x2){pk2(v.x, v.y), pk2(v.z, v.w)}; } }
        __syncthreads();
        {
            const int cc = C.tid & 15, rg = C.tid >> 4;
            const int f0 = pn * 128 + cc * 8;
            float wa[3][8], wg[3][8];
#pragma unroll
            for (int j = 0; j < 3; ++j)
#pragma unroll
                for (int e = 0; e < 8; ++e) { const bool ok = (f0 + e) < DFF; wa[j][e] = ok ? cw[j * 5504 + f0 + e] : 0.f; wg[j][e] = ok ? cw[j * 5504 + DFF + f0 + e] : 0.f; }
            for (int ps = 0; ps < 8; ++ps) {
                const int r = ps * 32 + rg, tpos = tpos0 + r;
                const bool valid = (r > 0 || tpos == 0) && (r < 255 || tpos == Ls - 1);
                if (!valid) continue;
                const bool hasl = tpos > 0, hasr = tpos < Ls - 1;
                const LAS unsigned char* base = C.lds + r * UROW + cc * 16;
                const u32x4 z = (u32x4){0u, 0u, 0u, 0u};
                const u32x4 a0 = hasl ? *(const LAS u32x4*)(base - UROW) : z, a1 = *(const LAS u32x4*)base, a2 = hasr ? *(const LAS u32x4*)(base + UROW) : z;
                const u32x4 g0 = hasl ? *(const LAS u32x4*)(base - UROW + 256) : z, g1 = *(const LAS u32x4*)(base + 256), g2 = hasr ? *(const LAS u32x4*)(base + UROW + 256) : z;
                float o[8];
#pragma unroll
                for (int e = 0; e < 8; ++e) {
                    const unsigned ua0 = a0[e >> 1], ua1 = a1[e >> 1], ua2 = a2[e >> 1], ug0 = g0[e >> 1], ug1 = g1[e >> 1], ug2 = g2[e >> 1];
                    const float xa0 = (e & 1) ? hi16(ua0) : lo16(ua0), xa1 = (e & 1) ? hi16(ua1) : lo16(ua1), xa2 = (e & 1) ? hi16(ua2) : lo16(ua2);
                    const float xg0 = (e & 1) ? hi16(ug0) : lo16(ug0), xg1 = (e & 1) ? hi16(ug1) : lo16(ug1), xg2 = (e & 1) ? hi16(ug2) : lo16(ug2);
                    const float av = xa0 * wa[0][e] + xa1 * wa[1][e] + xa2 * wa[2][e];
                    const float gv = xg0 * wg[0][e] + xg1 * wg[1][e] + xg2 * wg[2][e];
                    o[e] = siluf_(gv) * av;
                }
                *(u32x4*)(ACT + (size_t)(Trow0 + r) * LDACT + f0) = (u32x4){pk2(o[0], o[1]), pk2(o[2], o[3]), pk2(o[4], o[5]), pk2(o[6], o[7])};
            }
        }
        __syncthreads();
    }
};
__device__ __forceinline__ float dpp_ror1(float x) { return __int_as_float(__builtin_amdgcn_update_dpp(0, __float_as_int(x), 0x121, 0xf, 0xf, false)); }
__device__ __forceinline__ float dpp_ror15(float x) { return __int_as_float(__builtin_amdgcn_update_dpp(0, __float_as_int(x), 0x12F, 0xf, 0xf, false)); }
struct EpiUpConvReg {
    static constexpr bool PERM = true, AFTER_DRAIN = false; G8_EPI_PLAIN
    bf16_t* ACT; const float* cw; LAS unsigned* halo;
    __device__ __forceinline__ void operator()(const f32x4 (&acc)[2][2][4][2], const G8Unit& u, int wr, int wc, int fr_, int fq_) const {
        int fr = fr_, fq = fq_; asm volatile("" : "+v"(fr), "+v"(fq));
        const int Trow0 = u.e0, pn = u.e1, tpos0 = u.e2, Ls = u.e3;
        const int cl = wc * 32 + 8 * fq;
        unsigned xp[2][4][2][4];
#pragma unroll
        for (int ai = 0; ai < 2; ++ai)
#pragma unroll
            for (int m = 0; m < 4; ++m)
#pragma unroll
                for (int n = 0; n < 2; ++n)
#pragma unroll
                    for (int j = 0; j < 4; ++j) { xp[ai][m][n][j] = pk2(acc[ai][0][m][n][j], acc[ai][1][m][n][j]); asm volatile("" : "+v"(xp[ai][m][n][j])); }
#pragma unroll
        for (int ai = 0; ai < 2; ++ai) { const int b = ai * 2 + wr;
#pragma unroll
            for (int n = 0; n < 2; ++n) {
                if (fr == 0) *(LAS u32x4*)(halo + (b * 2 + 0) * 128 + cl + 4 * n) = (u32x4){xp[ai][0][n][0], xp[ai][0][n][1], xp[ai][0][n][2], xp[ai][0][n][3]};
                if (fr == 15) *(LAS u32x4*)(halo + (b * 2 + 1) * 128 + cl + 4 * n) = (u32x4){xp[ai][3][n][0], xp[ai][3][n][1], xp[ai][3][n][2], xp[ai][3][n][3]};
            } }
        LAS float* cwl = (LAS float*)(halo + 1024);
        const int tx = (wr * 4 + wc) * 64 + fq * 16 + fr;
        if (tx < 192) { const int jp = tx >> 5, ch = tx & 31, f = pn * 128 + ch * 4;
            const f32x4 v = (f < DFF) ? *(const f32x4*)(cw + (jp >> 1) * 5504 + (jp & 1) * DFF + f) : (f32x4){0.f, 0.f, 0.f, 0.f};
            *(LAS f32x4*)(cwl + jp * 128 + ch * 4) = v; }
        asm volatile("s_waitcnt vmcnt(0) lgkmcnt(0)\n\ts_barrier" ::: "memory");
        asm volatile("s_barrier" ::: "memory");
        const int f0 = pn * 128 + cl;
        const int src_up = ((fq << 4) | ((fr + 15) & 15)) << 2, src_dn = ((fq << 4) | ((fr + 1) & 15)) << 2;
        const bool seq_first = (tpos0 == 0), seq_last = (tpos0 + 256 == Ls);
        u32x2 pk0[2][4];
#pragma unroll
        for (int n = 0; n < 2; ++n) {
            f32x2 w0[4], w1[4], w2[4];
            { const f32x4 a0 = *(const LAS f32x4*)(cwl + 0 * 128 + cl + 4 * n), g0 = *(const LAS f32x4*)(cwl + 1 * 128 + cl + 4 * n);
                const f32x4 a1 = *(const LAS f32x4*)(cwl + 2 * 128 + cl + 4 * n), g1 = *(const LAS f32x4*)(cwl + 3 * 128 + cl + 4 * n);
                const f32x4 a2 = *(const LAS f32x4*)(cwl + 4 * 128 + cl + 4 * n), g2 = *(const LAS f32x4*)(cwl + 5 * 128 + cl + 4 * n);
#pragma unroll
                for (int j = 0; j < 4; ++j) { w0[j] = (f32x2){a0[j], g0[j]}; w1[j] = (f32x2){a1[j], g1[j]}; w2[j] = (f32x2){a2[j], g2[j]}; } }
#pragma unroll
            for (int ai = 0; ai < 2; ++ai) { const int b = ai * 2 + wr;
                u32x4 hup = (u32x4){0u, 0u, 0u, 0u}, hdn = hup;
                if (b > 0) hup = *(const LAS u32x4*)(halo + ((b - 1) * 2 + 1) * 128 + cl + 4 * n);
                if (b < 3) hdn = *(const LAS u32x4*)(halo + ((b + 1) * 2 + 0) * 128 + cl + 4 * n);
#pragma unroll
                for (int m = 0; m < 4; ++m) {
                    const int r = ai * 128 + wr * 64 + m * 16 + fr;
                    float o[4];
#pragma unroll
                    for (int j = 0; j < 4; ++j) {
                        const unsigned xc = xp[ai][m][n][j];
                        const unsigned pv = (m > 0) ? xp[ai][m > 0 ? m - 1 : 0][n][j] : hup[j], nv = (m < 3) ? xp[ai][m < 3 ? m + 1 : 3][n][j] : hdn[j];
                        unsigned upk = (unsigned)__builtin_amdgcn_update_dpp(0, (int)(fr == 15 ? pv : xc), 0x121, 0xf, 0xf, false);
                        unsigned dnk = (unsigned)__builtin_amdgcn_update_dpp(0, (int)(fr == 0 ? nv : xc), 0x12F, 0xf, 0xf, false);
                        if (ai == 0 && m == 0) { if (seq_first && r == 0) upk = 0u; }
                        if (ai == 1 && m == 3) { if (seq_last && r == 255) dnk = 0u; }
                        const f32x2 c2 = (f32x2){lo16(upk), hi16(upk)} * w0[j] + (f32x2){lo16(xc), hi16(xc)} * w1[j] + (f32x2){lo16(dnk), hi16(dnk)} * w2[j];
                        o[j] = siluf_(c2.y) * c2.x;
                    }
                    const u32x2 pkn = (u32x2){pk2(o[0], o[1]), pk2(o[2], o[3])};
                    if (n == 0) pk0[ai][m] = pkn;
                    else {
                        bool valid = true;
                        if (ai == 0 && m == 0) valid = (r > 0) || seq_first;
                        if (ai == 1 && m == 3) valid = (r < 255) || seq_last;
                        if (valid) *(u32x4*)(ACT + (size_t)(Trow0 + r) * LDACT + f0) = (u32x4){pk0[ai][m].x, pk0[ai][m].y, pkn.x, pkn.y};
                    }
                }
            }
        }
    }
};
struct UpSched {
    const char* H; const char* Wu; int G, c;
    __device__ __forceinline__ bool next(int i, G8Unit& u) const {
        const int Lu = i * G + c; if (Lu >= 50 * 22) return false;
        int mt, pn; unit_map(Lu, 50, 22, mt, pn);
        int Trow0, tpos0, Ls;
        if (mt < 32) { Trow0 = mt * 256; tpos0 = 0; Ls = 256; }
        else { const int v = mt - 32, b = v / 9, j = v % 9; tpos0 = (j < 8) ? 254 * j : 1792; Trow0 = NCTX + b * 2048 + tpos0; Ls = 2048; }
        u.A = H + (size_t)Trow0 * LDH * 2; u.B = Wu + (size_t)pn * 256 * LDW * 2; u.e0 = Trow0; u.e1 = pn; u.e2 = tpos0; u.e3 = Ls; return true;
    }
};
__device__ __forceinline__ void phase8(const Params& p, Ctx& C, int L) {
    UpSched S{(const char*)(p.ws + WS_H), (const char*)(p.ws + WS_W + (size_t)L * W_LAYER + WO_UP), C.G, C.bid};
    EpiUpConvReg E{(bf16_t*)(p.ws + WS_ACT), p.in[30] + (size_t)L * 3 * 5504, (LAS unsigned*)(C.lds + 131072)};
    gemm8(C, DM, LDH, LDW, S, E);
}

__global__ void __launch_bounds__(512, 2) mega_fwd(Params p) {
    extern __shared__ __attribute__((aligned(16))) unsigned char lds_raw[];
    Ctx C; C.lds = (LAS unsigned char*)lds_raw;
    C.ws = __builtin_amdgcn_readfirstlane((int)(threadIdx.x >> 6)); C.G = gridDim.x; C.bid = blockIdx.x;
#define FRESH() CTX_FRESH(C)
    FRESH();
    if (C.tid < 16) ((LAS unsigned*)(C.lds + LDS_CTL))[C.tid] = 0u;
    __syncthreads();
    XcdBarrier bar = xcd_barrier_post((unsigned*)(p.ws + WS_CTL) + CW_BAR, (volatile LAS unsigned*)(C.lds + LDS_CTL));
#define GRID_BAR() do { xcd_barrier(bar, C.tid); FRESH(); } while (0)
#ifndef PH
#define PH 0xffff
#endif
#ifndef DUP
#define DUP 0
#endif
    if (PH & 1) phase0(p, C); GRID_BAR();
    if (DUP & 1) { phase0(p, C); GRID_BAR(); }
    if (PH & 2) phase1(p, C); GRID_BAR();
    if (DUP & 2) { phase1(p, C); GRID_BAR(); }
#pragma unroll 1
    for (int L = 0; L < 2; ++L) {
        if (PH & 4) phase2(p, C, L); GRID_BAR();
        if (DUP & 4) { phase2(p, C, L); GRID_BAR(); }
        if (PH & 8) phase3(p, C, L); GRID_BAR();
        if (PH & 16) phase4(p, C, L); GRID_BAR();
        if (DUP & 16) { phase4(p, C, L, 1); GRID_BAR(); }
        if (PH & 32) phase5a(p, C, L); GRID_BAR();
        if (DUP & 32) { phase5a(p, C, L); GRID_BAR(); }
        if (PH & 64) phase5b<0>(p, C, L); GRID_BAR();
#ifdef PVAR
        if (DUP & 64) { phase5b<PVAR>(p, C, L); GRID_BAR(); }
#endif
        gemm_norm_phase<0>(p, C, L, (const bf16_t*)(p.ws + WS_MERGED), LDH, (const bf16_t*)(p.ws + WS_W + (size_t)L * W_LAYER + WO_OUT), LDW, DM); GRID_BAR();
        if (PH & 256) phase8(p, C, L); GRID_BAR();
        if (DUP & 256) { phase8(p, C, L); GRID_BAR(); }
        gemm_norm_phase<1>(p, C, L, (const bf16_t*)(p.ws + WS_ACT), LDACT, (const bf16_t*)(p.ws + WS_W + (size_t)L * W_LAYER + WO_DOWN), LDWD, DFFP);
        if (L == 0) GRID_BAR();
    }
}

extern "C" void kernel_launch(void* const* d_in, const int* in_sizes, int n_in, void* d_out, int out_size, void* d_ws, size_t ws_size, hipStream_t stream) {
    static int grid = 0;
    if (grid == 0) {
        if (n_in != 32 || ws_size < WS_END) { fprintf(stderr, "kernel_launch: unexpected n_in %d / ws %zu\n", n_in, ws_size); grid = -1; return; }
        int dev = 0, cus = 0;
        if (hipGetDevice(&dev) != hipSuccess || hipDeviceGetAttribute(&cus, hipDeviceAttributeMultiprocessorCount, dev) != hipSuccess) { grid = -1; return; }
        if (hipFuncSetAttribute((const void*)mega_fwd, hipFuncAttributeMaxDynamicSharedMemorySize, LDS_BYTES) != hipSuccess) { fprintf(stderr, "kernel_launch: hipFuncSetAttribute failed\n"); grid = -1; return; }
        grid = cus;
    }
    if (grid < 0) return;
    (void)hipMemsetAsync((char*)d_ws + WS_CTL, 0, (size_t)(CW_SEAM + 384 * 64) * 4, stream);
    Params a{};
    for (int i = 0; i < 32; ++i) a.in[i] = (const float*)d_in[i];
    a.out = (float*)d_out; a.ws = (unsigned char*)d_ws;
    hipLaunchKernelGGL(mega_fwd, dim3(grid), dim3(512), LDS_BYTES, stream, a);
}
```
